# Optimizing an MI355X kernel written in HIP

```python
import math
import jax, jax.numpy as jnp
from jax import lax
import numpy as np

D_MODEL = 1024
BATCH = 8
SEQ = 2048
DEPTH = 2
DEC_BATCH = 128
DEC_SEQ = 4
PAST_LEN = 16384
PAGE_SIZE = 128

N_HEADS = 4
HEAD_DIM = 128
MIX_W = N_HEADS * HEAD_DIM
N_BRANCH = 3
CONV_W = 4
FFN_CONV_W = 3
D_FF = 2816
CHUNK = 64
EPS = 1e-6
IN_SPLITS = (3 * MIX_W, MIX_W, N_HEADS, N_HEADS,
             MIX_W, MIX_W, MIX_W, MIX_W, N_HEADS, N_HEADS,
             MIX_W, MIX_W, MIX_W, MIX_W,
             N_BRANCH * D_MODEL)
N_IN = sum(IN_SPLITS)

kernel_name = "gdn_mlstm_hgrn2_parallel_hybrid_step"


def _rmsnorm(x, g):
    xf = x.astype(jnp.float32)
    return (xf * lax.rsqrt(jnp.mean(xf * xf, -1, keepdims=True) + EPS) * g).astype(x.dtype)


def _group_rmsnorm(t, g):
    B, L, _ = t.shape
    th = t.reshape(B, L, N_HEADS, HEAD_DIM)
    th = th * lax.rsqrt(jnp.mean(th * th, -1, keepdims=True) + EPS)
    return th.reshape(B, L, MIX_W) * g.astype(jnp.float32)


def _l2norm(t):
    return t * lax.rsqrt(jnp.sum(t * t, -1, keepdims=True) + EPS)


def _heads(t):
    B, L, _ = t.shape
    return t.astype(jnp.float32).reshape(B, L, N_HEADS, HEAD_DIM).transpose(0, 2, 1, 3)


def _merge(t):
    B, H, L, D = t.shape
    return t.transpose(0, 2, 1, 3).reshape(B, L, H * D)


def _chunk_len(L):
    return CHUNK if L % CHUNK == 0 else L


def _to_chunks(t, c):
    B, H, L = t.shape[:3]
    return jnp.moveaxis(t.reshape(B, H, L // c, c, *t.shape[3:]), 2, 0)


def _from_chunks(t):
    Nc, B, H, c = t.shape[:4]
    return jnp.moveaxis(t, 0, 2).reshape(B, H, Nc * c, *t.shape[4:])


def _causal_conv(x, buf, w):
    W = w.shape[0]
    L = x.shape[1]
    xp = jnp.concatenate([buf.astype(x.dtype), x], axis=1)
    y = sum(w[j] * xp[:, j:j + L] for j in range(W))
    return y, xp[:, L:]


def _gated_delta(q, k, v, beta, g, S0):
    c = _chunk_len(q.shape[2])
    causal = jnp.tril(jnp.ones((c, c), bool))
    strict = jnp.tril(jnp.ones((c, c), bool), -1)
    eye = jnp.eye(c, dtype=jnp.float32)

    def step(S, inp):
        qc, kc, vc, bc, gc = inp
        G = jnp.cumsum(gc, -1)
        decay = jnp.exp(jnp.where(causal, G[..., :, None] - G[..., None, :], -jnp.inf))
        A = jnp.where(strict, bc[..., None] * decay * jnp.einsum('bhtd,bhsd->bhts', kc, kc), 0.0)
        eG = jnp.exp(G)[..., None]
        rhs = bc[..., None] * (vc - eG * jnp.einsum('bhtd,bhde->bhte', kc, S))
        u = lax.linalg.triangular_solve(eye + A, rhs, left_side=True, lower=True)
        qk = jnp.einsum('bhtd,bhsd->bhts', qc, kc) * decay
        o = eG * jnp.einsum('bhtd,bhde->bhte', qc, S) + jnp.einsum('bhts,bhse->bhte', qk, u)
        wl = jnp.exp(G[..., -1:] - G)[..., None]
        S_new = jnp.exp(G[..., -1])[..., None, None] * S + jnp.einsum('bhsd,bhse->bhde', kc * wl, u)
        return S_new, o

    S, o = lax.scan(step, S0, tuple(_to_chunks(t, c) for t in (q, k, v, beta, g)))
    return _from_chunks(o), S


def _mlstm(q, k, v, ig, lf, C0, n0, m0):
    c = _chunk_len(q.shape[2])
    causal = jnp.tril(jnp.ones((c, c), bool))

    def step(carry, inp):
        C, n, m = carry
        qc, kc, vc, ic, fc = inp
        F = jnp.cumsum(fc, -1)
        logD = jnp.where(causal, F[..., :, None] - F[..., None, :] + ic[..., None, :], -jnp.inf)
        b = F + m[..., None]
        mt = jnp.maximum(b, jnp.max(logD, -1))
        s = jnp.einsum('bhtd,bhsd->bhts', qc, kc) * jnp.exp(logD - mt[..., None])
        inter = jnp.exp(b - mt)
        num = jnp.einsum('bhts,bhse->bhte', s, vc) + inter[..., None] * jnp.einsum('bhtd,bhde->bhte', qc, C)
        den = jnp.sum(s, -1) + inter * jnp.einsum('bhtd,bhd->bht', qc, n)
        h = num / jnp.maximum(jnp.abs(den), jnp.exp(-mt))[..., None]
        m_new = mt[..., -1]
        wl = jnp.exp(F[..., -1:] - F + ic - m_new[..., None])
        d0 = jnp.exp(F[..., -1] + m - m_new)
        C_new = d0[..., None, None] * C + jnp.einsum('bhsd,bhse->bhde', kc * wl[..., None], vc)
        n_new = d0[..., None] * n + jnp.einsum('bhs,bhsd->bhd', wl, kc)
        return (C_new, n_new, m_new), h

    state, h = lax.scan(step, (C0, n0, m0), tuple(_to_chunks(t, c) for t in (q, k, v, ig, lf)))
    return _from_chunks(h), state


def _hgrn2(q, k, lg, i, S0):
    c = _chunk_len(q.shape[2])
    causal = jnp.tril(jnp.ones((c, c), bool))[..., None]

    def step(S, inp):
        qc, kc, lgc, ic = inp
        G = jnp.cumsum(lgc, axis=2)
        decay = jnp.exp(jnp.where(causal, G[:, :, :, None, :] - G[:, :, None, :, :], -jnp.inf))
        A = jnp.einsum('bhtsd,bhsd->bhts', qc[:, :, :, None, :] * decay, kc)
        o = jnp.einsum('bhtd,bhde->bhte', qc * jnp.exp(G), S) + jnp.einsum('bhts,bhse->bhte', A, ic)
        S_new = jnp.exp(G[:, :, -1])[..., None] * S + jnp.einsum('bhsd,bhse->bhde', kc * jnp.exp(G[:, :, -1:] - G), ic)
        return S_new, o

    S, o = lax.scan(step, S0, tuple(_to_chunks(t, c) for t in (q, k, lg, i)))
    return _from_chunks(o), S


def _layer(x, gdn_S, gdn_conv, m_C, m_n, m_m, h_S, ffn_conv,
           ln_mix, w_in, gdn_conv_w, gdn_A_log, gdn_dt_bias, gdn_norm,
           m_ibias, m_fbias, m_norm, lb, hgrn_norm, w_br, w_out,
           ln_ffn, w_up, ffn_conv_w, ffn_conv_b, w_down):
    f32 = jnp.float32
    B, L, _ = x.shape
    h = _rmsnorm(x, ln_mix)
    proj = h @ w_in
    (g_qkv, g_z, g_b, g_a, m_q, m_k, m_v, m_o, m_i, m_f,
     h_q, h_f, h_i, h_g, br_gate) = jnp.split(proj, np.cumsum(IN_SPLITS)[:-1].tolist(), axis=-1)

    g_qkv, gdn_conv_new = _causal_conv(g_qkv, gdn_conv, gdn_conv_w)
    gq, gk, gv = jnp.split(jax.nn.silu(g_qkv.astype(f32)), 3, axis=-1)
    gq = _l2norm(_heads(gq)) * HEAD_DIM ** -0.5
    gk = _l2norm(_heads(gk))
    beta = jax.nn.sigmoid(g_b.astype(f32)).transpose(0, 2, 1)
    g_log = (-jnp.exp(gdn_A_log.astype(f32)) * jax.nn.softplus(g_a.astype(f32) + gdn_dt_bias)).transpose(0, 2, 1)
    o, gdn_S_new = _gated_delta(gq, gk, _heads(gv), beta, g_log, gdn_S.astype(f32))
    o_gdn = _group_rmsnorm(_merge(o), gdn_norm) * jax.nn.silu(g_z.astype(f32))

    ig = (m_i.astype(f32) + m_ibias).transpose(0, 2, 1)
    lf = jax.nn.log_sigmoid(m_f.astype(f32) + m_fbias).transpose(0, 2, 1)
    hm, (m_C_new, m_n_new, m_m_new) = _mlstm(_heads(m_q), _heads(m_k) * HEAD_DIM ** -0.5, _heads(m_v),
                                             ig, lf, m_C.astype(f32), m_n.astype(f32), m_m.astype(f32))
    o_m = _group_rmsnorm(_merge(hm), m_norm) * jax.nn.sigmoid(m_o.astype(f32))

    fg = lb + (1.0 - lb) * jax.nn.sigmoid(h_f.astype(f32))
    ho, h_S_new = _hgrn2(_heads(jax.nn.silu(h_q.astype(f32))), _heads(1.0 - fg), _heads(jnp.log(fg)),
                         _heads(h_i), h_S.astype(f32))
    o_h = _group_rmsnorm(_merge(ho), hgrn_norm) * jax.nn.silu(h_g.astype(f32))

    outs = jnp.stack([o_gdn, o_m, o_h], axis=0).astype(x.dtype)
    br = jnp.einsum('nblc,ncd->blnd', outs, w_br)
    gate = jax.nn.sigmoid(br_gate.reshape(B, L, N_BRANCH, D_MODEL))
    x = x + (jnp.sum(gate * br, axis=2) @ w_out).astype(x.dtype)

    u = _rmsnorm(x, ln_ffn) @ w_up
    u, ffn_conv_new = _causal_conv(u, ffn_conv, ffn_conv_w)
    ua, ub = jnp.split(u + ffn_conv_b, 2, axis=-1)
    x = x + ((jax.nn.silu(ua) * ub) @ w_down).astype(x.dtype)

    dt = x.dtype
    new = (gdn_S_new.astype(dt), gdn_conv_new.astype(dt), m_C_new.astype(dt), m_n_new.astype(dt),
           m_m_new.astype(dt), h_S_new.astype(dt), ffn_conv_new.astype(dt))
    return x, new


def _trunk(x, gdn_S, gdn_conv, m_C, m_n, m_m, h_S, ffn_conv,
           ln_mix, w_in, gdn_conv_w, gdn_A_log, gdn_dt_bias, gdn_norm,
           m_ibias, m_fbias, m_norm, hgrn_lb, hgrn_norm, w_br, w_out,
           ln_ffn, w_up, ffn_conv_w, ffn_conv_b, w_down, ln_final):
    lb_all = jnp.cumsum(jax.nn.softmax(hgrn_lb.astype(jnp.float32), axis=0), axis=0)
    lb_all = lb_all - lb_all[0]
    per_layer = []
    for l in range(DEPTH):
        x, st = _layer(x, gdn_S[l], gdn_conv[l], m_C[l], m_n[l], m_m[l], h_S[l], ffn_conv[l],
                       ln_mix[l], w_in[l], gdn_conv_w[l], gdn_A_log[l], gdn_dt_bias[l], gdn_norm[l],
                       m_ibias[l], m_fbias[l], m_norm[l], lb_all[l], hgrn_norm[l], w_br[l], w_out[l],
                       ln_ffn[l], w_up[l], ffn_conv_w[l], ffn_conv_b[l], w_down[l])
        per_layer.append(st)
    stacked = tuple(jnp.stack(s, axis=0) for s in zip(*per_layer))
    return _rmsnorm(x, ln_final), stacked


def setup_inputs(seed: int = 0) -> dict:
    key = jax.random.key(seed)
    ks = jax.random.split(key, 32)
    f32 = jnp.float32
    H, Dh = N_HEADS, HEAD_DIM

    def nrm(k, shape, s):
        return jax.random.normal(k, shape, f32) * s

    dt = jnp.exp(jax.random.uniform(ks[12], (DEPTH, H), f32) * (math.log(0.1) - math.log(0.001)) + math.log(0.001))
    return {
        'x_prompt': nrm(ks[0], (BATCH, SEQ, D_MODEL), 1.0),
        'x_sample': nrm(ks[1], (DEC_BATCH, DEC_SEQ, D_MODEL), 1.0),
        'state_gdn_S': nrm(ks[2], (DEPTH, DEC_BATCH, H, Dh, Dh), 0.05),
        'state_gdn_conv': nrm(ks[3], (DEPTH, DEC_BATCH, CONV_W - 1, 3 * MIX_W), 1.0),
        'state_mlstm_C': nrm(ks[4], (DEPTH, DEC_BATCH, H, Dh, Dh), 0.05),
        'state_mlstm_n': nrm(ks[5], (DEPTH, DEC_BATCH, H, Dh), 0.1),
        'state_mlstm_m': nrm(ks[6], (DEPTH, DEC_BATCH, H), 1.0),
        'state_hgrn_S': nrm(ks[7], (DEPTH, DEC_BATCH, H, Dh, Dh), 0.5),
        'state_ffn_conv': nrm(ks[8], (DEPTH, DEC_BATCH, FFN_CONV_W - 1, 2 * D_FF), 1.0),
        'ln_mix': 1.0 + nrm(ks[9], (DEPTH, D_MODEL), 0.02),
        'w_in': nrm(ks[10], (DEPTH, D_MODEL, N_IN), D_MODEL ** -0.5),
        'gdn_conv_w': nrm(ks[11], (DEPTH, CONV_W, 3 * MIX_W), CONV_W ** -0.5),
        'gdn_A_log': jnp.log(jax.random.uniform(ks[13], (DEPTH, H), f32, 1.0, 16.0)),
        'gdn_dt_bias': dt + jnp.log(-jnp.expm1(-dt)),
        'gdn_norm': 1.0 + nrm(ks[14], (DEPTH, MIX_W), 0.02),
        'm_ibias': nrm(ks[15], (DEPTH, H), 0.1),
        'm_fbias': 3.0 + 3.0 * jax.random.uniform(ks[16], (DEPTH, H), f32),
        'm_norm': 1.0 + nrm(ks[17], (DEPTH, MIX_W), 0.02),
        'hgrn_lb': nrm(ks[18], (DEPTH, MIX_W), 0.1),
        'hgrn_norm': 1.0 + nrm(ks[19], (DEPTH, MIX_W), 0.02),
        'w_br': nrm(ks[20], (DEPTH, N_BRANCH, MIX_W, D_MODEL), MIX_W ** -0.5),
        'w_out': nrm(ks[21], (DEPTH, D_MODEL, D_MODEL), D_MODEL ** -0.5),
        'ln_ffn': 1.0 + nrm(ks[22], (DEPTH, D_MODEL), 0.02),
        'w_up': nrm(ks[23], (DEPTH, D_MODEL, 2 * D_FF), D_MODEL ** -0.5),
        'ffn_conv_w': nrm(ks[24], (DEPTH, FFN_CONV_W, 2 * D_FF), FFN_CONV_W ** -0.5),
        'ffn_conv_b': nrm(ks[25], (DEPTH, 2 * D_FF), 0.01),
        'w_down': nrm(ks[26], (DEPTH, D_FF, D_MODEL), D_FF ** -0.5),
        'ln_final': 1.0 + nrm(ks[27], (D_MODEL,), 0.02),
    }


def reference(x_prompt, x_sample, state_gdn_S, state_gdn_conv, state_mlstm_C, state_mlstm_n,
              state_mlstm_m, state_hgrn_S, state_ffn_conv, ln_mix, w_in, gdn_conv_w, gdn_A_log,
              gdn_dt_bias, gdn_norm, m_ibias, m_fbias, m_norm, hgrn_lb, hgrn_norm, w_br, w_out,
              ln_ffn, w_up, ffn_conv_w, ffn_conv_b, w_down, ln_final):
    weights = (ln_mix, w_in, gdn_conv_w, gdn_A_log, gdn_dt_bias, gdn_norm, m_ibias, m_fbias, m_norm,
               hgrn_lb, hgrn_norm, w_br, w_out, ln_ffn, w_up, ffn_conv_w, ffn_conv_b, w_down, ln_final)
    B = x_prompt.shape[0]
    dt = x_prompt.dtype
    H, Dh = N_HEADS, HEAD_DIM
    z_S = jnp.zeros((DEPTH, B, H, Dh, Dh), dt)
    z_gconv = jnp.zeros((DEPTH, B, CONV_W - 1, 3 * MIX_W), dt)
    z_n = jnp.zeros((DEPTH, B, H, Dh), dt)
    z_m = jnp.zeros((DEPTH, B, H), dt)
    z_fconv = jnp.zeros((DEPTH, B, FFN_CONV_W - 1, 2 * D_FF), dt)
    y_prompt, (p_gdn_S, p_gdn_conv, p_mlstm_C, p_mlstm_n, p_mlstm_m, p_hgrn_S, p_ffn_conv) = _trunk(
        x_prompt, z_S, z_gconv, z_S, z_n, z_m, z_S, z_fconv, *weights)
    y_sample, (s_gdn_S, s_gdn_conv, s_mlstm_C, s_mlstm_n, s_mlstm_m, s_hgrn_S, s_ffn_conv) = _trunk(
        x_sample, state_gdn_S, state_gdn_conv, state_mlstm_C, state_mlstm_n, state_mlstm_m,
        state_hgrn_S, state_ffn_conv, *weights)
    return (y_prompt, y_sample,
            p_gdn_S, p_gdn_conv, p_mlstm_C, p_mlstm_n, p_mlstm_m, p_hgrn_S, p_ffn_conv,
            s_gdn_S, s_gdn_conv, s_mlstm_C, s_mlstm_n, s_mlstm_m, s_hgrn_S, s_ffn_conv)
```

```cpp
#include <hip/hip_runtime.h>
#include <hip/hip_cooperative_groups.h>
#include <cstdio>
namespace cg = cooperative_groups;
namespace pg8 {
#define PG8_LAS __attribute__((address_space(3)))
typedef unsigned short bf16_t;
typedef short bf16x8 __attribute__((ext_vector_type(8)));
typedef float f32x4 __attribute__((ext_vector_type(4)));
typedef unsigned u32x4 __attribute__((ext_vector_type(4)));
constexpr int BM = 256, BK = 64, HALF = 128, HTB = HALF * BK * 2  , STAGE_BYTES = 8 * HTB, NXCD = 8, WGM = 8;

__host__ __device__ __forceinline__ int lds_byte(int r, int c) { const int st = (r >> 4) * 2 + (c >> 5), rr = r & 15, cc = c & 31, ob = rr * 64 + cc * 2; return st * 1024 + (ob ^ (((ob >> 9) & 1) << 5)); }
__host__ __device__ __forceinline__ void stage_rc(int b, int& R, int& C) { const int st = b / 1024, sb = b % 1024, swz = sb ^ (((sb >> 9) & 1) << 5); R = (st >> 1) * 16 + swz / 64; C = (st & 1) * 32 + (swz % 64) / 2; }
__host__ __device__ __forceinline__ int perm32(int rho) { const int n = rho >> 4, i = rho & 15; return 8 * (i >> 2) + 4 * n + (i & 3); }

struct Unit { int pm, pn; };
struct Gemm { const bf16_t* A; const bf16_t* Bt; int M, N, K; };

struct StaticOrder {
    int nM, nN, nwg, G, c;
    __host__ __device__ void init(int M, int N, int G_, int c_) { nM = M / BM; nN = N / BM; nwg = nM * nN; G = G_; c = c_; }
    __host__ __device__ bool next(int i, Unit& u) const {
        const long L = (long)i * G + c; if (L >= nwg) return false;
        int wgid = (int)L; { const int q = nwg / NXCD, r = nwg % NXCD, xcd = wgid % NXCD, off = wgid / NXCD; wgid = (xcd < r ? xcd * (q + 1) : r * (q + 1) + (xcd - r) * q) + off; }
        const int nig = WGM * nN, gid = wgid / nig, fm = gid * WGM, gsz = (nM - fm) < WGM ? (nM - fm) : WGM;
        u.pm = fm + ((wgid % nig) % gsz); u.pn = (wgid % nig) / gsz; return true;
    }
    __device__ __forceinline__ void a_ready(const Unit&) const {}
    __device__ __forceinline__ void done(const Unit&) const {}
};
__device__ __forceinline__ unsigned cvt_pk_bf16(float lo, float hi) { unsigned r; asm volatile("v_cvt_pk_bf16_f32 %0, %1, %2" : "=v"(r) : "v"(lo), "v"(hi)); return r; }
template <class Epi, class Sched>
__device__ __forceinline__ void gemm_phase(PG8_LAS unsigned char* lds, const Gemm g, const Sched& S, const Epi& E) {
    int tid_ = threadIdx.x; asm volatile("" : "+v"(tid_));
    const int tid = tid_, wid = __builtin_amdgcn_readfirstlane(tid >> 6), lane = tid & 63, wr = wid >> 2, wc = wid & 3, fr = lane & 15, fq = lane >> 4;
    const int K = g.K, nt = K / BK;
    unsigned voffA[2], voffB[2];
#pragma unroll
    for (int i = 0; i < 2; ++i) { int R, C; stage_rc(tid * 16 + i * 8192, R, C); const int Rb = Epi::PERM ? ((R & ~31) + perm32(R & 31)) : R;
        voffA[i] = (unsigned)(R * K + C) * 2u; voffB[i] = (unsigned)(Rb * K + C) * 2u; }
    const size_t kstep = (size_t)(BK * 2);
    const size_t hstep = (size_t)HALF * K * 2;
    const size_t tstep = 2 * hstep;
    const unsigned ldsw = (unsigned)wid * 1024u;
    const int aoff = lds_byte(wr * 64 + fr, fq * 8), boff = lds_byte(wc * 32 + fr, fq * 8);
#define PG8_SA(b, h) (((b) * 2 + (h)) * HTB)
#define PG8_SB(b, h) ((4 + (b) * 2 + (h)) * HTB)
#define PG8_STAGE(bufoff, gbase, voff) do { _Pragma("unroll") for (int _i = 0; _i < 2; ++_i) \
        __builtin_amdgcn_global_load_lds((const unsigned*)((const char*)(gbase) + (voff)[_i]), (PG8_LAS unsigned*)(lds + (bufoff) + ldsw + _i * 8192), 16, 0, 0); } while (0)
#define PG8_LDA(dst, b, h) do { _Pragma("unroll") for (int m = 0; m < 4; ++m) _Pragma("unroll") for (int k = 0; k < 2; ++k) dst[m][k] = *(const PG8_LAS bf16x8*)(lds + PG8_SA(b, h) + aoff + m * 2048 + k * 1024); } while (0)
#define PG8_LDB(dst, b, h) do { _Pragma("unroll") for (int n = 0; n < 2; ++n) _Pragma("unroll") for (int k = 0; k < 2; ++k) dst[n][k] = *(const PG8_LAS bf16x8*)(lds + PG8_SB(b, h) + boff + n * 2048 + k * 1024); } while (0)
#define PG8_MMA(ai, bj, At, Bt) do { __builtin_amdgcn_s_setprio(1); _Pragma("unroll") for (int m = 0; m < 4; ++m) _Pragma("unroll") for (int n = 0; n < 2; ++n) _Pragma("unroll") for (int k = 0; k < 2; ++k) \
        acc[ai][bj][m][n] = __builtin_amdgcn_mfma_f32_16x16x32_bf16(Bt[n][k], At[m][k], acc[ai][bj][m][n], 0, 0, 0); __builtin_amdgcn_s_setprio(0); } while (0)
#define PG8_WAIT_V(n) asm volatile("s_waitcnt vmcnt(" #n ")" ::: "memory")
#define PG8_WAIT_L(n) asm volatile("s_waitcnt lgkmcnt(" #n ")" ::: "memory")
#define PG8_BAR __builtin_amdgcn_s_barrier()
#define PG8_SCHED __builtin_amdgcn_sched_barrier(0)
    Unit cur, nxt; int ui = 0;
    if (!S.next(0, cur)) return;
    f32x4 acc[2][2][4][2];
#pragma unroll
    for (int a = 0; a < 2; ++a)
#pragma unroll
        for (int b = 0; b < 2; ++b)
#pragma unroll
            for (int m = 0; m < 4; ++m)
#pragma unroll
                for (int n = 0; n < 2; ++n) acc[a][b][m][n] = (f32x4){0.f, 0.f, 0.f, 0.f};
    bf16x8 At[4][2], B0[2][2], B1[2][2];
    const char* cA = (const char*)g.A + (size_t)cur.pm * tstep; const char* cB = (const char*)g.Bt + (size_t)cur.pn * tstep;
    S.a_ready(cur);
    PG8_STAGE(PG8_SB(0, 0), cB, voffB); PG8_STAGE(PG8_SA(0, 0), cA, voffA); PG8_STAGE(PG8_SB(0, 1), cB + hstep, voffB); PG8_STAGE(PG8_SA(0, 1), cA + hstep, voffA);
    if (wr == 1) PG8_BAR;
    PG8_WAIT_V(4); PG8_BAR;
    PG8_STAGE(PG8_SB(1, 0), cB + kstep, voffB); PG8_STAGE(PG8_SA(1, 0), cA + kstep, voffA); PG8_STAGE(PG8_SB(1, 1), cB + hstep + kstep, voffB);
    PG8_WAIT_V(6); PG8_BAR;
    for (;;) {
        const bool has_next = S.next(ui + 1, nxt);
        const char* nA = has_next ? (const char*)g.A + (size_t)nxt.pm * tstep : cA; const char* nB = has_next ? (const char*)g.Bt + (size_t)nxt.pn * tstep : cB;
        for (int t = 0; t < nt; t += 2) {
            const bool last = (t == nt - 2);
            const char* a1 = cA + (size_t)(t + 1) * kstep;
            const char* a2 = last ? nA : cA + (size_t)(t + 2) * kstep; const char* b2 = last ? nB : cB + (size_t)(t + 2) * kstep;
            const char* a3 = a2 + kstep; const char* b3 = b2 + kstep;
            if (last && has_next) S.a_ready(nxt);
            PG8_LDB(B0, 0, 0); PG8_SCHED; PG8_LDA(At, 0, 0); PG8_STAGE(PG8_SA(1, 1), a1 + hstep, voffA);
            PG8_WAIT_L(8); PG8_BAR; PG8_WAIT_L(0); PG8_MMA(0, 0, At, B0); PG8_BAR; PG8_SCHED;
            PG8_LDB(B1, 0, 1); PG8_STAGE(PG8_SB(0, 0), b2, voffB);
            PG8_BAR; PG8_WAIT_L(0); PG8_MMA(0, 1, At, B1); PG8_BAR;
            PG8_LDA(At, 0, 1); PG8_STAGE(PG8_SA(0, 0), a2, voffA);
            PG8_BAR; PG8_WAIT_L(0); PG8_MMA(1, 0, At, B0); PG8_BAR; PG8_SCHED;
            PG8_STAGE(PG8_SB(0, 1), b2 + hstep, voffB);
            PG8_WAIT_V(6); PG8_BAR; PG8_MMA(1, 1, At, B1); PG8_BAR;
            PG8_LDB(B0, 1, 0); PG8_SCHED; PG8_LDA(At, 1, 0); PG8_STAGE(PG8_SA(0, 1), a2 + hstep, voffA);
            PG8_WAIT_L(8); PG8_BAR; PG8_WAIT_L(0); PG8_MMA(0, 0, At, B0); PG8_BAR; PG8_SCHED;
            PG8_LDB(B1, 1, 1); PG8_STAGE(PG8_SB(1, 0), b3, voffB);
            PG8_BAR; PG8_WAIT_L(0); PG8_MMA(0, 1, At, B1); PG8_BAR;
            PG8_LDA(At, 1, 1); PG8_STAGE(PG8_SA(1, 0), a3, voffA);
            PG8_BAR; PG8_WAIT_L(0); PG8_MMA(1, 0, At, B0); PG8_BAR; PG8_SCHED;
            PG8_STAGE(PG8_SB(1, 1), b3 + hstep, voffB);
            PG8_WAIT_V(6); PG8_BAR; PG8_MMA(1, 1, At, B1); PG8_BAR;
        }
        if constexpr (!Epi::AFTER_DRAIN) { E(acc, cur, wr, wc, fr, fq); S.done(cur); }
        if (!has_next) break;
#pragma unroll
        for (int a = 0; a < 2; ++a)
#pragma unroll
            for (int b = 0; b < 2; ++b)
#pragma unroll
                for (int m = 0; m < 4; ++m)
#pragma unroll
                    for (int n = 0; n < 2; ++n) acc[a][b][m][n] = (f32x4){0.f, 0.f, 0.f, 0.f};
        cur = nxt; cA = nA; cB = nB; ++ui;
    }
    PG8_WAIT_V(0);
    if (wr == 0) PG8_BAR;
    PG8_BAR;
    if constexpr (Epi::AFTER_DRAIN) { E.fused(acc, cur, wr, wc, fr, fq, lds, wid, lane); S.done(cur); }
#undef PG8_SA
#undef PG8_SB
#undef PG8_STAGE
#undef PG8_LDA
#undef PG8_LDB
#undef PG8_MMA
#undef PG8_WAIT_V
#undef PG8_WAIT_L
#undef PG8_BAR
#undef PG8_SCHED
}
}
using pg8::bf16_t; using pg8::f32x4; using pg8::bf16x8;
typedef unsigned u32x4_t __attribute__((ext_vector_type(4)));
typedef unsigned u32x2_t __attribute__((ext_vector_type(2)));

constexpr int DM = 1024, NBP = 8, SEQ = 2048, NBS = 128, SSEQ = 4, NH = 4, HD = 128, MW = 512;
constexpr int MP = NBP * SEQ, MS = NBS * SSEQ, MT = MP + MS;
constexpr int NIN = 9232, N1 = 9216, DFF = 2816, NUP = 5632;
constexpr float EPS = 1e-6f;
constexpr float QSCALE = 0.08838834764831845f;

constexpr size_t O_Y = 0;
constexpr size_t O_P_GS = (size_t)MT * DM;
constexpr size_t O_P_GC = O_P_GS + (size_t)2 * 8 * 4 * 128 * 128;
constexpr size_t O_P_MC = O_P_GC + (size_t)2 * 8 * 3 * 1536;
constexpr size_t O_P_MN = O_P_MC + (size_t)2 * 8 * 4 * 128 * 128;
constexpr size_t O_P_MM = O_P_MN + (size_t)2 * 8 * 4 * 128;
constexpr size_t O_P_HS = O_P_MM + (size_t)2 * 8 * 4;
constexpr size_t O_P_FC = O_P_HS + (size_t)2 * 8 * 4 * 128 * 128;
constexpr size_t O_S_GS = O_P_FC + (size_t)2 * 8 * 2 * 5632;
constexpr size_t O_S_GC = O_S_GS + (size_t)2 * 128 * 4 * 128 * 128;
constexpr size_t O_S_MC = O_S_GC + (size_t)2 * 128 * 3 * 1536;
constexpr size_t O_S_MN = O_S_MC + (size_t)2 * 128 * 4 * 128 * 128;
constexpr size_t O_S_MM = O_S_MN + (size_t)2 * 128 * 4 * 128;
constexpr size_t O_S_HS = O_S_MM + (size_t)2 * 128 * 4;
constexpr size_t O_S_FC = O_S_HS + (size_t)2 * 128 * 4 * 128 * 128;
constexpr size_t O_END  = O_S_FC + (size_t)2 * 128 * 2 * 5632;

constexpr size_t W_WIN = 0;
constexpr size_t W_WBR = W_WIN + (size_t)N1 * 1024 * 2;
constexpr size_t W_WOUT = W_WBR + (size_t)3 * 1024 * 512 * 2;
constexpr size_t W_WUP = W_WOUT + (size_t)1024 * 1024 * 2;
constexpr size_t W_WDN = W_WUP + (size_t)NUP * 1024 * 2;
constexpr size_t W_HBF = W_WDN + (size_t)1024 * DFF * 2;
constexpr size_t W_PROJ = W_HBF + (size_t)MT * 1024 * 2;
constexpr size_t W_ACT = W_PROJ + (size_t)MT * NUP * 2;
constexpr size_t W_OUTS = W_PROJ + (size_t)MT * N1 * 2;
constexpr size_t W_GATES = W_OUTS + (size_t)3 * MT * 512 * 2;
constexpr size_t W_DEN = W_GATES + (size_t)MT * 16 * 4;
constexpr size_t W_MT = W_DEN + (size_t)MT * 4 * 4;
constexpr size_t W_END = W_MT + (size_t)MT * 4 * 4;

constexpr int LDS_BYTES = 131072;

struct Params { const float* in[28]; float* out; unsigned char* ws; };
enum { I_XP = 0, I_XS, I_SGS, I_SGC, I_SMC, I_SMN, I_SMM, I_SHS, I_SFC, I_LNMIX, I_WIN, I_GCW, I_ALOG, I_DTB, I_GNORM, I_MIB, I_MFB, I_MNORM, I_HLB, I_HNORM,
       I_WBR, I_WOUT, I_LNFFN, I_WUP, I_FCW, I_FCB, I_WDN, I_LNF };

__device__ __forceinline__ float bf2f(bf16_t b) { return __uint_as_float(((unsigned)b) << 16); }
__device__ __forceinline__ float bflo(unsigned u) { return __uint_as_float(u << 16); }
__device__ __forceinline__ float bfhi(unsigned u) { return __uint_as_float(u & 0xffff0000u); }
__device__ __forceinline__ bf16_t f2bf(float f) { return (bf16_t)(pg8::cvt_pk_bf16(f, 0.f) & 0xffffu); }
__device__ __forceinline__ float sigm(float x) { return __builtin_amdgcn_rcpf(1.f + __expf(-x)); }
__device__ __forceinline__ float silu(float x) { return x * sigm(x); }
template <int CTRL> __device__ __forceinline__ float dppf(float x) { return __builtin_bit_cast(float, __builtin_amdgcn_update_dpp(0, __builtin_bit_cast(int, x), CTRL, 0xf, 0xf, true)); }
__device__ __forceinline__ float grp_sum8(float x) { x += dppf<0xB1>(x); x += dppf<0x4E>(x); x += dppf<0x141>(x); return x; }
__device__ __forceinline__ float grp_sum16(float x) { x = grp_sum8(x); x += dppf<0x140>(x); return x; }
__device__ __forceinline__ float wave_sum(float x) { x = grp_sum16(x); x += __shfl_xor(x, 16); x += __shfl_xor(x, 32); return x; }
template <int T> __device__ __forceinline__ float grp_sum(float x) { if constexpr (T == 16) return grp_sum16(x); else return grp_sum8(x); }

__device__ __forceinline__ int win_srccol(int n0) { const int blk = n0 >> 9, r = n0 & 511; int base;
    if (blk < 4) base = blk * 512; else if (blk < 8) base = 2056 + (blk - 4) * 512; else if (blk < 12) base = 4112 + (blk - 8) * 512; else base = 6160 + (blk - 12) * 512;
    return base + r; }
__device__ void conv_T(const float* __restrict__ src, int ld, bf16_t* __restrict__ dst, int K, int N, bool winmap, float* tile, int& tcount) {
    int tid_ = threadIdx.x; asm volatile("" : "+v"(tid_)); const int tid = tid_, ntn = N / 64, ntiles = ntn * (K / 64);
    for (int t = (int)blockIdx.x - (tcount % (int)gridDim.x); t < ntiles; t += gridDim.x) {
        if (t < 0) continue;
        const int tn = t % ntn, tk = t / ntn, n0 = tn * 64, k0 = tk * 64, sc0 = winmap ? win_srccol(n0) : n0;
        __syncthreads();
        { const int kk = tid >> 4, n4 = (tid & 15) * 4;
#pragma unroll
          for (int pp = 0; pp < 2; ++pp) { const float4 v = *(const float4*)(src + (size_t)(k0 + kk + 32 * pp) * ld + sc0 + n4); float* tp = tile + (kk + 32 * pp) * 65 + n4; tp[0] = v.x; tp[1] = v.y; tp[2] = v.z; tp[3] = v.w; } }
        __syncthreads();
        { const int n = tid >> 3, k8 = (tid & 7) * 8; float f[8];
#pragma unroll
          for (int i = 0; i < 8; ++i) f[i] = tile[(k8 + i) * 65 + n];
          u32x4_t o; o[0] = pg8::cvt_pk_bf16(f[0], f[1]); o[1] = pg8::cvt_pk_bf16(f[2], f[3]); o[2] = pg8::cvt_pk_bf16(f[4], f[5]); o[3] = pg8::cvt_pk_bf16(f[6], f[7]);
          *(u32x4_t*)(dst + (size_t)(n0 + n) * K + k0 + k8) = o; }
    }
    tcount += ntiles;
}

__device__ void phase_rmsnorm(const Params& p, int l, const float* xa, const float* xb, const float* __restrict__ gw, bf16_t* __restrict__ hout, bool do_gates, float* sm) {
    int tid_ = threadIdx.x; asm volatile("" : "+v"(tid_)); const int tid = tid_, lane = tid & 63, w = tid >> 6;
    float* wgT = sm;
    if (do_gates) {
        const float* win = p.in[I_WIN] + (size_t)l * 1024 * NIN;
        __syncthreads();
        for (int i = tid; i < 16 * 1024; i += 512) { const int k = i >> 4, j = i & 15; const int gc = j < 8 ? 2048 + j : 4104 + (j - 8); wgT[j * 1024 + k] = win[(size_t)k * NIN + gc]; }
        __syncthreads();
    }
    float4 g4[4];
#pragma unroll
    for (int i = 0; i < 4; ++i) g4[i] = *(const float4*)(gw + lane * 4 + 256 * i);
    for (int row = blockIdx.x * 8 + w; row < MT; row += gridDim.x * 8) {
        const float* xr = row < MP ? xa + (size_t)row * DM : xb + (size_t)(row - MP) * DM;
        float4 v[4]; float ss = 0.f;
#pragma unroll
        for (int i = 0; i < 4; ++i) { v[i] = *(const float4*)(xr + lane * 4 + 256 * i); ss += v[i].x * v[i].x + v[i].y * v[i].y + v[i].z * v[i].z + v[i].w * v[i].w; }
        ss = wave_sum(ss);
        const float rstd = rsqrtf(ss * (1.f / 1024.f) + EPS);
#pragma unroll
        for (int i = 0; i < 4; ++i) { v[i].x *= rstd * g4[i].x; v[i].y *= rstd * g4[i].y; v[i].z *= rstd * g4[i].z; v[i].w *= rstd * g4[i].w;
            u32x2_t o; o[0] = pg8::cvt_pk_bf16(v[i].x, v[i].y); o[1] = pg8::cvt_pk_bf16(v[i].z, v[i].w);
            *(u32x2_t*)(hout + (size_t)row * DM + lane * 4 + 256 * i) = o; }
        if (do_gates) {
            float mine = 0.f;
#pragma unroll
            for (int j = 0; j < 16; ++j) { float a = 0.f;
#pragma unroll
                for (int i = 0; i < 4; ++i) { const float4 wv = *(const float4*)(wgT + j * 1024 + lane * 4 + 256 * i); a += v[i].x * wv.x + v[i].y * wv.y + v[i].z * wv.z + v[i].w * wv.w; }
                a = wave_sum(a); if (lane == j) mine = a; }
            if (lane < 16) { const int h = lane & 3, kind = lane >> 2; float r;
                if (kind == 0) r = sigm(mine);
                else if (kind == 1) { const float xx = mine + p.in[I_DTB][l * 4 + h]; const float sp = xx > 20.f ? xx : log1pf(__expf(xx)); r = __expf(-__expf(p.in[I_ALOG][l * 4 + h]) * sp); }
                else if (kind == 2) r = mine + p.in[I_MIB][l * 4 + h];
                else { const float xx = -(mine + p.in[I_MFB][l * 4 + h]); r = -(xx > 20.f ? xx : log1pf(__expf(xx))); }
                ((float*)(p.ws + W_GATES))[(size_t)row * 16 + lane] = r; }
        }
    }
}

struct EpiProj {
    static constexpr bool PERM = true, AFTER_DRAIN = false;
    bf16_t* O; int ldc; int actmode;
    __device__ __forceinline__ void operator()(const f32x4 (&acc)[2][2][4][2], const pg8::Unit& u, int wr, int wc, int fr, int fq) const {
        const int row0 = u.pm * 256 + wr * 64 + fr, col0 = u.pn * 256 + wc * 32 + 8 * fq;
        int act = 0;
        if (actmode) { const int pn = u.pn; act = (pn >= 24 || pn == 14 || pn == 15) ? 2 : ((pn == 6 || pn == 7 || pn == 16 || pn == 17 || pn == 22 || pn == 23) ? 1 : 0); }
#pragma unroll
        for (int ai = 0; ai < 2; ++ai)
#pragma unroll
            for (int m = 0; m < 4; ++m) { bf16_t* rowp = O + (size_t)(row0 + ai * 128 + m * 16) * ldc + col0;
#pragma unroll
                for (int bj = 0; bj < 2; ++bj) { float v[8];
#pragma unroll
                    for (int i = 0; i < 4; ++i) { v[i] = acc[ai][bj][m][0][i]; v[4 + i] = acc[ai][bj][m][1][i]; }
                    if (act == 1) {
#pragma unroll
                        for (int i = 0; i < 8; ++i) v[i] = silu(v[i]); }
                    else if (act == 2) {
#pragma unroll
                        for (int i = 0; i < 8; ++i) v[i] = sigm(v[i]); }
                    u32x4_t o; o[0] = pg8::cvt_pk_bf16(v[0], v[1]); o[1] = pg8::cvt_pk_bf16(v[2], v[3]); o[2] = pg8::cvt_pk_bf16(v[4], v[5]); o[3] = pg8::cvt_pk_bf16(v[6], v[7]);
                    *(u32x4_t*)(rowp + bj * 128) = o; } }
    }
};
struct EpiMerge {
    static constexpr bool PERM = true, AFTER_DRAIN = false;
    const bf16_t* G; bf16_t* Mx; int first;
    __device__ __forceinline__ void operator()(const f32x4 (&acc)[2][2][4][2], const pg8::Unit& u, int wr, int wc, int fr, int fq) const {
        const int row0 = u.pm * 256 + wr * 64 + fr, col0 = u.pn * 256 + wc * 32 + 8 * fq;
#pragma unroll
        for (int ai = 0; ai < 2; ++ai)
#pragma unroll
            for (int m = 0; m < 4; ++m) { const size_t row = (size_t)(row0 + ai * 128 + m * 16);
#pragma unroll
                for (int bj = 0; bj < 2; ++bj) { const int col = col0 + bj * 128;
                    const u32x4_t g = *(const u32x4_t*)(G + row * N1 + col); float v[8];
#pragma unroll
                    for (int i = 0; i < 4; ++i) { v[i] = acc[ai][bj][m][0][i]; v[4 + i] = acc[ai][bj][m][1][i]; }
#pragma unroll
                    for (int i = 0; i < 4; ++i) { v[2 * i] *= bflo(g[i]); v[2 * i + 1] *= bfhi(g[i]); }
                    bf16_t* mp = Mx + row * DM + col;
                    if (!first) { const u32x4_t o = *(const u32x4_t*)mp;
#pragma unroll
                        for (int i = 0; i < 4; ++i) { v[2 * i] += bflo(o[i]); v[2 * i + 1] += bfhi(o[i]); } }
                    u32x4_t o; o[0] = pg8::cvt_pk_bf16(v[0], v[1]); o[1] = pg8::cvt_pk_bf16(v[2], v[3]); o[2] = pg8::cvt_pk_bf16(v[4], v[5]); o[3] = pg8::cvt_pk_bf16(v[6], v[7]);
                    *(u32x4_t*)mp = o; } }
    }
};
struct EpiResid {
    static constexpr bool PERM = false, AFTER_DRAIN = false;
    float* X;
    __device__ __forceinline__ void operator()(const f32x4 (&acc)[2][2][4][2], const pg8::Unit& u, int wr, int wc, int fr, int fq) const {
        const int row0 = u.pm * 256 + wr * 64 + fr, col0 = u.pn * 256 + wc * 32 + 4 * fq;
#pragma unroll
        for (int ai = 0; ai < 2; ++ai)
#pragma unroll
            for (int m = 0; m < 4; ++m) { float* rowp = X + (size_t)(row0 + ai * 128 + m * 16) * DM + col0;
#pragma unroll
                for (int bj = 0; bj < 2; ++bj)
#pragma unroll
                    for (int n = 0; n < 2; ++n) { f32x4* q = (f32x4*)(rowp + bj * 128 + n * 16); *q = *q + acc[ai][bj][m][n]; } }
    }
};
template <int MIX>
__device__ void scan_prompt_item(const Params& p, int l, int b, int h, int cgp, float* sm) {
    constexpr int T = (MIX == 0) ? 16 : 8, NG = 128 / (4 * T), ND = 4 * NG, CPW = 64 / T, CPG = 8 * CPW, TB = 32;
    int tid_ = threadIdx.x; asm volatile("" : "+v"(tid_)); const int tid = tid_, lane = tid & 63, w = tid >> 6, c = lane / T, j = lane % T;
    const int col = w * CPW + c, ecol = cgp * CPG + col;
    float* qk = sm; float* vv = sm + 8192; float* sc = sm + 10240; float* denp = sm + 10368; float* gsc = sm + 10624; float* mcar = sm + 10688;
    const bf16_t* proj = (const bf16_t*)(p.ws + W_PROJ);
    const float* gates = (const float*)(p.ws + W_GATES);
    bf16_t* outp = (bf16_t*)(p.ws + W_OUTS) + (size_t)MIX * MT * 512;
    const size_t rb = (size_t)b * SEQ;
    float S[ND];
#pragma unroll
    for (int i = 0; i < ND; ++i) S[i] = 0.f;
    float nn = 0.f, okeep = 0.f;
    if (MIX == 1 && tid == 0) mcar[0] = 0.f;
    const int ch = tid & 255, half = tid >> 8;
    int colq; float w0 = 0.f, w1 = 0.f, w2 = 0.f, w3 = 0.f, lbv = 0.f;
    float vw0 = 0.f, vw1 = 0.f, vw2 = 0.f, vw3 = 0.f;
    if (MIX == 0) { colq = (ch >> 7) * 512 + h * 128 + (ch & 127); const float* cw = p.in[I_GCW] + (size_t)l * 4 * 1536;
        w0 = cw[colq]; w1 = cw[1536 + colq]; w2 = cw[2 * 1536 + colq]; w3 = cw[3 * 1536 + colq];
        const int colv = 1024 + h * 128 + cgp * 32 + (tid & 31); vw0 = cw[colv]; vw1 = cw[1536 + colv]; vw2 = cw[2 * 1536 + colv]; vw3 = cw[3 * 1536 + colv]; }
    else if (MIX == 1) colq = 2048 + (ch >> 7) * 512 + h * 128 + (ch & 127);
    else { colq = 4096 + (ch >> 7) * 512 + h * 128 + (ch & 127);
        if (l > 0 && ch >= 128) { const float* hl = p.in[I_HLB]; const int cc = h * 128 + (ch & 127); lbv = sigm(hl[512 + cc] - hl[cc]); } }

    for (int t0 = 0; t0 < SEQ; t0 += TB) {
        __syncthreads();
        { const int ts = t0 + half * 16; const bf16_t* pr = proj + (rb + ts) * N1 + colq;
          if (MIX == 0) {
              float x0 = 0.f, x1 = 0.f, x2 = 0.f;
              if (ts > 0) { x0 = bf2f(pr[-3 * N1]); x1 = bf2f(pr[-2 * N1]); x2 = bf2f(pr[-1 * N1]); }
#pragma unroll 4
              for (int s = 0; s < 16; ++s) { const float x3 = bf2f(pr[(size_t)s * N1]); qk[(half * 16 + s) * 256 + ch] = silu(w0 * x0 + w1 * x1 + w2 * x2 + w3 * x3); x0 = x1; x1 = x2; x2 = x3; }
          } else if (MIX == 1) {
#pragma unroll 4
              for (int s = 0; s < 16; ++s) qk[(half * 16 + s) * 256 + ch] = bf2f(pr[(size_t)s * N1]);
          } else {
#pragma unroll 4
              for (int s = 0; s < 16; ++s) { float x = bf2f(pr[(size_t)s * N1]); if (ch >= 128) x = lbv + (1.f - lbv) * sigm(x); qk[(half * 16 + s) * 256 + ch] = x; }
          } }
        if (MIX == 0) { const int vc = tid & 31, sb = tid >> 5; const bf16_t* pv = proj + rb * N1 + 1024 + h * 128 + cgp * 32 + vc;
#pragma unroll
            for (int rep = 0; rep < 2; ++rep) { const int s = sb + rep * 16, t = t0 + s;
                const float x3 = bf2f(pv[(size_t)t * N1]);
                const float x2 = t >= 1 ? bf2f(pv[(size_t)(t - 1) * N1]) : 0.f, x1 = t >= 2 ? bf2f(pv[(size_t)(t - 2) * N1]) : 0.f, x0 = t >= 3 ? bf2f(pv[(size_t)(t - 3) * N1]) : 0.f;
                vv[s * 64 + vc] = silu(vw0 * x0 + vw1 * x1 + vw2 * x2 + vw3 * x3); }
            if (tid < TB) { const size_t r = rb + t0 + tid; sc[tid * 4 + 0] = gates[r * 16 + h]; sc[tid * 4 + 1] = gates[r * 16 + 4 + h]; }
        } else { const int vc = tid & 63, sb = tid >> 6; const bf16_t* pv = proj + rb * N1 + (MIX == 1 ? 3072 : 5120) + h * 128 + cgp * 64 + vc;
#pragma unroll
            for (int rep = 0; rep < 4; ++rep) { const int s = sb + rep * 8; vv[s * 64 + vc] = bf2f(pv[(size_t)(t0 + s) * N1]); }
            if (MIX == 1 && tid < TB) { const size_t r = rb + t0 + tid; gsc[tid * 2] = gates[r * 16 + 8 + h]; gsc[tid * 2 + 1] = gates[r * 16 + 12 + h]; }
        }
        __syncthreads();
        if (MIX == 0) {
#pragma unroll 2
            for (int v8 = 0; v8 < 8; ++v8) { const int vid = w * 8 + v8, s = vid >> 1, wh = vid & 1; float2* pp = (float2*)(qk + s * 256 + wh * 128 + lane * 2);
                float2 xy = *pp; const float ss = wave_sum(xy.x * xy.x + xy.y * xy.y); const float scl = rsqrtf(ss + EPS) * (wh == 0 ? QSCALE : 1.f);
                xy.x *= scl; xy.y *= scl; *pp = xy; }
            __syncthreads();
        } else if (MIX == 1) {
            if (tid == 0) { float m = mcar[0];
                for (int s = 0; s < TB; ++s) { const float ig = gsc[2 * s], lf = gsc[2 * s + 1]; const float mn = fmaxf(lf + m, ig);
                    sc[s * 4 + 0] = __expf(lf + m - mn); sc[s * 4 + 1] = __expf(ig - mn) * QSCALE; sc[s * 4 + 2] = mn; m = mn; }
                mcar[0] = m; }
            __syncthreads();
        }
#pragma unroll 2
        for (int s = 0; s < TB; ++s) {
            const float* qs = qk + s * 256;
            float q[ND], k[ND];
#pragma unroll
            for (int g = 0; g < NG; ++g) { const float4 a = *(const float4*)(qs + g * 4 * T + 4 * j), bb = *(const float4*)(qs + 128 + g * 4 * T + 4 * j);
                q[4 * g] = a.x; q[4 * g + 1] = a.y; q[4 * g + 2] = a.z; q[4 * g + 3] = a.w; k[4 * g] = bb.x; k[4 * g + 1] = bb.y; k[4 * g + 2] = bb.z; k[4 * g + 3] = bb.w; }
            const float v = vv[s * 64 + col];
            float o = 0.f;
            if (MIX == 0) {
                const float beta = sc[s * 4], a = sc[s * 4 + 1];
                float ks = 0.f;
#pragma unroll
                for (int i = 0; i < ND; ++i) ks += k[i] * S[i];
                ks = grp_sum<T>(ks);
                const float u = beta * (v - a * ks);
#pragma unroll
                for (int i = 0; i < ND; ++i) { S[i] = a * S[i] + k[i] * u; o += q[i] * S[i]; }
            } else if (MIX == 1) {
                const float fp = sc[s * 4], ip = sc[s * 4 + 1], iv = ip * v;
#pragma unroll
                for (int i = 0; i < ND; ++i) { S[i] = fp * S[i] + k[i] * iv; o += q[i] * S[i]; }
                const int dn = 16 * w + (lane & 15); const float kd = qs[128 + dn], qd = qs[dn];
                nn = fp * nn + ip * kd; const float dp = grp_sum16(qd * nn);
                if (lane == 0) denp[s * 8 + w] = dp;
            } else {
#pragma unroll
                for (int i = 0; i < ND; ++i) { S[i] = k[i] * (S[i] - v) + v; o += q[i] * S[i]; }
            }
            o = grp_sum<T>(o);
            if ((s & (T - 1)) == j) okeep = o;
            if ((s & (T - 1)) == T - 1) outp[(rb + t0 + s - (T - 1) + j) * 512 + h * 128 + ecol] = f2bf(okeep);
        }
        if (MIX == 1) {
            __syncthreads();
            if (cgp == 0 && tid < TB) { float d = 0.f;
#pragma unroll
                for (int i = 0; i < 8; ++i) d += denp[tid * 8 + i];
                const size_t r = rb + t0 + tid; ((float*)(p.ws + W_DEN))[r * 4 + h] = d; ((float*)(p.ws + W_MT))[r * 4 + h] = sc[tid * 4 + 2]; }
        }
    }
    const size_t sidx = ((size_t)(l * NBP + b) * NH + h);
    float* So = p.out + (MIX == 0 ? O_P_GS : (MIX == 1 ? O_P_MC : O_P_HS)) + sidx * 16384;
#pragma unroll
    for (int g = 0; g < NG; ++g)
#pragma unroll
        for (int e = 0; e < 4; ++e) So[(size_t)(g * 4 * T + 4 * j + e) * 128 + ecol] = S[4 * g + e];
    if (MIX == 1 && cgp == 0) {
        if (lane < 16) p.out[O_P_MN + sidx * 128 + 16 * w + lane] = nn;
        __syncthreads();
        if (tid == 0) p.out[O_P_MM + sidx] = mcar[0];
    }
}

__device__ void scan_sample_item(const Params& p, int l, int mix, int b, int h, float* sm) {
    int tid_ = threadIdx.x; asm volatile("" : "+v"(tid_)); const int tid = tid_, lane = tid & 63, w = tid >> 6, e = tid & 127, dg = tid >> 7;
    float* qk = sm; float* vv = sm + 1024; float* gs = sm + 1536; float* red = sm + 1600; float* dpart = sm + 1600 + 4096;
    const bf16_t* proj = (const bf16_t*)(p.ws + W_PROJ);
    const float* gates = (const float*)(p.ws + W_GATES);
    bf16_t* outp = (bf16_t*)(p.ws + W_OUTS) + (size_t)mix * MT * 512;
    const size_t rs = (size_t)MP + (size_t)b * SSEQ;
    const size_t sidx = ((size_t)(l * NBS + b) * NH + h);
    const float* Sin = p.in[mix == 0 ? I_SGS : (mix == 1 ? I_SMC : I_SHS)] + sidx * 16384;
    float S[32];
#pragma unroll
    for (int i = 0; i < 32; ++i) S[i] = Sin[(size_t)(32 * dg + i) * 128 + e];
    __syncthreads();
    for (int idx = tid; idx < 4 * 384; idx += 512) { const int s = idx / 384, ch = idx - s * 384; float val;
        if (mix == 0) { const int colx = (ch >> 7) * 512 + h * 128 + (ch & 127); const float* cw = p.in[I_GCW] + (size_t)l * 4 * 1536; const float* cs = p.in[I_SGC] + (size_t)(l * NBS + b) * 3 * 1536;
            float y = 0.f;
#pragma unroll
            for (int jj = 0; jj < 4; ++jj) { const int t = s - 3 + jj; const float x = t >= 0 ? bf2f(proj[(rs + t) * N1 + colx]) : cs[(3 + t) * 1536 + colx]; y += cw[jj * 1536 + colx] * x; }
            val = silu(y);
        } else if (mix == 1) { const int colx = 2048 + (ch >> 7) * 512 + h * 128 + (ch & 127); val = bf2f(proj[(rs + s) * N1 + colx]); }
        else { const int colx = 4096 + (ch >> 7) * 512 + h * 128 + (ch & 127); val = bf2f(proj[(rs + s) * N1 + colx]);
            if (ch >= 128 && ch < 256) { float lbv = 0.f; if (l > 0) { const float* hl = p.in[I_HLB]; const int cc = h * 128 + (ch & 127); lbv = sigm(hl[512 + cc] - hl[cc]); } val = lbv + (1.f - lbv) * sigm(val); } }
        if (ch < 256) qk[s * 256 + ch] = val; else vv[s * 128 + ch - 256] = val; }
    if (tid < 4) { const size_t r = rs + tid;
        if (mix == 0) { gs[tid * 4] = gates[r * 16 + h]; gs[tid * 4 + 1] = gates[r * 16 + 4 + h]; }
        else if (mix == 1) { gs[tid * 4] = gates[r * 16 + 8 + h]; gs[tid * 4 + 1] = gates[r * 16 + 12 + h]; } }
    __syncthreads();
    if (mix == 0) { const int s = w >> 1, wh = w & 1; float2* pp = (float2*)(qk + s * 256 + wh * 128 + lane * 2);
        float2 xy = *pp; const float ss = wave_sum(xy.x * xy.x + xy.y * xy.y); const float scl = rsqrtf(ss + EPS) * (wh == 0 ? QSCALE : 1.f); xy.x *= scl; xy.y *= scl; *pp = xy;
        __syncthreads(); }
    float m = 0.f, nn = 0.f, mts[4] = {0.f, 0.f, 0.f, 0.f};
    if (mix == 1) { m = p.in[I_SMM][sidx]; if (dg == 0) nn = p.in[I_SMN][sidx * 128 + e]; }
#pragma unroll
    for (int s = 0; s < 4; ++s) {
        const float* qs = qk + s * 256 + 32 * dg; const float* ksp = qs + 128;
        const float v = vv[s * 128 + e];
        float po = 0.f;
        if (mix == 0) {
            const float beta = gs[s * 4], a = gs[s * 4 + 1];
            float pk = 0.f;
#pragma unroll
            for (int i = 0; i < 32; ++i) pk += ksp[i] * S[i];
            red[((s * 2) * 4 + dg) * 128 + e] = pk;
            __syncthreads();
            const float ks = red[((s * 2) * 4 + 0) * 128 + e] + red[((s * 2) * 4 + 1) * 128 + e] + red[((s * 2) * 4 + 2) * 128 + e] + red[((s * 2) * 4 + 3) * 128 + e];
            const float u = beta * (v - a * ks);
#pragma unroll
            for (int i = 0; i < 32; ++i) { S[i] = a * S[i] + ksp[i] * u; po += qs[i] * S[i]; }
        } else if (mix == 1) {
            const float ig = gs[s * 4], lf = gs[s * 4 + 1]; const float mn = fmaxf(lf + m, ig); const float fp = __expf(lf + m - mn), ip = __expf(ig - mn) * QSCALE; m = mn; mts[s] = mn;
            const float iv = ip * v;
#pragma unroll
            for (int i = 0; i < 32; ++i) { S[i] = fp * S[i] + ksp[i] * iv; po += qs[i] * S[i]; }
            if (dg == 0) { nn = fp * nn + ip * qk[s * 256 + 128 + e]; const float dp = wave_sum(qk[s * 256 + e] * nn); if (lane == 0) dpart[s * 2 + w] = dp; }
        } else {
#pragma unroll
            for (int i = 0; i < 32; ++i) { S[i] = ksp[i] * (S[i] - v) + v; po += qs[i] * S[i]; }
        }
        red[((s * 2 + 1) * 4 + dg) * 128 + e] = po;
    }
    __syncthreads();
    if (tid < 128) {
#pragma unroll
        for (int s = 0; s < 4; ++s) { const float o = red[((s * 2 + 1) * 4 + 0) * 128 + e] + red[((s * 2 + 1) * 4 + 1) * 128 + e] + red[((s * 2 + 1) * 4 + 2) * 128 + e] + red[((s * 2 + 1) * 4 + 3) * 128 + e];
            outp[(rs + s) * 512 + h * 128 + e] = f2bf(o); } }
    if (mix == 1 && tid == 0) {
#pragma unroll
        for (int s = 0; s < 4; ++s) { ((float*)(p.ws + W_DEN))[(rs + s) * 4 + h] = dpart[s * 2] + dpart[s * 2 + 1]; ((float*)(p.ws + W_MT))[(rs + s) * 4 + h] = mts[s]; }
        p.out[O_S_MM + sidx] = m; }
    float* So = p.out + (mix == 0 ? O_S_GS : (mix == 1 ? O_S_MC : O_S_HS)) + sidx * 16384;
#pragma unroll
    for (int i = 0; i < 32; ++i) So[(size_t)(32 * dg + i) * 128 + e] = S[i];
    if (mix == 1 && dg == 0) p.out[O_S_MN + sidx * 128 + e] = nn;
}
__device__ void phase_postnorm(const Params& p, int l) {
    int tid_ = threadIdx.x; asm volatile("" : "+v"(tid_)); const int tid = tid_, j = tid & 15;
    bf16_t* outs = (bf16_t*)(p.ws + W_OUTS);
    const bf16_t* proj = (const bf16_t*)(p.ws + W_PROJ);
    const float* den = (const float*)(p.ws + W_DEN); const float* mt = (const float*)(p.ws + W_MT);
    const int ngroups = MT * 12;
    for (int gid = blockIdx.x * 32 + (tid >> 4); gid < ngroups; gid += gridDim.x * 32) {
        const int r = gid / 12, mh = gid - r * 12, mix = mh >> 2, h = mh & 3;
        bf16_t* op = outs + (size_t)mix * MT * 512 + (size_t)r * 512 + h * 128 + 8 * j;
        const u32x4_t raw = *(const u32x4_t*)op;
        float v[8];
#pragma unroll
        for (int i = 0; i < 4; ++i) { v[2 * i] = bflo(raw[i]); v[2 * i + 1] = bfhi(raw[i]); }
        if (mix == 1) { const float dn = fmaxf(fabsf(den[(size_t)r * 4 + h]), __expf(-mt[(size_t)r * 4 + h])); const float inv = 1.f / dn;
#pragma unroll
            for (int i = 0; i < 8; ++i) v[i] *= inv; }
        float ss = 0.f;
#pragma unroll
        for (int i = 0; i < 8; ++i) ss += v[i] * v[i];
        ss = grp_sum16(ss);
        const float rstd = rsqrtf(ss * (1.f / 128.f) + EPS);
        const int gcol = (mix == 0 ? 1536 : (mix == 1 ? 3584 : 5632)) + h * 128 + 8 * j;
        const u32x4_t gr = *(const u32x4_t*)(proj + (size_t)r * N1 + gcol);
        const float* nw = p.in[mix == 0 ? I_GNORM : (mix == 1 ? I_MNORM : I_HNORM)] + l * 512 + h * 128 + 8 * j;
        const float4 n0 = *(const float4*)nw, n1 = *(const float4*)(nw + 4);
        const float nwv[8] = {n0.x, n0.y, n0.z, n0.w, n1.x, n1.y, n1.z, n1.w};
#pragma unroll
        for (int i = 0; i < 4; ++i) { v[2 * i] *= rstd * nwv[2 * i] * bflo(gr[i]); v[2 * i + 1] *= rstd * nwv[2 * i + 1] * bfhi(gr[i]); }
        u32x4_t o; o[0] = pg8::cvt_pk_bf16(v[0], v[1]); o[1] = pg8::cvt_pk_bf16(v[2], v[3]); o[2] = pg8::cvt_pk_bf16(v[4], v[5]); o[3] = pg8::cvt_pk_bf16(v[6], v[7]);
        *(u32x4_t*)op = o;
    }
    const int ncs = (NBP + NBS) * 3 * 1536;
    for (int i = blockIdx.x * 512 + tid; i < ncs; i += gridDim.x * 512) {
        const int cc = i % 1536, ri = (i / 1536) % 3, bb = i / (3 * 1536);
        if (bb < NBP) p.out[O_P_GC + ((size_t)(l * NBP + bb) * 3 + ri) * 1536 + cc] = bf2f(proj[((size_t)bb * SEQ + SEQ - 3 + ri) * N1 + cc]);
        else { const int b2 = bb - NBP; p.out[O_S_GC + ((size_t)(l * NBS + b2) * 3 + ri) * 1536 + cc] = bf2f(proj[((size_t)MP + (size_t)b2 * SSEQ + 1 + ri) * N1 + cc]); }
    }
}

__device__ void phase_convffn(const Params& p, int l) {
    int tid_ = threadIdx.x; asm volatile("" : "+v"(tid_)); const int tid = tid_;
    const bf16_t* u = (const bf16_t*)(p.ws + W_PROJ);
    bf16_t* act = (bf16_t*)(p.ws + W_ACT);
    const float* cw = p.in[I_FCW] + (size_t)l * 3 * NUP; const float* cb = p.in[I_FCB] + (size_t)l * NUP;
    const int nitems = (MT / 4) * (DFF / 8);
    for (int it = blockIdx.x * 512 + tid; it < nitems; it += gridDim.x * 512) {
        const int jg = it % (DFF / 8), rbk = it / (DFF / 8), r0 = rbk * 4, jc = jg * 8;
        const bool samp = r0 >= MP; const int tf = samp ? 0 : (r0 & (SEQ - 1));
        float wa[3][8], wb[3][8], ba[8], bb[8];
#pragma unroll
        for (int i = 0; i < 3; ++i) { const float4 a0 = *(const float4*)(cw + i * NUP + jc), a1 = *(const float4*)(cw + i * NUP + jc + 4), b0 = *(const float4*)(cw + i * NUP + DFF + jc), b1 = *(const float4*)(cw + i * NUP + DFF + jc + 4);
            wa[i][0] = a0.x; wa[i][1] = a0.y; wa[i][2] = a0.z; wa[i][3] = a0.w; wa[i][4] = a1.x; wa[i][5] = a1.y; wa[i][6] = a1.z; wa[i][7] = a1.w;
            wb[i][0] = b0.x; wb[i][1] = b0.y; wb[i][2] = b0.z; wb[i][3] = b0.w; wb[i][4] = b1.x; wb[i][5] = b1.y; wb[i][6] = b1.z; wb[i][7] = b1.w; }
        { const float4 a0 = *(const float4*)(cb + jc), a1 = *(const float4*)(cb + jc + 4), b0 = *(const float4*)(cb + DFF + jc), b1 = *(const float4*)(cb + DFF + jc + 4);
            ba[0] = a0.x; ba[1] = a0.y; ba[2] = a0.z; ba[3] = a0.w; ba[4] = a1.x; ba[5] = a1.y; ba[6] = a1.z; ba[7] = a1.w;
            bb[0] = b0.x; bb[1] = b0.y; bb[2] = b0.z; bb[3] = b0.w; bb[4] = b1.x; bb[5] = b1.y; bb[6] = b1.z; bb[7] = b1.w; }
        float xa[6][8], xb[6][8];
#pragma unroll
        for (int rr = 0; rr < 6; ++rr) {
            if (rr < 2 && tf == 0) {
                if (samp) { const float* st = p.in[I_SFC] + ((size_t)(l * NBS + (r0 - MP) / 4) * 2 + rr) * NUP;
#pragma unroll
                    for (int i = 0; i < 8; ++i) { xa[rr][i] = st[jc + i]; xb[rr][i] = st[DFF + jc + i]; } }
                else {
#pragma unroll
                    for (int i = 0; i < 8; ++i) { xa[rr][i] = 0.f; xb[rr][i] = 0.f; } }
            } else { const bf16_t* ur = u + (size_t)(r0 - 2 + rr) * NUP; const u32x4_t ra = *(const u32x4_t*)(ur + jc), rbv = *(const u32x4_t*)(ur + DFF + jc);
#pragma unroll
                for (int i = 0; i < 4; ++i) { xa[rr][2 * i] = bflo(ra[i]); xa[rr][2 * i + 1] = bfhi(ra[i]); xb[rr][2 * i] = bflo(rbv[i]); xb[rr][2 * i + 1] = bfhi(rbv[i]); } }
        }
#pragma unroll
        for (int t = 0; t < 4; ++t) { float o[8];
#pragma unroll
            for (int i = 0; i < 8; ++i) { const float ya = wa[0][i] * xa[t][i] + wa[1][i] * xa[t + 1][i] + wa[2][i] * xa[t + 2][i] + ba[i]; const float yb = wb[0][i] * xb[t][i] + wb[1][i] * xb[t + 1][i] + wb[2][i] * xb[t + 2][i] + bb[i]; o[i] = silu(ya) * yb; }
            u32x4_t ov; ov[0] = pg8::cvt_pk_bf16(o[0], o[1]); ov[1] = pg8::cvt_pk_bf16(o[2], o[3]); ov[2] = pg8::cvt_pk_bf16(o[4], o[5]); ov[3] = pg8::cvt_pk_bf16(o[6], o[7]);
            *(u32x4_t*)(act + (size_t)(r0 + t) * DFF + jc) = ov; }
        if (samp || tf == SEQ - 4) {
            float* dst = samp ? p.out + O_S_FC + (size_t)(l * NBS + (r0 - MP) / 4) * 2 * NUP : p.out + O_P_FC + (size_t)(l * NBP + r0 / SEQ) * 2 * NUP;
#pragma unroll
            for (int rr = 0; rr < 2; ++rr)
#pragma unroll
                for (int i = 0; i < 8; ++i) { dst[(size_t)rr * NUP + jc + i] = xa[4 + rr][i]; dst[(size_t)rr * NUP + DFF + jc + i] = xb[4 + rr][i]; }
        }
    }
}

__device__ void phase_final_norm(const Params& p) {
    int tid_ = threadIdx.x; asm volatile("" : "+v"(tid_)); const int tid = tid_, lane = tid & 63, w = tid >> 6;
    const float* gw = p.in[I_LNF];
    float4 g4[4];
#pragma unroll
    for (int i = 0; i < 4; ++i) g4[i] = *(const float4*)(gw + lane * 4 + 256 * i);
    for (int row = blockIdx.x * 8 + w; row < MT; row += gridDim.x * 8) {
        float* xr = p.out + (size_t)row * DM; float4 v[4]; float ss = 0.f;
#pragma unroll
        for (int i = 0; i < 4; ++i) { v[i] = *(const float4*)(xr + lane * 4 + 256 * i); ss += v[i].x * v[i].x + v[i].y * v[i].y + v[i].z * v[i].z + v[i].w * v[i].w; }
        ss = wave_sum(ss); const float rstd = rsqrtf(ss * (1.f / 1024.f) + EPS);
#pragma unroll
        for (int i = 0; i < 4; ++i) { v[i].x *= rstd * g4[i].x; v[i].y *= rstd * g4[i].y; v[i].z *= rstd * g4[i].z; v[i].w *= rstd * g4[i].w; *(float4*)(xr + lane * 4 + 256 * i) = v[i]; }
    }
}

#ifndef PHM
#define PHM 0xFFFF
#endif
__global__ void __launch_bounds__(512, 2) fwd_megakernel(Params p) {
    extern __shared__ __attribute__((aligned(16))) unsigned char shm[];
    cg::grid_group grid = cg::this_grid();
    float* smf = (float*)shm;
    PG8_LAS unsigned char* lds = (PG8_LAS unsigned char*)shm;
    int tid_ = threadIdx.x; asm volatile("" : "+v"(tid_)); const int tid = tid_, G = (int)gridDim.x, bid = (int)blockIdx.x;
    float* X = p.out;
    bf16_t* hbf = (bf16_t*)(p.ws + W_HBF);
    bf16_t* proj = (bf16_t*)(p.ws + W_PROJ);

    for (int l = 0; l < 2; ++l) {
        if (PHM & 1) { int tc = 0;
          conv_T(p.in[I_WIN] + (size_t)l * 1024 * NIN, NIN, (bf16_t*)(p.ws + W_WIN), 1024, N1, true, smf, tc);
          for (int n = 0; n < 3; ++n) conv_T(p.in[I_WBR] + ((size_t)l * 3 + n) * 512 * 1024, 1024, (bf16_t*)(p.ws + W_WBR) + (size_t)n * 1024 * 512, 512, 1024, false, smf, tc);
          conv_T(p.in[I_WOUT] + (size_t)l * 1024 * 1024, 1024, (bf16_t*)(p.ws + W_WOUT), 1024, 1024, false, smf, tc);
          conv_T(p.in[I_WUP] + (size_t)l * 1024 * NUP, NUP, (bf16_t*)(p.ws + W_WUP), 1024, NUP, false, smf, tc);
          conv_T(p.in[I_WDN] + (size_t)l * DFF * 1024, 1024, (bf16_t*)(p.ws + W_WDN), DFF, 1024, false, smf, tc);
          __syncthreads(); }
        if (PHM & 2) { if (l == 0) {
            const float4* s0 = (const float4*)p.in[I_XP]; const float4* s1 = (const float4*)p.in[I_XS]; float4* d = (float4*)X;
            const size_t n0 = (size_t)MP * DM / 4, n1 = (size_t)MS * DM / 4;
            for (size_t i = (size_t)bid * 512 + tid; i < n0 + n1; i += (size_t)G * 512) d[i] = i < n0 ? s0[i] : s1[i - n0];
            phase_rmsnorm(p, l, p.in[I_XP], p.in[I_XS], p.in[I_LNMIX] + l * DM, hbf, true, smf);
        } else phase_rmsnorm(p, l, X, X + (size_t)MP * DM, p.in[I_LNMIX] + l * DM, hbf, true, smf); }
        grid.sync();
        if (PHM & 4) { pg8::Gemm g{hbf, (const bf16_t*)(p.ws + W_WIN), MT, N1, 1024}; pg8::StaticOrder S; S.init(MT, N1, G, bid); EpiProj E{proj, N1, 1}; pg8::gemm_phase(lds, g, S, E); }
        grid.sync();
        if (PHM & 8) for (int it = bid; it < 256; it += G) {
            if (it < 128) scan_prompt_item<0>(p, l, (it >> 2) >> 2, (it >> 2) & 3, it & 3, smf);
            else if (it < 192) { const int q = it - 128; scan_prompt_item<1>(p, l, (q >> 1) >> 2, (q >> 1) & 3, q & 1, smf); }
            else { const int q = it - 192; scan_prompt_item<2>(p, l, (q >> 1) >> 2, (q >> 1) & 3, q & 1, smf); }
        }
        if (PHM & 16) for (int it = bid; it < 3 * NBS * NH; it += G) { const int mix = it / (NBS * NH), r = it - mix * (NBS * NH); scan_sample_item(p, l, mix, r >> 2, r & 3, smf); }
        grid.sync();
        if (PHM & 32) phase_postnorm(p, l);
        grid.sync();
        if (PHM & 64) for (int n = 0; n < 3; ++n) { pg8::Gemm g{(const bf16_t*)(p.ws + W_OUTS) + (size_t)n * MT * 512, (const bf16_t*)(p.ws + W_WBR) + (size_t)n * 1024 * 512, MT, 1024, 512};
            pg8::StaticOrder S; S.init(MT, 1024, G, bid); EpiMerge E{proj + 6144 + n * 1024, hbf, n == 0}; pg8::gemm_phase(lds, g, S, E); }
        grid.sync();
        if (PHM & 128) { pg8::Gemm g{hbf, (const bf16_t*)(p.ws + W_WOUT), MT, 1024, 1024}; pg8::StaticOrder S; S.init(MT, 1024, G, bid); EpiResid E{X}; pg8::gemm_phase(lds, g, S, E); }
        grid.sync();
        if (PHM & 256) phase_rmsnorm(p, l, X, X + (size_t)MP * DM, p.in[I_LNFFN] + l * DM, hbf, false, smf);
        grid.sync();
        if (PHM & 512) { pg8::Gemm g{hbf, (const bf16_t*)(p.ws + W_WUP), MT, NUP, 1024}; pg8::StaticOrder S; S.init(MT, NUP, G, bid); EpiProj E{proj, NUP, 0}; pg8::gemm_phase(lds, g, S, E); }
        grid.sync();
        if (PHM & 1024) phase_convffn(p, l);
        grid.sync();
        if (PHM & 2048) { pg8::Gemm g{(const bf16_t*)(p.ws + W_ACT), (const bf16_t*)(p.ws + W_WDN), MT, 1024, DFF}; pg8::StaticOrder S; S.init(MT, 1024, G, bid); EpiResid E{X}; pg8::gemm_phase(lds, g, S, E); }
        grid.sync();
    }
    if (PHM & 4096) phase_final_norm(p);
}

extern "C" void kernel_launch(void* const* d_in, const int* in_sizes, int n_in, void* d_out, int out_size, void* d_ws, size_t ws_size, hipStream_t stream) {
    static int grid_blocks = 0;
    if (grid_blocks == 0) {
        if (n_in != 28 || (size_t)out_size != O_END || ws_size < W_END) { fprintf(stderr, "kernel_launch: unexpected shapes: n_in %d out %d (want %zu) ws %zu (need %zu)\n", n_in, out_size, (size_t)O_END, ws_size, (size_t)W_END); grid_blocks = -1; return; }
        int dev = 0, cus = 0, per_cu = 0;
        hipGetDevice(&dev); hipDeviceGetAttribute(&cus, hipDeviceAttributeMultiprocessorCount, dev);
        if (hipFuncSetAttribute((const void*)fwd_megakernel, hipFuncAttributeMaxDynamicSharedMemorySize, LDS_BYTES) != hipSuccess) { fprintf(stderr, "kernel_launch: hipFuncSetAttribute failed\n"); grid_blocks = -1; return; }
        if (hipOccupancyMaxActiveBlocksPerMultiprocessor(&per_cu, (const void*)fwd_megakernel, 512, LDS_BYTES) != hipSuccess || per_cu < 1) { fprintf(stderr, "kernel_launch: occupancy query gave %d\n", per_cu); per_cu = 1; (void)hipGetLastError(); }
        grid_blocks = cus * per_cu;
    }
    if (grid_blocks < 0) return;
    Params p{};
    for (int i = 0; i < 28; ++i) p.in[i] = (const float*)d_in[i];
    p.out = (float*)d_out; p.ws = (unsigned char*)d_ws;
    void* args[] = {&p};
    hipError_t e = hipLaunchCooperativeKernel((const void*)fwd_megakernel, dim3(grid_blocks), dim3(512), args, LDS_BYTES, stream);
    if (e != hipSuccess) fprintf(stderr, "kernel_launch: cooperative launch failed: %s (grid %d)\n", hipGetErrorString(e), grid_blocks);
}
```

```cpp
#include <hip/hip_runtime.h>
#include <hip/hip_cooperative_groups.h>
#include <cstdio>
namespace cg = cooperative_groups;
namespace pg8 {
#define PG8_LAS __attribute__((address_space(3)))
typedef unsigned short bf16_t;
typedef short bf16x8 __attribute__((ext_vector_type(8)));
typedef float f32x4 __attribute__((ext_vector_type(4)));
typedef unsigned u32x4 __attribute__((ext_vector_type(4)));
constexpr int BM = 256, BK = 64, HALF = 128, HTB = HALF * BK * 2  , STAGE_BYTES = 8 * HTB, NXCD = 8, WGM = 8;

__host__ __device__ __forceinline__ int lds_byte(int r, int c) { const int st = (r >> 4) * 2 + (c >> 5), rr = r & 15, cc = c & 31, ob = rr * 64 + cc * 2; return st * 1024 + (ob ^ (((ob >> 9) & 1) << 5)); }
__host__ __device__ __forceinline__ void stage_rc(int b, int& R, int& C) { const int st = b / 1024, sb = b % 1024, swz = sb ^ (((sb >> 9) & 1) << 5); R = (st >> 1) * 16 + swz / 64; C = (st & 1) * 32 + (swz % 64) / 2; }
__host__ __device__ __forceinline__ int perm32(int rho) { const int n = rho >> 4, i = rho & 15; return 8 * (i >> 2) + 4 * n + (i & 3); }

struct Unit { int pm, pn; };
struct Gemm { const bf16_t* A; const bf16_t* Bt; int M, N, K; };

struct StaticOrder {
    int nM, nN, nwg, G, c;
    __host__ __device__ void init(int M, int N, int G_, int c_) { nM = M / BM; nN = N / BM; nwg = nM * nN; G = G_; c = c_; }
    __host__ __device__ bool next(int i, Unit& u) const {
        const long L = (long)i * G + c; if (L >= nwg) return false;
        int wgid = (int)L; { const int q = nwg / NXCD, r = nwg % NXCD, xcd = wgid % NXCD, off = wgid / NXCD; wgid = (xcd < r ? xcd * (q + 1) : r * (q + 1) + (xcd - r) * q) + off; }
        const int nig = WGM * nN, gid = wgid / nig, fm = gid * WGM, gsz = (nM - fm) < WGM ? (nM - fm) : WGM;
        u.pm = fm + ((wgid % nig) % gsz); u.pn = (wgid % nig) / gsz; return true;
    }
    __device__ __forceinline__ void a_ready(const Unit&) const {}
    __device__ __forceinline__ void done(const Unit&) const {}
};
__device__ __forceinline__ unsigned cvt_pk_bf16(float lo, float hi) { unsigned r; asm volatile("v_cvt_pk_bf16_f32 %0, %1, %2" : "=v"(r) : "v"(lo), "v"(hi)); return r; }
template <class Epi, class Sched>
__device__ __forceinline__ void gemm_phase(PG8_LAS unsigned char* lds, const Gemm g, const Sched& S, const Epi& E) {
    int tid_ = threadIdx.x; asm volatile("" : "+v"(tid_));
    const int tid = tid_, wid = __builtin_amdgcn_readfirstlane(tid >> 6), lane = tid & 63, wr = wid >> 2, wc = wid & 3, fr = lane & 15, fq = lane >> 4;
    const int K = g.K, nt = K / BK;
    unsigned voffA[2], voffB[2];
#pragma unroll
    for (int i = 0; i < 2; ++i) { int R, C; stage_rc(tid * 16 + i * 8192, R, C); const int Rb = Epi::PERM ? ((R & ~31) + perm32(R & 31)) : R;
        voffA[i] = (unsigned)(R * K + C) * 2u; voffB[i] = (unsigned)(Rb * K + C) * 2u; }
    const size_t kstep = (size_t)(BK * 2);
    const size_t hstep = (size_t)HALF * K * 2;
    const size_t tstep = 2 * hstep;
    const unsigned ldsw = (unsigned)wid * 1024u;
    const int aoff = lds_byte(wr * 64 + fr, fq * 8), boff = lds_byte(wc * 32 + fr, fq * 8);
#define PG8_SA(b, h) (((b) * 2 + (h)) * HTB)
#define PG8_SB(b, h) ((4 + (b) * 2 + (h)) * HTB)
#define PG8_STAGE(bufoff, gbase, voff) do { _Pragma("unroll") for (int _i = 0; _i < 2; ++_i) \
        __builtin_amdgcn_global_load_lds((const unsigned*)((const char*)(gbase) + (voff)[_i]), (PG8_LAS unsigned*)(lds + (bufoff) + ldsw + _i * 8192), 16, 0, 0); } while (0)
#define PG8_LDA(dst, b, h) do { _Pragma("unroll") for (int m = 0; m < 4; ++m) _Pragma("unroll") for (int k = 0; k < 2; ++k) dst[m][k] = *(const PG8_LAS bf16x8*)(lds + PG8_SA(b, h) + aoff + m * 2048 + k * 1024); } while (0)
#define PG8_LDB(dst, b, h) do { _Pragma("unroll") for (int n = 0; n < 2; ++n) _Pragma("unroll") for (int k = 0; k < 2; ++k) dst[n][k] = *(const PG8_LAS bf16x8*)(lds + PG8_SB(b, h) + boff + n * 2048 + k * 1024); } while (0)
#define PG8_MMA(ai, bj, At, Bt) do { __builtin_amdgcn_s_setprio(1); _Pragma("unroll") for (int m = 0; m < 4; ++m) _Pragma("unroll") for (int n = 0; n < 2; ++n) _Pragma("unroll") for (int k = 0; k < 2; ++k) \
        acc[ai][bj][m][n] = __builtin_amdgcn_mfma_f32_16x16x32_bf16(Bt[n][k], At[m][k], acc[ai][bj][m][n], 0, 0, 0); __builtin_amdgcn_s_setprio(0); } while (0)
#define PG8_WAIT_V(n) asm volatile("s_waitcnt vmcnt(" #n ")" ::: "memory")
#define PG8_WAIT_L(n) asm volatile("s_waitcnt lgkmcnt(" #n ")" ::: "memory")
#define PG8_BAR __builtin_amdgcn_s_barrier()
#define PG8_SCHED __builtin_amdgcn_sched_barrier(0)
    Unit cur, nxt; int ui = 0;
    if (!S.next(0, cur)) return;
    f32x4 acc[2][2][4][2];
#pragma unroll
    for (int a = 0; a < 2; ++a)
#pragma unroll
        for (int b = 0; b < 2; ++b)
#pragma unroll
            for (int m = 0; m < 4; ++m)
#pragma unroll
                for (int n = 0; n < 2; ++n) acc[a][b][m][n] = (f32x4){0.f, 0.f, 0.f, 0.f};
    bf16x8 At[4][2], B0[2][2], B1[2][2];
    const char* cA = (const char*)g.A + (size_t)cur.pm * tstep; const char* cB = (const char*)g.Bt + (size_t)cur.pn * tstep;
    S.a_ready(cur);
    PG8_STAGE(PG8_SB(0, 0), cB, voffB); PG8_STAGE(PG8_SA(0, 0), cA, voffA); PG8_STAGE(PG8_SB(0, 1), cB + hstep, voffB); PG8_STAGE(PG8_SA(0, 1), cA + hstep, voffA);
    if (wr == 1) PG8_BAR;
    PG8_WAIT_V(4); PG8_BAR;
    PG8_STAGE(PG8_SB(1, 0), cB + kstep, voffB); PG8_STAGE(PG8_SA(1, 0), cA + kstep, voffA); PG8_STAGE(PG8_SB(1, 1), cB + hstep + kstep, voffB);
    PG8_WAIT_V(6); PG8_BAR;
    for (;;) {
        const bool has_next = S.next(ui + 1, nxt);
        const char* nA = has_next ? (const char*)g.A + (size_t)nxt.pm * tstep : cA; const char* nB = has_next ? (const char*)g.Bt + (size_t)nxt.pn * tstep : cB;
        for (int t = 0; t < nt; t += 2) {
            const bool last = (t == nt - 2);
            const char* a1 = cA + (size_t)(t + 1) * kstep;
            const char* a2 = last ? nA : cA + (size_t)(t + 2) * kstep; const char* b2 = last ? nB : cB + (size_t)(t + 2) * kstep;
            const char* a3 = a2 + kstep; const char* b3 = b2 + kstep;
            if (last && has_next) S.a_ready(nxt);
            PG8_LDB(B0, 0, 0); PG8_SCHED; PG8_LDA(At, 0, 0); PG8_STAGE(PG8_SA(1, 1), a1 + hstep, voffA);
            PG8_WAIT_L(8); PG8_BAR; PG8_WAIT_L(0); PG8_MMA(0, 0, At, B0); PG8_BAR; PG8_SCHED;
            PG8_LDB(B1, 0, 1); PG8_STAGE(PG8_SB(0, 0), b2, voffB);
            PG8_BAR; PG8_WAIT_L(0); PG8_MMA(0, 1, At, B1); PG8_BAR;
            PG8_LDA(At, 0, 1); PG8_STAGE(PG8_SA(0, 0), a2, voffA);
            PG8_BAR; PG8_WAIT_L(0); PG8_MMA(1, 0, At, B0); PG8_BAR; PG8_SCHED;
            PG8_STAGE(PG8_SB(0, 1), b2 + hstep, voffB);
            PG8_WAIT_V(6); PG8_BAR; PG8_MMA(1, 1, At, B1); PG8_BAR;
            PG8_LDB(B0, 1, 0); PG8_SCHED; PG8_LDA(At, 1, 0); PG8_STAGE(PG8_SA(0, 1), a2 + hstep, voffA);
            PG8_WAIT_L(8); PG8_BAR; PG8_WAIT_L(0); PG8_MMA(0, 0, At, B0); PG8_BAR; PG8_SCHED;
            PG8_LDB(B1, 1, 1); PG8_STAGE(PG8_SB(1, 0), b3, voffB);
            PG8_BAR; PG8_WAIT_L(0); PG8_MMA(0, 1, At, B1); PG8_BAR;
            PG8_LDA(At, 1, 1); PG8_STAGE(PG8_SA(1, 0), a3, voffA);
            PG8_BAR; PG8_WAIT_L(0); PG8_MMA(1, 0, At, B0); PG8_BAR; PG8_SCHED;
            PG8_STAGE(PG8_SB(1, 1), b3 + hstep, voffB);
            PG8_WAIT_V(6); PG8_BAR; PG8_MMA(1, 1, At, B1); PG8_BAR;
        }
        if constexpr (!Epi::AFTER_DRAIN) { E(acc, cur, wr, wc, fr, fq); S.done(cur); }
        if (!has_next) break;
#pragma unroll
        for (int a = 0; a < 2; ++a)
#pragma unroll
            for (int b = 0; b < 2; ++b)
#pragma unroll
                for (int m = 0; m < 4; ++m)
#pragma unroll
                    for (int n = 0; n < 2; ++n) acc[a][b][m][n] = (f32x4){0.f, 0.f, 0.f, 0.f};
        cur = nxt; cA = nA; cB = nB; ++ui;
    }
    PG8_WAIT_V(0);
    if (wr == 0) PG8_BAR;
    PG8_BAR;
    if constexpr (Epi::AFTER_DRAIN) { E.fused(acc, cur, wr, wc, fr, fq, lds, wid, lane); S.done(cur); }
#undef PG8_SA
#undef PG8_SB
#undef PG8_STAGE
#undef PG8_LDA
#undef PG8_LDB
#undef PG8_MMA
#undef PG8_WAIT_V
#undef PG8_WAIT_L
#undef PG8_BAR
#undef PG8_SCHED
}
}

#define XB_TMO      128
#define XB_XCNT(j)  (256  + 64 * (j))
#define XB_XSUB(j)  (1280 + 64 * (j))
#define XB_XGEN(j)  (2304 + 64 * (j))
#define XB_TOP      3328
#define XB_TOPGEN   3392
#define XCD_BAR_WORDS 3456
#define XB_SPIN_CAP (1u << 18)
#define XLAS __attribute__((address_space(3)))

__device__ __forceinline__ unsigned xb_ld(unsigned* p)              { return __hip_atomic_load(p, __ATOMIC_RELAXED, __HIP_MEMORY_SCOPE_AGENT); }
__device__ __forceinline__ unsigned xb_add(unsigned* p, unsigned v) { return __hip_atomic_fetch_add(p, v, __ATOMIC_RELAXED, __HIP_MEMORY_SCOPE_AGENT); }
__device__ __forceinline__ unsigned xb_xcc_id() { return (unsigned)__builtin_amdgcn_s_getreg((3 << 11) | 20) & 0xFu; }
#define XB_SPIN(cond, bar) do { unsigned _sp = 0; while (cond) { __builtin_amdgcn_s_sleep(1); \
    if ((++_sp & 255u) == 0u) { if (xb_ld(&(bar)[XB_TMO])) break; if (_sp > XB_SPIN_CAP) { atomicAdd(&(bar)[XB_TMO], 1u); break; } } } } while (0)

struct XcdBarrier {
    unsigned* bar; unsigned x;
    volatile XLAS unsigned* st;
};

__device__ __forceinline__ XcdBarrier xcd_barrier_post(unsigned* bar, volatile XLAS unsigned* st) {
    XcdBarrier b; b.bar = bar; b.x = xb_xcc_id(); b.st = st;
    if (threadIdx.x == 0) (void)xb_add(&bar[XB_XCNT(b.x)], 1u);
    return b;
}
__device__ __forceinline__ void xcd_barrier_complete(unsigned* bar, unsigned x, unsigned& nloc, unsigned& nx) {
    const unsigned G = gridDim.x * gridDim.y * gridDim.z;
    unsigned sum, cnt, mine, sp = 0u;
    for (;;) {
        sum = 0u; cnt = 0u; mine = 0u;
#pragma unroll
        for (unsigned j = 0; j < 16; ++j) { const unsigned c = xb_ld(&bar[XB_XCNT(j)]); sum += c; cnt += (c > 0u) ? 1u : 0u; mine = (j == x) ? c : mine; }
        if (sum == G) break;
        __builtin_amdgcn_s_sleep(1);
        if ((++sp & 255u) == 0u) { if (xb_ld(&bar[XB_TMO])) break; if (sp > XB_SPIN_CAP) { atomicAdd(&bar[XB_TMO], 1u); break; } }
    }
    nloc = mine > 0u ? mine : 1u; nx = cnt > 0u ? cnt : 1u;
}

__device__ __forceinline__ void xcd_barrier(const XcdBarrier& b) {
    asm volatile("s_waitcnt vmcnt(0)" ::: "memory");
    __syncthreads();
    if (threadIdx.x == 0) {
        unsigned* bar = b.bar;
        __builtin_amdgcn_s_waitcnt(0);
        unsigned nloc = b.st[0], nx = b.st[1];
        if (nloc == 0u) { xcd_barrier_complete(bar, b.x, nloc, nx); b.st[0] = nloc; b.st[1] = nx; }
        const unsigned old = xb_add(&bar[XB_XSUB(b.x)], 1u);
        const unsigned gen = old / nloc;
        if (old + 1u == (gen + 1u) * nloc) {
            __builtin_amdgcn_fence(__ATOMIC_RELEASE, "agent");
            asm volatile("s_waitcnt vmcnt(0)" ::: "memory");
            const unsigned og = xb_add(&bar[XB_TOP], 1u);
            const unsigned tg = og / nx;
            if (og + 1u == (tg + 1u) * nx) xb_add(&bar[XB_TOPGEN], 1u);
            else XB_SPIN(xb_ld(&bar[XB_TOPGEN]) == tg, bar);
            __builtin_amdgcn_fence(__ATOMIC_ACQUIRE, "agent");
            xb_add(&bar[XB_XGEN(b.x)], 1u);
            asm volatile("s_waitcnt vmcnt(0)" ::: "memory");
        } else {
            XB_SPIN(xb_ld(&bar[XB_XGEN(b.x)]) == gen, bar);
            __builtin_amdgcn_fence(__ATOMIC_ACQUIRE, "agent");
            asm volatile("s_waitcnt vmcnt(0)" ::: "memory");
        }
    }
    __syncthreads();
}

using pg8::bf16_t; using pg8::f32x4; using pg8::bf16x8;
typedef unsigned u32x4_t __attribute__((ext_vector_type(4)));
typedef unsigned u32x2_t __attribute__((ext_vector_type(2)));

constexpr int DM = 1024, NBP = 8, SEQ = 2048, NBS = 128, SSEQ = 4, NH = 4, HD = 128, MW = 512;
constexpr int MP = NBP * SEQ, MS = NBS * SSEQ, MT = MP + MS;
constexpr int NIN = 9232, N1 = 9216, DFF = 2816, NUP = 5632;
constexpr float EPS = 1e-6f;
constexpr float QSCALE = 0.08838834764831845f;

constexpr size_t O_Y = 0;
constexpr size_t O_P_GS = (size_t)MT * DM;
constexpr size_t O_P_GC = O_P_GS + (size_t)2 * 8 * 4 * 128 * 128;
constexpr size_t O_P_MC = O_P_GC + (size_t)2 * 8 * 3 * 1536;
constexpr size_t O_P_MN = O_P_MC + (size_t)2 * 8 * 4 * 128 * 128;
constexpr size_t O_P_MM = O_P_MN + (size_t)2 * 8 * 4 * 128;
constexpr size_t O_P_HS = O_P_MM + (size_t)2 * 8 * 4;
constexpr size_t O_P_FC = O_P_HS + (size_t)2 * 8 * 4 * 128 * 128;
constexpr size_t O_S_GS = O_P_FC + (size_t)2 * 8 * 2 * 5632;
constexpr size_t O_S_GC = O_S_GS + (size_t)2 * 128 * 4 * 128 * 128;
constexpr size_t O_S_MC = O_S_GC + (size_t)2 * 128 * 3 * 1536;
constexpr size_t O_S_MN = O_S_MC + (size_t)2 * 128 * 4 * 128 * 128;
constexpr size_t O_S_MM = O_S_MN + (size_t)2 * 128 * 4 * 128;
constexpr size_t O_S_HS = O_S_MM + (size_t)2 * 128 * 4;
constexpr size_t O_S_FC = O_S_HS + (size_t)2 * 128 * 4 * 128 * 128;
constexpr size_t O_END  = O_S_FC + (size_t)2 * 128 * 2 * 5632;

constexpr size_t W_WIN = 0;
constexpr size_t W_WBR = W_WIN + (size_t)N1 * 1024 * 2;
constexpr size_t W_WOUT = W_WBR + (size_t)3 * 1024 * 512 * 2;
constexpr size_t W_WUP = W_WOUT + (size_t)1024 * 1024 * 2;
constexpr size_t W_WDN = W_WUP + (size_t)NUP * 1024 * 2;
constexpr size_t W_HBF = W_WDN + (size_t)1024 * DFF * 2;
constexpr size_t W_PROJ = W_HBF + (size_t)MT * 1024 * 2;
constexpr size_t W_ACT = W_PROJ + (size_t)MT * NUP * 2;
constexpr size_t W_OUTS = W_PROJ + (size_t)MT * N1 * 2;
constexpr size_t W_GATES = W_OUTS + (size_t)3 * MT * 512 * 2;
constexpr size_t W_DEN = W_GATES + (size_t)MT * 16 * 4;
constexpr size_t W_MT = W_DEN + (size_t)MT * 4 * 4;
constexpr size_t W_BAR = W_MT + (size_t)MT * 4 * 4;
constexpr size_t W_END = W_BAR + 16384;

constexpr int LDS_BYTES = 131072 + 16;

struct Params { const float* in[28]; float* out; unsigned char* ws; };
enum { I_XP = 0, I_XS, I_SGS, I_SGC, I_SMC, I_SMN, I_SMM, I_SHS, I_SFC, I_LNMIX, I_WIN, I_GCW, I_ALOG, I_DTB, I_GNORM, I_MIB, I_MFB, I_MNORM, I_HLB, I_HNORM,
       I_WBR, I_WOUT, I_LNFFN, I_WUP, I_FCW, I_FCB, I_WDN, I_LNF };

typedef const float* const __attribute__((address_space(4))) * kargp_t;
__device__ __forceinline__ const float* argp(int i) { kargp_t kp = (kargp_t)__builtin_amdgcn_kernarg_segment_ptr(); asm volatile("" : "+s"(i)); return kp[i]; }
__device__ __forceinline__ int bidx() { int b = (int)blockIdx.x; asm volatile("" : "+s"(b)); return b; }
__device__ __forceinline__ int gdim() { int g = (int)gridDim.x; asm volatile("" : "+s"(g)); return g; }
#define PIN(i) argp(i)
#define POUT ((float*)argp(28))
#define PWS ((unsigned char*)argp(29))
__device__ __forceinline__ float bf2f(bf16_t b) { return __uint_as_float(((unsigned)b) << 16); }
__device__ __forceinline__ float bflo(unsigned u) { return __uint_as_float(u << 16); }
__device__ __forceinline__ float bfhi(unsigned u) { return __uint_as_float(u & 0xffff0000u); }
__device__ __forceinline__ bf16_t f2bf(float f) { return (bf16_t)(pg8::cvt_pk_bf16(f, 0.f) & 0xffffu); }
__device__ __forceinline__ float sigm(float x) { return __builtin_amdgcn_rcpf(1.f + __expf(-x)); }
__device__ __forceinline__ float silu(float x) { return x * sigm(x); }
template <int CTRL> __device__ __forceinline__ float dppf(float x) { return __builtin_bit_cast(float, __builtin_amdgcn_update_dpp(0, __builtin_bit_cast(int, x), CTRL, 0xf, 0xf, true)); }
__device__ __forceinline__ float grp_sum8(float x) { x += dppf<0xB1>(x); x += dppf<0x4E>(x); x += dppf<0x141>(x); return x; }
__device__ __forceinline__ float grp_sum16(float x) { x = grp_sum8(x); x += dppf<0x140>(x); return x; }
__device__ __forceinline__ float wave_sum(float x) { x = grp_sum16(x); x += __shfl_xor(x, 16); x += __shfl_xor(x, 32); return x; }
template <int T> __device__ __forceinline__ float grp_sum(float x) { if constexpr (T == 16) return grp_sum16(x); else return grp_sum8(x); }

__device__ __forceinline__ int win_srccol(int n0) { const int blk = n0 >> 9, r = n0 & 511; int base;
    if (blk < 4) base = blk * 512; else if (blk < 8) base = 2056 + (blk - 4) * 512; else if (blk < 12) base = 4112 + (blk - 8) * 512; else base = 6160 + (blk - 12) * 512;
    return base + r; }
__device__ __forceinline__ void conv_T(const float* __restrict__ src, int ld, bf16_t* __restrict__ dst, int K, int N, bool winmap, float* tile, int& tcount) {
    int tid_ = threadIdx.x; asm volatile("" : "+v"(tid_)); const int tid = tid_, ntn = N / 64, ntiles = ntn * (K / 64);
    for (int t = bidx() - (tcount % gdim()); t < ntiles; t += gdim()) {
        if (t < 0) continue;
        const int tn = t % ntn, tk = t / ntn, n0 = tn * 64, k0 = tk * 64, sc0 = winmap ? win_srccol(n0) : n0;
        __syncthreads();
        { const int kk = tid >> 4, n4 = (tid & 15) * 4;
#pragma unroll
          for (int pp = 0; pp < 2; ++pp) { const float4 v = *(const float4*)(src + (size_t)(k0 + kk + 32 * pp) * ld + sc0 + n4); float* tp = tile + (kk + 32 * pp) * 65 + n4; tp[0] = v.x; tp[1] = v.y; tp[2] = v.z; tp[3] = v.w; } }
        __syncthreads();
        { const int n = tid >> 3, k8 = (tid & 7) * 8; float f[8];
#pragma unroll
          for (int i = 0; i < 8; ++i) f[i] = tile[(k8 + i) * 65 + n];
          u32x4_t o; o[0] = pg8::cvt_pk_bf16(f[0], f[1]); o[1] = pg8::cvt_pk_bf16(f[2], f[3]); o[2] = pg8::cvt_pk_bf16(f[4], f[5]); o[3] = pg8::cvt_pk_bf16(f[6], f[7]);
          *(u32x4_t*)(dst + (size_t)(n0 + n) * K + k0 + k8) = o; }
    }
    tcount += ntiles;
}

__device__ __forceinline__ void phase_rmsnorm(const Params& p, int l, const float* xa, const float* xb, const float* __restrict__ gw, bf16_t* __restrict__ hout, bool do_gates, float* sm) {
    int tid_ = threadIdx.x; asm volatile("" : "+v"(tid_)); const int tid = tid_, lane = tid & 63, w = tid >> 6;
    float* wgT = sm;
    if (do_gates) {
        const float* win = PIN(I_WIN) + (size_t)l * 1024 * NIN;
        __syncthreads();
        for (int i = tid; i < 16 * 1024; i += 512) { const int k = i >> 4, j = i & 15; const int gc = j < 8 ? 2048 + j : 4104 + (j - 8); wgT[j * 1024 + k] = win[(size_t)k * NIN + gc]; }
        __syncthreads();
    }
    float4 g4[4];
#pragma unroll
    for (int i = 0; i < 4; ++i) g4[i] = *(const float4*)(gw + lane * 4 + 256 * i);
    for (int row = bidx() * 8 + w; row < MT; row += gdim() * 8) {
        const float* xr = row < MP ? xa + (size_t)row * DM : xb + (size_t)(row - MP) * DM;
        float4 v[4]; float ss = 0.f;
#pragma unroll
        for (int i = 0; i < 4; ++i) { v[i] = *(const float4*)(xr + lane * 4 + 256 * i); ss += v[i].x * v[i].x + v[i].y * v[i].y + v[i].z * v[i].z + v[i].w * v[i].w; }
        ss = wave_sum(ss);
        const float rstd = rsqrtf(ss * (1.f / 1024.f) + EPS);
#pragma unroll
        for (int i = 0; i < 4; ++i) { v[i].x *= rstd * g4[i].x; v[i].y *= rstd * g4[i].y; v[i].z *= rstd * g4[i].z; v[i].w *= rstd * g4[i].w;
            u32x2_t o; o[0] = pg8::cvt_pk_bf16(v[i].x, v[i].y); o[1] = pg8::cvt_pk_bf16(v[i].z, v[i].w);
            *(u32x2_t*)(hout + (size_t)row * DM + lane * 4 + 256 * i) = o; }
        if (do_gates) {
            float mine = 0.f;
#pragma unroll
            for (int j = 0; j < 16; ++j) { float a = 0.f;
#pragma unroll
                for (int i = 0; i < 4; ++i) { const float4 wv = *(const float4*)(wgT + j * 1024 + lane * 4 + 256 * i); a += v[i].x * wv.x + v[i].y * wv.y + v[i].z * wv.z + v[i].w * wv.w; }
                a = wave_sum(a); if (lane == j) mine = a; }
            if (lane < 16) { const int h = lane & 3, kind = lane >> 2; float r;
                if (kind == 0) r = sigm(mine);
                else if (kind == 1) { const float xx = mine + PIN(I_DTB)[l * 4 + h]; const float sp = xx > 20.f ? xx : log1pf(__expf(xx)); r = __expf(-__expf(PIN(I_ALOG)[l * 4 + h]) * sp); }
                else if (kind == 2) r = mine + PIN(I_MIB)[l * 4 + h];
                else { const float xx = -(mine + PIN(I_MFB)[l * 4 + h]); r = -(xx > 20.f ? xx : log1pf(__expf(xx))); }
                ((float*)(PWS + W_GATES))[(size_t)row * 16 + lane] = r; }
        }
    }
}

struct EpiProj {
    static constexpr bool PERM = true, AFTER_DRAIN = false;
    bf16_t* O; int ldc; int actmode;
    __device__ __forceinline__ void operator()(const f32x4 (&acc)[2][2][4][2], const pg8::Unit& u, int wr, int wc, int fr, int fq) const {
        const int row0 = u.pm * 256 + wr * 64 + fr, col0 = u.pn * 256 + wc * 32 + 8 * fq;
        int act = 0;
        if (actmode) { const int pn = u.pn; act = (pn >= 24 || pn == 14 || pn == 15) ? 2 : ((pn == 6 || pn == 7 || pn == 16 || pn == 17 || pn == 22 || pn == 23) ? 1 : 0); }
#pragma unroll
        for (int ai = 0; ai < 2; ++ai)
#pragma unroll
            for (int m = 0; m < 4; ++m) { bf16_t* rowp = O + (size_t)(row0 + ai * 128 + m * 16) * ldc + col0;
#pragma unroll
                for (int bj = 0; bj < 2; ++bj) { float v[8];
#pragma unroll
                    for (int i = 0; i < 4; ++i) { v[i] = acc[ai][bj][m][0][i]; v[4 + i] = acc[ai][bj][m][1][i]; }
                    if (act == 1) {
#pragma unroll
                        for (int i = 0; i < 8; ++i) v[i] = silu(v[i]); }
                    else if (act == 2) {
#pragma unroll
                        for (int i = 0; i < 8; ++i) v[i] = sigm(v[i]); }
                    u32x4_t o; o[0] = pg8::cvt_pk_bf16(v[0], v[1]); o[1] = pg8::cvt_pk_bf16(v[2], v[3]); o[2] = pg8::cvt_pk_bf16(v[4], v[5]); o[3] = pg8::cvt_pk_bf16(v[6], v[7]);
                    *(u32x4_t*)(rowp + bj * 128) = o; } }
    }
};
struct EpiMerge {
    static constexpr bool PERM = true, AFTER_DRAIN = false;
    const bf16_t* G; bf16_t* Mx; int first;
    __device__ __forceinline__ void operator()(const f32x4 (&acc)[2][2][4][2], const pg8::Unit& u, int wr, int wc, int fr, int fq) const {
        const int row0 = u.pm * 256 + wr * 64 + fr, col0 = u.pn * 256 + wc * 32 + 8 * fq;
#pragma unroll
        for (int ai = 0; ai < 2; ++ai)
#pragma unroll
            for (int m = 0; m < 4; ++m) { const size_t row = (size_t)(row0 + ai * 128 + m * 16);
#pragma unroll
                for (int bj = 0; bj < 2; ++bj) { const int col = col0 + bj * 128;
                    const u32x4_t g = *(const u32x4_t*)(G + row * N1 + col); float v[8];
#pragma unroll
                    for (int i = 0; i < 4; ++i) { v[i] = acc[ai][bj][m][0][i]; v[4 + i] = acc[ai][bj][m][1][i]; }
#pragma unroll
                    for (int i = 0; i < 4; ++i) { v[2 * i] *= bflo(g[i]); v[2 * i + 1] *= bfhi(g[i]); }
                    bf16_t* mp = Mx + row * DM + col;
                    if (!first) { const u32x4_t o = *(const u32x4_t*)mp;
#pragma unroll
                        for (int i = 0; i < 4; ++i) { v[2 * i] += bflo(o[i]); v[2 * i + 1] += bfhi(o[i]); } }
                    u32x4_t o; o[0] = pg8::cvt_pk_bf16(v[0], v[1]); o[1] = pg8::cvt_pk_bf16(v[2], v[3]); o[2] = pg8::cvt_pk_bf16(v[4], v[5]); o[3] = pg8::cvt_pk_bf16(v[6], v[7]);
                    *(u32x4_t*)mp = o; } }
    }
};
struct EpiResid {
    static constexpr bool PERM = false, AFTER_DRAIN = false;
    float* X;
    __device__ __forceinline__ void operator()(const f32x4 (&acc)[2][2][4][2], const pg8::Unit& u, int wr, int wc, int fr, int fq) const {
        const int row0 = u.pm * 256 + wr * 64 + fr, col0 = u.pn * 256 + wc * 32 + 4 * fq;
#pragma unroll
        for (int ai = 0; ai < 2; ++ai)
#pragma unroll
            for (int m = 0; m < 4; ++m) { float* rowp = X + (size_t)(row0 + ai * 128 + m * 16) * DM + col0;
#pragma unroll
                for (int bj = 0; bj < 2; ++bj)
#pragma unroll
                    for (int n = 0; n < 2; ++n) { f32x4* q = (f32x4*)(rowp + bj * 128 + n * 16); *q = *q + acc[ai][bj][m][n]; } }
    }
};
template <int MIX>
__device__ __forceinline__ void scan_prompt_item(const Params& p, int l, int b, int h, int cgp, float* sm) {
    constexpr int T = (MIX == 0) ? 16 : 8, NG = 128 / (4 * T), ND = 4 * NG, CPW = 64 / T, CPG = 8 * CPW, TB = 32;
    int tid_ = threadIdx.x; asm volatile("" : "+v"(tid_)); const int tid = tid_, lane = tid & 63, w = tid >> 6, c = lane / T, j = lane % T;
    const int col = w * CPW + c, ecol = cgp * CPG + col;
    float* qk = sm; float* vv = sm + 8192; float* sc = sm + 10240; float* denp = sm + 10368; float* gsc = sm + 10624; float* mcar = sm + 10688;
    const bf16_t* proj = (const bf16_t*)(PWS + W_PROJ);
    const float* gates = (const float*)(PWS + W_GATES);
    bf16_t* outp = (bf16_t*)(PWS + W_OUTS) + (size_t)MIX * MT * 512;
    const size_t rb = (size_t)b * SEQ;
    float S[ND];
#pragma unroll
    for (int i = 0; i < ND; ++i) S[i] = 0.f;
    float nn = 0.f, okeep = 0.f;
    if (MIX == 1 && tid == 0) mcar[0] = 0.f;
    const int ch = tid & 255, half = tid >> 8;
    int colq; float w0 = 0.f, w1 = 0.f, w2 = 0.f, w3 = 0.f, lbv = 0.f;
    float vw0 = 0.f, vw1 = 0.f, vw2 = 0.f, vw3 = 0.f;
    if (MIX == 0) { colq = (ch >> 7) * 512 + h * 128 + (ch & 127); const float* cw = PIN(I_GCW) + (size_t)l * 4 * 1536;
        w0 = cw[colq]; w1 = cw[1536 + colq]; w2 = cw[2 * 1536 + colq]; w3 = cw[3 * 1536 + colq];
        const int colv = 1024 + h * 128 + cgp * 32 + (tid & 31); vw0 = cw[colv]; vw1 = cw[1536 + colv]; vw2 = cw[2 * 1536 + colv]; vw3 = cw[3 * 1536 + colv]; }
    else if (MIX == 1) colq = 2048 + (ch >> 7) * 512 + h * 128 + (ch & 127);
    else { colq = 4096 + (ch >> 7) * 512 + h * 128 + (ch & 127);
        if (l > 0 && ch >= 128) { const float* hl = PIN(I_HLB); const int cc = h * 128 + (ch & 127); lbv = sigm(hl[512 + cc] - hl[cc]); } }

    for (int t0 = 0; t0 < SEQ; t0 += TB) {
        __syncthreads();
        { const int ts = t0 + half * 16; const bf16_t* pr = proj + (rb + ts) * N1 + colq;
          if (MIX == 0) {
              float x0 = 0.f, x1 = 0.f, x2 = 0.f;
              if (ts > 0) { x0 = bf2f(pr[-3 * N1]); x1 = bf2f(pr[-2 * N1]); x2 = bf2f(pr[-1 * N1]); }
#pragma unroll 4
              for (int s = 0; s < 16; ++s) { const float x3 = bf2f(pr[(size_t)s * N1]); qk[(half * 16 + s) * 256 + ch] = silu(w0 * x0 + w1 * x1 + w2 * x2 + w3 * x3); x0 = x1; x1 = x2; x2 = x3; }
          } else if (MIX == 1) {
#pragma unroll 4
              for (int s = 0; s < 16; ++s) qk[(half * 16 + s) * 256 + ch] = bf2f(pr[(size_t)s * N1]);
          } else {
#pragma unroll 4
              for (int s = 0; s < 16; ++s) { float x = bf2f(pr[(size_t)s * N1]); if (ch >= 128) x = lbv + (1.f - lbv) * sigm(x); qk[(half * 16 + s) * 256 + ch] = x; }
          } }
        if (MIX == 0) { const int vc = tid & 31, sb = tid >> 5; const bf16_t* pv = proj + rb * N1 + 1024 + h * 128 + cgp * 32 + vc;
#pragma unroll
            for (int rep = 0; rep < 2; ++rep) { const int s = sb + rep * 16, t = t0 + s;
                const float x3 = bf2f(pv[(size_t)t * N1]);
                const float x2 = t >= 1 ? bf2f(pv[(size_t)(t - 1) * N1]) : 0.f, x1 = t >= 2 ? bf2f(pv[(size_t)(t - 2) * N1]) : 0.f, x0 = t >= 3 ? bf2f(pv[(size_t)(t - 3) * N1]) : 0.f;
                vv[s * 64 + vc] = silu(vw0 * x0 + vw1 * x1 + vw2 * x2 + vw3 * x3); }
            if (tid < TB) { const size_t r = rb + t0 + tid; sc[tid * 4 + 0] = gates[r * 16 + h]; sc[tid * 4 + 1] = gates[r * 16 + 4 + h]; }
        } else { const int vc = tid & 63, sb = tid >> 6; const bf16_t* pv = proj + rb * N1 + (MIX == 1 ? 3072 : 5120) + h * 128 + cgp * 64 + vc;
#pragma unroll
            for (int rep = 0; rep < 4; ++rep) { const int s = sb + rep * 8; vv[s * 64 + vc] = bf2f(pv[(size_t)(t0 + s) * N1]); }
            if (MIX == 1 && tid < TB) { const size_t r = rb + t0 + tid; gsc[tid * 2] = gates[r * 16 + 8 + h]; gsc[tid * 2 + 1] = gates[r * 16 + 12 + h]; }
        }
        __syncthreads();
        if (MIX == 0) {
#pragma unroll 2
            for (int v8 = 0; v8 < 8; ++v8) { const int vid = w * 8 + v8, s = vid >> 1, wh = vid & 1; float2* pp = (float2*)(qk + s * 256 + wh * 128 + lane * 2);
                float2 xy = *pp; const float ss = wave_sum(xy.x * xy.x + xy.y * xy.y); const float scl = rsqrtf(ss + EPS) * (wh == 0 ? QSCALE : 1.f);
                xy.x *= scl; xy.y *= scl; *pp = xy; }
            __syncthreads();
        } else if (MIX == 1) {
            if (tid == 0) { float m = mcar[0];
                for (int s = 0; s < TB; ++s) { const float ig = gsc[2 * s], lf = gsc[2 * s + 1]; const float mn = fmaxf(lf + m, ig);
                    sc[s * 4 + 0] = __expf(lf + m - mn); sc[s * 4 + 1] = __expf(ig - mn) * QSCALE; sc[s * 4 + 2] = mn; m = mn; }
                mcar[0] = m; }
            __syncthreads();
        }
#pragma unroll 2
        for (int s = 0; s < TB; ++s) {
            const float* qs = qk + s * 256;
            float q[ND], k[ND];
#pragma unroll
            for (int g = 0; g < NG; ++g) { const float4 a = *(const float4*)(qs + g * 4 * T + 4 * j), bb = *(const float4*)(qs + 128 + g * 4 * T + 4 * j);
                q[4 * g] = a.x; q[4 * g + 1] = a.y; q[4 * g + 2] = a.z; q[4 * g + 3] = a.w; k[4 * g] = bb.x; k[4 * g + 1] = bb.y; k[4 * g + 2] = bb.z; k[4 * g + 3] = bb.w; }
            const float v = vv[s * 64 + col];
            float o = 0.f;
            if (MIX == 0) {
                const float beta = sc[s * 4], a = sc[s * 4 + 1];
                float ks = 0.f;
#pragma unroll
                for (int i = 0; i < ND; ++i) ks += k[i] * S[i];
                ks = grp_sum<T>(ks);
                const float u = beta * (v - a * ks);
#pragma unroll
                for (int i = 0; i < ND; ++i) { S[i] = a * S[i] + k[i] * u; o += q[i] * S[i]; }
            } else if (MIX == 1) {
                const float fp = sc[s * 4], ip = sc[s * 4 + 1], iv = ip * v;
#pragma unroll
                for (int i = 0; i < ND; ++i) { S[i] = fp * S[i] + k[i] * iv; o += q[i] * S[i]; }
                const int dn = 16 * w + (lane & 15); const float kd = qs[128 + dn], qd = qs[dn];
                nn = fp * nn + ip * kd; const float dp = grp_sum16(qd * nn);
                if (lane == 0) denp[s * 8 + w] = dp;
            } else {
#pragma unroll
                for (int i = 0; i < ND; ++i) { S[i] = k[i] * (S[i] - v) + v; o += q[i] * S[i]; }
            }
            o = grp_sum<T>(o);
            if ((s & (T - 1)) == j) okeep = o;
            if ((s & (T - 1)) == T - 1) outp[(rb + t0 + s - (T - 1) + j) * 512 + h * 128 + ecol] = f2bf(okeep);
        }
        if (MIX == 1) {
            __syncthreads();
            if (cgp == 0 && tid < TB) { float d = 0.f;
#pragma unroll
                for (int i = 0; i < 8; ++i) d += denp[tid * 8 + i];
                const size_t r = rb + t0 + tid; ((float*)(PWS + W_DEN))[r * 4 + h] = d; ((float*)(PWS + W_MT))[r * 4 + h] = sc[tid * 4 + 2]; }
        }
    }
    const size_t sidx = ((size_t)(l * NBP + b) * NH + h);
    float* So = POUT + (MIX == 0 ? O_P_GS : (MIX == 1 ? O_P_MC : O_P_HS)) + sidx * 16384;
#pragma unroll
    for (int g = 0; g < NG; ++g)
#pragma unroll
        for (int e = 0; e < 4; ++e) So[(size_t)(g * 4 * T + 4 * j + e) * 128 + ecol] = S[4 * g + e];
    if (MIX == 1 && cgp == 0) {
        if (lane < 16) POUT[O_P_MN + sidx * 128 + 16 * w + lane] = nn;
        __syncthreads();
        if (tid == 0) POUT[O_P_MM + sidx] = mcar[0];
    }
}

__device__ __forceinline__ void scan_sample_item(const Params& p, int l, int mix, int b, int h, float* sm) {
    int tid_ = threadIdx.x; asm volatile("" : "+v"(tid_)); const int tid = tid_, lane = tid & 63, w = tid >> 6, e = tid & 127, dg = tid >> 7;
    float* qk = sm; float* vv = sm + 1024; float* gs = sm + 1536; float* red = sm + 1600; float* dpart = sm + 1600 + 4096;
    const bf16_t* proj = (const bf16_t*)(PWS + W_PROJ);
    const float* gates = (const float*)(PWS + W_GATES);
    bf16_t* outp = (bf16_t*)(PWS + W_OUTS) + (size_t)mix * MT * 512;
    const size_t rs = (size_t)MP + (size_t)b * SSEQ;
    const size_t sidx = ((size_t)(l * NBS + b) * NH + h);
    const float* Sin = (mix == 0 ? PIN(I_SGS) : (mix == 1 ? PIN(I_SMC) : PIN(I_SHS))) + sidx * 16384;
    float S[32];
#pragma unroll
    for (int i = 0; i < 32; ++i) S[i] = Sin[(size_t)(32 * dg + i) * 128 + e];
    __syncthreads();
    for (int idx = tid; idx < 4 * 384; idx += 512) { const int s = idx / 384, ch = idx - s * 384; float val;
        if (mix == 0) { const int colx = (ch >> 7) * 512 + h * 128 + (ch & 127); const float* cw = PIN(I_GCW) + (size_t)l * 4 * 1536; const float* cs = PIN(I_SGC) + (size_t)(l * NBS + b) * 3 * 1536;
            float y = 0.f;
#pragma unroll
            for (int jj = 0; jj < 4; ++jj) { const int t = s - 3 + jj; const float x = t >= 0 ? bf2f(proj[(rs + t) * N1 + colx]) : cs[(3 + t) * 1536 + colx]; y += cw[jj * 1536 + colx] * x; }
            val = silu(y);
        } else if (mix == 1) { const int colx = 2048 + (ch >> 7) * 512 + h * 128 + (ch & 127); val = bf2f(proj[(rs + s) * N1 + colx]); }
        else { const int colx = 4096 + (ch >> 7) * 512 + h * 128 + (ch & 127); val = bf2f(proj[(rs + s) * N1 + colx]);
            if (ch >= 128 && ch < 256) { float lbv = 0.f; if (l > 0) { const float* hl = PIN(I_HLB); const int cc = h * 128 + (ch & 127); lbv = sigm(hl[512 + cc] - hl[cc]); } val = lbv + (1.f - lbv) * sigm(val); } }
        if (ch < 256) qk[s * 256 + ch] = val; else vv[s * 128 + ch - 256] = val; }
    if (tid < 4) { const size_t r = rs + tid;
        if (mix == 0) { gs[tid * 4] = gates[r * 16 + h]; gs[tid * 4 + 1] = gates[r * 16 + 4 + h]; }
        else if (mix == 1) { gs[tid * 4] = gates[r * 16 + 8 + h]; gs[tid * 4 + 1] = gates[r * 16 + 12 + h]; } }
    __syncthreads();
    if (mix == 0) { const int s = w >> 1, wh = w & 1; float2* pp = (float2*)(qk + s * 256 + wh * 128 + lane * 2);
        float2 xy = *pp; const float ss = wave_sum(xy.x * xy.x + xy.y * xy.y); const float scl = rsqrtf(ss + EPS) * (wh == 0 ? QSCALE : 1.f); xy.x *= scl; xy.y *= scl; *pp = xy;
        __syncthreads(); }
    float m = 0.f, nn = 0.f, mts[4] = {0.f, 0.f, 0.f, 0.f};
    if (mix == 1) { m = PIN(I_SMM)[sidx]; if (dg == 0) nn = PIN(I_SMN)[sidx * 128 + e]; }
#pragma unroll
    for (int s = 0; s < 4; ++s) {
        const float* qs = qk + s * 256 + 32 * dg; const float* ksp = qs + 128;
        const float v = vv[s * 128 + e];
        float po = 0.f;
        if (mix == 0) {
            const float beta = gs[s * 4], a = gs[s * 4 + 1];
            float pk = 0.f;
#pragma unroll
            for (int i = 0; i < 32; ++i) pk += ksp[i] * S[i];
            red[((s * 2) * 4 + dg) * 128 + e] = pk;
            __syncthreads();
            const float ks = red[((s * 2) * 4 + 0) * 128 + e] + red[((s * 2) * 4 + 1) * 128 + e] + red[((s * 2) * 4 + 2) * 128 + e] + red[((s * 2) * 4 + 3) * 128 + e];
            const float u = beta * (v - a * ks);
#pragma unroll
            for (int i = 0; i < 32; ++i) { S[i] = a * S[i] + ksp[i] * u; po += qs[i] * S[i]; }
        } else if (mix == 1) {
            const float ig = gs[s * 4], lf = gs[s * 4 + 1]; const float mn = fmaxf(lf + m, ig); const float fp = __expf(lf + m - mn), ip = __expf(ig - mn) * QSCALE; m = mn; mts[s] = mn;
            const float iv = ip * v;
#pragma unroll
            for (int i = 0; i < 32; ++i) { S[i] = fp * S[i] + ksp[i] * iv; po += qs[i] * S[i]; }
            if (dg == 0) { nn = fp * nn + ip * qk[s * 256 + 128 + e]; const float dp = wave_sum(qk[s * 256 + e] * nn); if (lane == 0) dpart[s * 2 + w] = dp; }
        } else {
#pragma unroll
            for (int i = 0; i < 32; ++i) { S[i] = ksp[i] * (S[i] - v) + v; po += qs[i] * S[i]; }
        }
        red[((s * 2 + 1) * 4 + dg) * 128 + e] = po;
    }
    __syncthreads();
    if (tid < 128) {
#pragma unroll
        for (int s = 0; s < 4; ++s) { const float o = red[((s * 2 + 1) * 4 + 0) * 128 + e] + red[((s * 2 + 1) * 4 + 1) * 128 + e] + red[((s * 2 + 1) * 4 + 2) * 128 + e] + red[((s * 2 + 1) * 4 + 3) * 128 + e];
            outp[(rs + s) * 512 + h * 128 + e] = f2bf(o); } }
    if (mix == 1 && tid == 0) {
#pragma unroll
        for (int s = 0; s < 4; ++s) { ((float*)(PWS + W_DEN))[(rs + s) * 4 + h] = dpart[s * 2] + dpart[s * 2 + 1]; ((float*)(PWS + W_MT))[(rs + s) * 4 + h] = mts[s]; }
        POUT[O_S_MM + sidx] = m; }
    float* So = POUT + (mix == 0 ? O_S_GS : (mix == 1 ? O_S_MC : O_S_HS)) + sidx * 16384;
#pragma unroll
    for (int i = 0; i < 32; ++i) So[(size_t)(32 * dg + i) * 128 + e] = S[i];
    if (mix == 1 && dg == 0) POUT[O_S_MN + sidx * 128 + e] = nn;
}
__device__ __forceinline__ void phase_postnorm(const Params& p, int l) {
    int tid_ = threadIdx.x; asm volatile("" : "+v"(tid_)); const int tid = tid_, j = tid & 15;
    bf16_t* outs = (bf16_t*)(PWS + W_OUTS);
    const bf16_t* proj = (const bf16_t*)(PWS + W_PROJ);
    const float* den = (const float*)(PWS + W_DEN); const float* mt = (const float*)(PWS + W_MT);
    const int ngroups = MT * 12;
    for (int gid = bidx() * 32 + (tid >> 4); gid < ngroups; gid += gdim() * 32) {
        const int r = gid / 12, mh = gid - r * 12, mix = mh >> 2, h = mh & 3;
        bf16_t* op = outs + (size_t)mix * MT * 512 + (size_t)r * 512 + h * 128 + 8 * j;
        const u32x4_t raw = *(const u32x4_t*)op;
        float v[8];
#pragma unroll
        for (int i = 0; i < 4; ++i) { v[2 * i] = bflo(raw[i]); v[2 * i + 1] = bfhi(raw[i]); }
        if (mix == 1) { const float dn = fmaxf(fabsf(den[(size_t)r * 4 + h]), __expf(-mt[(size_t)r * 4 + h])); const float inv = 1.f / dn;
#pragma unroll
            for (int i = 0; i < 8; ++i) v[i] *= inv; }
        float ss = 0.f;
#pragma unroll
        for (int i = 0; i < 8; ++i) ss += v[i] * v[i];
        ss = grp_sum16(ss);
        const float rstd = rsqrtf(ss * (1.f / 128.f) + EPS);
        const int gcol = (mix == 0 ? 1536 : (mix == 1 ? 3584 : 5632)) + h * 128 + 8 * j;
        const u32x4_t gr = *(const u32x4_t*)(proj + (size_t)r * N1 + gcol);
        const float* nw = (mix == 0 ? PIN(I_GNORM) : (mix == 1 ? PIN(I_MNORM) : PIN(I_HNORM))) + l * 512 + h * 128 + 8 * j;
        const float4 n0 = *(const float4*)nw, n1 = *(const float4*)(nw + 4);
        const float nwv[8] = {n0.x, n0.y, n0.z, n0.w, n1.x, n1.y, n1.z, n1.w};
#pragma unroll
        for (int i = 0; i < 4; ++i) { v[2 * i] *= rstd * nwv[2 * i] * bflo(gr[i]); v[2 * i + 1] *= rstd * nwv[2 * i + 1] * bfhi(gr[i]); }
        u32x4_t o; o[0] = pg8::cvt_pk_bf16(v[0], v[1]); o[1] = pg8::cvt_pk_bf16(v[2], v[3]); o[2] = pg8::cvt_pk_bf16(v[4], v[5]); o[3] = pg8::cvt_pk_bf16(v[6], v[7]);
        *(u32x4_t*)op = o;
    }
    const int ncs = (NBP + NBS) * 3 * 1536;
    for (int i = bidx() * 512 + tid; i < ncs; i += gdim() * 512) {
        const int cc = i % 1536, ri = (i / 1536) % 3, bb = i / (3 * 1536);
        if (bb < NBP) POUT[O_P_GC + ((size_t)(l * NBP + bb) * 3 + ri) * 1536 + cc] = bf2f(proj[((size_t)bb * SEQ + SEQ - 3 + ri) * N1 + cc]);
        else { const int b2 = bb - NBP; POUT[O_S_GC + ((size_t)(l * NBS + b2) * 3 + ri) * 1536 + cc] = bf2f(proj[((size_t)MP + (size_t)b2 * SSEQ + 1 + ri) * N1 + cc]); }
    }
}

__device__ __forceinline__ void phase_convffn(const Params& p, int l) {
    int tid_ = threadIdx.x; asm volatile("" : "+v"(tid_)); const int tid = tid_;
    const bf16_t* u = (const bf16_t*)(PWS + W_PROJ);
    bf16_t* act = (bf16_t*)(PWS + W_ACT);
    const float* cw = PIN(I_FCW) + (size_t)l * 3 * NUP; const float* cb = PIN(I_FCB) + (size_t)l * NUP;
    const int nitems = (MT / 4) * (DFF / 8);
    for (int it = bidx() * 512 + tid; it < nitems; it += gdim() * 512) {
        const int jg = it % (DFF / 8), rbk = it / (DFF / 8), r0 = rbk * 4, jc = jg * 8;
        const bool samp = r0 >= MP; const int tf = samp ? 0 : (r0 & (SEQ - 1));
        float wa[3][8], wb[3][8], ba[8], bb[8];
#pragma unroll
        for (int i = 0; i < 3; ++i) { const float4 a0 = *(const float4*)(cw + i * NUP + jc), a1 = *(const float4*)(cw + i * NUP + jc + 4), b0 = *(const float4*)(cw + i * NUP + DFF + jc), b1 = *(const float4*)(cw + i * NUP + DFF + jc + 4);
            wa[i][0] = a0.x; wa[i][1] = a0.y; wa[i][2] = a0.z; wa[i][3] = a0.w; wa[i][4] = a1.x; wa[i][5] = a1.y; wa[i][6] = a1.z; wa[i][7] = a1.w;
            wb[i][0] = b0.x; wb[i][1] = b0.y; wb[i][2] = b0.z; wb[i][3] = b0.w; wb[i][4] = b1.x; wb[i][5] = b1.y; wb[i][6] = b1.z; wb[i][7] = b1.w; }
        { const float4 a0 = *(const float4*)(cb + jc), a1 = *(const float4*)(cb + jc + 4), b0 = *(const float4*)(cb + DFF + jc), b1 = *(const float4*)(cb + DFF + jc + 4);
            ba[0] = a0.x; ba[1] = a0.y; ba[2] = a0.z; ba[3] = a0.w; ba[4] = a1.x; ba[5] = a1.y; ba[6] = a1.z; ba[7] = a1.w;
            bb[0] = b0.x; bb[1] = b0.y; bb[2] = b0.z; bb[3] = b0.w; bb[4] = b1.x; bb[5] = b1.y; bb[6] = b1.z; bb[7] = b1.w; }
        float xa[6][8], xb[6][8];
#pragma unroll
        for (int rr = 0; rr < 6; ++rr) {
            if (rr < 2 && tf == 0) {
                if (samp) { const float* st = PIN(I_SFC) + ((size_t)(l * NBS + (r0 - MP) / 4) * 2 + rr) * NUP;
#pragma unroll
                    for (int i = 0; i < 8; ++i) { xa[rr][i] = st[jc + i]; xb[rr][i] = st[DFF + jc + i]; } }
                else {
#pragma unroll
                    for (int i = 0; i < 8; ++i) { xa[rr][i] = 0.f; xb[rr][i] = 0.f; } }
            } else { const bf16_t* ur = u + (size_t)(r0 - 2 + rr) * NUP; const u32x4_t ra = *(const u32x4_t*)(ur + jc), rbv = *(const u32x4_t*)(ur + DFF + jc);
#pragma unroll
                for (int i = 0; i < 4; ++i) { xa[rr][2 * i] = bflo(ra[i]); xa[rr][2 * i + 1] = bfhi(ra[i]); xb[rr][2 * i] = bflo(rbv[i]); xb[rr][2 * i + 1] = bfhi(rbv[i]); } }
        }
#pragma unroll
        for (int t = 0; t < 4; ++t) { float o[8];
#pragma unroll
            for (int i = 0; i < 8; ++i) { const float ya = wa[0][i] * xa[t][i] + wa[1][i] * xa[t + 1][i] + wa[2][i] * xa[t + 2][i] + ba[i]; const float yb = wb[0][i] * xb[t][i] + wb[1][i] * xb[t + 1][i] + wb[2][i] * xb[t + 2][i] + bb[i]; o[i] = silu(ya) * yb; }
            u32x4_t ov; ov[0] = pg8::cvt_pk_bf16(o[0], o[1]); ov[1] = pg8::cvt_pk_bf16(o[2], o[3]); ov[2] = pg8::cvt_pk_bf16(o[4], o[5]); ov[3] = pg8::cvt_pk_bf16(o[6], o[7]);
            *(u32x4_t*)(act + (size_t)(r0 + t) * DFF + jc) = ov; }
        if (samp || tf == SEQ - 4) {
            float* dst = samp ? POUT + O_S_FC + (size_t)(l * NBS + (r0 - MP) / 4) * 2 * NUP : POUT + O_P_FC + (size_t)(l * NBP + r0 / SEQ) * 2 * NUP;
#pragma unroll
            for (int rr = 0; rr < 2; ++rr)
#pragma unroll
                for (int i = 0; i < 8; ++i) { dst[(size_t)rr * NUP + jc + i] = xa[4 + rr][i]; dst[(size_t)rr * NUP + DFF + jc + i] = xb[4 + rr][i]; }
        }
    }
}

__device__ __forceinline__ void phase_final_norm(const Params& p) {
    int tid_ = threadIdx.x; asm volatile("" : "+v"(tid_)); const int tid = tid_, lane = tid & 63, w = tid >> 6;
    const float* gw = PIN(I_LNF);
    float4 g4[4];
#pragma unroll
    for (int i = 0; i < 4; ++i) g4[i] = *(const float4*)(gw + lane * 4 + 256 * i);
    for (int row = bidx() * 8 + w; row < MT; row += gdim() * 8) {
        float* xr = POUT + (size_t)row * DM; float4 v[4]; float ss = 0.f;
#pragma unroll
        for (int i = 0; i < 4; ++i) { v[i] = *(const float4*)(xr + lane * 4 + 256 * i); ss += v[i].x * v[i].x + v[i].y * v[i].y + v[i].z * v[i].z + v[i].w * v[i].w; }
        ss = wave_sum(ss); const float rstd = rsqrtf(ss * (1.f / 1024.f) + EPS);
#pragma unroll
        for (int i = 0; i < 4; ++i) { v[i].x *= rstd * g4[i].x; v[i].y *= rstd * g4[i].y; v[i].z *= rstd * g4[i].z; v[i].w *= rstd * g4[i].w; *(float4*)(xr + lane * 4 + 256 * i) = v[i]; }
    }
}

#ifndef PHM
#define PHM 0xFFFF
#endif
#ifndef DUPB
#define DUPB 1
#endif
#ifndef DUPC
#define DUPC 1
#endif
#ifndef DUPS
#define DUPS 1
#endif
#ifndef DUPH
#define DUPH 1
#endif
#ifndef DUPY
#define DUPY 1
#endif
#ifndef DUPA
#define DUPA 1
#endif
#ifndef DUPI
#define DUPI 1
#endif
#define GSYNC() do { for (int y_ = 0; y_ < DUPY; ++y_) xcd_barrier(xb); } while (0)
__global__ void __launch_bounds__(512, 2) fwd_megakernel(Params p) {
    extern __shared__ __attribute__((aligned(16))) unsigned char shm[];
    cg::grid_group grid = cg::this_grid();
    float* smf = (float*)shm;
    PG8_LAS unsigned char* lds = (PG8_LAS unsigned char*)shm;
    int tid_ = threadIdx.x; asm volatile("" : "+v"(tid_)); const int tid = tid_;
    float* X = POUT;
    volatile XLAS unsigned* xst = (volatile XLAS unsigned*)(lds + 131072);
    if (tid == 0) { xst[0] = 0u; xst[1] = 0u; xst[2] = 0u; xst[3] = 0u; }
    __syncthreads();
    XcdBarrier xb = xcd_barrier_post((unsigned*)(PWS + W_BAR), xst);
    bool first_sync = true;
    bf16_t* hbf = (bf16_t*)(PWS + W_HBF);
    bf16_t* proj = (bf16_t*)(PWS + W_PROJ);

    for (int l = 0; l < 2; ++l) {
        const int G = gdim(), bid = bidx();
        for (int repa = 0; repa < DUPA; ++repa) { if (PHM & 1) { int tc = 0;
          conv_T(PIN(I_WIN) + (size_t)l * 1024 * NIN, NIN, (bf16_t*)(PWS + W_WIN), 1024, N1, true, smf, tc);
          for (int n = 0; n < 3; ++n) conv_T(PIN(I_WBR) + ((size_t)l * 3 + n) * 512 * 1024, 1024, (bf16_t*)(PWS + W_WBR) + (size_t)n * 1024 * 512, 512, 1024, false, smf, tc);
          conv_T(PIN(I_WOUT) + (size_t)l * 1024 * 1024, 1024, (bf16_t*)(PWS + W_WOUT), 1024, 1024, false, smf, tc);
          conv_T(PIN(I_WUP) + (size_t)l * 1024 * NUP, NUP, (bf16_t*)(PWS + W_WUP), 1024, NUP, false, smf, tc);
          conv_T(PIN(I_WDN) + (size_t)l * DFF * 1024, 1024, (bf16_t*)(PWS + W_WDN), DFF, 1024, false, smf, tc);
          __syncthreads(); }
        if (PHM & 2) { if (l == 0) {
            const float4* s0 = (const float4*)PIN(I_XP); const float4* s1 = (const float4*)PIN(I_XS); float4* d = (float4*)X;
            const size_t n0 = (size_t)MP * DM / 4, n1 = (size_t)MS * DM / 4;
            int tq_ = threadIdx.x; asm volatile("" : "+v"(tq_));
            for (size_t i = (size_t)bid * 512 + tq_; i < n0 + n1; i += (size_t)G * 512) d[i] = i < n0 ? s0[i] : s1[i - n0];
        }
        phase_rmsnorm(p, l, l == 0 ? PIN(I_XP) : X, l == 0 ? PIN(I_XS) : X + (size_t)MP * DM, PIN(I_LNMIX) + l * DM, hbf, true, smf); } }
        if (first_sync) { grid.sync(); first_sync = false; }
        else GSYNC();
        for (int rep = 0; rep < DUPB; ++rep) { pg8::Gemm g{hbf, (const bf16_t*)(PWS + W_WIN), MT, N1, 1024}; pg8::StaticOrder S; S.init(MT, N1, G, bid); EpiProj E{proj, N1, 1}; pg8::gemm_phase(lds, g, S, E); }
        GSYNC();
        for (int rep = 0; rep < DUPC; ++rep) for (int it = bid; it < 256; it += G) {
            if (it < 128) scan_prompt_item<0>(p, l, (it >> 2) >> 2, (it >> 2) & 3, it & 3, smf);
            else if (it < 192) { const int q = it - 128; scan_prompt_item<1>(p, l, (q >> 1) >> 2, (q >> 1) & 3, q & 1, smf); }
            else { const int q = it - 192; scan_prompt_item<2>(p, l, (q >> 1) >> 2, (q >> 1) & 3, q & 1, smf); }
        }
        for (int rep = 0; rep < DUPS; ++rep) for (int it = bid; it < 3 * NBS * NH; it += G) { const int mix = it / (NBS * NH), r = it - mix * (NBS * NH); scan_sample_item(p, l, mix, r >> 2, r & 3, smf); }
        GSYNC();
        if (PHM & 32) phase_postnorm(p, l);
        GSYNC();
        if (PHM & 64) for (int n = 0; n < 3; ++n) { pg8::Gemm g{(const bf16_t*)(PWS + W_OUTS) + (size_t)n * MT * 512, (const bf16_t*)(PWS + W_WBR) + (size_t)n * 1024 * 512, MT, 1024, 512};
            pg8::StaticOrder S; S.init(MT, 1024, G, bid); EpiMerge E{proj + 6144 + n * 1024, hbf, n == 0}; pg8::gemm_phase(lds, g, S, E); }
        GSYNC();
        if (PHM & 128) { pg8::Gemm g{hbf, (const bf16_t*)(PWS + W_WOUT), MT, 1024, 1024}; pg8::StaticOrder S; S.init(MT, 1024, G, bid); EpiResid E{X}; pg8::gemm_phase(lds, g, S, E); }
        GSYNC();
        if (PHM & 256) phase_rmsnorm(p, l, X, X + (size_t)MP * DM, PIN(I_LNFFN) + l * DM, hbf, false, smf);
        GSYNC();
        for (int rep = 0; rep < DUPH; ++rep) { pg8::Gemm g{hbf, (const bf16_t*)(PWS + W_WUP), MT, NUP, 1024}; pg8::StaticOrder S; S.init(MT, NUP, G, bid); EpiProj E{proj, NUP, 0}; pg8::gemm_phase(lds, g, S, E); }
        GSYNC();
        for (int repi = 0; repi < DUPI; ++repi) phase_convffn(p, l);
        GSYNC();
        if (PHM & 2048) { pg8::Gemm g{(const bf16_t*)(PWS + W_ACT), (const bf16_t*)(PWS + W_WDN), MT, 1024, DFF}; pg8::StaticOrder S; S.init(MT, 1024, G, bid); EpiResid E{X}; pg8::gemm_phase(lds, g, S, E); }
        GSYNC();
    }
    if (PHM & 4096) phase_final_norm(p);
}

extern "C" void kernel_launch(void* const* d_in, const int* in_sizes, int n_in, void* d_out, int out_size, void* d_ws, size_t ws_size, hipStream_t stream) {
    static int grid_blocks = 0;
    if (grid_blocks == 0) {
        if (n_in != 28 || (size_t)out_size != O_END || ws_size < W_END) { fprintf(stderr, "kernel_launch: unexpected shapes: n_in %d out %d (want %zu) ws %zu (need %zu)\n", n_in, out_size, (size_t)O_END, ws_size, (size_t)W_END); grid_blocks = -1; return; }
        int dev = 0, cus = 0, per_cu = 0;
        hipGetDevice(&dev); hipDeviceGetAttribute(&cus, hipDeviceAttributeMultiprocessorCount, dev);
        if (hipFuncSetAttribute((const void*)fwd_megakernel, hipFuncAttributeMaxDynamicSharedMemorySize, LDS_BYTES) != hipSuccess) { fprintf(stderr, "kernel_launch: hipFuncSetAttribute failed\n"); grid_blocks = -1; return; }
        if (hipOccupancyMaxActiveBlocksPerMultiprocessor(&per_cu, (const void*)fwd_megakernel, 512, LDS_BYTES) != hipSuccess || per_cu < 1) { fprintf(stderr, "kernel_launch: occupancy query gave %d\n", per_cu); per_cu = 1; (void)hipGetLastError(); }
        grid_blocks = cus * per_cu;
    }
    if (grid_blocks < 0) return;
    if (hipMemsetAsync((unsigned char*)d_ws + W_BAR, 0, XCD_BAR_WORDS * 4, stream) != hipSuccess) { fprintf(stderr, "kernel_launch: memset of barrier words failed\n"); return; }
    Params p{};
    for (int i = 0; i < 28; ++i) p.in[i] = (const float*)d_in[i];
    p.out = (float*)d_out; p.ws = (unsigned char*)d_ws;
    void* args[] = {&p};
    hipError_t e = hipLaunchCooperativeKernel((const void*)fwd_megakernel, dim3(grid_blocks), dim3(512), args, LDS_BYTES, stream);
    if (e != hipSuccess) fprintf(stderr, "kernel_launch: cooperative launch failed: %s (grid %d)\n", hipGetErrorString(e), grid_blocks);
}
```

```cpp
#include <hip/hip_runtime.h>
#include <hip/hip_cooperative_groups.h>
#include <cstdio>
namespace cg = cooperative_groups;
namespace pg8 {
#define PG8_LAS __attribute__((address_space(3)))
typedef unsigned short bf16_t;
typedef short bf16x8 __attribute__((ext_vector_type(8)));
typedef float f32x4 __attribute__((ext_vector_type(4)));
typedef unsigned u32x4 __attribute__((ext_vector_type(4)));
constexpr int BM = 256, BK = 64, HALF = 128, HTB = HALF * BK * 2  , STAGE_BYTES = 8 * HTB, NXCD = 8, WGM = 8;

__host__ __device__ __forceinline__ int lds_byte(int r, int c) { const int st = (r >> 4) * 2 + (c >> 5), rr = r & 15, cc = c & 31, ob = rr * 64 + cc * 2; return st * 1024 + (ob ^ (((ob >> 9) & 1) << 5)); }
__host__ __device__ __forceinline__ void stage_rc(int b, int& R, int& C) { const int st = b / 1024, sb = b % 1024, swz = sb ^ (((sb >> 9) & 1) << 5); R = (st >> 1) * 16 + swz / 64; C = (st & 1) * 32 + (swz % 64) / 2; }
__host__ __device__ __forceinline__ int perm32(int rho) { const int n = rho >> 4, i = rho & 15; return 8 * (i >> 2) + 4 * n + (i & 3); }

struct Unit { int pm, pn; };
struct Gemm { const bf16_t* A; const bf16_t* Bt; int M, N, K; };

struct StaticOrder {
    int nM, nN, nwg, G, c;
    __host__ __device__ void init(int M, int N, int G_, int c_) { nM = M / BM; nN = N / BM; nwg = nM * nN; G = G_; c = c_; }
    __host__ __device__ bool next(int i, Unit& u) const {
        const long L = (long)i * G + c; if (L >= nwg) return false;
        int wgid = (int)L; { const int q = nwg / NXCD, r = nwg % NXCD, xcd = wgid % NXCD, off = wgid / NXCD; wgid = (xcd < r ? xcd * (q + 1) : r * (q + 1) + (xcd - r) * q) + off; }
        const int nig = WGM * nN, gid = wgid / nig, fm = gid * WGM, gsz = (nM - fm) < WGM ? (nM - fm) : WGM;
        u.pm = fm + ((wgid % nig) % gsz); u.pn = (wgid % nig) / gsz; return true;
    }
    __device__ __forceinline__ void a_ready(const Unit&) const {}
    __device__ __forceinline__ void done(const Unit&) const {}
};
__device__ __forceinline__ unsigned cvt_pk_bf16(float lo, float hi) { unsigned r; asm volatile("v_cvt_pk_bf16_f32 %0, %1, %2" : "=v"(r) : "v"(lo), "v"(hi)); return r; }
template <class Epi, class Sched>
__device__ __forceinline__ void gemm_phase(PG8_LAS unsigned char* lds, const Gemm g, const Sched& S, const Epi& E) {
    int tid_ = threadIdx.x; asm volatile("" : "+v"(tid_));
    const int tid = tid_, wid = __builtin_amdgcn_readfirstlane(tid >> 6), lane = tid & 63, wr = wid >> 2, wc = wid & 3, fr = lane & 15, fq = lane >> 4;
    const int K = g.K, nt = K / BK;
    unsigned voffA[2], voffB[2];
#pragma unroll
    for (int i = 0; i < 2; ++i) { int R, C; stage_rc(tid * 16 + i * 8192, R, C); const int Rb = Epi::PERM ? ((R & ~31) + perm32(R & 31)) : R;
        voffA[i] = (unsigned)(R * K + C) * 2u; voffB[i] = (unsigned)(Rb * K + C) * 2u; }
    const size_t kstep = (size_t)(BK * 2);
    const size_t hstep = (size_t)HALF * K * 2;
    const size_t tstep = 2 * hstep;
    const unsigned ldsw = (unsigned)wid * 1024u;
    const int aoff = lds_byte(wr * 64 + fr, fq * 8), boff = lds_byte(wc * 32 + fr, fq * 8);
#define PG8_SA(b, h) (((b) * 2 + (h)) * HTB)
#define PG8_SB(b, h) ((4 + (b) * 2 + (h)) * HTB)
#define PG8_STAGE(bufoff, gbase, voff) do { _Pragma("unroll") for (int _i = 0; _i < 2; ++_i) \
        __builtin_amdgcn_global_load_lds((const unsigned*)((const char*)(gbase) + (voff)[_i]), (PG8_LAS unsigned*)(lds + (bufoff) + ldsw + _i * 8192), 16, 0, 0); } while (0)
#define PG8_LDA(dst, b, h) do { _Pragma("unroll") for (int m = 0; m < 4; ++m) _Pragma("unroll") for (int k = 0; k < 2; ++k) dst[m][k] = *(const PG8_LAS bf16x8*)(lds + PG8_SA(b, h) + aoff + m * 2048 + k * 1024); } while (0)
#define PG8_LDB(dst, b, h) do { _Pragma("unroll") for (int n = 0; n < 2; ++n) _Pragma("unroll") for (int k = 0; k < 2; ++k) dst[n][k] = *(const PG8_LAS bf16x8*)(lds + PG8_SB(b, h) + boff + n * 2048 + k * 1024); } while (0)
#define PG8_MMA(ai, bj, At, Bt) do { __builtin_amdgcn_s_setprio(1); _Pragma("unroll") for (int m = 0; m < 4; ++m) _Pragma("unroll") for (int n = 0; n < 2; ++n) _Pragma("unroll") for (int k = 0; k < 2; ++k) \
        acc[ai][bj][m][n] = __builtin_amdgcn_mfma_f32_16x16x32_bf16(Bt[n][k], At[m][k], acc[ai][bj][m][n], 0, 0, 0); __builtin_amdgcn_s_setprio(0); } while (0)
#define PG8_WAIT_V(n) asm volatile("s_waitcnt vmcnt(" #n ")" ::: "memory")
#define PG8_WAIT_L(n) asm volatile("s_waitcnt lgkmcnt(" #n ")" ::: "memory")
#define PG8_BAR __builtin_amdgcn_s_barrier()
#define PG8_SCHED __builtin_amdgcn_sched_barrier(0)
    Unit cur, nxt; int ui = 0;
    if (!S.next(0, cur)) return;
    f32x4 acc[2][2][4][2];
#pragma unroll
    for (int a = 0; a < 2; ++a)
#pragma unroll
        for (int b = 0; b < 2; ++b)
#pragma unroll
            for (int m = 0; m < 4; ++m)
#pragma unroll
                for (int n = 0; n < 2; ++n) acc[a][b][m][n] = (f32x4){0.f, 0.f, 0.f, 0.f};
    bf16x8 At[4][2], B0[2][2], B1[2][2];
    const char* cA = (const char*)g.A + (size_t)cur.pm * tstep; const char* cB = (const char*)g.Bt + (size_t)cur.pn * tstep;
    S.a_ready(cur);
    PG8_STAGE(PG8_SB(0, 0), cB, voffB); PG8_STAGE(PG8_SA(0, 0), cA, voffA); PG8_STAGE(PG8_SB(0, 1), cB + hstep, voffB); PG8_STAGE(PG8_SA(0, 1), cA + hstep, voffA);
    if (wr == 1) PG8_BAR;
    PG8_WAIT_V(4); PG8_BAR;
    PG8_STAGE(PG8_SB(1, 0), cB + kstep, voffB); PG8_STAGE(PG8_SA(1, 0), cA + kstep, voffA); PG8_STAGE(PG8_SB(1, 1), cB + hstep + kstep, voffB);
    PG8_WAIT_V(6); PG8_BAR;
    for (;;) {
        const bool has_next = S.next(ui + 1, nxt);
        const char* nA = has_next ? (const char*)g.A + (size_t)nxt.pm * tstep : cA; const char* nB = has_next ? (const char*)g.Bt + (size_t)nxt.pn * tstep : cB;
        for (int t = 0; t < nt; t += 2) {
            const bool last = (t == nt - 2);
            const char* a1 = cA + (size_t)(t + 1) * kstep;
            const char* a2 = last ? nA : cA + (size_t)(t + 2) * kstep; const char* b2 = last ? nB : cB + (size_t)(t + 2) * kstep;
            const char* a3 = a2 + kstep; const char* b3 = b2 + kstep;
            if (last && has_next) S.a_ready(nxt);
            PG8_LDB(B0, 0, 0); PG8_SCHED; PG8_LDA(At, 0, 0); PG8_STAGE(PG8_SA(1, 1), a1 + hstep, voffA);
            PG8_WAIT_L(8); PG8_BAR; PG8_WAIT_L(0); PG8_MMA(0, 0, At, B0); PG8_BAR; PG8_SCHED;
            PG8_LDB(B1, 0, 1); PG8_STAGE(PG8_SB(0, 0), b2, voffB);
            PG8_BAR; PG8_WAIT_L(0); PG8_MMA(0, 1, At, B1); PG8_BAR;
            PG8_LDA(At, 0, 1); PG8_STAGE(PG8_SA(0, 0), a2, voffA);
            PG8_BAR; PG8_WAIT_L(0); PG8_MMA(1, 0, At, B0); PG8_BAR; PG8_SCHED;
            PG8_STAGE(PG8_SB(0, 1), b2 + hstep, voffB);
            PG8_WAIT_V(6); PG8_BAR; PG8_MMA(1, 1, At, B1); PG8_BAR;
            PG8_LDB(B0, 1, 0); PG8_SCHED; PG8_LDA(At, 1, 0); PG8_STAGE(PG8_SA(0, 1), a2 + hstep, voffA);
            PG8_WAIT_L(8); PG8_BAR; PG8_WAIT_L(0); PG8_MMA(0, 0, At, B0); PG8_BAR; PG8_SCHED;
            PG8_LDB(B1, 1, 1); PG8_STAGE(PG8_SB(1, 0), b3, voffB);
            PG8_BAR; PG8_WAIT_L(0); PG8_MMA(0, 1, At, B1); PG8_BAR;
            PG8_LDA(At, 1, 1); PG8_STAGE(PG8_SA(1, 0), a3, voffA);
            PG8_BAR; PG8_WAIT_L(0); PG8_MMA(1, 0, At, B0); PG8_BAR; PG8_SCHED;
            PG8_STAGE(PG8_SB(1, 1), b3 + hstep, voffB);
            PG8_WAIT_V(6); PG8_BAR; PG8_MMA(1, 1, At, B1); PG8_BAR;
        }
        if constexpr (!Epi::AFTER_DRAIN) { E(acc, cur, wr, wc, fr, fq); S.done(cur); }
        if (!has_next) break;
#pragma unroll
        for (int a = 0; a < 2; ++a)
#pragma unroll
            for (int b = 0; b < 2; ++b)
#pragma unroll
                for (int m = 0; m < 4; ++m)
#pragma unroll
                    for (int n = 0; n < 2; ++n) acc[a][b][m][n] = (f32x4){0.f, 0.f, 0.f, 0.f};
        cur = nxt; cA = nA; cB = nB; ++ui;
    }
    PG8_WAIT_V(0);
    if (wr == 0) PG8_BAR;
    PG8_BAR;
    if constexpr (Epi::AFTER_DRAIN) { E.fused(acc, cur, wr, wc, fr, fq, lds, wid, lane); S.done(cur); }
#undef PG8_SA
#undef PG8_SB
#undef PG8_STAGE
#undef PG8_LDA
#undef PG8_LDB
#undef PG8_MMA
#undef PG8_WAIT_V
#undef PG8_WAIT_L
#undef PG8_BAR
#undef PG8_SCHED
}
}

#define XB_TMO      128
#define XB_XCNT(j)  (256  + 64 * (j))
#define XB_XSUB(j)  (1280 + 64 * (j))
#define XB_XGEN(j)  (2304 + 64 * (j))
#define XB_TOP      3328
#define XB_TOPGEN   3392
#define XCD_BAR_WORDS 3456
#define XB_SPIN_CAP (1u << 18)
#define XLAS __attribute__((address_space(3)))

__device__ __forceinline__ unsigned xb_ld(unsigned* p)              { return __hip_atomic_load(p, __ATOMIC_RELAXED, __HIP_MEMORY_SCOPE_AGENT); }
__device__ __forceinline__ unsigned xb_add(unsigned* p, unsigned v) { return __hip_atomic_fetch_add(p, v, __ATOMIC_RELAXED, __HIP_MEMORY_SCOPE_AGENT); }
__device__ __forceinline__ unsigned xb_xcc_id() { return (unsigned)__builtin_amdgcn_s_getreg((3 << 11) | 20) & 0xFu; }
#define XB_SPIN(cond, bar) do { unsigned _sp = 0; while (cond) { __builtin_amdgcn_s_sleep(1); \
    if ((++_sp & 255u) == 0u) { if (xb_ld(&(bar)[XB_TMO])) break; if (_sp > XB_SPIN_CAP) { atomicAdd(&(bar)[XB_TMO], 1u); break; } } } } while (0)

struct XcdBarrier {
    unsigned* bar; unsigned x;
    volatile XLAS unsigned* st;
};

__device__ __forceinline__ XcdBarrier xcd_barrier_post(unsigned* bar, volatile XLAS unsigned* st) {
    XcdBarrier b; b.bar = bar; b.x = xb_xcc_id(); b.st = st;
    if (threadIdx.x == 0) (void)xb_add(&bar[XB_XCNT(b.x)], 1u);
    return b;
}
__device__ __forceinline__ void xcd_barrier_complete(unsigned* bar, unsigned x, unsigned& nloc, unsigned& nx) {
    const unsigned G = gridDim.x * gridDim.y * gridDim.z;
    unsigned sum, cnt, mine, sp = 0u;
    for (;;) {
        sum = 0u; cnt = 0u; mine = 0u;
#pragma unroll
        for (unsigned j = 0; j < 16; ++j) { const unsigned c = xb_ld(&bar[XB_XCNT(j)]); sum += c; cnt += (c > 0u) ? 1u : 0u; mine = (j == x) ? c : mine; }
        if (sum == G) break;
        __builtin_amdgcn_s_sleep(1);
        if ((++sp & 255u) == 0u) { if (xb_ld(&bar[XB_TMO])) break; if (sp > XB_SPIN_CAP) { atomicAdd(&bar[XB_TMO], 1u); break; } }
    }
    nloc = mine > 0u ? mine : 1u; nx = cnt > 0u ? cnt : 1u;
}

__device__ __forceinline__ void xcd_barrier(const XcdBarrier& b) {
    asm volatile("s_waitcnt vmcnt(0)" ::: "memory");
    __syncthreads();
    if (threadIdx.x == 0) {
        unsigned* bar = b.bar;
        __builtin_amdgcn_s_waitcnt(0);
        unsigned nloc = b.st[0], nx = b.st[1];
        if (nloc == 0u) { xcd_barrier_complete(bar, b.x, nloc, nx); b.st[0] = nloc; b.st[1] = nx; }
        const unsigned old = xb_add(&bar[XB_XSUB(b.x)], 1u);
        const unsigned gen = old / nloc;
        if (old + 1u == (gen + 1u) * nloc) {
            __builtin_amdgcn_fence(__ATOMIC_RELEASE, "agent");
            asm volatile("s_waitcnt vmcnt(0)" ::: "memory");
            const unsigned og = xb_add(&bar[XB_TOP], 1u);
            const unsigned tg = og / nx;
            if (og + 1u == (tg + 1u) * nx) xb_add(&bar[XB_TOPGEN], 1u);
            else XB_SPIN(xb_ld(&bar[XB_TOPGEN]) == tg, bar);
            __builtin_amdgcn_fence(__ATOMIC_ACQUIRE, "agent");
            xb_add(&bar[XB_XGEN(b.x)], 1u);
            asm volatile("s_waitcnt vmcnt(0)" ::: "memory");
        } else {
            XB_SPIN(xb_ld(&bar[XB_XGEN(b.x)]) == gen, bar);
            __builtin_amdgcn_fence(__ATOMIC_ACQUIRE, "agent");
            asm volatile("s_waitcnt vmcnt(0)" ::: "memory");
        }
    }
    __syncthreads();
}

using pg8::bf16_t; using pg8::f32x4; using pg8::bf16x8;
typedef unsigned u32x4_t __attribute__((ext_vector_type(4)));
typedef unsigned u32x2_t __attribute__((ext_vector_type(2)));

constexpr int DM = 1024, NBP = 8, SEQ = 2048, NBS = 128, SSEQ = 4, NH = 4, HD = 128, MW = 512;
constexpr int MP = NBP * SEQ, MS = NBS * SSEQ, MT = MP + MS;
constexpr int NIN = 9232, N1 = 9216, DFF = 2816, NUP = 5632;
constexpr float EPS = 1e-6f;
constexpr float QSCALE = 0.08838834764831845f;

constexpr size_t O_Y = 0;
constexpr size_t O_P_GS = (size_t)MT * DM;
constexpr size_t O_P_GC = O_P_GS + (size_t)2 * 8 * 4 * 128 * 128;
constexpr size_t O_P_MC = O_P_GC + (size_t)2 * 8 * 3 * 1536;
constexpr size_t O_P_MN = O_P_MC + (size_t)2 * 8 * 4 * 128 * 128;
constexpr size_t O_P_MM = O_P_MN + (size_t)2 * 8 * 4 * 128;
constexpr size_t O_P_HS = O_P_MM + (size_t)2 * 8 * 4;
constexpr size_t O_P_FC = O_P_HS + (size_t)2 * 8 * 4 * 128 * 128;
constexpr size_t O_S_GS = O_P_FC + (size_t)2 * 8 * 2 * 5632;
constexpr size_t O_S_GC = O_S_GS + (size_t)2 * 128 * 4 * 128 * 128;
constexpr size_t O_S_MC = O_S_GC + (size_t)2 * 128 * 3 * 1536;
constexpr size_t O_S_MN = O_S_MC + (size_t)2 * 128 * 4 * 128 * 128;
constexpr size_t O_S_MM = O_S_MN + (size_t)2 * 128 * 4 * 128;
constexpr size_t O_S_HS = O_S_MM + (size_t)2 * 128 * 4;
constexpr size_t O_S_FC = O_S_HS + (size_t)2 * 128 * 4 * 128 * 128;
constexpr size_t O_END  = O_S_FC + (size_t)2 * 128 * 2 * 5632;

constexpr size_t W_WIN = 0;
constexpr size_t W_WBR = W_WIN + (size_t)N1 * 1024 * 2;
constexpr size_t W_WOUT = W_WBR + (size_t)3 * 1024 * 512 * 2;
constexpr size_t W_WUP = W_WOUT + (size_t)1024 * 1024 * 2;
constexpr size_t W_WDN = W_WUP + (size_t)NUP * 1024 * 2;
constexpr size_t W_HBF = W_WDN + (size_t)1024 * DFF * 2;
constexpr size_t W_PROJ = W_HBF + (size_t)MT * 1024 * 2;
constexpr size_t W_ACT = W_PROJ + (size_t)MT * NUP * 2;
constexpr size_t W_OUTS = W_PROJ + (size_t)MT * N1 * 2;
constexpr size_t W_GATES = W_OUTS + (size_t)3 * MT * 512 * 2;
constexpr size_t W_DEN = W_GATES + (size_t)MT * 16 * 4;
constexpr size_t W_MT = W_DEN + (size_t)MT * 4 * 4;
constexpr size_t W_BAR = W_MT + (size_t)MT * 4 * 4;
constexpr size_t W_END = W_BAR + 16384;

constexpr int LDS_BYTES = 131072 + 16;

struct Params { const float* in[28]; float* out; unsigned char* ws; };
enum { I_XP = 0, I_XS, I_SGS, I_SGC, I_SMC, I_SMN, I_SMM, I_SHS, I_SFC, I_LNMIX, I_WIN, I_GCW, I_ALOG, I_DTB, I_GNORM, I_MIB, I_MFB, I_MNORM, I_HLB, I_HNORM,
       I_WBR, I_WOUT, I_LNFFN, I_WUP, I_FCW, I_FCB, I_WDN, I_LNF };

typedef const float* const __attribute__((address_space(4))) * kargp_t;
__device__ __forceinline__ const float* argp(int i) { kargp_t kp = (kargp_t)__builtin_amdgcn_kernarg_segment_ptr(); asm volatile("" : "+s"(i)); return kp[i]; }
__device__ __forceinline__ int bidx() { int b = (int)blockIdx.x; asm volatile("" : "+s"(b)); return b; }
__device__ __forceinline__ int gdim() { int g = (int)gridDim.x; asm volatile("" : "+s"(g)); return g; }
#define PIN(i) argp(i)
#define POUT ((float*)argp(28))
#define PWS ((unsigned char*)argp(29))
__device__ __forceinline__ float bf2f(bf16_t b) { return __uint_as_float(((unsigned)b) << 16); }
__device__ __forceinline__ float bflo(unsigned u) { return __uint_as_float(u << 16); }
__device__ __forceinline__ float bfhi(unsigned u) { return __uint_as_float(u & 0xffff0000u); }
__device__ __forceinline__ bf16_t f2bf(float f) { return (bf16_t)(pg8::cvt_pk_bf16(f, 0.f) & 0xffffu); }
__device__ __forceinline__ float sigm(float x) { return __builtin_amdgcn_rcpf(1.f + __expf(-x)); }
__device__ __forceinline__ float silu(float x) { return x * sigm(x); }
template <int CTRL> __device__ __forceinline__ float dppf(float x) { return __builtin_bit_cast(float, __builtin_amdgcn_update_dpp(0, __builtin_bit_cast(int, x), CTRL, 0xf, 0xf, true)); }
__device__ __forceinline__ float grp_sum8(float x) { x += dppf<0xB1>(x); x += dppf<0x4E>(x); x += dppf<0x141>(x); return x; }
__device__ __forceinline__ float grp_sum16(float x) { x = grp_sum8(x); x += dppf<0x140>(x); return x; }
__device__ __forceinline__ float wave_sum(float x) { x = grp_sum16(x); x += __shfl_xor(x, 16); x += __shfl_xor(x, 32); return x; }
template <int T> __device__ __forceinline__ float grp_sum(float x) { if constexpr (T == 16) return grp_sum16(x); else return grp_sum8(x); }

__device__ __forceinline__ int win_srccol(int n0) { const int blk = n0 >> 9, r = n0 & 511; int base;
    if (blk < 4) base = blk * 512; else if (blk < 8) base = 2056 + (blk - 4) * 512; else if (blk < 12) base = 4112 + (blk - 8) * 512; else base = 6160 + (blk - 12) * 512;
    return base + r; }
__device__ __forceinline__ void conv_T(const float* __restrict__ src, int ld, bf16_t* __restrict__ dst, int K, int N, bool winmap, float* tile, int& tcount) {
    int tid_ = threadIdx.x; asm volatile("" : "+v"(tid_)); const int tid = tid_, ntn = N / 64, ntiles = ntn * (K / 64);
    for (int t = bidx() - (tcount % gdim()); t < ntiles; t += gdim()) {
        if (t < 0) continue;
        const int tn = t % ntn, tk = t / ntn, n0 = tn * 64, k0 = tk * 64, sc0 = winmap ? win_srccol(n0) : n0;
        __syncthreads();
        { const int kk = tid >> 4, n4 = (tid & 15) * 4;
#pragma unroll
          for (int pp = 0; pp < 2; ++pp) { const float4 v = *(const float4*)(src + (size_t)(k0 + kk + 32 * pp) * ld + sc0 + n4); float* tp = tile + (kk + 32 * pp) * 65 + n4; tp[0] = v.x; tp[1] = v.y; tp[2] = v.z; tp[3] = v.w; } }
        __syncthreads();
        { const int n = tid >> 3, k8 = (tid & 7) * 8; float f[8];
#pragma unroll
          for (int i = 0; i < 8; ++i) f[i] = tile[(k8 + i) * 65 + n];
          u32x4_t o; o[0] = pg8::cvt_pk_bf16(f[0], f[1]); o[1] = pg8::cvt_pk_bf16(f[2], f[3]); o[2] = pg8::cvt_pk_bf16(f[4], f[5]); o[3] = pg8::cvt_pk_bf16(f[6], f[7]);
          *(u32x4_t*)(dst + (size_t)(n0 + n) * K + k0 + k8) = o; }
    }
    tcount += ntiles;
}

__device__ __forceinline__ void phase_rmsnorm(const Params& p, int l, const float* xa, const float* xb, const float* __restrict__ gw, bf16_t* __restrict__ hout, bool do_gates, float* sm) {
    int tid_ = threadIdx.x; asm volatile("" : "+v"(tid_)); const int tid = tid_, lane = tid & 63, w = tid >> 6;
    float* wgT = sm;
    if (do_gates) {
        const float* win = PIN(I_WIN) + (size_t)l * 1024 * NIN;
        __syncthreads();
        for (int i = tid; i < 16 * 1024; i += 512) { const int k = i >> 4, j = i & 15; const int gc = j < 8 ? 2048 + j : 4104 + (j - 8); wgT[j * 1024 + k] = win[(size_t)k * NIN + gc]; }
        __syncthreads();
    }
    float4 g4[4];
#pragma unroll
    for (int i = 0; i < 4; ++i) g4[i] = *(const float4*)(gw + lane * 4 + 256 * i);
    for (int row = bidx() * 8 + w; row < MT; row += gdim() * 8) {
        const float* xr = row < MP ? xa + (size_t)row * DM : xb + (size_t)(row - MP) * DM;
        float4 v[4]; float ss = 0.f;
#pragma unroll
        for (int i = 0; i < 4; ++i) { v[i] = *(const float4*)(xr + lane * 4 + 256 * i); ss += v[i].x * v[i].x + v[i].y * v[i].y + v[i].z * v[i].z + v[i].w * v[i].w; }
        ss = wave_sum(ss);
        const float rstd = rsqrtf(ss * (1.f / 1024.f) + EPS);
#pragma unroll
        for (int i = 0; i < 4; ++i) { v[i].x *= rstd * g4[i].x; v[i].y *= rstd * g4[i].y; v[i].z *= rstd * g4[i].z; v[i].w *= rstd * g4[i].w;
            u32x2_t o; o[0] = pg8::cvt_pk_bf16(v[i].x, v[i].y); o[1] = pg8::cvt_pk_bf16(v[i].z, v[i].w);
            *(u32x2_t*)(hout + (size_t)row * DM + lane * 4 + 256 * i) = o; }
        if (do_gates) {
            float mine = 0.f;
#pragma unroll
            for (int j = 0; j < 16; ++j) { float a = 0.f;
#pragma unroll
                for (int i = 0; i < 4; ++i) { const float4 wv = *(const float4*)(wgT + j * 1024 + lane * 4 + 256 * i); a += v[i].x * wv.x + v[i].y * wv.y + v[i].z * wv.z + v[i].w * wv.w; }
                a = wave_sum(a); if (lane == j) mine = a; }
            if (lane < 16) { const int h = lane & 3, kind = lane >> 2; float r;
                if (kind == 0) r = sigm(mine);
                else if (kind == 1) { const float xx = mine + PIN(I_DTB)[l * 4 + h]; const float sp = xx > 20.f ? xx : log1pf(__expf(xx)); r = __expf(-__expf(PIN(I_ALOG)[l * 4 + h]) * sp); }
                else if (kind == 2) r = mine + PIN(I_MIB)[l * 4 + h];
                else { const float xx = -(mine + PIN(I_MFB)[l * 4 + h]); r = -(xx > 20.f ? xx : log1pf(__expf(xx))); }
                ((float*)(PWS + W_GATES))[(size_t)row * 16 + lane] = r; }
        }
    }
}

struct EpiProj {
    static constexpr bool PERM = true, AFTER_DRAIN = false;
    bf16_t* O; int ldc; int actmode;
    __device__ __forceinline__ void operator()(const f32x4 (&acc)[2][2][4][2], const pg8::Unit& u, int wr, int wc, int fr, int fq) const {
        const int row0 = u.pm * 256 + wr * 64 + fr, col0 = u.pn * 256 + wc * 32 + 8 * fq;
        int act = 0;
        if (actmode) { const int pn = u.pn; act = (pn >= 24 || pn == 14 || pn == 15) ? 2 : ((pn == 6 || pn == 7 || pn == 16 || pn == 17 || pn == 22 || pn == 23) ? 1 : 0); }
#pragma unroll
        for (int ai = 0; ai < 2; ++ai)
#pragma unroll
            for (int m = 0; m < 4; ++m) { bf16_t* rowp = O + (size_t)(row0 + ai * 128 + m * 16) * ldc + col0;
#pragma unroll
                for (int bj = 0; bj < 2; ++bj) { float v[8];
#pragma unroll
                    for (int i = 0; i < 4; ++i) { v[i] = acc[ai][bj][m][0][i]; v[4 + i] = acc[ai][bj][m][1][i]; }
                    if (act == 1) {
#pragma unroll
                        for (int i = 0; i < 8; ++i) v[i] = silu(v[i]); }
                    else if (act == 2) {
#pragma unroll
                        for (int i = 0; i < 8; ++i) v[i] = sigm(v[i]); }
                    u32x4_t o; o[0] = pg8::cvt_pk_bf16(v[0], v[1]); o[1] = pg8::cvt_pk_bf16(v[2], v[3]); o[2] = pg8::cvt_pk_bf16(v[4], v[5]); o[3] = pg8::cvt_pk_bf16(v[6], v[7]);
                    *(u32x4_t*)(rowp + bj * 128) = o; } }
    }
};
struct EpiMerge {
    static constexpr bool PERM = true, AFTER_DRAIN = false;
    const bf16_t* G; bf16_t* Mx; int first;
    __device__ __forceinline__ void operator()(const f32x4 (&acc)[2][2][4][2], const pg8::Unit& u, int wr, int wc, int fr, int fq) const {
        const int row0 = u.pm * 256 + wr * 64 + fr, col0 = u.pn * 256 + wc * 32 + 8 * fq;
#pragma unroll
        for (int ai = 0; ai < 2; ++ai)
#pragma unroll
            for (int m = 0; m < 4; ++m) { const size_t row = (size_t)(row0 + ai * 128 + m * 16);
#pragma unroll
                for (int bj = 0; bj < 2; ++bj) { const int col = col0 + bj * 128;
                    const u32x4_t g = *(const u32x4_t*)(G + row * N1 + col); float v[8];
#pragma unroll
                    for (int i = 0; i < 4; ++i) { v[i] = acc[ai][bj][m][0][i]; v[4 + i] = acc[ai][bj][m][1][i]; }
#pragma unroll
                    for (int i = 0; i < 4; ++i) { v[2 * i] *= bflo(g[i]); v[2 * i + 1] *= bfhi(g[i]); }
                    bf16_t* mp = Mx + row * DM + col;
                    if (!first) { const u32x4_t o = *(const u32x4_t*)mp;
#pragma unroll
                        for (int i = 0; i < 4; ++i) { v[2 * i] += bflo(o[i]); v[2 * i + 1] += bfhi(o[i]); } }
                    u32x4_t o; o[0] = pg8::cvt_pk_bf16(v[0], v[1]); o[1] = pg8::cvt_pk_bf16(v[2], v[3]); o[2] = pg8::cvt_pk_bf16(v[4], v[5]); o[3] = pg8::cvt_pk_bf16(v[6], v[7]);
                    *(u32x4_t*)mp = o; } }
    }
};
struct EpiResid {
    static constexpr bool PERM = false, AFTER_DRAIN = false;
    float* X;
    __device__ __forceinline__ void operator()(const f32x4 (&acc)[2][2][4][2], const pg8::Unit& u, int wr, int wc, int fr, int fq) const {
        const int row0 = u.pm * 256 + wr * 64 + fr, col0 = u.pn * 256 + wc * 32 + 4 * fq;
#pragma unroll
        for (int ai = 0; ai < 2; ++ai)
#pragma unroll
            for (int m = 0; m < 4; ++m) { float* rowp = X + (size_t)(row0 + ai * 128 + m * 16) * DM + col0;
#pragma unroll
                for (int bj = 0; bj < 2; ++bj)
#pragma unroll
                    for (int n = 0; n < 2; ++n) { f32x4* q = (f32x4*)(rowp + bj * 128 + n * 16); *q = *q + acc[ai][bj][m][n]; } }
    }
};
__device__ __forceinline__ void phase_gdnprep(const Params& p, int l) {
    int tid_ = threadIdx.x; asm volatile("" : "+v"(tid_)); const int tid = tid_, j = tid & 15;
    const bf16_t* proj = (const bf16_t*)(PWS + W_PROJ);
    bf16_t* qkd = (bf16_t*)(PWS + W_HBF); bf16_t* vd = (bf16_t*)(PWS + W_OUTS);
    const float* cw = PIN(I_GCW) + (size_t)l * 4 * 1536; const float* cst = PIN(I_SGC) + (size_t)l * NBS * 3 * 1536;
    const int ngroups = MT * 12;
    for (int gid = bidx() * 32 + (tid >> 4); gid < ngroups; gid += gdim() * 32) {
        const int r = gid / 12, part = gid - r * 12, col = part * 128 + 8 * j;
        const bool samp = r >= MP; const int t = samp ? ((r - MP) & 3) : (r & (SEQ - 1)), b2 = samp ? ((r - MP) >> 2) : 0;
        float y[8];
#pragma unroll
        for (int i = 0; i < 8; ++i) y[i] = 0.f;
#pragma unroll
        for (int jj = 0; jj < 4; ++jj) { const int tt = t - 3 + jj; float x[8];
            if (tt >= 0) { const u32x4_t raw = *(const u32x4_t*)(proj + (size_t)(r - 3 + jj) * N1 + col);
#pragma unroll
                for (int i = 0; i < 4; ++i) { x[2 * i] = bflo(raw[i]); x[2 * i + 1] = bfhi(raw[i]); } }
            else if (samp) { const float* cp = cst + (size_t)(b2 * 3 + 3 + tt) * 1536 + col; const float4 a0 = *(const float4*)cp, a1 = *(const float4*)(cp + 4);
                x[0] = a0.x; x[1] = a0.y; x[2] = a0.z; x[3] = a0.w; x[4] = a1.x; x[5] = a1.y; x[6] = a1.z; x[7] = a1.w; }
            else {
#pragma unroll
                for (int i = 0; i < 8; ++i) x[i] = 0.f; }
            const float4 w0 = *(const float4*)(cw + jj * 1536 + col), w1 = *(const float4*)(cw + jj * 1536 + col + 4);
            y[0] += w0.x * x[0]; y[1] += w0.y * x[1]; y[2] += w0.z * x[2]; y[3] += w0.w * x[3]; y[4] += w1.x * x[4]; y[5] += w1.y * x[5]; y[6] += w1.z * x[6]; y[7] += w1.w * x[7]; }
        float ss = 0.f;
#pragma unroll
        for (int i = 0; i < 8; ++i) { y[i] = silu(y[i]); ss += y[i] * y[i]; }
        ss = grp_sum16(ss);
        const float scl = part < 4 ? rsqrtf(ss + EPS) * QSCALE : (part < 8 ? rsqrtf(ss + EPS) : 1.f);
        u32x4_t o; o[0] = pg8::cvt_pk_bf16(y[0] * scl, y[1] * scl); o[1] = pg8::cvt_pk_bf16(y[2] * scl, y[3] * scl); o[2] = pg8::cvt_pk_bf16(y[4] * scl, y[5] * scl); o[3] = pg8::cvt_pk_bf16(y[6] * scl, y[7] * scl);
        if (part < 8) *(u32x4_t*)(qkd + (size_t)r * 1024 + col) = o; else *(u32x4_t*)(vd + (size_t)r * 512 + (col - 1024)) = o;
    }
}

typedef float f2 __attribute__((ext_vector_type(2)));
typedef float f4 __attribute__((ext_vector_type(4)));
template <int MIX>
__device__ __forceinline__ void scan_prompt_item(const Params& p, int l, int b, int h, int cgp, float* sm) {
    constexpr int T = (MIX == 0) ? 16 : 8, NG = 128 / (4 * T), NP = 2 * NG, CPW = 64 / T, CPG = 8 * CPW, TB = 32, BUFSZ = 10624, NBLK = SEQ / TB;
    int tid_ = threadIdx.x; asm volatile("" : "+v"(tid_)); const int tid = tid_, lane = tid & 63, w = tid >> 6, c = lane / T, j = lane % T;
    const int col = w * CPW + c, ecol = cgp * CPG + col;
    float* misc = sm + 2 * BUFSZ; float* gsc = misc; float* mcar = misc + 64;
    const float* gates = (const float*)(PWS + W_GATES);
    bf16_t* outp = (bf16_t*)(PWS + W_OUTS) + (size_t)MIX * MT * 512;
    const size_t rb = (size_t)b * SEQ;
    const int c8 = (tid & 31) * 8, srow = tid >> 5;
    const bf16_t* qsrc; size_t qld; const bf16_t* vsrc; size_t vld;
    if (MIX == 0) { qsrc = (const bf16_t*)(PWS + W_HBF) + rb * 1024 + (c8 < 128 ? h * 128 + c8 : 512 + h * 128 + (c8 - 128)); qld = 1024;
        vsrc = (const bf16_t*)(PWS + W_OUTS) + rb * 512 + h * 128 + cgp * 32; vld = 512; }
    else { const int base = MIX == 1 ? 2048 : 4096; qsrc = (const bf16_t*)(PWS + W_PROJ) + rb * N1 + base + (c8 < 128 ? h * 128 + c8 : 512 + h * 128 + (c8 - 128)); qld = N1;
        vsrc = (const bf16_t*)(PWS + W_PROJ) + rb * N1 + base + 1024 + h * 128 + cgp * 64; vld = N1; }
    constexpr int VPC = CPG / 8;
    const int vs = tid / VPC, vc8 = (tid % VPC) * 8; const bool vact = tid < TB * VPC;
    float lb8[8];
#pragma unroll
    for (int i = 0; i < 8; ++i) lb8[i] = 0.f;
    if (MIX == 2 && l > 0 && c8 >= 128) { const float* hl = PIN(I_HLB);
#pragma unroll
        for (int i = 0; i < 8; ++i) { const int cc = h * 128 + (c8 - 128) + i; lb8[i] = sigm(hl[512 + cc] - hl[cc]); } }
    f2 S2[NP];
#pragma unroll
    for (int i = 0; i < NP; ++i) S2[i] = (f2){0.f, 0.f};
    float nn = 0.f, okeep = 0.f;
    u32x4_t rq[2], rv; float rg0 = 0.f, rg1 = 0.f;
    rv = (u32x4_t){0u, 0u, 0u, 0u};
#define SCAN_ISSUE(t0_) do { \
        _Pragma("unroll") for (int i_ = 0; i_ < 2; ++i_) rq[i_] = *(const u32x4_t*)(qsrc + (size_t)((t0_) + srow + 16 * i_) * qld); \
        if (vact) rv = *(const u32x4_t*)(vsrc + (size_t)((t0_) + vs) * vld + vc8); \
        if (MIX != 2 && tid < TB) { const size_t r_ = rb + (t0_) + tid; rg0 = gates[r_ * 16 + (MIX == 0 ? 0 : 8) + h]; rg1 = gates[r_ * 16 + (MIX == 0 ? 4 : 12) + h]; } } while (0)
#define SCAN_FINISH(B_) do { float* qk_ = (B_); float* vv_ = (B_) + 8192; float* sc_ = (B_) + 10240; \
        _Pragma("unroll") for (int i_ = 0; i_ < 2; ++i_) { float x_[8]; \
            _Pragma("unroll") for (int e_ = 0; e_ < 4; ++e_) { x_[2 * e_] = bflo(rq[i_][e_]); x_[2 * e_ + 1] = bfhi(rq[i_][e_]); } \
            if (MIX == 2 && c8 >= 128) { _Pragma("unroll") for (int e_ = 0; e_ < 8; ++e_) x_[e_] = lb8[e_] + (1.f - lb8[e_]) * sigm(x_[e_]); } \
            float* d_ = qk_ + (srow + 16 * i_) * 256 + c8; *(f4*)d_ = (f4){x_[0], x_[1], x_[2], x_[3]}; *(f4*)(d_ + 4) = (f4){x_[4], x_[5], x_[6], x_[7]}; } \
        if (vact) { float* d_ = vv_ + vs * 64 + vc8; *(f4*)d_ = (f4){bflo(rv[0]), bfhi(rv[0]), bflo(rv[1]), bfhi(rv[1])}; *(f4*)(d_ + 4) = (f4){bflo(rv[2]), bfhi(rv[2]), bflo(rv[3]), bfhi(rv[3])}; } \
        if (MIX == 0 && tid < TB) { sc_[tid * 4] = rg0; sc_[tid * 4 + 1] = rg1; } \
        if (MIX == 1 && tid < TB) { gsc[tid * 2] = rg0; gsc[tid * 2 + 1] = rg1; } } while (0)
#define SCAN_CHAIN(B_) do { if (tid == 64) { float* sc_ = (B_) + 10240; float m_ = mcar[0]; \
            for (int s_ = 0; s_ < TB; ++s_) { const float ig_ = gsc[2 * s_], lf_ = gsc[2 * s_ + 1]; const float mn_ = fmaxf(lf_ + m_, ig_); \
                sc_[s_ * 4] = __expf(lf_ + m_ - mn_); sc_[s_ * 4 + 1] = __expf(ig_ - mn_) * QSCALE; sc_[s_ * 4 + 2] = mn_; m_ = mn_; } \
            mcar[0] = m_; } } while (0)
    if (MIX == 1 && tid == 64) mcar[0] = 0.f;
    __syncthreads();
    SCAN_ISSUE(0);
    SCAN_FINISH(sm);
    __syncthreads();
    if (MIX == 1) { SCAN_CHAIN(sm); __syncthreads(); }
#pragma unroll 1
    for (int blk = 0; blk < NBLK; ++blk) {
        const int t0 = blk * TB;
        float* B = sm + (blk & 1) * BUFSZ; float* Bn = sm + ((blk & 1) ^ 1) * BUFSZ;
        const float* qk = B; const float* vv = B + 8192; const float* sc = B + 10240; float* denp = B + 10368;
        if (blk + 1 < NBLK) SCAN_ISSUE(t0 + TB);
        f4 qa[2][NG], ka[2][NG]; float va[2], sa[2], sb[2], kda[2], qda[2];
#define SCAN_LOADOPS(slot_, s_) do { const float* qs_ = qk + (s_) * 256; \
            _Pragma("unroll") for (int g_ = 0; g_ < NG; ++g_) { qa[slot_][g_] = *(const f4*)(qs_ + g_ * 4 * T + 4 * j); ka[slot_][g_] = *(const f4*)(qs_ + 128 + g_ * 4 * T + 4 * j); } \
            va[slot_] = vv[(s_) * 64 + col]; \
            if (MIX != 2) { sa[slot_] = sc[(s_) * 4]; sb[slot_] = sc[(s_) * 4 + 1]; } \
            if (MIX == 1) { const int dn_ = 16 * w + (lane & 15); kda[slot_] = qs_[128 + dn_]; qda[slot_] = qs_[dn_]; } } while (0)
        SCAN_LOADOPS(0, 0);
#pragma unroll 1
        for (int sg = 0; sg < TB; sg += T) {
#pragma unroll
            for (int ss = 0; ss < T; ++ss) {
                const int s = sg + ss; constexpr int dummy = 0; (void)dummy;
                const int cur = ss & 1, nxt = cur ^ 1;
                SCAN_LOADOPS(nxt, (s + 1) & (TB - 1));
                __builtin_amdgcn_sched_barrier(0);
                f2 qq[NP], kk[NP];
#pragma unroll
                for (int g = 0; g < NG; ++g) { qq[2 * g] = qa[cur][g].xy; qq[2 * g + 1] = qa[cur][g].zw; kk[2 * g] = ka[cur][g].xy; kk[2 * g + 1] = ka[cur][g].zw; }
                const float v = va[cur];
                f2 oa = (f2){0.f, 0.f}, ob = (f2){0.f, 0.f};
                if (MIX == 0) {
                    const float beta = sa[cur], a = sb[cur];
                    f2 ka2 = kk[0] * S2[0], kb2 = kk[1] * S2[1];
#pragma unroll
                    for (int i = 2; i < NP; i += 2) { ka2 = kk[i] * S2[i] + ka2; kb2 = kk[i + 1] * S2[i + 1] + kb2; }
                    ka2 = ka2 + kb2;
                    const float ks = grp_sum<T>(ka2.x + ka2.y);
                    const float u = beta * (v - a * ks);
                    const f2 a2 = (f2){a, a}, u2 = (f2){u, u};
#pragma unroll
                    for (int i = 0; i < NP; i += 2) { S2[i] = S2[i] * a2 + kk[i] * u2; S2[i + 1] = S2[i + 1] * a2 + kk[i + 1] * u2; oa = qq[i] * S2[i] + oa; ob = qq[i + 1] * S2[i + 1] + ob; }
                } else if (MIX == 1) {
                    const float fp = sa[cur], ip = sb[cur], iv = ip * v;
                    const f2 f2v = (f2){fp, fp}, iv2 = (f2){iv, iv};
#pragma unroll
                    for (int i = 0; i < NP; i += 2) { S2[i] = S2[i] * f2v + kk[i] * iv2; S2[i + 1] = S2[i + 1] * f2v + kk[i + 1] * iv2; oa = qq[i] * S2[i] + oa; ob = qq[i + 1] * S2[i + 1] + ob; }
                    nn = fp * nn + ip * kda[cur]; const float dp = grp_sum16(qda[cur] * nn);
                    denp[s * 8 + w] = dp;
                } else {
                    const f2 v2 = (f2){v, v};
#pragma unroll
                    for (int i = 0; i < NP; i += 2) { S2[i] = kk[i] * (S2[i] - v2) + v2; S2[i + 1] = kk[i + 1] * (S2[i + 1] - v2) + v2; oa = qq[i] * S2[i] + oa; ob = qq[i + 1] * S2[i + 1] + ob; }
                }
                oa = oa + ob;
                const float o = grp_sum<T>(oa.x + oa.y);
                okeep = (ss == j) ? o : okeep;
            }
            outp[(rb + t0 + sg + j) * 512 + h * 128 + ecol] = f2bf(okeep);
        }
#undef SCAN_LOADOPS
        if (blk + 1 < NBLK) SCAN_FINISH(Bn);
        __syncthreads();
        if (MIX == 1) {
            if (cgp == 0 && tid < TB) { float d = 0.f;
#pragma unroll
                for (int i = 0; i < 8; ++i) d += denp[tid * 8 + i];
                const size_t r = rb + t0 + tid; ((float*)(PWS + W_DEN))[r * 4 + h] = d; ((float*)(PWS + W_MT))[r * 4 + h] = sc[tid * 4 + 2]; }
            if (blk + 1 < NBLK) SCAN_CHAIN(Bn);
            __syncthreads();
        }
    }
#undef SCAN_ISSUE
#undef SCAN_FINISH
#undef SCAN_CHAIN
    const size_t sidx = ((size_t)(l * NBP + b) * NH + h);
    float* So = POUT + (MIX == 0 ? O_P_GS : (MIX == 1 ? O_P_MC : O_P_HS)) + sidx * 16384;
#pragma unroll
    for (int g = 0; g < NG; ++g) { const int d0 = g * 4 * T + 4 * j;
        So[(size_t)(d0 + 0) * 128 + ecol] = S2[2 * g].x; So[(size_t)(d0 + 1) * 128 + ecol] = S2[2 * g].y; So[(size_t)(d0 + 2) * 128 + ecol] = S2[2 * g + 1].x; So[(size_t)(d0 + 3) * 128 + ecol] = S2[2 * g + 1].y; }
    if (MIX == 1 && cgp == 0) {
        if (lane < 16) POUT[O_P_MN + sidx * 128 + 16 * w + lane] = nn;
        if (tid == 64) POUT[O_P_MM + sidx] = mcar[0];
    }
    __syncthreads();
}

__device__ __forceinline__ void scan_sample_item(const Params& p, int l, int mix, int b, int h, float* sm) {
    int tid_ = threadIdx.x; asm volatile("" : "+v"(tid_)); const int tid = tid_, lane = tid & 63, w = tid >> 6, e = tid & 127, dg = tid >> 7;
    float* qk = sm; float* vv = sm + 1024; float* gs = sm + 1536; float* red = sm + 1600; float* dpart = sm + 1600 + 4096;
    const bf16_t* proj = (const bf16_t*)(PWS + W_PROJ);
    const float* gates = (const float*)(PWS + W_GATES);
    bf16_t* outp = (bf16_t*)(PWS + W_OUTS) + (size_t)mix * MT * 512;
    const size_t rs = (size_t)MP + (size_t)b * SSEQ;
    const size_t sidx = ((size_t)(l * NBS + b) * NH + h);
    const float* Sin = (mix == 0 ? PIN(I_SGS) : (mix == 1 ? PIN(I_SMC) : PIN(I_SHS))) + sidx * 16384;
    float S[32];
#pragma unroll
    for (int i = 0; i < 32; ++i) S[i] = Sin[(size_t)(32 * dg + i) * 128 + e];
    __syncthreads();
    for (int idx = tid; idx < 4 * 384; idx += 512) { const int s = idx / 384, ch = idx - s * 384; float val;
        if (mix == 0) { val = ch < 256 ? bf2f(((const bf16_t*)(PWS + W_HBF))[(rs + s) * 1024 + (ch >> 7) * 512 + h * 128 + (ch & 127)]) : bf2f(outp[(rs + s) * 512 + h * 128 + (ch - 256)]);
        } else if (mix == 1) { const int colx = 2048 + (ch >> 7) * 512 + h * 128 + (ch & 127); val = bf2f(proj[(rs + s) * N1 + colx]); }
        else { const int colx = 4096 + (ch >> 7) * 512 + h * 128 + (ch & 127); val = bf2f(proj[(rs + s) * N1 + colx]);
            if (ch >= 128 && ch < 256) { float lbv = 0.f; if (l > 0) { const float* hl = PIN(I_HLB); const int cc = h * 128 + (ch & 127); lbv = sigm(hl[512 + cc] - hl[cc]); } val = lbv + (1.f - lbv) * sigm(val); } }
        if (ch < 256) qk[s * 256 + ch] = val; else vv[s * 128 + ch - 256] = val; }
    if (tid < 4) { const size_t r = rs + tid;
        if (mix == 0) { gs[tid * 4] = gates[r * 16 + h]; gs[tid * 4 + 1] = gates[r * 16 + 4 + h]; }
        else if (mix == 1) { gs[tid * 4] = gates[r * 16 + 8 + h]; gs[tid * 4 + 1] = gates[r * 16 + 12 + h]; } }
    __syncthreads();
    float m = 0.f, nn = 0.f, mts[4] = {0.f, 0.f, 0.f, 0.f};
    if (mix == 1) { m = PIN(I_SMM)[sidx]; if (dg == 0) nn = PIN(I_SMN)[sidx * 128 + e]; }
#pragma unroll
    for (int s = 0; s < 4; ++s) {
        const float* qs = qk + s * 256 + 32 * dg; const float* ksp = qs + 128;
        const float v = vv[s * 128 + e];
        float po = 0.f;
        if (mix == 0) {
            const float beta = gs[s * 4], a = gs[s * 4 + 1];
            float pk = 0.f;
#pragma unroll
            for (int i = 0; i < 32; ++i) pk += ksp[i] * S[i];
            red[((s * 2) * 4 + dg) * 128 + e] = pk;
            __syncthreads();
            const float ks = red[((s * 2) * 4 + 0) * 128 + e] + red[((s * 2) * 4 + 1) * 128 + e] + red[((s * 2) * 4 + 2) * 128 + e] + red[((s * 2) * 4 + 3) * 128 + e];
            const float u = beta * (v - a * ks);
#pragma unroll
            for (int i = 0; i < 32; ++i) { S[i] = a * S[i] + ksp[i] * u; po += qs[i] * S[i]; }
        } else if (mix == 1) {
            const float ig = gs[s * 4], lf = gs[s * 4 + 1]; const float mn = fmaxf(lf + m, ig); const float fp = __expf(lf + m - mn), ip = __expf(ig - mn) * QSCALE; m = mn; mts[s] = mn;
            const float iv = ip * v;
#pragma unroll
            for (int i = 0; i < 32; ++i) { S[i] = fp * S[i] + ksp[i] * iv; po += qs[i] * S[i]; }
            if (dg == 0) { nn = fp * nn + ip * qk[s * 256 + 128 + e]; const float dp = wave_sum(qk[s * 256 + e] * nn); if (lane == 0) dpart[s * 2 + w] = dp; }
        } else {
#pragma unroll
            for (int i = 0; i < 32; ++i) { S[i] = ksp[i] * (S[i] - v) + v; po += qs[i] * S[i]; }
        }
        red[((s * 2 + 1) * 4 + dg) * 128 + e] = po;
    }
    __syncthreads();
    if (tid < 128) {
#pragma unroll
        for (int s = 0; s < 4; ++s) { const float o = red[((s * 2 + 1) * 4 + 0) * 128 + e] + red[((s * 2 + 1) * 4 + 1) * 128 + e] + red[((s * 2 + 1) * 4 + 2) * 128 + e] + red[((s * 2 + 1) * 4 + 3) * 128 + e];
            outp[(rs + s) * 512 + h * 128 + e] = f2bf(o); } }
    if (mix == 1 && tid == 0) {
#pragma unroll
        for (int s = 0; s < 4; ++s) { ((float*)(PWS + W_DEN))[(rs + s) * 4 + h] = dpart[s * 2] + dpart[s * 2 + 1]; ((float*)(PWS + W_MT))[(rs + s) * 4 + h] = mts[s]; }
        POUT[O_S_MM + sidx] = m; }
    float* So = POUT + (mix == 0 ? O_S_GS : (mix == 1 ? O_S_MC : O_S_HS)) + sidx * 16384;
#pragma unroll
    for (int i = 0; i < 32; ++i) So[(size_t)(32 * dg + i) * 128 + e] = S[i];
    if (mix == 1 && dg == 0) POUT[O_S_MN + sidx * 128 + e] = nn;
}
__device__ __forceinline__ void phase_postnorm(const Params& p, int l) {
    int tid_ = threadIdx.x; asm volatile("" : "+v"(tid_)); const int tid = tid_, j = tid & 15;
    bf16_t* outs = (bf16_t*)(PWS + W_OUTS);
    const bf16_t* proj = (const bf16_t*)(PWS + W_PROJ);
    const float* den = (const float*)(PWS + W_DEN); const float* mt = (const float*)(PWS + W_MT);
    const int ngroups = MT * 12;
    for (int gid = bidx() * 32 + (tid >> 4); gid < ngroups; gid += gdim() * 32) {
        const int r = gid / 12, mh = gid - r * 12, mix = mh >> 2, h = mh & 3;
        bf16_t* op = outs + (size_t)mix * MT * 512 + (size_t)r * 512 + h * 128 + 8 * j;
        const u32x4_t raw = *(const u32x4_t*)op;
        float v[8];
#pragma unroll
        for (int i = 0; i < 4; ++i) { v[2 * i] = bflo(raw[i]); v[2 * i + 1] = bfhi(raw[i]); }
        if (mix == 1) { const float dn = fmaxf(fabsf(den[(size_t)r * 4 + h]), __expf(-mt[(size_t)r * 4 + h])); const float inv = 1.f / dn;
#pragma unroll
            for (int i = 0; i < 8; ++i) v[i] *= inv; }
        float ss = 0.f;
#pragma unroll
        for (int i = 0; i < 8; ++i) ss += v[i] * v[i];
        ss = grp_sum16(ss);
        const float rstd = rsqrtf(ss * (1.f / 128.f) + EPS);
        const int gcol = (mix == 0 ? 1536 : (mix == 1 ? 3584 : 5632)) + h * 128 + 8 * j;
        const u32x4_t gr = *(const u32x4_t*)(proj + (size_t)r * N1 + gcol);
        const float* nw = (mix == 0 ? PIN(I_GNORM) : (mix == 1 ? PIN(I_MNORM) : PIN(I_HNORM))) + l * 512 + h * 128 + 8 * j;
        const float4 n0 = *(const float4*)nw, n1 = *(const float4*)(nw + 4);
        const float nwv[8] = {n0.x, n0.y, n0.z, n0.w, n1.x, n1.y, n1.z, n1.w};
#pragma unroll
        for (int i = 0; i < 4; ++i) { v[2 * i] *= rstd * nwv[2 * i] * bflo(gr[i]); v[2 * i + 1] *= rstd * nwv[2 * i + 1] * bfhi(gr[i]); }
        u32x4_t o; o[0] = pg8::cvt_pk_bf16(v[0], v[1]); o[1] = pg8::cvt_pk_bf16(v[2], v[3]); o[2] = pg8::cvt_pk_bf16(v[4], v[5]); o[3] = pg8::cvt_pk_bf16(v[6], v[7]);
        *(u32x4_t*)op = o;
    }
    const int ncs = (NBP + NBS) * 3 * 1536;
    for (int i = bidx() * 512 + tid; i < ncs; i += gdim() * 512) {
        const int cc = i % 1536, ri = (i / 1536) % 3, bb = i / (3 * 1536);
        if (bb < NBP) POUT[O_P_GC + ((size_t)(l * NBP + bb) * 3 + ri) * 1536 + cc] = bf2f(proj[((size_t)bb * SEQ + SEQ - 3 + ri) * N1 + cc]);
        else { const int b2 = bb - NBP; POUT[O_S_GC + ((size_t)(l * NBS + b2) * 3 + ri) * 1536 + cc] = bf2f(proj[((size_t)MP + (size_t)b2 * SSEQ + 1 + ri) * N1 + cc]); }
    }
}

__device__ __forceinline__ void phase_convffn(const Params& p, int l) {
    int tid_ = threadIdx.x; asm volatile("" : "+v"(tid_)); const int tid = tid_;
    const bf16_t* u = (const bf16_t*)(PWS + W_PROJ);
    bf16_t* act = (bf16_t*)(PWS + W_ACT);
    const float* cw = PIN(I_FCW) + (size_t)l * 3 * NUP; const float* cb = PIN(I_FCB) + (size_t)l * NUP;
    const int nitems = (MT / 4) * (DFF / 8);
    for (int it = bidx() * 512 + tid; it < nitems; it += gdim() * 512) {
        const int jg = it % (DFF / 8), rbk = it / (DFF / 8), r0 = rbk * 4, jc = jg * 8;
        const bool samp = r0 >= MP; const int tf = samp ? 0 : (r0 & (SEQ - 1));
        float wa[3][8], wb[3][8], ba[8], bb[8];
#pragma unroll
        for (int i = 0; i < 3; ++i) { const float4 a0 = *(const float4*)(cw + i * NUP + jc), a1 = *(const float4*)(cw + i * NUP + jc + 4), b0 = *(const float4*)(cw + i * NUP + DFF + jc), b1 = *(const float4*)(cw + i * NUP + DFF + jc + 4);
            wa[i][0] = a0.x; wa[i][1] = a0.y; wa[i][2] = a0.z; wa[i][3] = a0.w; wa[i][4] = a1.x; wa[i][5] = a1.y; wa[i][6] = a1.z; wa[i][7] = a1.w;
            wb[i][0] = b0.x; wb[i][1] = b0.y; wb[i][2] = b0.z; wb[i][3] = b0.w; wb[i][4] = b1.x; wb[i][5] = b1.y; wb[i][6] = b1.z; wb[i][7] = b1.w; }
        { const float4 a0 = *(const float4*)(cb + jc), a1 = *(const float4*)(cb + jc + 4), b0 = *(const float4*)(cb + DFF + jc), b1 = *(const float4*)(cb + DFF + jc + 4);
            ba[0] = a0.x; ba[1] = a0.y; ba[2] = a0.z; ba[3] = a0.w; ba[4] = a1.x; ba[5] = a1.y; ba[6] = a1.z; ba[7] = a1.w;
            bb[0] = b0.x; bb[1] = b0.y; bb[2] = b0.z; bb[3] = b0.w; bb[4] = b1.x; bb[5] = b1.y; bb[6] = b1.z; bb[7] = b1.w; }
        float xa[6][8], xb[6][8];
#pragma unroll
        for (int rr = 0; rr < 6; ++rr) {
            if (rr < 2 && tf == 0) {
                if (samp) { const float* st = PIN(I_SFC) + ((size_t)(l * NBS + (r0 - MP) / 4) * 2 + rr) * NUP;
#pragma unroll
                    for (int i = 0; i < 8; ++i) { xa[rr][i] = st[jc + i]; xb[rr][i] = st[DFF + jc + i]; } }
                else {
#pragma unroll
                    for (int i = 0; i < 8; ++i) { xa[rr][i] = 0.f; xb[rr][i] = 0.f; } }
            } else { const bf16_t* ur = u + (size_t)(r0 - 2 + rr) * NUP; const u32x4_t ra = *(const u32x4_t*)(ur + jc), rbv = *(const u32x4_t*)(ur + DFF + jc);
#pragma unroll
                for (int i = 0; i < 4; ++i) { xa[rr][2 * i] = bflo(ra[i]); xa[rr][2 * i + 1] = bfhi(ra[i]); xb[rr][2 * i] = bflo(rbv[i]); xb[rr][2 * i + 1] = bfhi(rbv[i]); } }
        }
#pragma unroll
        for (int t = 0; t < 4; ++t) { float o[8];
#pragma unroll
            for (int i = 0; i < 8; ++i) { const float ya = wa[0][i] * xa[t][i] + wa[1][i] * xa[t + 1][i] + wa[2][i] * xa[t + 2][i] + ba[i]; const float yb = wb[0][i] * xb[t][i] + wb[1][i] * xb[t + 1][i] + wb[2][i] * xb[t + 2][i] + bb[i]; o[i] = silu(ya) * yb; }
            u32x4_t ov; ov[0] = pg8::cvt_pk_bf16(o[0], o[1]); ov[1] = pg8::cvt_pk_bf16(o[2], o[3]); ov[2] = pg8::cvt_pk_bf16(o[4], o[5]); ov[3] = pg8::cvt_pk_bf16(o[6], o[7]);
            *(u32x4_t*)(act + (size_t)(r0 + t) * DFF + jc) = ov; }
        if (samp || tf == SEQ - 4) {
            float* dst = samp ? POUT + O_S_FC + (size_t)(l * NBS + (r0 - MP) / 4) * 2 * NUP : POUT + O_P_FC + (size_t)(l * NBP + r0 / SEQ) * 2 * NUP;
#pragma unroll
            for (int rr = 0; rr < 2; ++rr)
#pragma unroll
                for (int i = 0; i < 8; ++i) { dst[(size_t)rr * NUP + jc + i] = xa[4 + rr][i]; dst[(size_t)rr * NUP + DFF + jc + i] = xb[4 + rr][i]; }
        }
    }
}

__device__ __forceinline__ void phase_final_norm(const Params& p) {
    int tid_ = threadIdx.x; asm volatile("" : "+v"(tid_)); const int tid = tid_, lane = tid & 63, w = tid >> 6;
    const float* gw = PIN(I_LNF);
    float4 g4[4];
#pragma unroll
    for (int i = 0; i < 4; ++i) g4[i] = *(const float4*)(gw + lane * 4 + 256 * i);
    for (int row = bidx() * 8 + w; row < MT; row += gdim() * 8) {
        float* xr = POUT + (size_t)row * DM; float4 v[4]; float ss = 0.f;
#pragma unroll
        for (int i = 0; i < 4; ++i) { v[i] = *(const float4*)(xr + lane * 4 + 256 * i); ss += v[i].x * v[i].x + v[i].y * v[i].y + v[i].z * v[i].z + v[i].w * v[i].w; }
        ss = wave_sum(ss); const float rstd = rsqrtf(ss * (1.f / 1024.f) + EPS);
#pragma unroll
        for (int i = 0; i < 4; ++i) { v[i].x *= rstd * g4[i].x; v[i].y *= rstd * g4[i].y; v[i].z *= rstd * g4[i].z; v[i].w *= rstd * g4[i].w; *(float4*)(xr + lane * 4 + 256 * i) = v[i]; }
    }
}

#ifndef PHM
#define PHM 0xFFFF
#endif
#ifndef DUPB
#define DUPB 1
#endif
#ifndef DUPC
#define DUPC 1
#endif
#ifndef DUPS
#define DUPS 1
#endif
#ifndef DUPH
#define DUPH 1
#endif
#ifndef DUPY
#define DUPY 1
#endif
#ifndef DUPA
#define DUPA 1
#endif
#ifndef DUPI
#define DUPI 1
#endif
#define GSYNC() do { for (int y_ = 0; y_ < DUPY; ++y_) xcd_barrier(xb); } while (0)
__global__ void __launch_bounds__(512, 2) fwd_megakernel(Params p) {
    extern __shared__ __attribute__((aligned(16))) unsigned char shm[];
    cg::grid_group grid = cg::this_grid();
    float* smf = (float*)shm;
    PG8_LAS unsigned char* lds = (PG8_LAS unsigned char*)shm;
    int tid_ = threadIdx.x; asm volatile("" : "+v"(tid_)); const int tid = tid_;
    float* X = POUT;
    volatile XLAS unsigned* xst = (volatile XLAS unsigned*)(lds + 131072);
    if (tid == 0) { xst[0] = 0u; xst[1] = 0u; xst[2] = 0u; xst[3] = 0u; }
    __syncthreads();
    XcdBarrier xb = xcd_barrier_post((unsigned*)(PWS + W_BAR), xst);
    bool first_sync = true;
    bf16_t* hbf = (bf16_t*)(PWS + W_HBF);
    bf16_t* proj = (bf16_t*)(PWS + W_PROJ);

    for (int l = 0; l < 2; ++l) {
        const int G = gdim(), bid = bidx();
        for (int repa = 0; repa < DUPA; ++repa) { if (PHM & 1) { int tc = 0;
          conv_T(PIN(I_WIN) + (size_t)l * 1024 * NIN, NIN, (bf16_t*)(PWS + W_WIN), 1024, N1, true, smf, tc);
          for (int n = 0; n < 3; ++n) conv_T(PIN(I_WBR) + ((size_t)l * 3 + n) * 512 * 1024, 1024, (bf16_t*)(PWS + W_WBR) + (size_t)n * 1024 * 512, 512, 1024, false, smf, tc);
          conv_T(PIN(I_WOUT) + (size_t)l * 1024 * 1024, 1024, (bf16_t*)(PWS + W_WOUT), 1024, 1024, false, smf, tc);
          conv_T(PIN(I_WUP) + (size_t)l * 1024 * NUP, NUP, (bf16_t*)(PWS + W_WUP), 1024, NUP, false, smf, tc);
          conv_T(PIN(I_WDN) + (size_t)l * DFF * 1024, 1024, (bf16_t*)(PWS + W_WDN), DFF, 1024, false, smf, tc);
          __syncthreads(); }
        if (PHM & 2) { if (l == 0) {
            const float4* s0 = (const float4*)PIN(I_XP); const float4* s1 = (const float4*)PIN(I_XS); float4* d = (float4*)X;
            const size_t n0 = (size_t)MP * DM / 4, n1 = (size_t)MS * DM / 4;
            int tq_ = threadIdx.x; asm volatile("" : "+v"(tq_));
            for (size_t i = (size_t)bid * 512 + tq_; i < n0 + n1; i += (size_t)G * 512) d[i] = i < n0 ? s0[i] : s1[i - n0];
        }
        phase_rmsnorm(p, l, l == 0 ? PIN(I_XP) : X, l == 0 ? PIN(I_XS) : X + (size_t)MP * DM, PIN(I_LNMIX) + l * DM, hbf, true, smf); } }
        if (first_sync) { grid.sync(); first_sync = false; }
        else GSYNC();
        for (int rep = 0; rep < DUPB; ++rep) { pg8::Gemm g{hbf, (const bf16_t*)(PWS + W_WIN), MT, N1, 1024}; pg8::StaticOrder S; S.init(MT, N1, G, bid); EpiProj E{proj, N1, 1}; pg8::gemm_phase(lds, g, S, E); }
        GSYNC();
        phase_gdnprep(p, l);
        GSYNC();
        for (int rep = 0; rep < DUPC; ++rep) for (int it = bid; it < 256; it += G) {
            if (it < 128) scan_prompt_item<0>(p, l, (it >> 2) >> 2, (it >> 2) & 3, it & 3, smf);
            else if (it < 192) { const int q = it - 128; scan_prompt_item<1>(p, l, (q >> 1) >> 2, (q >> 1) & 3, q & 1, smf); }
            else { const int q = it - 192; scan_prompt_item<2>(p, l, (q >> 1) >> 2, (q >> 1) & 3, q & 1, smf); }
        }
        for (int rep = 0; rep < DUPS; ++rep) for (int it = bid; it < 3 * NBS * NH; it += G) { const int mix = it / (NBS * NH), r = it - mix * (NBS * NH); scan_sample_item(p, l, mix, r >> 2, r & 3, smf); }
        GSYNC();
        if (PHM & 32) phase_postnorm(p, l);
        GSYNC();
        if (PHM & 64) for (int n = 0; n < 3; ++n) { pg8::Gemm g{(const bf16_t*)(PWS + W_OUTS) + (size_t)n * MT * 512, (const bf16_t*)(PWS + W_WBR) + (size_t)n * 1024 * 512, MT, 1024, 512};
            pg8::StaticOrder S; S.init(MT, 1024, G, bid); EpiMerge E{proj + 6144 + n * 1024, hbf, n == 0}; pg8::gemm_phase(lds, g, S, E); }
        GSYNC();
        if (PHM & 128) { pg8::Gemm g{hbf, (const bf16_t*)(PWS + W_WOUT), MT, 1024, 1024}; pg8::StaticOrder S; S.init(MT, 1024, G, bid); EpiResid E{X}; pg8::gemm_phase(lds, g, S, E); }
        GSYNC();
        if (PHM & 256) phase_rmsnorm(p, l, X, X + (size_t)MP * DM, PIN(I_LNFFN) + l * DM, hbf, false, smf);
        GSYNC();
        for (int rep = 0; rep < DUPH; ++rep) { pg8::Gemm g{hbf, (const bf16_t*)(PWS + W_WUP), MT, NUP, 1024}; pg8::StaticOrder S; S.init(MT, NUP, G, bid); EpiProj E{proj, NUP, 0}; pg8::gemm_phase(lds, g, S, E); }
        GSYNC();
        for (int repi = 0; repi < DUPI; ++repi) phase_convffn(p, l);
        GSYNC();
        if (PHM & 2048) { pg8::Gemm g{(const bf16_t*)(PWS + W_ACT), (const bf16_t*)(PWS + W_WDN), MT, 1024, DFF}; pg8::StaticOrder S; S.init(MT, 1024, G, bid); EpiResid E{X}; pg8::gemm_phase(lds, g, S, E); }
        GSYNC();
    }
    if (PHM & 4096) phase_final_norm(p);
}

extern "C" void kernel_launch(void* const* d_in, const int* in_sizes, int n_in, void* d_out, int out_size, void* d_ws, size_t ws_size, hipStream_t stream) {
    static int grid_blocks = 0;
    if (grid_blocks == 0) {
        if (n_in != 28 || (size_t)out_size != O_END || ws_size < W_END) { fprintf(stderr, "kernel_launch: unexpected shapes: n_in %d out %d (want %zu) ws %zu (need %zu)\n", n_in, out_size, (size_t)O_END, ws_size, (size_t)W_END); grid_blocks = -1; return; }
        int dev = 0, cus = 0, per_cu = 0;
        hipGetDevice(&dev); hipDeviceGetAttribute(&cus, hipDeviceAttributeMultiprocessorCount, dev);
        if (hipFuncSetAttribute((const void*)fwd_megakernel, hipFuncAttributeMaxDynamicSharedMemorySize, LDS_BYTES) != hipSuccess) { fprintf(stderr, "kernel_launch: hipFuncSetAttribute failed\n"); grid_blocks = -1; return; }
        if (hipOccupancyMaxActiveBlocksPerMultiprocessor(&per_cu, (const void*)fwd_megakernel, 512, LDS_BYTES) != hipSuccess || per_cu < 1) { fprintf(stderr, "kernel_launch: occupancy query gave %d\n", per_cu); per_cu = 1; (void)hipGetLastError(); }
        grid_blocks = cus * per_cu;
    }
    if (grid_blocks < 0) return;
    if (hipMemsetAsync((unsigned char*)d_ws + W_BAR, 0, XCD_BAR_WORDS * 4, stream) != hipSuccess) { fprintf(stderr, "kernel_launch: memset of barrier words failed\n"); return; }
    Params p{};
    for (int i = 0; i < 28; ++i) p.in[i] = (const float*)d_in[i];
    p.out = (float*)d_out; p.ws = (unsigned char*)d_ws;
    void* args[] = {&p};
    hipError_t e = hipLaunchCooperativeKernel((const void*)fwd_megakernel, dim3(grid_blocks), dim3(512), args, LDS_BYTES, stream);
    if (e != hipSuccess) fprintf(stderr, "kernel_launch: cooperative launch failed: %s (grid %d)\n", hipGetErrorString(e), grid_blocks);
}
```

```cpp
#include <hip/hip_runtime.h>
#include <hip/hip_cooperative_groups.h>
#include <cstdio>
namespace cg = cooperative_groups;
namespace pg8 {
#define PG8_LAS __attribute__((address_space(3)))
typedef unsigned short bf16_t;
typedef short bf16x8 __attribute__((ext_vector_type(8)));
typedef float f32x4 __attribute__((ext_vector_type(4)));
typedef unsigned u32x4 __attribute__((ext_vector_type(4)));
constexpr int BM = 256, BK = 64, HALF = 128, HTB = HALF * BK * 2  , STAGE_BYTES = 8 * HTB, NXCD = 8, WGM = 8;

__host__ __device__ __forceinline__ int lds_byte(int r, int c) { const int st = (r >> 4) * 2 + (c >> 5), rr = r & 15, cc = c & 31, ob = rr * 64 + cc * 2; return st * 1024 + (ob ^ (((ob >> 9) & 1) << 5)); }
__host__ __device__ __forceinline__ void stage_rc(int b, int& R, int& C) { const int st = b / 1024, sb = b % 1024, swz = sb ^ (((sb >> 9) & 1) << 5); R = (st >> 1) * 16 + swz / 64; C = (st & 1) * 32 + (swz % 64) / 2; }
__host__ __device__ __forceinline__ int perm32(int rho) { const int n = rho >> 4, i = rho & 15; return 8 * (i >> 2) + 4 * n + (i & 3); }

struct Unit { int pm, pn; };
struct Gemm { const bf16_t* A; const bf16_t* Bt; int M, N, K; };

struct StaticOrder {
    int nM, nN, nwg, G, c;
    __host__ __device__ void init(int M, int N, int G_, int c_) { nM = M / BM; nN = N / BM; nwg = nM * nN; G = G_; c = c_; }
    __host__ __device__ bool next(int i, Unit& u) const {
        const long L = (long)i * G + c; if (L >= nwg) return false;
        int wgid = (int)L; { const int q = nwg / NXCD, r = nwg % NXCD, xcd = wgid % NXCD, off = wgid / NXCD; wgid = (xcd < r ? xcd * (q + 1) : r * (q + 1) + (xcd - r) * q) + off; }
        const int nig = WGM * nN, gid = wgid / nig, fm = gid * WGM, gsz = (nM - fm) < WGM ? (nM - fm) : WGM;
        u.pm = fm + ((wgid % nig) % gsz); u.pn = (wgid % nig) / gsz; return true;
    }
    __device__ __forceinline__ void a_ready(const Unit&) const {}
    __device__ __forceinline__ void done(const Unit&) const {}
};
__device__ __forceinline__ unsigned cvt_pk_bf16(float lo, float hi) { unsigned r; asm volatile("v_cvt_pk_bf16_f32 %0, %1, %2" : "=v"(r) : "v"(lo), "v"(hi)); return r; }
template <class Epi, class Sched>
__device__ __forceinline__ void gemm_phase(PG8_LAS unsigned char* lds, const Gemm g, const Sched& S, const Epi& E) {
    int tid_ = threadIdx.x; asm volatile("" : "+v"(tid_));
    const int tid = tid_, wid = __builtin_amdgcn_readfirstlane(tid >> 6), lane = tid & 63, wr = wid >> 2, wc = wid & 3, fr = lane & 15, fq = lane >> 4;
    const int K = g.K, nt = K / BK;
    unsigned voffA[2], voffB[2];
#pragma unroll
    for (int i = 0; i < 2; ++i) { int R, C; stage_rc(tid * 16 + i * 8192, R, C); const int Rb = Epi::PERM ? ((R & ~31) + perm32(R & 31)) : R;
        voffA[i] = (unsigned)(R * K + C) * 2u; voffB[i] = (unsigned)(Rb * K + C) * 2u; }
    const size_t kstep = (size_t)(BK * 2);
    const size_t hstep = (size_t)HALF * K * 2;
    const size_t tstep = 2 * hstep;
    const unsigned ldsw = (unsigned)wid * 1024u;
    const int aoff = lds_byte(wr * 64 + fr, fq * 8), boff = lds_byte(wc * 32 + fr, fq * 8);
#define PG8_SA(b, h) (((b) * 2 + (h)) * HTB)
#define PG8_SB(b, h) ((4 + (b) * 2 + (h)) * HTB)
#define PG8_STAGE(bufoff, gbase, voff) do { _Pragma("unroll") for (int _i = 0; _i < 2; ++_i) \
        __builtin_amdgcn_global_load_lds((const unsigned*)((const char*)(gbase) + (voff)[_i]), (PG8_LAS unsigned*)(lds + (bufoff) + ldsw + _i * 8192), 16, 0, 0); } while (0)
#define PG8_LDA(dst, b, h) do { _Pragma("unroll") for (int m = 0; m < 4; ++m) _Pragma("unroll") for (int k = 0; k < 2; ++k) dst[m][k] = *(const PG8_LAS bf16x8*)(lds + PG8_SA(b, h) + aoff + m * 2048 + k * 1024); } while (0)
#define PG8_LDB(dst, b, h) do { _Pragma("unroll") for (int n = 0; n < 2; ++n) _Pragma("unroll") for (int k = 0; k < 2; ++k) dst[n][k] = *(const PG8_LAS bf16x8*)(lds + PG8_SB(b, h) + boff + n * 2048 + k * 1024); } while (0)
#define PG8_MMA(ai, bj, At, Bt) do { __builtin_amdgcn_s_setprio(1); _Pragma("unroll") for (int m = 0; m < 4; ++m) _Pragma("unroll") for (int n = 0; n < 2; ++n) _Pragma("unroll") for (int k = 0; k < 2; ++k) \
        acc[ai][bj][m][n] = __builtin_amdgcn_mfma_f32_16x16x32_bf16(Bt[n][k], At[m][k], acc[ai][bj][m][n], 0, 0, 0); __builtin_amdgcn_s_setprio(0); } while (0)
#define PG8_WAIT_V(n) asm volatile("s_waitcnt vmcnt(" #n ")" ::: "memory")
#define PG8_WAIT_L(n) asm volatile("s_waitcnt lgkmcnt(" #n ")" ::: "memory")
#define PG8_BAR __builtin_amdgcn_s_barrier()
#define PG8_SCHED __builtin_amdgcn_sched_barrier(0)
    Unit cur, nxt; int ui = 0;
    if (!S.next(0, cur)) return;
    f32x4 acc[2][2][4][2];
#pragma unroll
    for (int a = 0; a < 2; ++a)
#pragma unroll
        for (int b = 0; b < 2; ++b)
#pragma unroll
            for (int m = 0; m < 4; ++m)
#pragma unroll
                for (int n = 0; n < 2; ++n) acc[a][b][m][n] = (f32x4){0.f, 0.f, 0.f, 0.f};
    bf16x8 At[4][2], B0[2][2], B1[2][2];
    const char* cA = (const char*)g.A + (size_t)cur.pm * tstep; const char* cB = (const char*)g.Bt + (size_t)cur.pn * tstep;
    S.a_ready(cur);
    PG8_STAGE(PG8_SB(0, 0), cB, voffB); PG8_STAGE(PG8_SA(0, 0), cA, voffA); PG8_STAGE(PG8_SB(0, 1), cB + hstep, voffB); PG8_STAGE(PG8_SA(0, 1), cA + hstep, voffA);
    if (wr == 1) PG8_BAR;
    PG8_WAIT_V(4); PG8_BAR;
    PG8_STAGE(PG8_SB(1, 0), cB + kstep, voffB); PG8_STAGE(PG8_SA(1, 0), cA + kstep, voffA); PG8_STAGE(PG8_SB(1, 1), cB + hstep + kstep, voffB);
    PG8_WAIT_V(6); PG8_BAR;
    for (;;) {
        const bool has_next = S.next(ui + 1, nxt);
        const char* nA = has_next ? (const char*)g.A + (size_t)nxt.pm * tstep : cA; const char* nB = has_next ? (const char*)g.Bt + (size_t)nxt.pn * tstep : cB;
        for (int t = 0; t < nt; t += 2) {
            const bool last = (t == nt - 2);
            const char* a1 = cA + (size_t)(t + 1) * kstep;
            const char* a2 = last ? nA : cA + (size_t)(t + 2) * kstep; const char* b2 = last ? nB : cB + (size_t)(t + 2) * kstep;
            const char* a3 = a2 + kstep; const char* b3 = b2 + kstep;
            if (last && has_next) S.a_ready(nxt);
            PG8_LDB(B0, 0, 0); PG8_SCHED; PG8_LDA(At, 0, 0); PG8_STAGE(PG8_SA(1, 1), a1 + hstep, voffA);
            PG8_WAIT_L(8); PG8_BAR; PG8_WAIT_L(0); PG8_MMA(0, 0, At, B0); PG8_BAR; PG8_SCHED;
            PG8_LDB(B1, 0, 1); PG8_STAGE(PG8_SB(0, 0), b2, voffB);
            PG8_BAR; PG8_WAIT_L(0); PG8_MMA(0, 1, At, B1); PG8_BAR;
            PG8_LDA(At, 0, 1); PG8_STAGE(PG8_SA(0, 0), a2, voffA);
            PG8_BAR; PG8_WAIT_L(0); PG8_MMA(1, 0, At, B0); PG8_BAR; PG8_SCHED;
            PG8_STAGE(PG8_SB(0, 1), b2 + hstep, voffB);
            PG8_WAIT_V(6); PG8_BAR; PG8_MMA(1, 1, At, B1); PG8_BAR;
            PG8_LDB(B0, 1, 0); PG8_SCHED; PG8_LDA(At, 1, 0); PG8_STAGE(PG8_SA(0, 1), a2 + hstep, voffA);
            PG8_WAIT_L(8); PG8_BAR; PG8_WAIT_L(0); PG8_MMA(0, 0, At, B0); PG8_BAR; PG8_SCHED;
            PG8_LDB(B1, 1, 1); PG8_STAGE(PG8_SB(1, 0), b3, voffB);
            PG8_BAR; PG8_WAIT_L(0); PG8_MMA(0, 1, At, B1); PG8_BAR;
            PG8_LDA(At, 1, 1); PG8_STAGE(PG8_SA(1, 0), a3, voffA);
            PG8_BAR; PG8_WAIT_L(0); PG8_MMA(1, 0, At, B0); PG8_BAR; PG8_SCHED;
            PG8_STAGE(PG8_SB(1, 1), b3 + hstep, voffB);
            PG8_WAIT_V(6); PG8_BAR; PG8_MMA(1, 1, At, B1); PG8_BAR;
        }
        if constexpr (!Epi::AFTER_DRAIN) { E(acc, cur, wr, wc, fr, fq); S.done(cur); }
        if (!has_next) break;
#pragma unroll
        for (int a = 0; a < 2; ++a)
#pragma unroll
            for (int b = 0; b < 2; ++b)
#pragma unroll
                for (int m = 0; m < 4; ++m)
#pragma unroll
                    for (int n = 0; n < 2; ++n) acc[a][b][m][n] = (f32x4){0.f, 0.f, 0.f, 0.f};
        cur = nxt; cA = nA; cB = nB; ++ui;
    }
    PG8_WAIT_V(0);
    if (wr == 0) PG8_BAR;
    PG8_BAR;
    if constexpr (Epi::AFTER_DRAIN) { E.fused(acc, cur, wr, wc, fr, fq, lds, wid, lane); S.done(cur); }
#undef PG8_SA
#undef PG8_SB
#undef PG8_STAGE
#undef PG8_LDA
#undef PG8_LDB
#undef PG8_MMA
#undef PG8_WAIT_V
#undef PG8_WAIT_L
#undef PG8_BAR
#undef PG8_SCHED
}
}

#define XB_TMO      128
#define XB_XCNT(j)  (256  + 64 * (j))
#define XB_XSUB(j)  (1280 + 64 * (j))
#define XB_XGEN(j)  (2304 + 64 * (j))
#define XB_TOP      3328
#define XB_TOPGEN   3392
#define XCD_BAR_WORDS 3456
#define XB_SPIN_CAP (1u << 18)
#define XLAS __attribute__((address_space(3)))

__device__ __forceinline__ unsigned xb_ld(unsigned* p)              { return __hip_atomic_load(p, __ATOMIC_RELAXED, __HIP_MEMORY_SCOPE_AGENT); }
__device__ __forceinline__ unsigned xb_add(unsigned* p, unsigned v) { return __hip_atomic_fetch_add(p, v, __ATOMIC_RELAXED, __HIP_MEMORY_SCOPE_AGENT); }
__device__ __forceinline__ unsigned xb_xcc_id() { return (unsigned)__builtin_amdgcn_s_getreg((3 << 11) | 20) & 0xFu; }
#define XB_SPIN(cond, bar) do { unsigned _sp = 0; while (cond) { __builtin_amdgcn_s_sleep(1); \
    if ((++_sp & 255u) == 0u) { if (xb_ld(&(bar)[XB_TMO])) break; if (_sp > XB_SPIN_CAP) { atomicAdd(&(bar)[XB_TMO], 1u); break; } } } } while (0)

struct XcdBarrier {
    unsigned* bar; unsigned x;
    volatile XLAS unsigned* st;
};

__device__ __forceinline__ XcdBarrier xcd_barrier_post(unsigned* bar, volatile XLAS unsigned* st) {
    XcdBarrier b; b.bar = bar; b.x = xb_xcc_id(); b.st = st;
    if (threadIdx.x == 0) (void)xb_add(&bar[XB_XCNT(b.x)], 1u);
    return b;
}
__device__ __forceinline__ void xcd_barrier_complete(unsigned* bar, unsigned x, unsigned& nloc, unsigned& nx) {
    const unsigned G = gridDim.x * gridDim.y * gridDim.z;
    unsigned sum, cnt, mine, sp = 0u;
    for (;;) {
        sum = 0u; cnt = 0u; mine = 0u;
#pragma unroll
        for (unsigned j = 0; j < 16; ++j) { const unsigned c = xb_ld(&bar[XB_XCNT(j)]); sum += c; cnt += (c > 0u) ? 1u : 0u; mine = (j == x) ? c : mine; }
        if (sum == G) break;
        __builtin_amdgcn_s_sleep(1);
        if ((++sp & 255u) == 0u) { if (xb_ld(&bar[XB_TMO])) break; if (sp > XB_SPIN_CAP) { atomicAdd(&bar[XB_TMO], 1u); break; } }
    }
    nloc = mine > 0u ? mine : 1u; nx = cnt > 0u ? cnt : 1u;
}

__device__ __forceinline__ void xcd_barrier(const XcdBarrier& b) {
    asm volatile("s_waitcnt vmcnt(0)" ::: "memory");
    __syncthreads();
    if (threadIdx.x == 0) {
        unsigned* bar = b.bar;
        __builtin_amdgcn_s_waitcnt(0);
        unsigned nloc = b.st[0], nx = b.st[1];
        if (nloc == 0u) { xcd_barrier_complete(bar, b.x, nloc, nx); b.st[0] = nloc; b.st[1] = nx; }
        const unsigned old = xb_add(&bar[XB_XSUB(b.x)], 1u);
        const unsigned gen = old / nloc;
        if (old + 1u == (gen + 1u) * nloc) {
            __builtin_amdgcn_fence(__ATOMIC_RELEASE, "agent");
            asm volatile("s_waitcnt vmcnt(0)" ::: "memory");
            const unsigned og = xb_add(&bar[XB_TOP], 1u);
            const unsigned tg = og / nx;
            if (og + 1u == (tg + 1u) * nx) xb_add(&bar[XB_TOPGEN], 1u);
            else XB_SPIN(xb_ld(&bar[XB_TOPGEN]) == tg, bar);
            __builtin_amdgcn_fence(__ATOMIC_ACQUIRE, "agent");
            xb_add(&bar[XB_XGEN(b.x)], 1u);
            asm volatile("s_waitcnt vmcnt(0)" ::: "memory");
        } else {
            XB_SPIN(xb_ld(&bar[XB_XGEN(b.x)]) == gen, bar);
            __builtin_amdgcn_fence(__ATOMIC_ACQUIRE, "agent");
            asm volatile("s_waitcnt vmcnt(0)" ::: "memory");
        }
    }
    __syncthreads();
}

using pg8::bf16_t; using pg8::f32x4; using pg8::bf16x8;
typedef unsigned u32x4_t __attribute__((ext_vector_type(4)));
typedef unsigned u32x2_t __attribute__((ext_vector_type(2)));

constexpr int DM = 1024, NBP = 8, SEQ = 2048, NBS = 128, SSEQ = 4, NH = 4, HD = 128, MW = 512;
constexpr int MP = NBP * SEQ, MS = NBS * SSEQ, MT = MP + MS;
constexpr int NIN = 9232, N1 = 9216, DFF = 2816, NUP = 5632;
constexpr float EPS = 1e-6f;
constexpr float QSCALE = 0.08838834764831845f;

constexpr size_t O_Y = 0;
constexpr size_t O_P_GS = (size_t)MT * DM;
constexpr size_t O_P_GC = O_P_GS + (size_t)2 * 8 * 4 * 128 * 128;
constexpr size_t O_P_MC = O_P_GC + (size_t)2 * 8 * 3 * 1536;
constexpr size_t O_P_MN = O_P_MC + (size_t)2 * 8 * 4 * 128 * 128;
constexpr size_t O_P_MM = O_P_MN + (size_t)2 * 8 * 4 * 128;
constexpr size_t O_P_HS = O_P_MM + (size_t)2 * 8 * 4;
constexpr size_t O_P_FC = O_P_HS + (size_t)2 * 8 * 4 * 128 * 128;
constexpr size_t O_S_GS = O_P_FC + (size_t)2 * 8 * 2 * 5632;
constexpr size_t O_S_GC = O_S_GS + (size_t)2 * 128 * 4 * 128 * 128;
constexpr size_t O_S_MC = O_S_GC + (size_t)2 * 128 * 3 * 1536;
constexpr size_t O_S_MN = O_S_MC + (size_t)2 * 128 * 4 * 128 * 128;
constexpr size_t O_S_MM = O_S_MN + (size_t)2 * 128 * 4 * 128;
constexpr size_t O_S_HS = O_S_MM + (size_t)2 * 128 * 4;
constexpr size_t O_S_FC = O_S_HS + (size_t)2 * 128 * 4 * 128 * 128;
constexpr size_t O_END  = O_S_FC + (size_t)2 * 128 * 2 * 5632;

constexpr size_t W_WIN = 0;
constexpr size_t W_WBR = W_WIN + (size_t)N1 * 1024 * 2;
constexpr size_t W_WOUT = W_WBR + (size_t)3 * 1024 * 512 * 2;
constexpr size_t W_WUP = W_WOUT + (size_t)1024 * 1024 * 2;
constexpr size_t W_WDN = W_WUP + (size_t)NUP * 1024 * 2;
constexpr size_t W_HBF = W_WDN + (size_t)1024 * DFF * 2;
constexpr size_t W_PROJ = W_HBF + (size_t)MT * 1024 * 2;
constexpr size_t W_ACT = W_PROJ + (size_t)MT * NUP * 2;
constexpr size_t W_OUTS = W_PROJ + (size_t)MT * N1 * 2;
constexpr size_t W_GATES = W_OUTS + (size_t)3 * MT * 512 * 2;
constexpr size_t W_DEN = W_GATES + (size_t)MT * 16 * 4;
constexpr size_t W_MT = W_DEN + (size_t)MT * 4 * 4;
constexpr size_t W_BAR = W_MT + (size_t)MT * 4 * 4;
constexpr size_t W_END = W_BAR + 16384;

constexpr int LDS_BYTES = 131072 + 16;

struct Params { const float* in[28]; float* out; unsigned char* ws; };
enum { I_XP = 0, I_XS, I_SGS, I_SGC, I_SMC, I_SMN, I_SMM, I_SHS, I_SFC, I_LNMIX, I_WIN, I_GCW, I_ALOG, I_DTB, I_GNORM, I_MIB, I_MFB, I_MNORM, I_HLB, I_HNORM,
       I_WBR, I_WOUT, I_LNFFN, I_WUP, I_FCW, I_FCB, I_WDN, I_LNF };

typedef const float* const __attribute__((address_space(4))) * kargp_t;
__device__ __forceinline__ const float* argp(int i) { kargp_t kp = (kargp_t)__builtin_amdgcn_kernarg_segment_ptr(); asm volatile("" : "+s"(i)); return kp[i]; }
__device__ __forceinline__ int bidx() { int b = (int)blockIdx.x; asm volatile("" : "+s"(b)); return b; }
__device__ __forceinline__ int gdim() { int g = (int)gridDim.x; asm volatile("" : "+s"(g)); return g; }
#define PIN(i) argp(i)
#define POUT ((float*)argp(28))
#define PWS ((unsigned char*)argp(29))
__device__ __forceinline__ float bf2f(bf16_t b) { return __uint_as_float(((unsigned)b) << 16); }
__device__ __forceinline__ float bflo(unsigned u) { return __uint_as_float(u << 16); }
__device__ __forceinline__ float bfhi(unsigned u) { return __uint_as_float(u & 0xffff0000u); }
__device__ __forceinline__ bf16_t f2bf(float f) { return (bf16_t)(pg8::cvt_pk_bf16(f, 0.f) & 0xffffu); }
__device__ __forceinline__ float sigm(float x) { return __builtin_amdgcn_rcpf(1.f + __expf(-x)); }
__device__ __forceinline__ float silu(float x) { return x * sigm(x); }
__device__ __forceinline__ float rdlane(float x, int l) { return __builtin_bit_cast(float, __builtin_amdgcn_readlane(__builtin_bit_cast(int, x), l)); }
template <int CTRL> __device__ __forceinline__ float dppf(float x) { return __builtin_bit_cast(float, __builtin_amdgcn_update_dpp(0, __builtin_bit_cast(int, x), CTRL, 0xf, 0xf, true)); }
__device__ __forceinline__ float grp_sum8(float x) { x += dppf<0xB1>(x); x += dppf<0x4E>(x); x += dppf<0x141>(x); return x; }
__device__ __forceinline__ float grp_sum16(float x) { x = grp_sum8(x); x += dppf<0x140>(x); return x; }
__device__ __forceinline__ float wave_sum(float x) { x = grp_sum16(x);
    x += __builtin_bit_cast(float, __builtin_amdgcn_update_dpp(0, __builtin_bit_cast(int, x), 0x142, 0xa, 0xf, false));
    x += __builtin_bit_cast(float, __builtin_amdgcn_update_dpp(0, __builtin_bit_cast(int, x), 0x143, 0xc, 0xf, false));
    return rdlane(x, 63); }
template <int CTRL> __device__ __forceinline__ float dppm(float x) { return __builtin_bit_cast(float, __builtin_amdgcn_update_dpp(__builtin_bit_cast(int, -INFINITY), __builtin_bit_cast(int, x), CTRL, 0xf, 0xf, false)); }
template <int T> __device__ __forceinline__ float grp_sum(float x) { if constexpr (T == 16) return grp_sum16(x); else return grp_sum8(x); }

__device__ __forceinline__ int win_srccol(int n0) { const int blk = n0 >> 9, r = n0 & 511; int base;
    if (blk < 4) base = blk * 512; else if (blk < 8) base = 2056 + (blk - 4) * 512; else if (blk < 12) base = 4112 + (blk - 8) * 512; else base = 6160 + (blk - 12) * 512;
    return base + r; }
__device__ __forceinline__ void conv_T(const float* __restrict__ src, int ld, bf16_t* __restrict__ dst, int K, int N, bool winmap, float* tile, int& tcount) {
    int tid_ = threadIdx.x; asm volatile("" : "+v"(tid_)); const int tid = tid_, ntn = N / 64, ntiles = ntn * (K / 64);
    for (int t = bidx() - (tcount % gdim()); t < ntiles; t += gdim()) {
        if (t < 0) continue;
        const int tn = t % ntn, tk = t / ntn, n0 = tn * 64, k0 = tk * 64, sc0 = winmap ? win_srccol(n0) : n0;
        __syncthreads();
        { const int kk = tid >> 4, n4 = (tid & 15) * 4;
#pragma unroll
          for (int pp = 0; pp < 2; ++pp) { const float4 v = *(const float4*)(src + (size_t)(k0 + kk + 32 * pp) * ld + sc0 + n4); float* tp = tile + (kk + 32 * pp) * 65 + n4; tp[0] = v.x; tp[1] = v.y; tp[2] = v.z; tp[3] = v.w; } }
        __syncthreads();
        { const int n = tid >> 3, k8 = (tid & 7) * 8; float f[8];
#pragma unroll
          for (int i = 0; i < 8; ++i) f[i] = tile[(k8 + i) * 65 + n];
          u32x4_t o; o[0] = pg8::cvt_pk_bf16(f[0], f[1]); o[1] = pg8::cvt_pk_bf16(f[2], f[3]); o[2] = pg8::cvt_pk_bf16(f[4], f[5]); o[3] = pg8::cvt_pk_bf16(f[6], f[7]);
          *(u32x4_t*)(dst + (size_t)(n0 + n) * K + k0 + k8) = o; }
    }
    tcount += ntiles;
}

__device__ __forceinline__ void phase_rmsnorm(const Params& p, int l, const float* xa, const float* xb, const float* __restrict__ gw, bf16_t* __restrict__ hout, bool do_gates, float* sm) {
    int tid_ = threadIdx.x; asm volatile("" : "+v"(tid_)); const int tid = tid_, lane = tid & 63, w = tid >> 6;
    float* wgT = sm;
    if (do_gates) {
        const float* win = PIN(I_WIN) + (size_t)l * 1024 * NIN;
        __syncthreads();
        for (int i = tid; i < 16 * 1024; i += 512) { const int k = i >> 4, j = i & 15; const int gc = j < 8 ? 2048 + j : 4104 + (j - 8); wgT[j * 1024 + k] = win[(size_t)k * NIN + gc]; }
        __syncthreads();
    }
    float4 g4[4];
#pragma unroll
    for (int i = 0; i < 4; ++i) g4[i] = *(const float4*)(gw + lane * 4 + 256 * i);
    for (int row = bidx() * 8 + w; row < MT; row += gdim() * 8) {
        const float* xr = row < MP ? xa + (size_t)row * DM : xb + (size_t)(row - MP) * DM;
        float4 v[4]; float ss = 0.f;
#pragma unroll
        for (int i = 0; i < 4; ++i) { v[i] = *(const float4*)(xr + lane * 4 + 256 * i); ss += v[i].x * v[i].x + v[i].y * v[i].y + v[i].z * v[i].z + v[i].w * v[i].w; }
        ss = wave_sum(ss);
        const float rstd = rsqrtf(ss * (1.f / 1024.f) + EPS);
#pragma unroll
        for (int i = 0; i < 4; ++i) { v[i].x *= rstd * g4[i].x; v[i].y *= rstd * g4[i].y; v[i].z *= rstd * g4[i].z; v[i].w *= rstd * g4[i].w;
            u32x2_t o; o[0] = pg8::cvt_pk_bf16(v[i].x, v[i].y); o[1] = pg8::cvt_pk_bf16(v[i].z, v[i].w);
            *(u32x2_t*)(hout + (size_t)row * DM + lane * 4 + 256 * i) = o; }
        if (do_gates) {
            float mine = 0.f;
#pragma unroll
            for (int j = 0; j < 16; ++j) { float a = 0.f;
#pragma unroll
                for (int i = 0; i < 4; ++i) { const float4 wv = *(const float4*)(wgT + j * 1024 + lane * 4 + 256 * i); a += v[i].x * wv.x + v[i].y * wv.y + v[i].z * wv.z + v[i].w * wv.w; }
                a = wave_sum(a); if (lane == j) mine = a; }
            if (lane < 16) { const int h = lane & 3, kind = lane >> 2; float r;
                if (kind == 0) r = sigm(mine);
                else if (kind == 1) { const float xx = mine + PIN(I_DTB)[l * 4 + h]; const float sp = xx > 20.f ? xx : log1pf(__expf(xx)); r = __expf(-__expf(PIN(I_ALOG)[l * 4 + h]) * sp); }
                else if (kind == 2) r = mine + PIN(I_MIB)[l * 4 + h];
                else { const float xx = -(mine + PIN(I_MFB)[l * 4 + h]); r = -(xx > 20.f ? xx : log1pf(__expf(xx))); }
                ((float*)(PWS + W_GATES))[(size_t)row * 16 + lane] = r; }
        }
    }
}

struct EpiProj {
    static constexpr bool PERM = true, AFTER_DRAIN = false;
    bf16_t* O; int ldc; int actmode;
    __device__ __forceinline__ void operator()(const f32x4 (&acc)[2][2][4][2], const pg8::Unit& u, int wr, int wc, int fr, int fq) const {
        const int row0 = u.pm * 256 + wr * 64 + fr, col0 = u.pn * 256 + wc * 32 + 8 * fq;
        int act = 0;
        if (actmode) { const int pn = u.pn; act = (pn >= 24 || pn == 14 || pn == 15) ? 2 : ((pn == 6 || pn == 7 || pn == 16 || pn == 17 || pn == 22 || pn == 23) ? 1 : 0); }
#pragma unroll
        for (int ai = 0; ai < 2; ++ai)
#pragma unroll
            for (int m = 0; m < 4; ++m) { bf16_t* rowp = O + (size_t)(row0 + ai * 128 + m * 16) * ldc + col0;
#pragma unroll
                for (int bj = 0; bj < 2; ++bj) { float v[8];
#pragma unroll
                    for (int i = 0; i < 4; ++i) { v[i] = acc[ai][bj][m][0][i]; v[4 + i] = acc[ai][bj][m][1][i]; }
                    if (act == 1) {
#pragma unroll
                        for (int i = 0; i < 8; ++i) v[i] = silu(v[i]); }
                    else if (act == 2) {
#pragma unroll
                        for (int i = 0; i < 8; ++i) v[i] = sigm(v[i]); }
                    u32x4_t o; o[0] = pg8::cvt_pk_bf16(v[0], v[1]); o[1] = pg8::cvt_pk_bf16(v[2], v[3]); o[2] = pg8::cvt_pk_bf16(v[4], v[5]); o[3] = pg8::cvt_pk_bf16(v[6], v[7]);
                    *(u32x4_t*)(rowp + bj * 128) = o; } }
    }
};
struct EpiMerge {
    static constexpr bool PERM = true, AFTER_DRAIN = false;
    const bf16_t* G; bf16_t* Mx; int first;
    __device__ __forceinline__ void operator()(const f32x4 (&acc)[2][2][4][2], const pg8::Unit& u, int wr, int wc, int fr, int fq) const {
        const int row0 = u.pm * 256 + wr * 64 + fr, col0 = u.pn * 256 + wc * 32 + 8 * fq;
#pragma unroll
        for (int ai = 0; ai < 2; ++ai)
#pragma unroll
            for (int m = 0; m < 4; ++m) { const size_t row = (size_t)(row0 + ai * 128 + m * 16);
#pragma unroll
                for (int bj = 0; bj < 2; ++bj) { const int col = col0 + bj * 128;
                    const u32x4_t g = *(const u32x4_t*)(G + row * N1 + col); float v[8];
#pragma unroll
                    for (int i = 0; i < 4; ++i) { v[i] = acc[ai][bj][m][0][i]; v[4 + i] = acc[ai][bj][m][1][i]; }
#pragma unroll
                    for (int i = 0; i < 4; ++i) { v[2 * i] *= bflo(g[i]); v[2 * i + 1] *= bfhi(g[i]); }
                    bf16_t* mp = Mx + row * DM + col;
                    if (!first) { const u32x4_t o = *(const u32x4_t*)mp;
#pragma unroll
                        for (int i = 0; i < 4; ++i) { v[2 * i] += bflo(o[i]); v[2 * i + 1] += bfhi(o[i]); } }
                    u32x4_t o; o[0] = pg8::cvt_pk_bf16(v[0], v[1]); o[1] = pg8::cvt_pk_bf16(v[2], v[3]); o[2] = pg8::cvt_pk_bf16(v[4], v[5]); o[3] = pg8::cvt_pk_bf16(v[6], v[7]);
                    *(u32x4_t*)mp = o; } }
    }
};
struct EpiResid {
    static constexpr bool PERM = false, AFTER_DRAIN = false;
    float* X; const float* Sa; const float* Sb;
    __device__ __forceinline__ void operator()(const f32x4 (&acc)[2][2][4][2], const pg8::Unit& u, int wr, int wc, int fr, int fq) const {
        const int row0 = u.pm * 256 + wr * 64 + fr, col0 = u.pn * 256 + wc * 32 + 4 * fq;
        const float* S = u.pm * 256 < MP ? Sa : Sb - (size_t)MP * DM;
#pragma unroll
        for (int ai = 0; ai < 2; ++ai)
#pragma unroll
            for (int m = 0; m < 4; ++m) { const size_t ro = (size_t)(row0 + ai * 128 + m * 16) * DM + col0;
#pragma unroll
                for (int bj = 0; bj < 2; ++bj)
#pragma unroll
                    for (int n = 0; n < 2; ++n) { *(f32x4*)(X + ro + bj * 128 + n * 16) = *(const f32x4*)(S + ro + bj * 128 + n * 16) + acc[ai][bj][m][n]; } }
    }
};
__device__ __forceinline__ void phase_gdnprep(const Params& p, int l) {
    int tid_ = threadIdx.x; asm volatile("" : "+v"(tid_)); const int tid = tid_, j = tid & 15;
    const bf16_t* proj = (const bf16_t*)(PWS + W_PROJ);
    bf16_t* qkd = (bf16_t*)(PWS + W_HBF); bf16_t* vd = (bf16_t*)(PWS + W_OUTS);
    const float* cw = PIN(I_GCW) + (size_t)l * 4 * 1536; const float* cst = PIN(I_SGC) + (size_t)l * NBS * 3 * 1536;
    const int ngroups = MT * 12;
    for (int gid = bidx() * 32 + (tid >> 4); gid < ngroups; gid += gdim() * 32) {
        const int r = gid / 12, part = gid - r * 12, col = part * 128 + 8 * j;
        const bool samp = r >= MP; const int t = samp ? ((r - MP) & 3) : (r & (SEQ - 1)), b2 = samp ? ((r - MP) >> 2) : 0;
        float y[8];
#pragma unroll
        for (int i = 0; i < 8; ++i) y[i] = 0.f;
#pragma unroll
        for (int jj = 0; jj < 4; ++jj) { const int tt = t - 3 + jj; float x[8];
            if (tt >= 0) { const u32x4_t raw = *(const u32x4_t*)(proj + (size_t)(r - 3 + jj) * N1 + col);
#pragma unroll
                for (int i = 0; i < 4; ++i) { x[2 * i] = bflo(raw[i]); x[2 * i + 1] = bfhi(raw[i]); } }
            else if (samp) { const float* cp = cst + (size_t)(b2 * 3 + 3 + tt) * 1536 + col; const float4 a0 = *(const float4*)cp, a1 = *(const float4*)(cp + 4);
                x[0] = a0.x; x[1] = a0.y; x[2] = a0.z; x[3] = a0.w; x[4] = a1.x; x[5] = a1.y; x[6] = a1.z; x[7] = a1.w; }
            else {
#pragma unroll
                for (int i = 0; i < 8; ++i) x[i] = 0.f; }
            const float4 w0 = *(const float4*)(cw + jj * 1536 + col), w1 = *(const float4*)(cw + jj * 1536 + col + 4);
            y[0] += w0.x * x[0]; y[1] += w0.y * x[1]; y[2] += w0.z * x[2]; y[3] += w0.w * x[3]; y[4] += w1.x * x[4]; y[5] += w1.y * x[5]; y[6] += w1.z * x[6]; y[7] += w1.w * x[7]; }
        float ss = 0.f;
#pragma unroll
        for (int i = 0; i < 8; ++i) { y[i] = silu(y[i]); ss += y[i] * y[i]; }
        ss = grp_sum16(ss);
        const float scl = part < 4 ? rsqrtf(ss + EPS) * QSCALE : (part < 8 ? rsqrtf(ss + EPS) : 1.f);
        u32x4_t o; o[0] = pg8::cvt_pk_bf16(y[0] * scl, y[1] * scl); o[1] = pg8::cvt_pk_bf16(y[2] * scl, y[3] * scl); o[2] = pg8::cvt_pk_bf16(y[4] * scl, y[5] * scl); o[3] = pg8::cvt_pk_bf16(y[6] * scl, y[7] * scl);
        if (part < 8) *(u32x4_t*)(qkd + (size_t)r * 1024 + col) = o; else *(u32x4_t*)(vd + (size_t)r * 512 + (col - 1024)) = o;
    }
}

typedef float f2 __attribute__((ext_vector_type(2)));
typedef float f4 __attribute__((ext_vector_type(4)));
template <int MIX>
__device__ __forceinline__ void scan_prompt_item(const Params& p, int l, int b, int h, int cgp, float* sm) {
    constexpr int T = (MIX == 0) ? 16 : 8, NG = 128 / (4 * T), NP = 2 * NG, CPW = 64 / T, CPG = 8 * CPW, TB = 32, BUFSZ = 14464, NBLK = SEQ / TB;
    int tid_ = threadIdx.x; asm volatile("" : "+v"(tid_)); const int tid = tid_, lane = tid & 63, w = tid >> 6, c = lane / T, j = lane % T;
    const int col = w * CPW + c, ecol = cgp * CPG + col;
    float* misc = sm + 2 * BUFSZ; float* gsc = misc; float* mcar = misc + 64;
    const float* gates = (const float*)(PWS + W_GATES);
    bf16_t* outp = (bf16_t*)(PWS + W_OUTS) + (size_t)MIX * MT * 512;
    const size_t rb = (size_t)b * SEQ;
    const int c8 = (tid & 31) * 8, srow = tid >> 5;
    const bf16_t* qsrc; size_t qld; const bf16_t* vsrc; size_t vld;
    if (MIX == 0) { qsrc = (const bf16_t*)(PWS + W_HBF) + rb * 1024 + (c8 < 128 ? h * 128 + c8 : 512 + h * 128 + (c8 - 128)); qld = 1024;
        vsrc = (const bf16_t*)(PWS + W_OUTS) + rb * 512 + h * 128 + cgp * 32; vld = 512; }
    else { const int base = MIX == 1 ? 2048 : 4096; qsrc = (const bf16_t*)(PWS + W_PROJ) + rb * N1 + base + (c8 < 128 ? h * 128 + c8 : 512 + h * 128 + (c8 - 128)); qld = N1;
        vsrc = (const bf16_t*)(PWS + W_PROJ) + rb * N1 + base + 1024 + h * 128 + cgp * 64; vld = N1; }
    constexpr int VPC = CPG / 8;
    const int vs = tid / VPC, vc8 = (tid % VPC) * 8; const bool vact = tid < TB * VPC;
    float lb8[8];
#pragma unroll
    for (int i = 0; i < 8; ++i) lb8[i] = 0.f;
    if (MIX == 2 && l > 0 && c8 >= 128) { const float* hl = PIN(I_HLB);
#pragma unroll
        for (int i = 0; i < 8; ++i) { const int cc = h * 128 + (c8 - 128) + i; lb8[i] = sigm(hl[512 + cc] - hl[cc]); } }
    f2 S2[NP];
#pragma unroll
    for (int i = 0; i < NP; ++i) S2[i] = (f2){0.f, 0.f};
    float nn = 0.f, okeep = 0.f, oprev = 0.f;
    u32x4_t rq[2], rv; float rg0 = 0.f, rg1 = 0.f;
    rv = (u32x4_t){0u, 0u, 0u, 0u};
#define SCAN_ISSUE(t0_) do { \
        _Pragma("unroll") for (int i_ = 0; i_ < 2; ++i_) rq[i_] = *(const u32x4_t*)(qsrc + (size_t)((t0_) + srow + 16 * i_) * qld); \
        if (vact) rv = *(const u32x4_t*)(vsrc + (size_t)((t0_) + vs) * vld + vc8); \
        if (MIX != 2 && tid < TB) { const size_t r_ = rb + (t0_) + tid; rg0 = gates[r_ * 16 + (MIX == 0 ? 0 : 8) + h]; rg1 = gates[r_ * 16 + (MIX == 0 ? 4 : 12) + h]; } } while (0)
#define SCAN_FINISH(B_) do { float* qk_ = (B_); float* vv_ = (B_) + 8192; float* sc_ = (B_) + 10240; \
        _Pragma("unroll") for (int i_ = 0; i_ < 2; ++i_) { float x_[8]; \
            _Pragma("unroll") for (int e_ = 0; e_ < 4; ++e_) { x_[2 * e_] = bflo(rq[i_][e_]); x_[2 * e_ + 1] = bfhi(rq[i_][e_]); } \
            if (MIX == 2 && c8 >= 128) { _Pragma("unroll") for (int e_ = 0; e_ < 8; ++e_) x_[e_] = lb8[e_] + (1.f - lb8[e_]) * sigm(x_[e_]); } \
            float* d_ = qk_ + (srow + 16 * i_) * 256 + c8; *(f4*)d_ = (f4){x_[0], x_[1], x_[2], x_[3]}; *(f4*)(d_ + 4) = (f4){x_[4], x_[5], x_[6], x_[7]}; } \
        if (vact) { float* d_ = vv_ + vs * 64 + vc8; *(f4*)d_ = (f4){bflo(rv[0]), bfhi(rv[0]), bflo(rv[1]), bfhi(rv[1])}; *(f4*)(d_ + 4) = (f4){bflo(rv[2]), bfhi(rv[2]), bflo(rv[3]), bfhi(rv[3])}; } \
        if (MIX == 0 && tid < TB) { sc_[tid * 4] = rg0; sc_[tid * 4 + 1] = rg1; } \
        if (MIX == 1 && tid < TB) { gsc[tid * 2] = rg0; gsc[tid * 2 + 1] = rg1; } } while (0)
#define SCAN_CHAIN(B_) do { if (w == 1) { float* sc_ = (B_) + 10240; const int ls_ = lane & 31; const float m0_ = mcar[0]; \
            const float ig_ = gsc[2 * ls_], lf_ = gsc[2 * ls_ + 1]; \
            float F_ = lf_; F_ += dppf<0x111>(F_); F_ += dppf<0x112>(F_); F_ += dppf<0x114>(F_); F_ += dppf<0x118>(F_);              \
            { const float t0_ = rdlane(F_, 15); if (lane & 16) F_ += t0_; } \
            float P_ = ig_ - F_; P_ = fmaxf(P_, dppm<0x111>(P_)); P_ = fmaxf(P_, dppm<0x112>(P_)); P_ = fmaxf(P_, dppm<0x114>(P_)); P_ = fmaxf(P_, dppm<0x118>(P_)); \
            { const float t1_ = rdlane(P_, 15); if (lane & 16) P_ = fmaxf(P_, t1_); } \
            const float m_ = F_ + fmaxf(m0_, P_); \
            float mp_ = dppf<0x111>(m_); { const float t2_ = rdlane(m_, 15); if ((lane & 15) == 0) mp_ = (lane & 16) ? t2_ : m0_; } \
            const float mlast_ = rdlane(m_, 31); \
            if (lane < 32) { sc_[lane * 4] = __expf(lf_ + mp_ - m_); sc_[lane * 4 + 1] = __expf(ig_ - m_) * QSCALE; sc_[lane * 4 + 2] = m_; } \
            if (lane == 0) mcar[0] = mlast_; } } while (0)
    if (MIX == 1 && tid == 64) mcar[0] = 0.f;
    __syncthreads();
    SCAN_ISSUE(0);
    SCAN_FINISH(sm);
    __syncthreads();
    if (MIX == 1) { SCAN_CHAIN(sm); __syncthreads(); }
#pragma unroll 1
    for (int blk = 0; blk < NBLK; ++blk) {
        const int t0 = blk * TB;
        float* B = sm + (blk & 1) * BUFSZ; float* Bn = sm + ((blk & 1) ^ 1) * BUFSZ;
        const float* qk = B; const float* vv = B + 8192; const float* sc = B + 10240; float* denp = B + 10368;
        if (blk + 1 < NBLK) SCAN_ISSUE(t0 + TB);
        f4 qa[2][NG], ka[2][NG]; float va[2], sa[2], sb[2], kda[2], qda[2];
#define SCAN_LOADOPS(slot_, s_) do { const float* qs_ = qk + (s_) * 256; \
            _Pragma("unroll") for (int g_ = 0; g_ < NG; ++g_) { qa[slot_][g_] = *(const f4*)(qs_ + g_ * 4 * T + 4 * j); ka[slot_][g_] = *(const f4*)(qs_ + 128 + g_ * 4 * T + 4 * j); } \
            va[slot_] = vv[(s_) * 64 + col]; \
            if (MIX != 2) { sa[slot_] = sc[(s_) * 4]; sb[slot_] = sc[(s_) * 4 + 1]; } \
            if (MIX == 1) { const int dn_ = 16 * w + (lane & 15); kda[slot_] = qs_[128 + dn_]; qda[slot_] = qs_[dn_]; } } while (0)
        SCAN_LOADOPS(0, 0);
#pragma unroll 1
        for (int sg = 0; sg < TB; sg += T) {
#pragma unroll
            for (int ss = 0; ss < T; ++ss) {
                const int s = sg + ss; constexpr int dummy = 0; (void)dummy;
                const int cur = ss & 1, nxt = cur ^ 1;
                SCAN_LOADOPS(nxt, (s + 1) & (TB - 1));
                __builtin_amdgcn_sched_barrier(0);
                f2 qq[NP], kk[NP];
#pragma unroll
                for (int g = 0; g < NG; ++g) { qq[2 * g] = qa[cur][g].xy; qq[2 * g + 1] = qa[cur][g].zw; kk[2 * g] = ka[cur][g].xy; kk[2 * g + 1] = ka[cur][g].zw; }
                const float v = va[cur];
                f2 oa = (f2){0.f, 0.f}, ob = (f2){0.f, 0.f};
                if (MIX == 0) {
                    const float beta = sa[cur], a = sb[cur];
                    f2 ka2 = kk[0] * S2[0], kb2 = kk[1] * S2[1];
#pragma unroll
                    for (int i = 2; i < NP; i += 2) { ka2 = kk[i] * S2[i] + ka2; kb2 = kk[i + 1] * S2[i + 1] + kb2; }
                    ka2 = ka2 + kb2;
                    const float ks = grp_sum<T>(ka2.x + ka2.y);
                    const float u = beta * (v - a * ks);
                    const f2 a2 = (f2){a, a}, u2 = (f2){u, u};
#pragma unroll
                    for (int i = 0; i < NP; i += 2) { S2[i] = S2[i] * a2 + kk[i] * u2; S2[i + 1] = S2[i + 1] * a2 + kk[i + 1] * u2; oa = qq[i] * S2[i] + oa; ob = qq[i + 1] * S2[i + 1] + ob; }
                } else if (MIX == 1) {
                    const float fp = sa[cur], ip = sb[cur], iv = ip * v;
                    const f2 f2v = (f2){fp, fp}, iv2 = (f2){iv, iv};
#pragma unroll
                    for (int i = 0; i < NP; i += 2) { S2[i] = S2[i] * f2v + kk[i] * iv2; S2[i + 1] = S2[i + 1] * f2v + kk[i + 1] * iv2; oa = qq[i] * S2[i] + oa; ob = qq[i + 1] * S2[i + 1] + ob; }
                    nn = fp * nn + ip * kda[cur];
                    denp[s * 128 + 16 * w + (lane & 15)] = qda[cur] * nn;
                } else {
                    const f2 v2 = (f2){v, v};
#pragma unroll
                    for (int i = 0; i < NP; i += 2) { S2[i] = kk[i] * (S2[i] - v2) + v2; S2[i + 1] = kk[i + 1] * (S2[i + 1] - v2) + v2; oa = qq[i] * S2[i] + oa; ob = qq[i + 1] * S2[i + 1] + ob; }
                }
                if (ss > 0) { const float o = grp_sum<T>(oprev); okeep = (ss - 1 == j) ? o : okeep; }
                oa = oa + ob; oprev = oa.x + oa.y;
            }
            { const float o = grp_sum<T>(oprev); okeep = (T - 1 == j) ? o : okeep; }
            outp[(rb + t0 + sg + j) * 512 + h * 128 + ecol] = f2bf(okeep);
        }
#undef SCAN_LOADOPS
        if (blk + 1 < NBLK) SCAN_FINISH(Bn);
        __syncthreads();
        if (MIX == 1) {
            if (cgp == 0) { const int sr = tid >> 4, jl = tid & 15; const f4 a0 = *(const f4*)(denp + sr * 128 + 8 * jl), a1 = *(const f4*)(denp + sr * 128 + 8 * jl + 4);
                const float d = grp_sum16((a0.x + a0.y) + (a0.z + a0.w) + (a1.x + a1.y) + (a1.z + a1.w));
                if (jl == 0) { const size_t r = rb + t0 + sr; ((float*)(PWS + W_DEN))[r * 4 + h] = d; ((float*)(PWS + W_MT))[r * 4 + h] = sc[sr * 4 + 2]; } }
            if (blk + 1 < NBLK) SCAN_CHAIN(Bn);
            __syncthreads();
        }
    }
#undef SCAN_ISSUE
#undef SCAN_FINISH
#undef SCAN_CHAIN
    const size_t sidx = ((size_t)(l * NBP + b) * NH + h);
    float* So = POUT + (MIX == 0 ? O_P_GS : (MIX == 1 ? O_P_MC : O_P_HS)) + sidx * 16384;
#pragma unroll
    for (int g = 0; g < NG; ++g) { const int d0 = g * 4 * T + 4 * j;
        So[(size_t)(d0 + 0) * 128 + ecol] = S2[2 * g].x; So[(size_t)(d0 + 1) * 128 + ecol] = S2[2 * g].y; So[(size_t)(d0 + 2) * 128 + ecol] = S2[2 * g + 1].x; So[(size_t)(d0 + 3) * 128 + ecol] = S2[2 * g + 1].y; }
    if (MIX == 1 && cgp == 0) {
        if (lane < 16) POUT[O_P_MN + sidx * 128 + 16 * w + lane] = nn;
        if (tid == 64) POUT[O_P_MM + sidx] = mcar[0];
    }
    __syncthreads();
}

__device__ __forceinline__ void scan_sample_item(const Params& p, int l, int mix, int b, int h, float* sm) {
    int tid_ = threadIdx.x; asm volatile("" : "+v"(tid_)); const int tid = tid_, lane = tid & 63, w = tid >> 6, e = tid & 127, dg = tid >> 7;
    float* qk = sm; float* vv = sm + 1024; float* gs = sm + 1536; float* red = sm + 1600; float* dpart = sm + 1600 + 4096;
    const bf16_t* proj = (const bf16_t*)(PWS + W_PROJ);
    const float* gates = (const float*)(PWS + W_GATES);
    bf16_t* outp = (bf16_t*)(PWS + W_OUTS) + (size_t)mix * MT * 512;
    const size_t rs = (size_t)MP + (size_t)b * SSEQ;
    const size_t sidx = ((size_t)(l * NBS + b) * NH + h);
    const float* Sin = (mix == 0 ? PIN(I_SGS) : (mix == 1 ? PIN(I_SMC) : PIN(I_SHS))) + sidx * 16384;
    float S[32];
#pragma unroll
    for (int i = 0; i < 32; ++i) S[i] = Sin[(size_t)(32 * dg + i) * 128 + e];
    __syncthreads();
    for (int idx = tid; idx < 4 * 384; idx += 512) { const int s = idx / 384, ch = idx - s * 384; float val;
        if (mix == 0) { val = ch < 256 ? bf2f(((const bf16_t*)(PWS + W_HBF))[(rs + s) * 1024 + (ch >> 7) * 512 + h * 128 + (ch & 127)]) : bf2f(outp[(rs + s) * 512 + h * 128 + (ch - 256)]);
        } else if (mix == 1) { const int colx = 2048 + (ch >> 7) * 512 + h * 128 + (ch & 127); val = bf2f(proj[(rs + s) * N1 + colx]); }
        else { const int colx = 4096 + (ch >> 7) * 512 + h * 128 + (ch & 127); val = bf2f(proj[(rs + s) * N1 + colx]);
            if (ch >= 128 && ch < 256) { float lbv = 0.f; if (l > 0) { const float* hl = PIN(I_HLB); const int cc = h * 128 + (ch & 127); lbv = sigm(hl[512 + cc] - hl[cc]); } val = lbv + (1.f - lbv) * sigm(val); } }
        if (ch < 256) qk[s * 256 + ch] = val; else vv[s * 128 + ch - 256] = val; }
    if (tid < 4) { const size_t r = rs + tid;
        if (mix == 0) { gs[tid * 4] = gates[r * 16 + h]; gs[tid * 4 + 1] = gates[r * 16 + 4 + h]; }
        else if (mix == 1) { gs[tid * 4] = gates[r * 16 + 8 + h]; gs[tid * 4 + 1] = gates[r * 16 + 12 + h]; } }
    __syncthreads();
    float m = 0.f, nn = 0.f, mts[4] = {0.f, 0.f, 0.f, 0.f};
    if (mix == 1) { m = PIN(I_SMM)[sidx]; if (dg == 0) nn = PIN(I_SMN)[sidx * 128 + e]; }
#pragma unroll
    for (int s = 0; s < 4; ++s) {
        const float* qs = qk + s * 256 + 32 * dg; const float* ksp = qs + 128;
        const float v = vv[s * 128 + e];
        float po = 0.f;
        if (mix == 0) {
            const float beta = gs[s * 4], a = gs[s * 4 + 1];
            float pk = 0.f;
#pragma unroll
            for (int i = 0; i < 32; ++i) pk += ksp[i] * S[i];
            red[((s * 2) * 4 + dg) * 128 + e] = pk;
            __syncthreads();
            const float ks = red[((s * 2) * 4 + 0) * 128 + e] + red[((s * 2) * 4 + 1) * 128 + e] + red[((s * 2) * 4 + 2) * 128 + e] + red[((s * 2) * 4 + 3) * 128 + e];
            const float u = beta * (v - a * ks);
#pragma unroll
            for (int i = 0; i < 32; ++i) { S[i] = a * S[i] + ksp[i] * u; po += qs[i] * S[i]; }
        } else if (mix == 1) {
            const float ig = gs[s * 4], lf = gs[s * 4 + 1]; const float mn = fmaxf(lf + m, ig); const float fp = __expf(lf + m - mn), ip = __expf(ig - mn) * QSCALE; m = mn; mts[s] = mn;
            const float iv = ip * v;
#pragma unroll
            for (int i = 0; i < 32; ++i) { S[i] = fp * S[i] + ksp[i] * iv; po += qs[i] * S[i]; }
            if (dg == 0) { nn = fp * nn + ip * qk[s * 256 + 128 + e]; const float dp = wave_sum(qk[s * 256 + e] * nn); if (lane == 0) dpart[s * 2 + w] = dp; }
        } else {
#pragma unroll
            for (int i = 0; i < 32; ++i) { S[i] = ksp[i] * (S[i] - v) + v; po += qs[i] * S[i]; }
        }
        red[((s * 2 + 1) * 4 + dg) * 128 + e] = po;
    }
    __syncthreads();
    if (tid < 128) {
#pragma unroll
        for (int s = 0; s < 4; ++s) { const float o = red[((s * 2 + 1) * 4 + 0) * 128 + e] + red[((s * 2 + 1) * 4 + 1) * 128 + e] + red[((s * 2 + 1) * 4 + 2) * 128 + e] + red[((s * 2 + 1) * 4 + 3) * 128 + e];
            outp[(rs + s) * 512 + h * 128 + e] = f2bf(o); } }
    if (mix == 1 && tid == 0) {
#pragma unroll
        for (int s = 0; s < 4; ++s) { ((float*)(PWS + W_DEN))[(rs + s) * 4 + h] = dpart[s * 2] + dpart[s * 2 + 1]; ((float*)(PWS + W_MT))[(rs + s) * 4 + h] = mts[s]; }
        POUT[O_S_MM + sidx] = m; }
    float* So = POUT + (mix == 0 ? O_S_GS : (mix == 1 ? O_S_MC : O_S_HS)) + sidx * 16384;
#pragma unroll
    for (int i = 0; i < 32; ++i) So[(size_t)(32 * dg + i) * 128 + e] = S[i];
    if (mix == 1 && dg == 0) POUT[O_S_MN + sidx * 128 + e] = nn;
}
__device__ __forceinline__ void phase_postnorm(const Params& p, int l) {
    int tid_ = threadIdx.x; asm volatile("" : "+v"(tid_)); const int tid = tid_, j = tid & 15;
    bf16_t* outs = (bf16_t*)(PWS + W_OUTS);
    const bf16_t* proj = (const bf16_t*)(PWS + W_PROJ);
    const float* den = (const float*)(PWS + W_DEN); const float* mt = (const float*)(PWS + W_MT);
    const int ngroups = MT * 12;
    for (int gid = bidx() * 32 + (tid >> 4); gid < ngroups; gid += gdim() * 32) {
        const int r = gid / 12, mh = gid - r * 12, mix = mh >> 2, h = mh & 3;
        bf16_t* op = outs + (size_t)mix * MT * 512 + (size_t)r * 512 + h * 128 + 8 * j;
        const u32x4_t raw = *(const u32x4_t*)op;
        float v[8];
#pragma unroll
        for (int i = 0; i < 4; ++i) { v[2 * i] = bflo(raw[i]); v[2 * i + 1] = bfhi(raw[i]); }
        if (mix == 1) { const float dn = fmaxf(fabsf(den[(size_t)r * 4 + h]), __expf(-mt[(size_t)r * 4 + h])); const float inv = 1.f / dn;
#pragma unroll
            for (int i = 0; i < 8; ++i) v[i] *= inv; }
        float ss = 0.f;
#pragma unroll
        for (int i = 0; i < 8; ++i) ss += v[i] * v[i];
        ss = grp_sum16(ss);
        const float rstd = rsqrtf(ss * (1.f / 128.f) + EPS);
        const int gcol = (mix == 0 ? 1536 : (mix == 1 ? 3584 : 5632)) + h * 128 + 8 * j;
        const u32x4_t gr = *(const u32x4_t*)(proj + (size_t)r * N1 + gcol);
        const float* nw = (mix == 0 ? PIN(I_GNORM) : (mix == 1 ? PIN(I_MNORM) : PIN(I_HNORM))) + l * 512 + h * 128 + 8 * j;
        const float4 n0 = *(const float4*)nw, n1 = *(const float4*)(nw + 4);
        const float nwv[8] = {n0.x, n0.y, n0.z, n0.w, n1.x, n1.y, n1.z, n1.w};
#pragma unroll
        for (int i = 0; i < 4; ++i) { v[2 * i] *= rstd * nwv[2 * i] * bflo(gr[i]); v[2 * i + 1] *= rstd * nwv[2 * i + 1] * bfhi(gr[i]); }
        u32x4_t o; o[0] = pg8::cvt_pk_bf16(v[0], v[1]); o[1] = pg8::cvt_pk_bf16(v[2], v[3]); o[2] = pg8::cvt_pk_bf16(v[4], v[5]); o[3] = pg8::cvt_pk_bf16(v[6], v[7]);
        *(u32x4_t*)op = o;
    }
    const int ncs = (NBP + NBS) * 3 * 1536;
    for (int i = bidx() * 512 + tid; i < ncs; i += gdim() * 512) {
        const int cc = i % 1536, ri = (i / 1536) % 3, bb = i / (3 * 1536);
        if (bb < NBP) POUT[O_P_GC + ((size_t)(l * NBP + bb) * 3 + ri) * 1536 + cc] = bf2f(proj[((size_t)bb * SEQ + SEQ - 3 + ri) * N1 + cc]);
        else { const int b2 = bb - NBP; POUT[O_S_GC + ((size_t)(l * NBS + b2) * 3 + ri) * 1536 + cc] = bf2f(proj[((size_t)MP + (size_t)b2 * SSEQ + 1 + ri) * N1 + cc]); }
    }
}

__device__ __forceinline__ void phase_convffn(const Params& p, int l) {
    int tid_ = threadIdx.x; asm volatile("" : "+v"(tid_)); const int tid = tid_;
    const bf16_t* u = (const bf16_t*)(PWS + W_PROJ);
    bf16_t* act = (bf16_t*)(PWS + W_ACT);
    const float* cw = PIN(I_FCW) + (size_t)l * 3 * NUP; const float* cb = PIN(I_FCB) + (size_t)l * NUP;
    const int nitems = (MT / 4) * (DFF / 8);
    for (int it = bidx() * 512 + tid; it < nitems; it += gdim() * 512) {
        const int jg = it % (DFF / 8), rbk = it / (DFF / 8), r0 = rbk * 4, jc = jg * 8;
        const bool samp = r0 >= MP; const int tf = samp ? 0 : (r0 & (SEQ - 1));
        float wa[3][8], wb[3][8], ba[8], bb[8];
#pragma unroll
        for (int i = 0; i < 3; ++i) { const float4 a0 = *(const float4*)(cw + i * NUP + jc), a1 = *(const float4*)(cw + i * NUP + jc + 4), b0 = *(const float4*)(cw + i * NUP + DFF + jc), b1 = *(const float4*)(cw + i * NUP + DFF + jc + 4);
            wa[i][0] = a0.x; wa[i][1] = a0.y; wa[i][2] = a0.z; wa[i][3] = a0.w; wa[i][4] = a1.x; wa[i][5] = a1.y; wa[i][6] = a1.z; wa[i][7] = a1.w;
            wb[i][0] = b0.x; wb[i][1] = b0.y; wb[i][2] = b0.z; wb[i][3] = b0.w; wb[i][4] = b1.x; wb[i][5] = b1.y; wb[i][6] = b1.z; wb[i][7] = b1.w; }
        { const float4 a0 = *(const float4*)(cb + jc), a1 = *(const float4*)(cb + jc + 4), b0 = *(const float4*)(cb + DFF + jc), b1 = *(const float4*)(cb + DFF + jc + 4);
            ba[0] = a0.x; ba[1] = a0.y; ba[2] = a0.z; ba[3] = a0.w; ba[4] = a1.x; ba[5] = a1.y; ba[6] = a1.z; ba[7] = a1.w;
            bb[0] = b0.x; bb[1] = b0.y; bb[2] = b0.z; bb[3] = b0.w; bb[4] = b1.x; bb[5] = b1.y; bb[6] = b1.z; bb[7] = b1.w; }
        float xa[6][8], xb[6][8];
#pragma unroll
        for (int rr = 0; rr < 6; ++rr) {
            if (rr < 2 && tf == 0) {
                if (samp) { const float* st = PIN(I_SFC) + ((size_t)(l * NBS + (r0 - MP) / 4) * 2 + rr) * NUP;
#pragma unroll
                    for (int i = 0; i < 8; ++i) { xa[rr][i] = st[jc + i]; xb[rr][i] = st[DFF + jc + i]; } }
                else {
#pragma unroll
                    for (int i = 0; i < 8; ++i) { xa[rr][i] = 0.f; xb[rr][i] = 0.f; } }
            } else { const bf16_t* ur = u + (size_t)(r0 - 2 + rr) * NUP; const u32x4_t ra = *(const u32x4_t*)(ur + jc), rbv = *(const u32x4_t*)(ur + DFF + jc);
#pragma unroll
                for (int i = 0; i < 4; ++i) { xa[rr][2 * i] = bflo(ra[i]); xa[rr][2 * i + 1] = bfhi(ra[i]); xb[rr][2 * i] = bflo(rbv[i]); xb[rr][2 * i + 1] = bfhi(rbv[i]); } }
        }
#pragma unroll
        for (int t = 0; t < 4; ++t) { float o[8];
#pragma unroll
            for (int i = 0; i < 8; ++i) { const float ya = wa[0][i] * xa[t][i] + wa[1][i] * xa[t + 1][i] + wa[2][i] * xa[t + 2][i] + ba[i]; const float yb = wb[0][i] * xb[t][i] + wb[1][i] * xb[t + 1][i] + wb[2][i] * xb[t + 2][i] + bb[i]; o[i] = silu(ya) * yb; }
            u32x4_t ov; ov[0] = pg8::cvt_pk_bf16(o[0], o[1]); ov[1] = pg8::cvt_pk_bf16(o[2], o[3]); ov[2] = pg8::cvt_pk_bf16(o[4], o[5]); ov[3] = pg8::cvt_pk_bf16(o[6], o[7]);
            *(u32x4_t*)(act + (size_t)(r0 + t) * DFF + jc) = ov; }
        if (samp || tf == SEQ - 4) {
            float* dst = samp ? POUT + O_S_FC + (size_t)(l * NBS + (r0 - MP) / 4) * 2 * NUP : POUT + O_P_FC + (size_t)(l * NBP + r0 / SEQ) * 2 * NUP;
#pragma unroll
            for (int rr = 0; rr < 2; ++rr)
#pragma unroll
                for (int i = 0; i < 8; ++i) { dst[(size_t)rr * NUP + jc + i] = xa[4 + rr][i]; dst[(size_t)rr * NUP + DFF + jc + i] = xb[4 + rr][i]; }
        }
    }
}

__device__ __forceinline__ void phase_final_norm(const Params& p) {
    int tid_ = threadIdx.x; asm volatile("" : "+v"(tid_)); const int tid = tid_, lane = tid & 63, w = tid >> 6;
    const float* gw = PIN(I_LNF);
    float4 g4[4];
#pragma unroll
    for (int i = 0; i < 4; ++i) g4[i] = *(const float4*)(gw + lane * 4 + 256 * i);
    for (int row = bidx() * 8 + w; row < MT; row += gdim() * 8) {
        float* xr = POUT + (size_t)row * DM; float4 v[4]; float ss = 0.f;
#pragma unroll
        for (int i = 0; i < 4; ++i) { v[i] = *(const float4*)(xr + lane * 4 + 256 * i); ss += v[i].x * v[i].x + v[i].y * v[i].y + v[i].z * v[i].z + v[i].w * v[i].w; }
        ss = wave_sum(ss); const float rstd = rsqrtf(ss * (1.f / 1024.f) + EPS);
#pragma unroll
        for (int i = 0; i < 4; ++i) { v[i].x *= rstd * g4[i].x; v[i].y *= rstd * g4[i].y; v[i].z *= rstd * g4[i].z; v[i].w *= rstd * g4[i].w; *(float4*)(xr + lane * 4 + 256 * i) = v[i]; }
    }
}

#ifndef PHM
#define PHM 0xFFFF
#endif
#ifndef DUPB
#define DUPB 1
#endif
#ifndef DUPC
#define DUPC 1
#endif
#ifndef DUPS
#define DUPS 1
#endif
#ifndef DUPH
#define DUPH 1
#endif
#ifndef DUPY
#define DUPY 1
#endif
#ifndef DUPA
#define DUPA 1
#endif
#ifndef DUPI
#define DUPI 1
#endif
#define GSYNC() do { for (int y_ = 0; y_ < DUPY; ++y_) xcd_barrier(xb); } while (0)
__global__ void __launch_bounds__(512, 2) fwd_megakernel(Params p) {
    extern __shared__ __attribute__((aligned(16))) unsigned char shm[];
    cg::grid_group grid = cg::this_grid();
    float* smf = (float*)shm;
    PG8_LAS unsigned char* lds = (PG8_LAS unsigned char*)shm;
    int tid_ = threadIdx.x; asm volatile("" : "+v"(tid_)); const int tid = tid_;
    float* X = POUT;
    volatile XLAS unsigned* xst = (volatile XLAS unsigned*)(lds + 131072);
    if (tid == 0) { xst[0] = 0u; xst[1] = 0u; xst[2] = 0u; xst[3] = 0u; }
    __syncthreads();
    XcdBarrier xb = xcd_barrier_post((unsigned*)(PWS + W_BAR), xst);
    bool first_sync = true;
    bf16_t* hbf = (bf16_t*)(PWS + W_HBF);
    bf16_t* proj = (bf16_t*)(PWS + W_PROJ);

    for (int l = 0; l < 2; ++l) {
        const int G = gdim(), bid = bidx();
        for (int repa = 0; repa < DUPA; ++repa) { if (PHM & 1) { int tc = 0;
          conv_T(PIN(I_WIN) + (size_t)l * 1024 * NIN, NIN, (bf16_t*)(PWS + W_WIN), 1024, N1, true, smf, tc);
          for (int n = 0; n < 3; ++n) conv_T(PIN(I_WBR) + ((size_t)l * 3 + n) * 512 * 1024, 1024, (bf16_t*)(PWS + W_WBR) + (size_t)n * 1024 * 512, 512, 1024, false, smf, tc);
          conv_T(PIN(I_WOUT) + (size_t)l * 1024 * 1024, 1024, (bf16_t*)(PWS + W_WOUT), 1024, 1024, false, smf, tc);
          conv_T(PIN(I_WUP) + (size_t)l * 1024 * NUP, NUP, (bf16_t*)(PWS + W_WUP), 1024, NUP, false, smf, tc);
          conv_T(PIN(I_WDN) + (size_t)l * DFF * 1024, 1024, (bf16_t*)(PWS + W_WDN), DFF, 1024, false, smf, tc);
          __syncthreads(); }
        if (PHM & 2) {
        phase_rmsnorm(p, l, l == 0 ? PIN(I_XP) : X, l == 0 ? PIN(I_XS) : X + (size_t)MP * DM, PIN(I_LNMIX) + l * DM, hbf, true, smf); } }
        if (first_sync) { grid.sync(); first_sync = false; }
        else GSYNC();
        for (int rep = 0; rep < DUPB; ++rep) { pg8::Gemm g{hbf, (const bf16_t*)(PWS + W_WIN), MT, N1, 1024}; pg8::StaticOrder S; S.init(MT, N1, G, bid); EpiProj E{proj, N1, 1}; pg8::gemm_phase(lds, g, S, E); }
        GSYNC();
        phase_gdnprep(p, l);
        GSYNC();
        for (int rep = 0; rep < DUPC; ++rep) for (int it = bid; it < 256; it += G) {
            if (it < 128) scan_prompt_item<0>(p, l, (it >> 2) >> 2, (it >> 2) & 3, it & 3, smf);
            else if (it < 192) { const int q = it - 128; scan_prompt_item<1>(p, l, (q >> 1) >> 2, (q >> 1) & 3, q & 1, smf); }
            else { const int q = it - 192; scan_prompt_item<2>(p, l, (q >> 1) >> 2, (q >> 1) & 3, q & 1, smf); }
        }
        for (int rep = 0; rep < DUPS; ++rep) for (int it = bid; it < 3 * NBS * NH; it += G) { const int mix = it / (NBS * NH), r = it - mix * (NBS * NH); scan_sample_item(p, l, mix, r >> 2, r & 3, smf); }
        GSYNC();
        if (PHM & 32) phase_postnorm(p, l);
        GSYNC();
        if (PHM & 64) for (int n = 0; n < 3; ++n) { pg8::Gemm g{(const bf16_t*)(PWS + W_OUTS) + (size_t)n * MT * 512, (const bf16_t*)(PWS + W_WBR) + (size_t)n * 1024 * 512, MT, 1024, 512};
            pg8::StaticOrder S; S.init(MT, 1024, G, bid); EpiMerge E{proj + 6144 + n * 1024, hbf, n == 0}; pg8::gemm_phase(lds, g, S, E); }
        GSYNC();
        if (PHM & 128) { pg8::Gemm g{hbf, (const bf16_t*)(PWS + W_WOUT), MT, 1024, 1024}; pg8::StaticOrder S; S.init(MT, 1024, G, bid); EpiResid E{X, l == 0 ? PIN(I_XP) : X, l == 0 ? PIN(I_XS) : X + (size_t)MP * DM}; pg8::gemm_phase(lds, g, S, E); }
        GSYNC();
        if (PHM & 256) phase_rmsnorm(p, l, X, X + (size_t)MP * DM, PIN(I_LNFFN) + l * DM, hbf, false, smf);
        GSYNC();
        for (int rep = 0; rep < DUPH; ++rep) { pg8::Gemm g{hbf, (const bf16_t*)(PWS + W_WUP), MT, NUP, 1024}; pg8::StaticOrder S; S.init(MT, NUP, G, bid); EpiProj E{proj, NUP, 0}; pg8::gemm_phase(lds, g, S, E); }
        GSYNC();
        for (int repi = 0; repi < DUPI; ++repi) phase_convffn(p, l);
        GSYNC();
        if (PHM & 2048) { pg8::Gemm g{(const bf16_t*)(PWS + W_ACT), (const bf16_t*)(PWS + W_WDN), MT, 1024, DFF}; pg8::StaticOrder S; S.init(MT, 1024, G, bid); EpiResid E{X, X, X + (size_t)MP * DM}; pg8::gemm_phase(lds, g, S, E); }
        GSYNC();
    }
    if (PHM & 4096) phase_final_norm(p);
}

extern "C" void kernel_launch(void* const* d_in, const int* in_sizes, int n_in, void* d_out, int out_size, void* d_ws, size_t ws_size, hipStream_t stream) {
    static int grid_blocks = 0;
    if (grid_blocks == 0) {
        if (n_in != 28 || (size_t)out_size != O_END || ws_size < W_END) { fprintf(stderr, "kernel_launch: unexpected shapes: n_in %d out %d (want %zu) ws %zu (need %zu)\n", n_in, out_size, (size_t)O_END, ws_size, (size_t)W_END); grid_blocks = -1; return; }
        int dev = 0, cus = 0, per_cu = 0;
        hipGetDevice(&dev); hipDeviceGetAttribute(&cus, hipDeviceAttributeMultiprocessorCount, dev);
        if (hipFuncSetAttribute((const void*)fwd_megakernel, hipFuncAttributeMaxDynamicSharedMemorySize, LDS_BYTES) != hipSuccess) { fprintf(stderr, "kernel_launch: hipFuncSetAttribute failed\n"); grid_blocks = -1; return; }
        if (hipOccupancyMaxActiveBlocksPerMultiprocessor(&per_cu, (const void*)fwd_megakernel, 512, LDS_BYTES) != hipSuccess || per_cu < 1) { fprintf(stderr, "kernel_launch: occupancy query gave %d\n", per_cu); per_cu = 1; (void)hipGetLastError(); }
        grid_blocks = cus * per_cu;
    }
    if (grid_blocks < 0) return;
    if (hipMemsetAsync((unsigned char*)d_ws + W_BAR, 0, XCD_BAR_WORDS * 4, stream) != hipSuccess) { fprintf(stderr, "kernel_launch: memset of barrier words failed\n"); return; }
    Params p{};
    for (int i = 0; i < 28; ++i) p.in[i] = (const float*)d_in[i];
    p.out = (float*)d_out; p.ws = (unsigned char*)d_ws;
    void* args[] = {&p};
    hipError_t e = hipLaunchCooperativeKernel((const void*)fwd_megakernel, dim3(grid_blocks), dim3(512), args, LDS_BYTES, stream);
    if (e != hipSuccess) fprintf(stderr, "kernel_launch: cooperative launch failed: %s (grid %d)\n", hipGetErrorString(e), grid_blocks);
}
```

```cpp
#include <hip/hip_runtime.h>
#include <hip/hip_cooperative_groups.h>
#include <cstdio>
namespace cg = cooperative_groups;
namespace pg8 {
#define PG8_LAS __attribute__((address_space(3)))
typedef unsigned short bf16_t;
typedef short bf16x8 __attribute__((ext_vector_type(8)));
typedef float f32x4 __attribute__((ext_vector_type(4)));
typedef unsigned u32x4 __attribute__((ext_vector_type(4)));
constexpr int BM = 256, BK = 64, HALF = 128, HTB = HALF * BK * 2  , STAGE_BYTES = 8 * HTB, NXCD = 8, WGM = 8;

__host__ __device__ __forceinline__ int lds_byte(int r, int c) { const int st = (r >> 4) * 2 + (c >> 5), rr = r & 15, cc = c & 31, ob = rr * 64 + cc * 2; return st * 1024 + (ob ^ (((ob >> 9) & 1) << 5)); }
__host__ __device__ __forceinline__ void stage_rc(int b, int& R, int& C) { const int st = b / 1024, sb = b % 1024, swz = sb ^ (((sb >> 9) & 1) << 5); R = (st >> 1) * 16 + swz / 64; C = (st & 1) * 32 + (swz % 64) / 2; }
__host__ __device__ __forceinline__ int perm32(int rho) { const int n = rho >> 4, i = rho & 15; return 8 * (i >> 2) + 4 * n + (i & 3); }

struct Unit { int pm, pn, pk; };
struct Gemm { const bf16_t* A; const bf16_t* Bt; int M, N, K, ld; };

struct StaticOrder {
    int nM, nN, nwg, G, c;
    __host__ __device__ void init(int M, int N, int G_, int c_) { nM = M / BM; nN = N / BM; nwg = nM * nN; G = G_; c = c_; }
    __host__ __device__ bool next(int i, Unit& u) const {
        const long L = (long)i * G + c; if (L >= nwg) return false;
        int wgid = (int)L; { const int q = nwg / NXCD, r = nwg % NXCD, xcd = wgid % NXCD, off = wgid / NXCD; wgid = (xcd < r ? xcd * (q + 1) : r * (q + 1) + (xcd - r) * q) + off; }
        const int nig = WGM * nN, gid = wgid / nig, fm = gid * WGM, gsz = (nM - fm) < WGM ? (nM - fm) : WGM;
        u.pm = fm + ((wgid % nig) % gsz); u.pn = (wgid % nig) / gsz; u.pk = 0; return true;
    }
    __device__ __forceinline__ void a_ready(const Unit&) const {}
    __device__ __forceinline__ void done(const Unit&) const {}
};
__device__ __forceinline__ unsigned cvt_pk_bf16(float lo, float hi) { unsigned r; asm volatile("v_cvt_pk_bf16_f32 %0, %1, %2" : "=v"(r) : "v"(lo), "v"(hi)); return r; }
template <class Epi, class Sched>
__device__ __forceinline__ void gemm_phase(PG8_LAS unsigned char* lds, const Gemm g, const Sched& S, const Epi& E) {
    int tid_ = threadIdx.x; asm volatile("" : "+v"(tid_));
    const int tid = tid_, wid = __builtin_amdgcn_readfirstlane(tid >> 6), lane = tid & 63, wr = wid >> 2, wc = wid & 3, fr = lane & 15, fq = lane >> 4;
    const int K = g.K, nt = K / BK, ld = g.ld;
    unsigned voffA[2], voffB[2];
#pragma unroll
    for (int i = 0; i < 2; ++i) { int R, C; stage_rc(tid * 16 + i * 8192, R, C); const int Rb = Epi::PERM ? ((R & ~31) + perm32(R & 31)) : R;
        voffA[i] = (unsigned)(R * ld + C) * 2u; voffB[i] = (unsigned)(Rb * ld + C) * 2u; }
    const size_t kstep = (size_t)(BK * 2);
    const size_t hstep = (size_t)HALF * ld * 2;
    const size_t tstep = 2 * hstep;
    const unsigned ldsw = (unsigned)wid * 1024u;
    const int aoff = lds_byte(wr * 64 + fr, fq * 8), boff = lds_byte(wc * 32 + fr, fq * 8);
#define PG8_SA(b, h) (((b) * 2 + (h)) * HTB)
#define PG8_SB(b, h) ((4 + (b) * 2 + (h)) * HTB)
#define PG8_STAGE(bufoff, gbase, voff) do { _Pragma("unroll") for (int _i = 0; _i < 2; ++_i) \
        __builtin_amdgcn_global_load_lds((const unsigned*)((const char*)(gbase) + (voff)[_i]), (PG8_LAS unsigned*)(lds + (bufoff) + ldsw + _i * 8192), 16, 0, 0); } while (0)
#define PG8_LDA(dst, b, h) do { _Pragma("unroll") for (int m = 0; m < 4; ++m) _Pragma("unroll") for (int k = 0; k < 2; ++k) dst[m][k] = *(const PG8_LAS bf16x8*)(lds + PG8_SA(b, h) + aoff + m * 2048 + k * 1024); } while (0)
#define PG8_LDB(dst, b, h) do { _Pragma("unroll") for (int n = 0; n < 2; ++n) _Pragma("unroll") for (int k = 0; k < 2; ++k) dst[n][k] = *(const PG8_LAS bf16x8*)(lds + PG8_SB(b, h) + boff + n * 2048 + k * 1024); } while (0)
#define PG8_MMA(ai, bj, At, Bt) do { __builtin_amdgcn_s_setprio(1); _Pragma("unroll") for (int m = 0; m < 4; ++m) _Pragma("unroll") for (int n = 0; n < 2; ++n) _Pragma("unroll") for (int k = 0; k < 2; ++k) \
        acc[ai][bj][m][n] = __builtin_amdgcn_mfma_f32_16x16x32_bf16(Bt[n][k], At[m][k], acc[ai][bj][m][n], 0, 0, 0); __builtin_amdgcn_s_setprio(0); } while (0)
#define PG8_WAIT_V(n) asm volatile("s_waitcnt vmcnt(" #n ")" ::: "memory")
#define PG8_WAIT_L(n) asm volatile("s_waitcnt lgkmcnt(" #n ")" ::: "memory")
#define PG8_BAR __builtin_amdgcn_s_barrier()
#define PG8_SCHED __builtin_amdgcn_sched_barrier(0)
    Unit cur, nxt; int ui = 0;
    if (!S.next(0, cur)) return;
    f32x4 acc[2][2][4][2];
#pragma unroll
    for (int a = 0; a < 2; ++a)
#pragma unroll
        for (int b = 0; b < 2; ++b)
#pragma unroll
            for (int m = 0; m < 4; ++m)
#pragma unroll
                for (int n = 0; n < 2; ++n) acc[a][b][m][n] = (f32x4){0.f, 0.f, 0.f, 0.f};
    bf16x8 At[4][2], B0[2][2], B1[2][2];
    const char* cA = (const char*)g.A + (size_t)cur.pm * tstep + (size_t)cur.pk * K * 2; const char* cB = (const char*)g.Bt + (size_t)cur.pn * tstep + (size_t)cur.pk * K * 2;
    S.a_ready(cur);
    PG8_STAGE(PG8_SB(0, 0), cB, voffB); PG8_STAGE(PG8_SA(0, 0), cA, voffA); PG8_STAGE(PG8_SB(0, 1), cB + hstep, voffB); PG8_STAGE(PG8_SA(0, 1), cA + hstep, voffA);
    if (wr == 1) PG8_BAR;
    PG8_WAIT_V(4); PG8_BAR;
    PG8_STAGE(PG8_SB(1, 0), cB + kstep, voffB); PG8_STAGE(PG8_SA(1, 0), cA + kstep, voffA); PG8_STAGE(PG8_SB(1, 1), cB + hstep + kstep, voffB);
    PG8_WAIT_V(6); PG8_BAR;
    for (;;) {
        const bool has_next = S.next(ui + 1, nxt);
        const char* nA = has_next ? (const char*)g.A + (size_t)nxt.pm * tstep + (size_t)nxt.pk * K * 2 : cA; const char* nB = has_next ? (const char*)g.Bt + (size_t)nxt.pn * tstep + (size_t)nxt.pk * K * 2 : cB;
        for (int t = 0; t < nt; t += 2) {
            const bool last = (t == nt - 2);
            const char* a1 = cA + (size_t)(t + 1) * kstep;
            const char* a2 = last ? nA : cA + (size_t)(t + 2) * kstep; const char* b2 = last ? nB : cB + (size_t)(t + 2) * kstep;
            const char* a3 = a2 + kstep; const char* b3 = b2 + kstep;
            if (last && has_next) S.a_ready(nxt);
            PG8_LDB(B0, 0, 0); PG8_SCHED; PG8_LDA(At, 0, 0); PG8_STAGE(PG8_SA(1, 1), a1 + hstep, voffA);
            PG8_WAIT_L(8); PG8_BAR; PG8_WAIT_L(0); PG8_MMA(0, 0, At, B0); PG8_BAR; PG8_SCHED;
            PG8_LDB(B1, 0, 1); PG8_STAGE(PG8_SB(0, 0), b2, voffB);
            PG8_BAR; PG8_WAIT_L(0); PG8_MMA(0, 1, At, B1); PG8_BAR;
            PG8_LDA(At, 0, 1); PG8_STAGE(PG8_SA(0, 0), a2, voffA);
            PG8_BAR; PG8_WAIT_L(0); PG8_MMA(1, 0, At, B0); PG8_BAR; PG8_SCHED;
            PG8_STAGE(PG8_SB(0, 1), b2 + hstep, voffB);
            PG8_WAIT_V(6); PG8_BAR; PG8_MMA(1, 1, At, B1); PG8_BAR;
            PG8_LDB(B0, 1, 0); PG8_SCHED; PG8_LDA(At, 1, 0); PG8_STAGE(PG8_SA(0, 1), a2 + hstep, voffA);
            PG8_WAIT_L(8); PG8_BAR; PG8_WAIT_L(0); PG8_MMA(0, 0, At, B0); PG8_BAR; PG8_SCHED;
            PG8_LDB(B1, 1, 1); PG8_STAGE(PG8_SB(1, 0), b3, voffB);
            PG8_BAR; PG8_WAIT_L(0); PG8_MMA(0, 1, At, B1); PG8_BAR;
            PG8_LDA(At, 1, 1); PG8_STAGE(PG8_SA(1, 0), a3, voffA);
            PG8_BAR; PG8_WAIT_L(0); PG8_MMA(1, 0, At, B0); PG8_BAR; PG8_SCHED;
            PG8_STAGE(PG8_SB(1, 1), b3 + hstep, voffB);
            PG8_WAIT_V(6); PG8_BAR; PG8_MMA(1, 1, At, B1); PG8_BAR;
        }
        if constexpr (!Epi::AFTER_DRAIN) { E(acc, cur, wr, wc, fr, fq); S.done(cur); }
        if (!has_next) break;
#pragma unroll
        for (int a = 0; a < 2; ++a)
#pragma unroll
            for (int b = 0; b < 2; ++b)
#pragma unroll
                for (int m = 0; m < 4; ++m)
#pragma unroll
                    for (int n = 0; n < 2; ++n) acc[a][b][m][n] = (f32x4){0.f, 0.f, 0.f, 0.f};
        cur = nxt; cA = nA; cB = nB; ++ui;
    }
    PG8_WAIT_V(0);
    if (wr == 0) PG8_BAR;
    PG8_BAR;
    if constexpr (Epi::AFTER_DRAIN) { E.fused(acc, cur, wr, wc, fr, fq, lds, wid, lane); S.done(cur); }
#undef PG8_SA
#undef PG8_SB
#undef PG8_STAGE
#undef PG8_LDA
#undef PG8_LDB
#undef PG8_MMA
#undef PG8_WAIT_V
#undef PG8_WAIT_L
#undef PG8_BAR
#undef PG8_SCHED
}
}

#define XB_TMO      128
#define XB_XCNT(j)  (256  + 64 * (j))
#define XB_XSUB(j)  (1280 + 64 * (j))
#define XB_XGEN(j)  (2304 + 64 * (j))
#define XB_TOP      3328
#define XB_TOPGEN   3392
#define XCD_BAR_WORDS 3456
#define XB_SPIN_CAP (1u << 18)
#define XLAS __attribute__((address_space(3)))

__device__ __forceinline__ unsigned xb_ld(unsigned* p)              { return __hip_atomic_load(p, __ATOMIC_RELAXED, __HIP_MEMORY_SCOPE_AGENT); }
__device__ __forceinline__ unsigned xb_add(unsigned* p, unsigned v) { return __hip_atomic_fetch_add(p, v, __ATOMIC_RELAXED, __HIP_MEMORY_SCOPE_AGENT); }
__device__ __forceinline__ unsigned xb_xcc_id() { return (unsigned)__builtin_amdgcn_s_getreg((3 << 11) | 20) & 0xFu; }
#define XB_SPIN(cond, bar) do { unsigned _sp = 0; while (cond) { __builtin_amdgcn_s_sleep(1); \
    if ((++_sp & 255u) == 0u) { if (xb_ld(&(bar)[XB_TMO])) break; if (_sp > XB_SPIN_CAP) { atomicAdd(&(bar)[XB_TMO], 1u); break; } } } } while (0)

struct XcdBarrier {
    unsigned* bar; unsigned x;
    volatile XLAS unsigned* st;
};

__device__ __forceinline__ XcdBarrier xcd_barrier_post(unsigned* bar, volatile XLAS unsigned* st) {
    XcdBarrier b; b.bar = bar; b.x = xb_xcc_id(); b.st = st;
    if (threadIdx.x == 0) (void)xb_add(&bar[XB_XCNT(b.x)], 1u);
    return b;
}
__device__ __forceinline__ void xcd_barrier_complete(unsigned* bar, unsigned x, unsigned& nloc, unsigned& nx) {
    const unsigned G = gridDim.x * gridDim.y * gridDim.z;
    unsigned sum, cnt, mine, sp = 0u;
    for (;;) {
        sum = 0u; cnt = 0u; mine = 0u;
#pragma unroll
        for (unsigned j = 0; j < 16; ++j) { const unsigned c = xb_ld(&bar[XB_XCNT(j)]); sum += c; cnt += (c > 0u) ? 1u : 0u; mine = (j == x) ? c : mine; }
        if (sum == G) break;
        __builtin_amdgcn_s_sleep(1);
        if ((++sp & 255u) == 0u) { if (xb_ld(&bar[XB_TMO])) break; if (sp > XB_SPIN_CAP) { atomicAdd(&bar[XB_TMO], 1u); break; } }
    }
    nloc = mine > 0u ? mine : 1u; nx = cnt > 0u ? cnt : 1u;
}

__device__ __forceinline__ void xcd_barrier(const XcdBarrier& b) {
    asm volatile("s_waitcnt vmcnt(0)" ::: "memory");
    __syncthreads();
    if (threadIdx.x == 0) {
        unsigned* bar = b.bar;
        __builtin_amdgcn_s_waitcnt(0);
        unsigned nloc = b.st[0], nx = b.st[1];
        if (nloc == 0u) { xcd_barrier_complete(bar, b.x, nloc, nx); b.st[0] = nloc; b.st[1] = nx; }
        const unsigned old = xb_add(&bar[XB_XSUB(b.x)], 1u);
        const unsigned gen = old / nloc;
        if (old + 1u == (gen + 1u) * nloc) {
            __builtin_amdgcn_fence(__ATOMIC_RELEASE, "agent");
            asm volatile("s_waitcnt vmcnt(0)" ::: "memory");
            const unsigned og = xb_add(&bar[XB_TOP], 1u);
            const unsigned tg = og / nx;
            if (og + 1u == (tg + 1u) * nx) xb_add(&bar[XB_TOPGEN], 1u);
            else XB_SPIN(xb_ld(&bar[XB_TOPGEN]) == tg, bar);
            __builtin_amdgcn_fence(__ATOMIC_ACQUIRE, "agent");
            xb_add(&bar[XB_XGEN(b.x)], 1u);
            asm volatile("s_waitcnt vmcnt(0)" ::: "memory");
        } else {
            XB_SPIN(xb_ld(&bar[XB_XGEN(b.x)]) == gen, bar);
            __builtin_amdgcn_fence(__ATOMIC_ACQUIRE, "agent");
            asm volatile("s_waitcnt vmcnt(0)" ::: "memory");
        }
    }
    __syncthreads();
}

using pg8::bf16_t; using pg8::f32x4; using pg8::bf16x8;
typedef unsigned u32x4_t __attribute__((ext_vector_type(4)));
typedef unsigned u32x2_t __attribute__((ext_vector_type(2)));

constexpr int DM = 1024, NBP = 8, SEQ = 2048, NBS = 128, SSEQ = 4, NH = 4, HD = 128, MW = 512;
constexpr int MP = NBP * SEQ, MS = NBS * SSEQ, MT = MP + MS;
constexpr int NIN = 9232, N1 = 9216, DFF = 2816, NUP = 5632;
constexpr float EPS = 1e-6f;
constexpr float QSCALE = 0.08838834764831845f;

constexpr size_t O_Y = 0;
constexpr size_t O_P_GS = (size_t)MT * DM;
constexpr size_t O_P_GC = O_P_GS + (size_t)2 * 8 * 4 * 128 * 128;
constexpr size_t O_P_MC = O_P_GC + (size_t)2 * 8 * 3 * 1536;
constexpr size_t O_P_MN = O_P_MC + (size_t)2 * 8 * 4 * 128 * 128;
constexpr size_t O_P_MM = O_P_MN + (size_t)2 * 8 * 4 * 128;
constexpr size_t O_P_HS = O_P_MM + (size_t)2 * 8 * 4;
constexpr size_t O_P_FC = O_P_HS + (size_t)2 * 8 * 4 * 128 * 128;
constexpr size_t O_S_GS = O_P_FC + (size_t)2 * 8 * 2 * 5632;
constexpr size_t O_S_GC = O_S_GS + (size_t)2 * 128 * 4 * 128 * 128;
constexpr size_t O_S_MC = O_S_GC + (size_t)2 * 128 * 3 * 1536;
constexpr size_t O_S_MN = O_S_MC + (size_t)2 * 128 * 4 * 128 * 128;
constexpr size_t O_S_MM = O_S_MN + (size_t)2 * 128 * 4 * 128;
constexpr size_t O_S_HS = O_S_MM + (size_t)2 * 128 * 4;
constexpr size_t O_S_FC = O_S_HS + (size_t)2 * 128 * 4 * 128 * 128;
constexpr size_t O_END  = O_S_FC + (size_t)2 * 128 * 2 * 5632;

constexpr size_t W_WIN = 0;
constexpr size_t W_WBR = W_WIN + (size_t)N1 * 1024 * 2;
constexpr size_t W_WOUT = W_WBR + (size_t)3 * 1024 * 512 * 2;
constexpr size_t W_WUP = W_WOUT + (size_t)1024 * 1024 * 2;
constexpr size_t W_WDN = W_WUP + (size_t)NUP * 1024 * 2;
constexpr size_t W_HBF = W_WDN + (size_t)1024 * DFF * 2;
constexpr size_t W_PROJ = W_HBF + (size_t)MT * 1024 * 2;
constexpr size_t W_ACT = W_PROJ + (size_t)MT * NUP * 2;
constexpr size_t W_OUTS = W_PROJ + (size_t)MT * N1 * 2;
constexpr size_t W_GATES = W_OUTS + (size_t)3 * MT * 512 * 2;
constexpr size_t W_DEN = W_GATES + (size_t)MT * 16 * 4;
constexpr size_t W_MT = W_DEN + (size_t)MT * 4 * 4;
constexpr size_t W_BAR = W_MT + (size_t)MT * 4 * 4;
constexpr size_t W_END = W_BAR + 16384;

constexpr int LDS_BYTES = 131072 + 64 + 512;

struct Params { const float* in[28]; float* out; unsigned char* ws; };
enum { I_XP = 0, I_XS, I_SGS, I_SGC, I_SMC, I_SMN, I_SMM, I_SHS, I_SFC, I_LNMIX, I_WIN, I_GCW, I_ALOG, I_DTB, I_GNORM, I_MIB, I_MFB, I_MNORM, I_HLB, I_HNORM,
       I_WBR, I_WOUT, I_LNFFN, I_WUP, I_FCW, I_FCB, I_WDN, I_LNF };

typedef const float* const __attribute__((address_space(4))) * kargp_t;
__device__ __forceinline__ const float* argp(int i) { kargp_t kp = (kargp_t)__builtin_amdgcn_kernarg_segment_ptr(); asm volatile("" : "+s"(i)); return kp[i]; }
__device__ __forceinline__ int bidx() { int b = (int)blockIdx.x; asm volatile("" : "+s"(b)); return b; }
__device__ __forceinline__ int gdim() { int g = (int)gridDim.x; asm volatile("" : "+s"(g)); return g; }
#define PIN(i) argp(i)
#define POUT ((float*)argp(28))
#define PWS ((unsigned char*)argp(29))
__device__ __forceinline__ float bf2f(bf16_t b) { return __uint_as_float(((unsigned)b) << 16); }
__device__ __forceinline__ float bflo(unsigned u) { return __uint_as_float(u << 16); }
__device__ __forceinline__ float bfhi(unsigned u) { return __uint_as_float(u & 0xffff0000u); }
__device__ __forceinline__ bf16_t f2bf(float f) { return (bf16_t)(pg8::cvt_pk_bf16(f, 0.f) & 0xffffu); }
__device__ __forceinline__ float sigm(float x) { return __builtin_amdgcn_rcpf(1.f + __expf(-x)); }
__device__ __forceinline__ float silu(float x) { return x * sigm(x); }
__device__ __forceinline__ float rdlane(float x, int l) { return __builtin_bit_cast(float, __builtin_amdgcn_readlane(__builtin_bit_cast(int, x), l)); }
template <int CTRL> __device__ __forceinline__ float dppf(float x) { return __builtin_bit_cast(float, __builtin_amdgcn_update_dpp(0, __builtin_bit_cast(int, x), CTRL, 0xf, 0xf, true)); }
__device__ __forceinline__ float grp_sum8(float x) { x += dppf<0xB1>(x); x += dppf<0x4E>(x); x += dppf<0x141>(x); return x; }
__device__ __forceinline__ float grp_sum16(float x) { x = grp_sum8(x); x += dppf<0x140>(x); return x; }
__device__ __forceinline__ float wave_sum(float x) { x = grp_sum16(x);
    x += __builtin_bit_cast(float, __builtin_amdgcn_update_dpp(0, __builtin_bit_cast(int, x), 0x142, 0xa, 0xf, false));
    x += __builtin_bit_cast(float, __builtin_amdgcn_update_dpp(0, __builtin_bit_cast(int, x), 0x143, 0xc, 0xf, false));
    return rdlane(x, 63); }
template <int CTRL> __device__ __forceinline__ float dppm(float x) { return __builtin_bit_cast(float, __builtin_amdgcn_update_dpp(__builtin_bit_cast(int, -INFINITY), __builtin_bit_cast(int, x), CTRL, 0xf, 0xf, false)); }
template <int T> __device__ __forceinline__ float grp_sum(float x) { if constexpr (T == 16) return grp_sum16(x); else return grp_sum8(x); }

__device__ __forceinline__ int win_srccol(int n0) { const int blk = n0 >> 9, r = n0 & 511; int base;
    if (blk < 4) base = blk * 512; else if (blk < 8) base = 2056 + (blk - 4) * 512; else if (blk < 12) base = 4112 + (blk - 8) * 512; else base = 6160 + (blk - 12) * 512;
    return base + r; }
__device__ __forceinline__ void conv_T(const float* __restrict__ src, int ld, bf16_t* __restrict__ dst, int K, int N, bool winmap, float* tile, int& tcount) {
    int tid_ = threadIdx.x; asm volatile("" : "+v"(tid_)); const int tid = tid_, ntn = N / 64, ntiles = ntn * (K / 64);
    for (int t = bidx() - (tcount % gdim()); t < ntiles; t += gdim()) {
        if (t < 0) continue;
        const int tn = t % ntn, tk = t / ntn, n0 = tn * 64, k0 = tk * 64, sc0 = winmap ? win_srccol(n0) : n0;
        __syncthreads();
        { const int kk = tid >> 4, n4 = (tid & 15) * 4;
#pragma unroll
          for (int pp = 0; pp < 2; ++pp) { const float4 v = *(const float4*)(src + (size_t)(k0 + kk + 32 * pp) * ld + sc0 + n4); float* tp = tile + (kk + 32 * pp) * 65 + n4; tp[0] = v.x; tp[1] = v.y; tp[2] = v.z; tp[3] = v.w; } }
        __syncthreads();
        { const int n = tid >> 3, k8 = (tid & 7) * 8; float f[8];
#pragma unroll
          for (int i = 0; i < 8; ++i) f[i] = tile[(k8 + i) * 65 + n];
          u32x4_t o; o[0] = pg8::cvt_pk_bf16(f[0], f[1]); o[1] = pg8::cvt_pk_bf16(f[2], f[3]); o[2] = pg8::cvt_pk_bf16(f[4], f[5]); o[3] = pg8::cvt_pk_bf16(f[6], f[7]);
          *(u32x4_t*)(dst + (size_t)(n0 + n) * K + k0 + k8) = o; }
    }
    tcount += ntiles;
}

__device__ __forceinline__ void phase_rmsnorm(const Params& p, int l, const float* xa, const float* xb, const float* __restrict__ gw, bf16_t* __restrict__ hout, bool do_gates, float* sm) {
    int tid_ = threadIdx.x; asm volatile("" : "+v"(tid_)); const int tid = tid_, lane = tid & 63, w = tid >> 6;
    float* wgT = sm;
    if (do_gates) {
        const float* win = PIN(I_WIN) + (size_t)l * 1024 * NIN;
        __syncthreads();
        for (int i = tid; i < 16 * 1024; i += 512) { const int k = i >> 4, j = i & 15; const int gc = j < 8 ? 2048 + j : 4104 + (j - 8); wgT[j * 1024 + k] = win[(size_t)k * NIN + gc]; }
        __syncthreads();
    }
    float4 g4[4];
#pragma unroll
    for (int i = 0; i < 4; ++i) g4[i] = *(const float4*)(gw + lane * 4 + 256 * i);
    for (int row = bidx() * 8 + w; row < MT; row += gdim() * 8) {
        const float* xr = row < MP ? xa + (size_t)row * DM : xb + (size_t)(row - MP) * DM;
        float4 v[4]; float ss = 0.f;
#pragma unroll
        for (int i = 0; i < 4; ++i) { v[i] = *(const float4*)(xr + lane * 4 + 256 * i); ss += v[i].x * v[i].x + v[i].y * v[i].y + v[i].z * v[i].z + v[i].w * v[i].w; }
        ss = wave_sum(ss);
        const float rstd = rsqrtf(ss * (1.f / 1024.f) + EPS);
#pragma unroll
        for (int i = 0; i < 4; ++i) { v[i].x *= rstd * g4[i].x; v[i].y *= rstd * g4[i].y; v[i].z *= rstd * g4[i].z; v[i].w *= rstd * g4[i].w;
            u32x2_t o; o[0] = pg8::cvt_pk_bf16(v[i].x, v[i].y); o[1] = pg8::cvt_pk_bf16(v[i].z, v[i].w);
            *(u32x2_t*)(hout + (size_t)row * DM + lane * 4 + 256 * i) = o; }
        if (do_gates) {
            float mine = 0.f;
#pragma unroll
            for (int j = 0; j < 16; ++j) { float a = 0.f;
#pragma unroll
                for (int i = 0; i < 4; ++i) { const float4 wv = *(const float4*)(wgT + j * 1024 + lane * 4 + 256 * i); a += v[i].x * wv.x + v[i].y * wv.y + v[i].z * wv.z + v[i].w * wv.w; }
                a = wave_sum(a); if (lane == j) mine = a; }
            if (lane < 16) { const int h = lane & 3, kind = lane >> 2; float r;
                if (kind == 0) r = sigm(mine);
                else if (kind == 1) { const float xx = mine + PIN(I_DTB)[l * 4 + h]; const float sp = xx > 20.f ? xx : log1pf(__expf(xx)); r = __expf(-__expf(PIN(I_ALOG)[l * 4 + h]) * sp); }
                else if (kind == 2) r = mine + PIN(I_MIB)[l * 4 + h];
                else { const float xx = -(mine + PIN(I_MFB)[l * 4 + h]); r = -(xx > 20.f ? xx : log1pf(__expf(xx))); }
                ((float*)(PWS + W_GATES))[(size_t)row * 16 + lane] = r; }
        }
    }
}

struct EpiProj {
    static constexpr bool PERM = true, AFTER_DRAIN = false;
    bf16_t* O; int ldc; int actmode;
    __device__ __forceinline__ void operator()(const f32x4 (&acc)[2][2][4][2], const pg8::Unit& u, int wr, int wc, int fr, int fq) const {
        const int row0 = u.pm * 256 + wr * 64 + fr, col0 = u.pn * 256 + wc * 32 + 8 * fq;
        int act = 0;
        if (actmode) { const int pn = u.pn; act = (pn >= 24 || pn == 14 || pn == 15) ? 2 : ((pn == 6 || pn == 7 || pn == 16 || pn == 17 || pn == 22 || pn == 23) ? 1 : 0); }
#pragma unroll
        for (int ai = 0; ai < 2; ++ai)
#pragma unroll
            for (int m = 0; m < 4; ++m) { bf16_t* rowp = O + (size_t)(row0 + ai * 128 + m * 16) * ldc + col0;
#pragma unroll
                for (int bj = 0; bj < 2; ++bj) { float v[8];
#pragma unroll
                    for (int i = 0; i < 4; ++i) { v[i] = acc[ai][bj][m][0][i]; v[4 + i] = acc[ai][bj][m][1][i]; }
                    if (act == 1) {
#pragma unroll
                        for (int i = 0; i < 8; ++i) v[i] = silu(v[i]); }
                    else if (act == 2) {
#pragma unroll
                        for (int i = 0; i < 8; ++i) v[i] = sigm(v[i]); }
                    u32x4_t o; o[0] = pg8::cvt_pk_bf16(v[0], v[1]); o[1] = pg8::cvt_pk_bf16(v[2], v[3]); o[2] = pg8::cvt_pk_bf16(v[4], v[5]); o[3] = pg8::cvt_pk_bf16(v[6], v[7]);
                    *(u32x4_t*)(rowp + bj * 128) = o; } }
    }
};
struct EpiMerge {
    static constexpr bool PERM = true, AFTER_DRAIN = false;
    const bf16_t* G; bf16_t* Mx;
    __device__ __forceinline__ void operator()(const f32x4 (&acc)[2][2][4][2], const pg8::Unit& u, int wr, int wc, int fr, int fq) const {
        const int n = u.pn >> 2, first = (n == 0);
        const int row0 = (u.pm - n * (MT / 256)) * 256 + wr * 64 + fr, col0 = (u.pn & 3) * 256 + wc * 32 + 8 * fq;
        const bf16_t* Gn = G + n * 1024 + col0; bf16_t* Mc = Mx + col0;
        u32x4_t gc[2], oc[2], gn[2], on[2];
#pragma unroll
        for (int bj = 0; bj < 2; ++bj) { gc[bj] = *(const u32x4_t*)(Gn + (size_t)row0 * N1 + bj * 128); oc[bj] = first ? (u32x4_t){0u, 0u, 0u, 0u} : *(const u32x4_t*)(Mc + (size_t)row0 * DM + bj * 128); }
#pragma unroll
        for (int gI = 0; gI < 8; ++gI) { const int ai = gI >> 2, m = gI & 3; const size_t row = (size_t)(row0 + ai * 128 + m * 16);
            if (gI < 7) { const size_t row2 = (size_t)(row0 + ((gI + 1) >> 2) * 128 + ((gI + 1) & 3) * 16);
#pragma unroll
                for (int bj = 0; bj < 2; ++bj) { gn[bj] = *(const u32x4_t*)(Gn + row2 * N1 + bj * 128); on[bj] = first ? (u32x4_t){0u, 0u, 0u, 0u} : *(const u32x4_t*)(Mc + row2 * DM + bj * 128); } }
#pragma unroll
            for (int bj = 0; bj < 2; ++bj) { float v[8];
#pragma unroll
                for (int i = 0; i < 4; ++i) { v[i] = acc[ai][bj][m][0][i]; v[4 + i] = acc[ai][bj][m][1][i]; }
#pragma unroll
                for (int i = 0; i < 4; ++i) { v[2 * i] = v[2 * i] * bflo(gc[bj][i]) + bflo(oc[bj][i]); v[2 * i + 1] = v[2 * i + 1] * bfhi(gc[bj][i]) + bfhi(oc[bj][i]); }
                u32x4_t o; o[0] = pg8::cvt_pk_bf16(v[0], v[1]); o[1] = pg8::cvt_pk_bf16(v[2], v[3]); o[2] = pg8::cvt_pk_bf16(v[4], v[5]); o[3] = pg8::cvt_pk_bf16(v[6], v[7]);
                *(u32x4_t*)(Mc + row * DM + bj * 128) = o; }
#pragma unroll
            for (int bj = 0; bj < 2; ++bj) { gc[bj] = gn[bj]; oc[bj] = on[bj]; } }
    }
};
struct EpiResid {
    static constexpr bool PERM = false, AFTER_DRAIN = false;
    float* X; const float* Sa; const float* Sb;
    __device__ __forceinline__ void operator()(const f32x4 (&acc)[2][2][4][2], const pg8::Unit& u, int wr, int wc, int fr, int fq) const {
        const int row0 = u.pm * 256 + wr * 64 + fr, col0 = u.pn * 256 + wc * 32 + 4 * fq;
        const float* S = u.pm * 256 < MP ? Sa : Sb - (size_t)MP * DM;
        f32x4 cur[4], nxt[4];
#pragma unroll
        for (int q = 0; q < 4; ++q) cur[q] = *(const f32x4*)(S + (size_t)row0 * DM + col0 + (q >> 1) * 128 + (q & 1) * 16);
#pragma unroll
        for (int gI = 0; gI < 8; ++gI) { const int ai = gI >> 2, m = gI & 3; const size_t ro = (size_t)(row0 + ai * 128 + m * 16) * DM + col0;
            if (gI < 7) { const int ai2 = (gI + 1) >> 2, m2 = (gI + 1) & 3; const size_t ro2 = (size_t)(row0 + ai2 * 128 + m2 * 16) * DM + col0;
#pragma unroll
                for (int q = 0; q < 4; ++q) nxt[q] = *(const f32x4*)(S + ro2 + (q >> 1) * 128 + (q & 1) * 16); }
#pragma unroll
            for (int q = 0; q < 4; ++q) *(f32x4*)(X + ro + (q >> 1) * 128 + (q & 1) * 16) = cur[q] + acc[ai][q >> 1][m][q & 1];
#pragma unroll
            for (int q = 0; q < 4; ++q) cur[q] = nxt[q]; }
    }
};

struct EpiAtomic {
    static constexpr bool PERM = false, AFTER_DRAIN = false;
    float* X;
    __device__ __forceinline__ void operator()(const f32x4 (&acc)[2][2][4][2], const pg8::Unit& u, int wr, int wc, int fr, int fq) const {
        const int row0 = u.pm * 256 + wr * 64 + fr, col0 = u.pn * 256 + wc * 32 + 4 * fq;
#pragma unroll
        for (int ai = 0; ai < 2; ++ai)
#pragma unroll
            for (int m = 0; m < 4; ++m) { float* rowp = X + (size_t)(row0 + ai * 128 + m * 16) * DM + col0;
#pragma unroll
                for (int bj = 0; bj < 2; ++bj)
#pragma unroll
                    for (int n = 0; n < 2; ++n)
#pragma unroll
                        for (int e = 0; e < 4; ++e) unsafeAtomicAdd(rowp + bj * 128 + n * 16 + e, acc[ai][bj][m][n][e]); }
    }
};
struct MergeOrder {
    pg8::StaticOrder base;
    __device__ void init(int G_, int c_) { base.init(MT, 1024, G_, c_); }
    __device__ bool next(int i, pg8::Unit& u) const { const int t = i / 3, n = i - 3 * t; pg8::Unit b; if (!base.next(t, b)) return false; u.pm = n * (MT / 256) + b.pm; u.pn = n * 4 + b.pn; u.pk = 0; return true; }
    __device__ __forceinline__ void a_ready(const pg8::Unit&) const {}
    __device__ __forceinline__ void done(const pg8::Unit&) const {}
};
struct PieceOrder {
    int G, c, KP;
    __device__ bool next(int i, pg8::Unit& u) const { const int L = i * G + c; if (L >= 8 * KP) return false; const int tile = L / KP; u.pk = L - tile * KP; u.pm = MP / 256 + (tile >> 2); u.pn = tile & 3; return true; }
    __device__ __forceinline__ void a_ready(const pg8::Unit&) const {}
    __device__ __forceinline__ void done(const pg8::Unit&) const {}
};
__device__ __forceinline__ void phase_gdnprep(const Params& p, int l) {
    int tid_ = threadIdx.x; asm volatile("" : "+v"(tid_)); const int tid = tid_, j = tid & 15;
    const bf16_t* proj = (const bf16_t*)(PWS + W_PROJ);
    bf16_t* qkd = (bf16_t*)(PWS + W_HBF); bf16_t* vd = (bf16_t*)(PWS + W_OUTS);
    const float* cw = PIN(I_GCW) + (size_t)l * 4 * 1536; const float* cst = PIN(I_SGC) + (size_t)l * NBS * 3 * 1536;
    const int ngroups = MT * 12;
    for (int gid = bidx() * 32 + (tid >> 4); gid < ngroups; gid += gdim() * 32) {
        const int r = gid / 12, part = gid - r * 12, col = part * 128 + 8 * j;
        const bool samp = r >= MP; const int t = samp ? ((r - MP) & 3) : (r & (SEQ - 1)), b2 = samp ? ((r - MP) >> 2) : 0;
        float y[8];
#pragma unroll
        for (int i = 0; i < 8; ++i) y[i] = 0.f;
#pragma unroll
        for (int jj = 0; jj < 4; ++jj) { const int tt = t - 3 + jj; float x[8];
            if (tt >= 0) { const u32x4_t raw = *(const u32x4_t*)(proj + (size_t)(r - 3 + jj) * N1 + col);
#pragma unroll
                for (int i = 0; i < 4; ++i) { x[2 * i] = bflo(raw[i]); x[2 * i + 1] = bfhi(raw[i]); } }
            else if (samp) { const float* cp = cst + (size_t)(b2 * 3 + 3 + tt) * 1536 + col; const float4 a0 = *(const float4*)cp, a1 = *(const float4*)(cp + 4);
                x[0] = a0.x; x[1] = a0.y; x[2] = a0.z; x[3] = a0.w; x[4] = a1.x; x[5] = a1.y; x[6] = a1.z; x[7] = a1.w; }
            else {
#pragma unroll
                for (int i = 0; i < 8; ++i) x[i] = 0.f; }
            const float4 w0 = *(const float4*)(cw + jj * 1536 + col), w1 = *(const float4*)(cw + jj * 1536 + col + 4);
            y[0] += w0.x * x[0]; y[1] += w0.y * x[1]; y[2] += w0.z * x[2]; y[3] += w0.w * x[3]; y[4] += w1.x * x[4]; y[5] += w1.y * x[5]; y[6] += w1.z * x[6]; y[7] += w1.w * x[7]; }
        float ss = 0.f;
#pragma unroll
        for (int i = 0; i < 8; ++i) { y[i] = silu(y[i]); ss += y[i] * y[i]; }
        ss = grp_sum16(ss);
        const float scl = part < 4 ? rsqrtf(ss + EPS) * QSCALE : (part < 8 ? rsqrtf(ss + EPS) : 1.f);
        u32x4_t o; o[0] = pg8::cvt_pk_bf16(y[0] * scl, y[1] * scl); o[1] = pg8::cvt_pk_bf16(y[2] * scl, y[3] * scl); o[2] = pg8::cvt_pk_bf16(y[4] * scl, y[5] * scl); o[3] = pg8::cvt_pk_bf16(y[6] * scl, y[7] * scl);
        if (part < 8) *(u32x4_t*)(qkd + (size_t)r * 1024 + col) = o; else *(u32x4_t*)(vd + (size_t)r * 512 + (col - 1024)) = o;
    }
}

typedef float f2 __attribute__((ext_vector_type(2)));
typedef float f4 __attribute__((ext_vector_type(4)));
template <int MIX>
__device__ __forceinline__ void scan_prompt_item(const Params& p, int l, int b, int h, int cgp, float* sm) {
    constexpr int T = 16, CPL = (MIX == 0) ? 1 : 2, NG = 128 / (4 * T), NP = 2 * NG, CPW = (64 / T) * CPL, CPG = 8 * CPW, TB = 32, BUFSZ = 14464, NBLK = SEQ / TB;
    int tid_ = threadIdx.x; asm volatile("" : "+v"(tid_)); const int tid = tid_, lane = tid & 63, w = tid >> 6, c = lane / T, j = lane % T;
    const int col = w * CPW + c, ecol = cgp * CPG + col;
    float* misc = sm + 2 * BUFSZ; float* gsc = misc; float* mcar = misc + 64;
    const float* gates = (const float*)(PWS + W_GATES);
    bf16_t* outp = (bf16_t*)(PWS + W_OUTS) + (size_t)MIX * MT * 512;
    const size_t rb = (size_t)b * SEQ;
    const int c8 = (tid & 31) * 8, srow = tid >> 5;
    const bf16_t* qsrc; size_t qld; const bf16_t* vsrc; size_t vld;
    if (MIX == 0) { qsrc = (const bf16_t*)(PWS + W_HBF) + rb * 1024 + (c8 < 128 ? h * 128 + c8 : 512 + h * 128 + (c8 - 128)); qld = 1024;
        vsrc = (const bf16_t*)(PWS + W_OUTS) + rb * 512 + h * 128 + cgp * 32; vld = 512; }
    else { const int base = MIX == 1 ? 2048 : 4096; qsrc = (const bf16_t*)(PWS + W_PROJ) + rb * N1 + base + (c8 < 128 ? h * 128 + c8 : 512 + h * 128 + (c8 - 128)); qld = N1;
        vsrc = (const bf16_t*)(PWS + W_PROJ) + rb * N1 + base + 1024 + h * 128 + cgp * 64; vld = N1; }
    constexpr int VPC = CPG / 8;
    const int vs = tid / VPC, vc8 = (tid % VPC) * 8; const bool vact = tid < TB * VPC;
    float lb8[8];
#pragma unroll
    for (int i = 0; i < 8; ++i) lb8[i] = 0.f;
    if (MIX == 2 && l > 0 && c8 >= 128) { const float* hl = PIN(I_HLB);
#pragma unroll
        for (int i = 0; i < 8; ++i) { const int cc = h * 128 + (c8 - 128) + i; lb8[i] = sigm(hl[512 + cc] - hl[cc]); } }
    f2 S2[CPL][NP];
#pragma unroll
    for (int cc = 0; cc < CPL; ++cc)
#pragma unroll
        for (int i = 0; i < NP; ++i) S2[cc][i] = (f2){0.f, 0.f};
    float nn = 0.f, okeep[CPL], oprev[CPL];
#pragma unroll
    for (int cc = 0; cc < CPL; ++cc) { okeep[cc] = 0.f; oprev[cc] = 0.f; }
    u32x4_t rq[2], rv; float rg0 = 0.f, rg1 = 0.f;
    rv = (u32x4_t){0u, 0u, 0u, 0u};
#define SCAN_ISSUE(t0_) do { \
        _Pragma("unroll") for (int i_ = 0; i_ < 2; ++i_) rq[i_] = *(const u32x4_t*)(qsrc + (size_t)((t0_) + srow + 16 * i_) * qld); \
        if (vact) rv = *(const u32x4_t*)(vsrc + (size_t)((t0_) + vs) * vld + vc8); \
        if (MIX != 2 && tid < TB) { const size_t r_ = rb + (t0_) + tid; rg0 = gates[r_ * 16 + (MIX == 0 ? 0 : 8) + h]; rg1 = gates[r_ * 16 + (MIX == 0 ? 4 : 12) + h]; } } while (0)
#define SCAN_FINISH(B_) do { float* qk_ = (B_); float* vv_ = (B_) + 8192; float* sc_ = (B_) + 10240; \
        _Pragma("unroll") for (int i_ = 0; i_ < 2; ++i_) { float x_[8]; \
            _Pragma("unroll") for (int e_ = 0; e_ < 4; ++e_) { x_[2 * e_] = bflo(rq[i_][e_]); x_[2 * e_ + 1] = bfhi(rq[i_][e_]); } \
            if (MIX == 2 && c8 >= 128) { _Pragma("unroll") for (int e_ = 0; e_ < 8; ++e_) x_[e_] = lb8[e_] + (1.f - lb8[e_]) * sigm(x_[e_]); } \
            float* d_ = qk_ + (srow + 16 * i_) * 256 + c8; *(f4*)d_ = (f4){x_[0], x_[1], x_[2], x_[3]}; *(f4*)(d_ + 4) = (f4){x_[4], x_[5], x_[6], x_[7]}; } \
        if (vact) { float* d_ = vv_ + vs * 64 + vc8; *(f4*)d_ = (f4){bflo(rv[0]), bfhi(rv[0]), bflo(rv[1]), bfhi(rv[1])}; *(f4*)(d_ + 4) = (f4){bflo(rv[2]), bfhi(rv[2]), bflo(rv[3]), bfhi(rv[3])}; } \
        if (MIX == 0 && tid < TB) { sc_[tid * 4] = rg0; sc_[tid * 4 + 1] = rg1; } \
        if (MIX == 1 && tid < TB) { gsc[tid * 2] = rg0; gsc[tid * 2 + 1] = rg1; } } while (0)
#define SCAN_CHAIN(B_) do { if (w == 1) { float* sc_ = (B_) + 10240; const int ls_ = lane & 31; const float m0_ = mcar[0]; \
            const float ig_ = gsc[2 * ls_], lf_ = gsc[2 * ls_ + 1]; \
            float F_ = lf_; F_ += dppf<0x111>(F_); F_ += dppf<0x112>(F_); F_ += dppf<0x114>(F_); F_ += dppf<0x118>(F_);              \
            { const float t0_ = rdlane(F_, 15); if (lane & 16) F_ += t0_; } \
            float P_ = ig_ - F_; P_ = fmaxf(P_, dppm<0x111>(P_)); P_ = fmaxf(P_, dppm<0x112>(P_)); P_ = fmaxf(P_, dppm<0x114>(P_)); P_ = fmaxf(P_, dppm<0x118>(P_)); \
            { const float t1_ = rdlane(P_, 15); if (lane & 16) P_ = fmaxf(P_, t1_); } \
            const float m_ = F_ + fmaxf(m0_, P_); \
            float mp_ = dppf<0x111>(m_); { const float t2_ = rdlane(m_, 15); if ((lane & 15) == 0) mp_ = (lane & 16) ? t2_ : m0_; } \
            const float mlast_ = rdlane(m_, 31); \
            if (lane < 32) { sc_[lane * 4] = __expf(lf_ + mp_ - m_); sc_[lane * 4 + 1] = __expf(ig_ - m_) * QSCALE; sc_[lane * 4 + 2] = m_; } \
            if (lane == 0) mcar[0] = mlast_; } } while (0)
    if (MIX == 1 && tid == 64) mcar[0] = 0.f;
    __syncthreads();
    SCAN_ISSUE(0);
    SCAN_FINISH(sm);
    __syncthreads();
    if (MIX == 1) { SCAN_CHAIN(sm); __syncthreads(); }
#pragma unroll 1
    for (int blk = 0; blk < NBLK; ++blk) {
        const int t0 = blk * TB;
        float* B = sm + (blk & 1) * BUFSZ; float* Bn = sm + ((blk & 1) ^ 1) * BUFSZ;
        const float* qk = B; const float* vv = B + 8192; const float* sc = B + 10240; float* denp = B + 10368;
        if (blk + 1 < NBLK) SCAN_ISSUE(t0 + TB);
        f4 qa[2][NG], ka[2][NG]; float va[2][CPL], sa[2], sb[2], kda[2], qda[2];
#define SCAN_LOADOPS(slot_, s_) do { const float* qs_ = qk + (s_) * 256; \
            _Pragma("unroll") for (int g_ = 0; g_ < NG; ++g_) { qa[slot_][g_] = *(const f4*)(qs_ + g_ * 4 * T + 4 * j); ka[slot_][g_] = *(const f4*)(qs_ + 128 + g_ * 4 * T + 4 * j); } \
            _Pragma("unroll") for (int cc_ = 0; cc_ < CPL; ++cc_) va[slot_][cc_] = vv[(s_) * 64 + col + 4 * cc_]; \
            if (MIX != 2) { sa[slot_] = sc[(s_) * 4]; sb[slot_] = sc[(s_) * 4 + 1]; } \
            if (MIX == 1) { const int dn_ = 16 * w + (lane & 15); kda[slot_] = qs_[128 + dn_]; qda[slot_] = qs_[dn_]; } } while (0)
        SCAN_LOADOPS(0, 0);
#pragma unroll 1
        for (int sg = 0; sg < TB; sg += T) {
#pragma unroll
            for (int ss = 0; ss < T; ++ss) {
                const int s = sg + ss; constexpr int dummy = 0; (void)dummy;
                const int cur = ss & 1, nxt = cur ^ 1;
                SCAN_LOADOPS(nxt, (s + 1) & (TB - 1));
                __builtin_amdgcn_sched_barrier(0);
                f2 qq[NP], kk[NP];
#pragma unroll
                for (int g = 0; g < NG; ++g) { qq[2 * g] = qa[cur][g].xy; qq[2 * g + 1] = qa[cur][g].zw; kk[2 * g] = ka[cur][g].xy; kk[2 * g + 1] = ka[cur][g].zw; }
                float onew[CPL];
#pragma unroll
                for (int cc = 0; cc < CPL; ++cc) {
                    const float v = va[cur][cc];
                    f2 oa = (f2){0.f, 0.f}, ob = (f2){0.f, 0.f};
                    if (MIX == 0) {
                        const float beta = sa[cur], a = sb[cur];
                        f2 ka2 = kk[0] * S2[cc][0], kb2 = kk[1] * S2[cc][1];
#pragma unroll
                        for (int i = 2; i < NP; i += 2) { ka2 = kk[i] * S2[cc][i] + ka2; kb2 = kk[i + 1] * S2[cc][i + 1] + kb2; }
                        ka2 = ka2 + kb2;
                        const float ks = grp_sum<T>(ka2.x + ka2.y);
                        const float u = beta * (v - a * ks);
                        const f2 a2 = (f2){a, a}, u2 = (f2){u, u};
#pragma unroll
                        for (int i = 0; i < NP; i += 2) { S2[cc][i] = S2[cc][i] * a2 + kk[i] * u2; S2[cc][i + 1] = S2[cc][i + 1] * a2 + kk[i + 1] * u2; oa = qq[i] * S2[cc][i] + oa; ob = qq[i + 1] * S2[cc][i + 1] + ob; }
                    } else if (MIX == 1) {
                        const float fp = sa[cur], ip = sb[cur], iv = ip * v;
                        const f2 f2v = (f2){fp, fp}, iv2 = (f2){iv, iv};
#pragma unroll
                        for (int i = 0; i < NP; i += 2) { S2[cc][i] = S2[cc][i] * f2v + kk[i] * iv2; S2[cc][i + 1] = S2[cc][i + 1] * f2v + kk[i + 1] * iv2; oa = qq[i] * S2[cc][i] + oa; ob = qq[i + 1] * S2[cc][i + 1] + ob; }
                    } else {
                        const f2 v2 = (f2){v, v};
#pragma unroll
                        for (int i = 0; i < NP; i += 2) { S2[cc][i] = kk[i] * (S2[cc][i] - v2) + v2; S2[cc][i + 1] = kk[i + 1] * (S2[cc][i + 1] - v2) + v2; oa = qq[i] * S2[cc][i] + oa; ob = qq[i + 1] * S2[cc][i + 1] + ob; }
                    }
                    oa = oa + ob; onew[cc] = oa.x + oa.y;
                }
                if (MIX == 1) { const float fp = sa[cur], ip = sb[cur];
                    nn = fp * nn + ip * kda[cur];
                    denp[s * 128 + 16 * w + (lane & 15)] = qda[cur] * nn; }
#pragma unroll
                for (int cc = 0; cc < CPL; ++cc) {
                    if (ss > 0) { const float o = grp_sum<T>(oprev[cc]); okeep[cc] = (ss - 1 == j) ? o : okeep[cc]; }
                    oprev[cc] = onew[cc]; }
            }
#pragma unroll
            for (int cc = 0; cc < CPL; ++cc) { const float o = grp_sum<T>(oprev[cc]); okeep[cc] = (T - 1 == j) ? o : okeep[cc];
                outp[(rb + t0 + sg + j) * 512 + h * 128 + ecol + 4 * cc] = f2bf(okeep[cc]); }
        }
#undef SCAN_LOADOPS
        if (blk + 1 < NBLK) SCAN_FINISH(Bn);
        __syncthreads();
        if (MIX == 1) {
            if (cgp == 0) { const int sr = tid >> 4, jl = tid & 15; const f4 a0 = *(const f4*)(denp + sr * 128 + 8 * jl), a1 = *(const f4*)(denp + sr * 128 + 8 * jl + 4);
                const float d = grp_sum16((a0.x + a0.y) + (a0.z + a0.w) + (a1.x + a1.y) + (a1.z + a1.w));
                if (jl == 0) { const size_t r = rb + t0 + sr; ((float*)(PWS + W_DEN))[r * 4 + h] = d; ((float*)(PWS + W_MT))[r * 4 + h] = sc[sr * 4 + 2]; } }
            if (blk + 1 < NBLK) SCAN_CHAIN(Bn);
            __syncthreads();
        }
    }
#undef SCAN_ISSUE
#undef SCAN_FINISH
#undef SCAN_CHAIN
    const size_t sidx = ((size_t)(l * NBP + b) * NH + h);
    float* So = POUT + (MIX == 0 ? O_P_GS : (MIX == 1 ? O_P_MC : O_P_HS)) + sidx * 16384;
#pragma unroll
    for (int cc = 0; cc < CPL; ++cc)
#pragma unroll
        for (int g = 0; g < NG; ++g) { const int d0 = g * 4 * T + 4 * j, ec = ecol + 4 * cc;
            So[(size_t)(d0 + 0) * 128 + ec] = S2[cc][2 * g].x; So[(size_t)(d0 + 1) * 128 + ec] = S2[cc][2 * g].y; So[(size_t)(d0 + 2) * 128 + ec] = S2[cc][2 * g + 1].x; So[(size_t)(d0 + 3) * 128 + ec] = S2[cc][2 * g + 1].y; }
    if (MIX == 1 && cgp == 0) {
        if (lane < 16) POUT[O_P_MN + sidx * 128 + 16 * w + lane] = nn;
        if (tid == 64) POUT[O_P_MM + sidx] = mcar[0];
    }
    __syncthreads();
}

__device__ __forceinline__ void scan_sample_item(const Params& p, int l, int mix, int b, int h, float* sm) {
    int tid_ = threadIdx.x; asm volatile("" : "+v"(tid_)); const int tid = tid_, lane = tid & 63, w = tid >> 6, e = tid & 127, dg = tid >> 7;
    float* qk = sm; float* vv = sm + 1024; float* gs = sm + 1536; float* red = sm + 1600; float* dpart = sm + 1600 + 4096;
    const bf16_t* proj = (const bf16_t*)(PWS + W_PROJ);
    const float* gates = (const float*)(PWS + W_GATES);
    bf16_t* outp = (bf16_t*)(PWS + W_OUTS) + (size_t)mix * MT * 512;
    const size_t rs = (size_t)MP + (size_t)b * SSEQ;
    const size_t sidx = ((size_t)(l * NBS + b) * NH + h);
    const float* Sin = (mix == 0 ? PIN(I_SGS) : (mix == 1 ? PIN(I_SMC) : PIN(I_SHS))) + sidx * 16384;
    float S[32];
#pragma unroll
    for (int i = 0; i < 32; ++i) S[i] = Sin[(size_t)(32 * dg + i) * 128 + e];
    __syncthreads();
    for (int idx = tid; idx < 4 * 384; idx += 512) { const int s = idx / 384, ch = idx - s * 384; float val;
        if (mix == 0) { val = ch < 256 ? bf2f(((const bf16_t*)(PWS + W_HBF))[(rs + s) * 1024 + (ch >> 7) * 512 + h * 128 + (ch & 127)]) : bf2f(outp[(rs + s) * 512 + h * 128 + (ch - 256)]);
        } else if (mix == 1) { const int colx = 2048 + (ch >> 7) * 512 + h * 128 + (ch & 127); val = bf2f(proj[(rs + s) * N1 + colx]); }
        else { const int colx = 4096 + (ch >> 7) * 512 + h * 128 + (ch & 127); val = bf2f(proj[(rs + s) * N1 + colx]);
            if (ch >= 128 && ch < 256) { float lbv = 0.f; if (l > 0) { const float* hl = PIN(I_HLB); const int cc = h * 128 + (ch & 127); lbv = sigm(hl[512 + cc] - hl[cc]); } val = lbv + (1.f - lbv) * sigm(val); } }
        if (ch < 256) qk[s * 256 + ch] = val; else vv[s * 128 + ch - 256] = val; }
    if (tid < 4) { const size_t r = rs + tid;
        if (mix == 0) { gs[tid * 4] = gates[r * 16 + h]; gs[tid * 4 + 1] = gates[r * 16 + 4 + h]; }
        else if (mix == 1) { gs[tid * 4] = gates[r * 16 + 8 + h]; gs[tid * 4 + 1] = gates[r * 16 + 12 + h]; } }
    __syncthreads();
    float m = 0.f, nn = 0.f, mts[4] = {0.f, 0.f, 0.f, 0.f};
    if (mix == 1) { m = PIN(I_SMM)[sidx]; if (dg == 0) nn = PIN(I_SMN)[sidx * 128 + e]; }
#pragma unroll
    for (int s = 0; s < 4; ++s) {
        const float* qs = qk + s * 256 + 32 * dg; const float* ksp = qs + 128;
        const float v = vv[s * 128 + e];
        float po = 0.f;
        if (mix == 0) {
            const float beta = gs[s * 4], a = gs[s * 4 + 1];
            float pk = 0.f;
#pragma unroll
            for (int i = 0; i < 32; ++i) pk += ksp[i] * S[i];
            red[((s * 2) * 4 + dg) * 128 + e] = pk;
            __syncthreads();
            const float ks = red[((s * 2) * 4 + 0) * 128 + e] + red[((s * 2) * 4 + 1) * 128 + e] + red[((s * 2) * 4 + 2) * 128 + e] + red[((s * 2) * 4 + 3) * 128 + e];
            const float u = beta * (v - a * ks);
#pragma unroll
            for (int i = 0; i < 32; ++i) { S[i] = a * S[i] + ksp[i] * u; po += qs[i] * S[i]; }
        } else if (mix == 1) {
            const float ig = gs[s * 4], lf = gs[s * 4 + 1]; const float mn = fmaxf(lf + m, ig); const float fp = __expf(lf + m - mn), ip = __expf(ig - mn) * QSCALE; m = mn; mts[s] = mn;
            const float iv = ip * v;
#pragma unroll
            for (int i = 0; i < 32; ++i) { S[i] = fp * S[i] + ksp[i] * iv; po += qs[i] * S[i]; }
            if (dg == 0) { nn = fp * nn + ip * qk[s * 256 + 128 + e]; const float dp = wave_sum(qk[s * 256 + e] * nn); if (lane == 0) dpart[s * 2 + w] = dp; }
        } else {
#pragma unroll
            for (int i = 0; i < 32; ++i) { S[i] = ksp[i] * (S[i] - v) + v; po += qs[i] * S[i]; }
        }
        red[((s * 2 + 1) * 4 + dg) * 128 + e] = po;
    }
    __syncthreads();
    if (tid < 128) {
#pragma unroll
        for (int s = 0; s < 4; ++s) { const float o = red[((s * 2 + 1) * 4 + 0) * 128 + e] + red[((s * 2 + 1) * 4 + 1) * 128 + e] + red[((s * 2 + 1) * 4 + 2) * 128 + e] + red[((s * 2 + 1) * 4 + 3) * 128 + e];
            outp[(rs + s) * 512 + h * 128 + e] = f2bf(o); } }
    if (mix == 1 && tid == 0) {
#pragma unroll
        for (int s = 0; s < 4; ++s) { ((float*)(PWS + W_DEN))[(rs + s) * 4 + h] = dpart[s * 2] + dpart[s * 2 + 1]; ((float*)(PWS + W_MT))[(rs + s) * 4 + h] = mts[s]; }
        POUT[O_S_MM + sidx] = m; }
    float* So = POUT + (mix == 0 ? O_S_GS : (mix == 1 ? O_S_MC : O_S_HS)) + sidx * 16384;
#pragma unroll
    for (int i = 0; i < 32; ++i) So[(size_t)(32 * dg + i) * 128 + e] = S[i];
    if (mix == 1 && dg == 0) POUT[O_S_MN + sidx * 128 + e] = nn;
}
__device__ __forceinline__ void phase_postnorm(const Params& p, int l) {
    int tid_ = threadIdx.x; asm volatile("" : "+v"(tid_)); const int tid = tid_, j = tid & 15;
    bf16_t* outs = (bf16_t*)(PWS + W_OUTS);
    const bf16_t* proj = (const bf16_t*)(PWS + W_PROJ);
    const float* den = (const float*)(PWS + W_DEN); const float* mt = (const float*)(PWS + W_MT);
    const int ngroups = MT * 12;
    for (int gid = bidx() * 32 + (tid >> 4); gid < ngroups; gid += gdim() * 32) {
        const int r = gid / 12, mh = gid - r * 12, mix = mh >> 2, h = mh & 3;
        bf16_t* op = outs + (size_t)mix * MT * 512 + (size_t)r * 512 + h * 128 + 8 * j;
        const u32x4_t raw = *(const u32x4_t*)op;
        float v[8];
#pragma unroll
        for (int i = 0; i < 4; ++i) { v[2 * i] = bflo(raw[i]); v[2 * i + 1] = bfhi(raw[i]); }
        if (mix == 1) { const float dn = fmaxf(fabsf(den[(size_t)r * 4 + h]), __expf(-mt[(size_t)r * 4 + h])); const float inv = 1.f / dn;
#pragma unroll
            for (int i = 0; i < 8; ++i) v[i] *= inv; }
        float ss = 0.f;
#pragma unroll
        for (int i = 0; i < 8; ++i) ss += v[i] * v[i];
        ss = grp_sum16(ss);
        const float rstd = rsqrtf(ss * (1.f / 128.f) + EPS);
        const int gcol = (mix == 0 ? 1536 : (mix == 1 ? 3584 : 5632)) + h * 128 + 8 * j;
        const u32x4_t gr = *(const u32x4_t*)(proj + (size_t)r * N1 + gcol);
        const float* nw = (mix == 0 ? PIN(I_GNORM) : (mix == 1 ? PIN(I_MNORM) : PIN(I_HNORM))) + l * 512 + h * 128 + 8 * j;
        const float4 n0 = *(const float4*)nw, n1 = *(const float4*)(nw + 4);
        const float nwv[8] = {n0.x, n0.y, n0.z, n0.w, n1.x, n1.y, n1.z, n1.w};
#pragma unroll
        for (int i = 0; i < 4; ++i) { v[2 * i] *= rstd * nwv[2 * i] * bflo(gr[i]); v[2 * i + 1] *= rstd * nwv[2 * i + 1] * bfhi(gr[i]); }
        u32x4_t o; o[0] = pg8::cvt_pk_bf16(v[0], v[1]); o[1] = pg8::cvt_pk_bf16(v[2], v[3]); o[2] = pg8::cvt_pk_bf16(v[4], v[5]); o[3] = pg8::cvt_pk_bf16(v[6], v[7]);
        *(u32x4_t*)op = o;
    }
    const int ncs = (NBP + NBS) * 3 * 1536;
    for (int i = bidx() * 512 + tid; i < ncs; i += gdim() * 512) {
        const int cc = i % 1536, ri = (i / 1536) % 3, bb = i / (3 * 1536);
        if (bb < NBP) POUT[O_P_GC + ((size_t)(l * NBP + bb) * 3 + ri) * 1536 + cc] = bf2f(proj[((size_t)bb * SEQ + SEQ - 3 + ri) * N1 + cc]);
        else { const int b2 = bb - NBP; POUT[O_S_GC + ((size_t)(l * NBS + b2) * 3 + ri) * 1536 + cc] = bf2f(proj[((size_t)MP + (size_t)b2 * SSEQ + 1 + ri) * N1 + cc]); }
    }
}

__device__ __forceinline__ void phase_convffn(const Params& p, int l) {
    int tid_ = threadIdx.x; asm volatile("" : "+v"(tid_)); const int tid = tid_;
    const bf16_t* u = (const bf16_t*)(PWS + W_PROJ);
    bf16_t* act = (bf16_t*)(PWS + W_ACT);
    const float* cw = PIN(I_FCW) + (size_t)l * 3 * NUP; const float* cb = PIN(I_FCB) + (size_t)l * NUP;
    const int nitems = (MT / 4) * (DFF / 8);
    for (int it = bidx() * 512 + tid; it < nitems; it += gdim() * 512) {
        const int jg = it % (DFF / 8), rbk = it / (DFF / 8), r0 = rbk * 4, jc = jg * 8;
        const bool samp = r0 >= MP; const int tf = samp ? 0 : (r0 & (SEQ - 1));
        float wa[3][8], wb[3][8], ba[8], bb[8];
#pragma unroll
        for (int i = 0; i < 3; ++i) { const float4 a0 = *(const float4*)(cw + i * NUP + jc), a1 = *(const float4*)(cw + i * NUP + jc + 4), b0 = *(const float4*)(cw + i * NUP + DFF + jc), b1 = *(const float4*)(cw + i * NUP + DFF + jc + 4);
            wa[i][0] = a0.x; wa[i][1] = a0.y; wa[i][2] = a0.z; wa[i][3] = a0.w; wa[i][4] = a1.x; wa[i][5] = a1.y; wa[i][6] = a1.z; wa[i][7] = a1.w;
            wb[i][0] = b0.x; wb[i][1] = b0.y; wb[i][2] = b0.z; wb[i][3] = b0.w; wb[i][4] = b1.x; wb[i][5] = b1.y; wb[i][6] = b1.z; wb[i][7] = b1.w; }
        { const float4 a0 = *(const float4*)(cb + jc), a1 = *(const float4*)(cb + jc + 4), b0 = *(const float4*)(cb + DFF + jc), b1 = *(const float4*)(cb + DFF + jc + 4);
            ba[0] = a0.x; ba[1] = a0.y; ba[2] = a0.z; ba[3] = a0.w; ba[4] = a1.x; ba[5] = a1.y; ba[6] = a1.z; ba[7] = a1.w;
            bb[0] = b0.x; bb[1] = b0.y; bb[2] = b0.z; bb[3] = b0.w; bb[4] = b1.x; bb[5] = b1.y; bb[6] = b1.z; bb[7] = b1.w; }
        float xa[6][8], xb[6][8];
#pragma unroll
        for (int rr = 0; rr < 6; ++rr) {
            if (rr < 2 && tf == 0) {
                if (samp) { const float* st = PIN(I_SFC) + ((size_t)(l * NBS + (r0 - MP) / 4) * 2 + rr) * NUP;
#pragma unroll
                    for (int i = 0; i < 8; ++i) { xa[rr][i] = st[jc + i]; xb[rr][i] = st[DFF + jc + i]; } }
                else {
#pragma unroll
                    for (int i = 0; i < 8; ++i) { xa[rr][i] = 0.f; xb[rr][i] = 0.f; } }
            } else { const bf16_t* ur = u + (size_t)(r0 - 2 + rr) * NUP; const u32x4_t ra = *(const u32x4_t*)(ur + jc), rbv = *(const u32x4_t*)(ur + DFF + jc);
#pragma unroll
                for (int i = 0; i < 4; ++i) { xa[rr][2 * i] = bflo(ra[i]); xa[rr][2 * i + 1] = bfhi(ra[i]); xb[rr][2 * i] = bflo(rbv[i]); xb[rr][2 * i + 1] = bfhi(rbv[i]); } }
        }
#pragma unroll
        for (int t = 0; t < 4; ++t) { float o[8];
#pragma unroll
            for (int i = 0; i < 8; ++i) { const float ya = wa[0][i] * xa[t][i] + wa[1][i] * xa[t + 1][i] + wa[2][i] * xa[t + 2][i] + ba[i]; const float yb = wb[0][i] * xb[t][i] + wb[1][i] * xb[t + 1][i] + wb[2][i] * xb[t + 2][i] + bb[i]; o[i] = silu(ya) * yb; }
            u32x4_t ov; ov[0] = pg8::cvt_pk_bf16(o[0], o[1]); ov[1] = pg8::cvt_pk_bf16(o[2], o[3]); ov[2] = pg8::cvt_pk_bf16(o[4], o[5]); ov[3] = pg8::cvt_pk_bf16(o[6], o[7]);
            *(u32x4_t*)(act + (size_t)(r0 + t) * DFF + jc) = ov; }
        if (samp || tf == SEQ - 4) {
            float* dst = samp ? POUT + O_S_FC + (size_t)(l * NBS + (r0 - MP) / 4) * 2 * NUP : POUT + O_P_FC + (size_t)(l * NBP + r0 / SEQ) * 2 * NUP;
#pragma unroll
            for (int rr = 0; rr < 2; ++rr)
#pragma unroll
                for (int i = 0; i < 8; ++i) { dst[(size_t)rr * NUP + jc + i] = xa[4 + rr][i]; dst[(size_t)rr * NUP + DFF + jc + i] = xb[4 + rr][i]; }
        }
    }
}

__device__ __forceinline__ void phase_final_norm(const Params& p) {
    int tid_ = threadIdx.x; asm volatile("" : "+v"(tid_)); const int tid = tid_, lane = tid & 63, w = tid >> 6;
    const float* gw = PIN(I_LNF);
    float4 g4[4];
#pragma unroll
    for (int i = 0; i < 4; ++i) g4[i] = *(const float4*)(gw + lane * 4 + 256 * i);
    for (int row = bidx() * 8 + w; row < MT; row += gdim() * 8) {
        float* xr = POUT + (size_t)row * DM; float4 v[4]; float ss = 0.f;
#pragma unroll
        for (int i = 0; i < 4; ++i) { v[i] = *(const float4*)(xr + lane * 4 + 256 * i); ss += v[i].x * v[i].x + v[i].y * v[i].y + v[i].z * v[i].z + v[i].w * v[i].w; }
        ss = wave_sum(ss); const float rstd = rsqrtf(ss * (1.f / 1024.f) + EPS);
#pragma unroll
        for (int i = 0; i < 4; ++i) { v[i].x *= rstd * g4[i].x; v[i].y *= rstd * g4[i].y; v[i].z *= rstd * g4[i].z; v[i].w *= rstd * g4[i].w; *(float4*)(xr + lane * 4 + 256 * i) = v[i]; }
    }
}

#ifndef PHM
#define PHM 0xFFFF
#endif
#ifndef DUPB
#define DUPB 1
#endif
#ifndef DUPC
#define DUPC 1
#endif
#ifndef DUPS
#define DUPS 1
#endif
#ifndef DUPH
#define DUPH 1
#endif
#ifndef DUPY
#define DUPY 1
#endif
#ifndef DUPA
#define DUPA 1
#endif
#ifndef DUPI
#define DUPI 1
#endif
#define GSYNC() do { for (int y_ = 0; y_ < DUPY; ++y_) xcd_barrier(xb); } while (0)
__global__ void __launch_bounds__(512, 2) fwd_megakernel(Params p) {
    extern __shared__ __attribute__((aligned(16))) unsigned char shm[];
    cg::grid_group grid = cg::this_grid();
    float* smf = (float*)shm;
    PG8_LAS unsigned char* lds = (PG8_LAS unsigned char*)shm;
    int tid_ = threadIdx.x; asm volatile("" : "+v"(tid_)); const int tid = tid_;
    float* X = POUT;
    volatile XLAS unsigned* xst = (volatile XLAS unsigned*)(lds + 131072);
    if (tid == 0) { xst[0] = 0u; xst[1] = 0u; xst[2] = 0u; xst[3] = 0u; }
    __syncthreads();
    XcdBarrier xb = xcd_barrier_post((unsigned*)(PWS + W_BAR), xst);
    bool first_sync = true;
#ifdef TPROBE1
    volatile XLAS unsigned long long* stp = (volatile XLAS unsigned long long*)(lds + 131072 + 64);
    int nst = 0;
#define STAMP() do { if (blockIdx.x == TPROBE_WG && threadIdx.x == 0) stp[nst] = __builtin_amdgcn_s_memrealtime(); ++nst; } while (0)
#else
#define STAMP() do {} while (0)
#endif
    STAMP();
    bf16_t* hbf = (bf16_t*)(PWS + W_HBF);
    bf16_t* proj = (bf16_t*)(PWS + W_PROJ);

    for (int l = 0; l < 2; ++l) {
        const int G = gdim(), bid = bidx();
        for (int repa = 0; repa < DUPA; ++repa) { if (PHM & 1) { int tc = 0;
          conv_T(PIN(I_WIN) + (size_t)l * 1024 * NIN, NIN, (bf16_t*)(PWS + W_WIN), 1024, N1, true, smf, tc);
          for (int n = 0; n < 3; ++n) conv_T(PIN(I_WBR) + ((size_t)l * 3 + n) * 512 * 1024, 1024, (bf16_t*)(PWS + W_WBR) + (size_t)n * 1024 * 512, 512, 1024, false, smf, tc);
          conv_T(PIN(I_WOUT) + (size_t)l * 1024 * 1024, 1024, (bf16_t*)(PWS + W_WOUT), 1024, 1024, false, smf, tc);
          conv_T(PIN(I_WUP) + (size_t)l * 1024 * NUP, NUP, (bf16_t*)(PWS + W_WUP), 1024, NUP, false, smf, tc);
          conv_T(PIN(I_WDN) + (size_t)l * DFF * 1024, 1024, (bf16_t*)(PWS + W_WDN), DFF, 1024, false, smf, tc);
          __syncthreads(); }
        if (PHM & 2) {
        if (l == 0) { int tq_ = threadIdx.x; asm volatile("" : "+v"(tq_)); const float4* s1 = (const float4*)PIN(I_XS); float4* d1 = (float4*)(X + (size_t)MP * DM);
            for (int i = bid * 512 + tq_; i < MS * DM / 4; i += G * 512) d1[i] = s1[i]; }
        phase_rmsnorm(p, l, l == 0 ? PIN(I_XP) : X, l == 0 ? PIN(I_XS) : X + (size_t)MP * DM, PIN(I_LNMIX) + l * DM, hbf, true, smf); } }
        if (first_sync) { grid.sync(); first_sync = false; }
        else GSYNC();
        STAMP();
        for (int rep = 0; rep < DUPB; ++rep) { pg8::Gemm g{hbf, (const bf16_t*)(PWS + W_WIN), MT, N1, 1024, 1024}; pg8::StaticOrder S; S.init(MT, N1, G, bid); EpiProj E{proj, N1, 1}; pg8::gemm_phase(lds, g, S, E); }
        GSYNC(); STAMP();
        phase_gdnprep(p, l);
        GSYNC(); STAMP();
        for (int rep = 0; rep < DUPC; ++rep) for (int it = bid; it < 256; it += G) {
            if (it < 128) scan_prompt_item<0>(p, l, (it >> 2) >> 2, (it >> 2) & 3, it & 3, smf);
            else if (it < 192) { const int q = it - 128; scan_prompt_item<1>(p, l, (q >> 1) >> 2, (q >> 1) & 3, q & 1, smf); }
            else { const int q = it - 192; scan_prompt_item<2>(p, l, (q >> 1) >> 2, (q >> 1) & 3, q & 1, smf); }
        }
        STAMP();
        for (int rep = 0; rep < DUPS; ++rep) for (int it = bid; it < 3 * NBS * NH; it += G) { const int mix = it / (NBS * NH), r = it - mix * (NBS * NH); scan_sample_item(p, l, mix, r >> 2, r & 3, smf); }
        GSYNC(); STAMP();
        if (PHM & 32) phase_postnorm(p, l);
        GSYNC(); STAMP();
        if (PHM & 64) { pg8::Gemm g{(const bf16_t*)(PWS + W_OUTS), (const bf16_t*)(PWS + W_WBR), 3 * MT, 3 * 1024, 512, 512};
            MergeOrder S; S.init(G, bid); EpiMerge E{proj + 6144, hbf}; pg8::gemm_phase(lds, g, S, E); }
        GSYNC(); STAMP();
        if (PHM & 128) { { pg8::Gemm g{hbf, (const bf16_t*)(PWS + W_WOUT), MP, 1024, 1024, 1024}; pg8::StaticOrder S; S.init(MP, 1024, G, bid); EpiResid E{X, l == 0 ? PIN(I_XP) : X, X + (size_t)MP * DM}; pg8::gemm_phase(lds, g, S, E); }
            { pg8::Gemm g{hbf, (const bf16_t*)(PWS + W_WOUT), MT, 1024, 256, 1024}; PieceOrder S{G, (bid + G / 2) % G, 4}; EpiAtomic E{X}; pg8::gemm_phase(lds, g, S, E); } }
        GSYNC(); STAMP();
        if (PHM & 256) phase_rmsnorm(p, l, X, X + (size_t)MP * DM, PIN(I_LNFFN) + l * DM, hbf, false, smf);
        GSYNC(); STAMP();
        for (int rep = 0; rep < DUPH; ++rep) { pg8::Gemm g{hbf, (const bf16_t*)(PWS + W_WUP), MT, NUP, 1024, 1024}; pg8::StaticOrder S; S.init(MT, NUP, G, bid); EpiProj E{proj, NUP, 0}; pg8::gemm_phase(lds, g, S, E); }
        GSYNC(); STAMP();
        for (int repi = 0; repi < DUPI; ++repi) phase_convffn(p, l);
        GSYNC(); STAMP();
        if (PHM & 2048) { { pg8::Gemm g{(const bf16_t*)(PWS + W_ACT), (const bf16_t*)(PWS + W_WDN), MP, 1024, DFF, DFF}; pg8::StaticOrder S; S.init(MP, 1024, G, bid); EpiResid E{X, X, X + (size_t)MP * DM}; pg8::gemm_phase(lds, g, S, E); }
            { pg8::Gemm g{(const bf16_t*)(PWS + W_ACT), (const bf16_t*)(PWS + W_WDN), MT, 1024, 256, DFF}; PieceOrder S{G, (bid + G / 2) % G, 11}; EpiAtomic E{X}; pg8::gemm_phase(lds, g, S, E); } }
        GSYNC(); STAMP();
    }
    if (PHM & 4096) phase_final_norm(p);
#ifdef TPROBE1
    if (blockIdx.x == TPROBE_WG && threadIdx.x == 0) {
        const int per = (nst - 1) / 2;
        unsigned long long d1 = 0, d2 = 0;
        for (int l2 = 0; l2 < 2; ++l2) { d1 += stp[l2 * per + TPROBE1E] - stp[l2 * per + TPROBE1]; d2 += stp[l2 * per + TPROBE2E] - stp[l2 * per + TPROBE2]; }
        unsigned long long q1 = (d1 + 1000) / 2000, q2 = (d2 + 500) / 1000;
        const unsigned long long wait = (q1 * 100 + q2) * 2000ull, t0 = __builtin_amdgcn_s_memrealtime();
        while (__builtin_amdgcn_s_memrealtime() - t0 < wait) __builtin_amdgcn_s_sleep(32);
    }
#endif
}

extern "C" void kernel_launch(void* const* d_in, const int* in_sizes, int n_in, void* d_out, int out_size, void* d_ws, size_t ws_size, hipStream_t stream) {
    static int grid_blocks = 0;
    if (grid_blocks == 0) {
        if (n_in != 28 || (size_t)out_size != O_END || ws_size < W_END) { fprintf(stderr, "kernel_launch: unexpected shapes: n_in %d out %d (want %zu) ws %zu (need %zu)\n", n_in, out_size, (size_t)O_END, ws_size, (size_t)W_END); grid_blocks = -1; return; }
        int dev = 0, cus = 0, per_cu = 0;
        hipGetDevice(&dev); hipDeviceGetAttribute(&cus, hipDeviceAttributeMultiprocessorCount, dev);
        if (hipFuncSetAttribute((const void*)fwd_megakernel, hipFuncAttributeMaxDynamicSharedMemorySize, LDS_BYTES) != hipSuccess) { fprintf(stderr, "kernel_launch: hipFuncSetAttribute failed\n"); grid_blocks = -1; return; }
        if (hipOccupancyMaxActiveBlocksPerMultiprocessor(&per_cu, (const void*)fwd_megakernel, 512, LDS_BYTES) != hipSuccess || per_cu < 1) { fprintf(stderr, "kernel_launch: occupancy query gave %d\n", per_cu); per_cu = 1; (void)hipGetLastError(); }
        grid_blocks = cus * per_cu;
    }
    if (grid_blocks < 0) return;
    if (hipMemsetAsync((unsigned char*)d_ws + W_BAR, 0, XCD_BAR_WORDS * 4, stream) != hipSuccess) { fprintf(stderr, "kernel_launch: memset of barrier words failed\n"); return; }
    Params p{};
    for (int i = 0; i < 28; ++i) p.in[i] = (const float*)d_in[i];
    p.out = (float*)d_out; p.ws = (unsigned char*)d_ws;
    void* args[] = {&p};
    hipError_t e = hipLaunchCooperativeKernel((const void*)fwd_megakernel, dim3(grid_blocks), dim3(512), args, LDS_BYTES, stream);
    if (e != hipSuccess) fprintf(stderr, "kernel_launch: cooperative launch failed: %s (grid %d)\n", hipGetErrorString(e), grid_blocks);
}
```

```cpp
#include <hip/hip_runtime.h>
#include <hip/hip_cooperative_groups.h>
#include <cstdio>
namespace cg = cooperative_groups;
namespace pg8 {
#define PG8_LAS __attribute__((address_space(3)))
typedef unsigned short bf16_t;
typedef short bf16x8 __attribute__((ext_vector_type(8)));
typedef float f32x4 __attribute__((ext_vector_type(4)));
typedef unsigned u32x4 __attribute__((ext_vector_type(4)));
constexpr int BM = 256, BK = 64, HALF = 128, HTB = HALF * BK * 2  , STAGE_BYTES = 8 * HTB, NXCD = 8, WGM = 8;

__host__ __device__ __forceinline__ int lds_byte(int r, int c) { const int st = (r >> 4) * 2 + (c >> 5), rr = r & 15, cc = c & 31, ob = rr * 64 + cc * 2; return st * 1024 + (ob ^ (((ob >> 9) & 1) << 5)); }
__host__ __device__ __forceinline__ void stage_rc(int b, int& R, int& C) { const int st = b / 1024, sb = b % 1024, swz = sb ^ (((sb >> 9) & 1) << 5); R = (st >> 1) * 16 + swz / 64; C = (st & 1) * 32 + (swz % 64) / 2; }
__host__ __device__ __forceinline__ int perm32(int rho) { const int n = rho >> 4, i = rho & 15; return 8 * (i >> 2) + 4 * n + (i & 3); }

struct Unit { int pm, pn, pk; };
struct Gemm { const bf16_t* A; const bf16_t* Bt; int M, N, K, ld; };

struct StaticOrder {
    int nM, nN, nwg, G, c;
    __host__ __device__ void init(int M, int N, int G_, int c_) { nM = M / BM; nN = N / BM; nwg = nM * nN; G = G_; c = c_; }
    __host__ __device__ bool next(int i, Unit& u) const {
        const long L = (long)i * G + c; if (L >= nwg) return false;
        int wgid = (int)L; { const int q = nwg / NXCD, r = nwg % NXCD, xcd = wgid % NXCD, off = wgid / NXCD; wgid = (xcd < r ? xcd * (q + 1) : r * (q + 1) + (xcd - r) * q) + off; }
        const int nig = WGM * nN, gid = wgid / nig, fm = gid * WGM, gsz = (nM - fm) < WGM ? (nM - fm) : WGM;
        u.pm = fm + ((wgid % nig) % gsz); u.pn = (wgid % nig) / gsz; u.pk = 0; return true;
    }
    __device__ __forceinline__ void a_ready(const Unit&) const {}
    __device__ __forceinline__ void done(const Unit&) const {}
};
__device__ __forceinline__ unsigned cvt_pk_bf16(float lo, float hi) { unsigned r; asm volatile("v_cvt_pk_bf16_f32 %0, %1, %2" : "=v"(r) : "v"(lo), "v"(hi)); return r; }
template <class Epi, class Sched>
__device__ __forceinline__ void gemm_phase(PG8_LAS unsigned char* lds, const Gemm g, const Sched& S, const Epi& E) {
    int tid_ = threadIdx.x; asm volatile("" : "+v"(tid_));
    const int tid = tid_, wid = __builtin_amdgcn_readfirstlane(tid >> 6), lane = tid & 63, wr = wid >> 2, wc = wid & 3, fr = lane & 15, fq = lane >> 4;
    const int K = g.K, nt = K / BK, ld = g.ld;
    unsigned voffA[2], voffB[2];
#pragma unroll
    for (int i = 0; i < 2; ++i) { int R, C; stage_rc(tid * 16 + i * 8192, R, C); const int Rb = Epi::PERM ? ((R & ~31) + perm32(R & 31)) : R;
        voffA[i] = (unsigned)(R * ld + C) * 2u; voffB[i] = (unsigned)(Rb * ld + C) * 2u; }
    const size_t kstep = (size_t)(BK * 2);
    const size_t hstep = (size_t)HALF * ld * 2;
    const size_t tstep = 2 * hstep;
    const unsigned ldsw = (unsigned)wid * 1024u;
    const int aoff = lds_byte(wr * 64 + fr, fq * 8), boff = lds_byte(wc * 32 + fr, fq * 8);
#define PG8_SA(b, h) (((b) * 2 + (h)) * HTB)
#define PG8_SB(b, h) ((4 + (b) * 2 + (h)) * HTB)
#define PG8_STAGE(bufoff, gbase, voff) do { _Pragma("unroll") for (int _i = 0; _i < 2; ++_i) \
        __builtin_amdgcn_global_load_lds((const unsigned*)((const char*)(gbase) + (voff)[_i]), (PG8_LAS unsigned*)(lds + (bufoff) + ldsw + _i * 8192), 16, 0, 0); } while (0)
#define PG8_LDA(dst, b, h) do { _Pragma("unroll") for (int m = 0; m < 4; ++m) _Pragma("unroll") for (int k = 0; k < 2; ++k) dst[m][k] = *(const PG8_LAS bf16x8*)(lds + PG8_SA(b, h) + aoff + m * 2048 + k * 1024); } while (0)
#define PG8_LDB(dst, b, h) do { _Pragma("unroll") for (int n = 0; n < 2; ++n) _Pragma("unroll") for (int k = 0; k < 2; ++k) dst[n][k] = *(const PG8_LAS bf16x8*)(lds + PG8_SB(b, h) + boff + n * 2048 + k * 1024); } while (0)
#define PG8_MMA(ai, bj, At, Bt) do { __builtin_amdgcn_s_setprio(1); _Pragma("unroll") for (int m = 0; m < 4; ++m) _Pragma("unroll") for (int n = 0; n < 2; ++n) _Pragma("unroll") for (int k = 0; k < 2; ++k) \
        acc[ai][bj][m][n] = __builtin_amdgcn_mfma_f32_16x16x32_bf16(Bt[n][k], At[m][k], acc[ai][bj][m][n], 0, 0, 0); __builtin_amdgcn_s_setprio(0); } while (0)
#define PG8_WAIT_V(n) asm volatile("s_waitcnt vmcnt(" #n ")" ::: "memory")
#define PG8_WAIT_L(n) asm volatile("s_waitcnt lgkmcnt(" #n ")" ::: "memory")
#define PG8_BAR __builtin_amdgcn_s_barrier()
#define PG8_SCHED __builtin_amdgcn_sched_barrier(0)
    Unit cur, nxt; int ui = 0;
    if (!S.next(0, cur)) return;
    f32x4 acc[2][2][4][2];
#pragma unroll
    for (int a = 0; a < 2; ++a)
#pragma unroll
        for (int b = 0; b < 2; ++b)
#pragma unroll
            for (int m = 0; m < 4; ++m)
#pragma unroll
                for (int n = 0; n < 2; ++n) acc[a][b][m][n] = (f32x4){0.f, 0.f, 0.f, 0.f};
    bf16x8 At[4][2], B0[2][2], B1[2][2];
    const char* cA = (const char*)g.A + (size_t)cur.pm * tstep + (size_t)cur.pk * K * 2; const char* cB = (const char*)g.Bt + (size_t)cur.pn * tstep + (size_t)cur.pk * K * 2;
    S.a_ready(cur);
    PG8_STAGE(PG8_SB(0, 0), cB, voffB); PG8_STAGE(PG8_SA(0, 0), cA, voffA); PG8_STAGE(PG8_SB(0, 1), cB + hstep, voffB); PG8_STAGE(PG8_SA(0, 1), cA + hstep, voffA);
    if (wr == 1) PG8_BAR;
    PG8_WAIT_V(4); PG8_BAR;
    PG8_STAGE(PG8_SB(1, 0), cB + kstep, voffB); PG8_STAGE(PG8_SA(1, 0), cA + kstep, voffA); PG8_STAGE(PG8_SB(1, 1), cB + hstep + kstep, voffB);
    PG8_WAIT_V(6); PG8_BAR;
    for (;;) {
        const bool has_next = S.next(ui + 1, nxt);
        const char* nA = has_next ? (const char*)g.A + (size_t)nxt.pm * tstep + (size_t)nxt.pk * K * 2 : cA; const char* nB = has_next ? (const char*)g.Bt + (size_t)nxt.pn * tstep + (size_t)nxt.pk * K * 2 : cB;
        for (int t = 0; t < nt; t += 2) {
            const bool last = (t == nt - 2);
            const char* a1 = cA + (size_t)(t + 1) * kstep;
            const char* a2 = last ? nA : cA + (size_t)(t + 2) * kstep; const char* b2 = last ? nB : cB + (size_t)(t + 2) * kstep;
            const char* a3 = a2 + kstep; const char* b3 = b2 + kstep;
            if (last && has_next) S.a_ready(nxt);
            PG8_LDB(B0, 0, 0); PG8_SCHED; PG8_LDA(At, 0, 0); PG8_STAGE(PG8_SA(1, 1), a1 + hstep, voffA);
            PG8_WAIT_L(8); PG8_BAR; PG8_WAIT_L(0); PG8_MMA(0, 0, At, B0); PG8_BAR; PG8_SCHED;
            PG8_LDB(B1, 0, 1); PG8_STAGE(PG8_SB(0, 0), b2, voffB);
            PG8_BAR; PG8_WAIT_L(0); PG8_MMA(0, 1, At, B1); PG8_BAR;
            PG8_LDA(At, 0, 1); PG8_STAGE(PG8_SA(0, 0), a2, voffA);
            PG8_BAR; PG8_WAIT_L(0); PG8_MMA(1, 0, At, B0); PG8_BAR; PG8_SCHED;
            PG8_STAGE(PG8_SB(0, 1), b2 + hstep, voffB);
            PG8_WAIT_V(6); PG8_BAR; PG8_MMA(1, 1, At, B1); PG8_BAR;
            PG8_LDB(B0, 1, 0); PG8_SCHED; PG8_LDA(At, 1, 0); PG8_STAGE(PG8_SA(0, 1), a2 + hstep, voffA);
            PG8_WAIT_L(8); PG8_BAR; PG8_WAIT_L(0); PG8_MMA(0, 0, At, B0); PG8_BAR; PG8_SCHED;
            PG8_LDB(B1, 1, 1); PG8_STAGE(PG8_SB(1, 0), b3, voffB);
            PG8_BAR; PG8_WAIT_L(0); PG8_MMA(0, 1, At, B1); PG8_BAR;
            PG8_LDA(At, 1, 1); PG8_STAGE(PG8_SA(1, 0), a3, voffA);
            PG8_BAR; PG8_WAIT_L(0); PG8_MMA(1, 0, At, B0); PG8_BAR; PG8_SCHED;
            PG8_STAGE(PG8_SB(1, 1), b3 + hstep, voffB);
            PG8_WAIT_V(6); PG8_BAR; PG8_MMA(1, 1, At, B1); PG8_BAR;
        }
        if constexpr (!Epi::AFTER_DRAIN) { E(acc, cur, wr, wc, fr, fq); S.done(cur); }
        if (!has_next) break;
#pragma unroll
        for (int a = 0; a < 2; ++a)
#pragma unroll
            for (int b = 0; b < 2; ++b)
#pragma unroll
                for (int m = 0; m < 4; ++m)
#pragma unroll
                    for (int n = 0; n < 2; ++n) acc[a][b][m][n] = (f32x4){0.f, 0.f, 0.f, 0.f};
        cur = nxt; cA = nA; cB = nB; ++ui;
    }
    PG8_WAIT_V(0);
    if (wr == 0) PG8_BAR;
    PG8_BAR;
    if constexpr (Epi::AFTER_DRAIN) { E.fused(acc, cur, wr, wc, fr, fq, lds, wid, lane); S.done(cur); }
#undef PG8_SA
#undef PG8_SB
#undef PG8_STAGE
#undef PG8_LDA
#undef PG8_LDB
#undef PG8_MMA
#undef PG8_WAIT_V
#undef PG8_WAIT_L
#undef PG8_BAR
#undef PG8_SCHED
}
}

#define XB_TMO      128
#define XB_XCNT(j)  (256  + 64 * (j))
#define XB_XSUB(j)  (1280 + 64 * (j))
#define XB_XGEN(j)  (2304 + 64 * (j))
#define XB_TOP      3328
#define XB_TOPGEN   3392
#define XCD_BAR_WORDS 3456
#define XB_SPIN_CAP (1u << 18)
#define XLAS __attribute__((address_space(3)))

__device__ __forceinline__ unsigned xb_ld(unsigned* p)              { return __hip_atomic_load(p, __ATOMIC_RELAXED, __HIP_MEMORY_SCOPE_AGENT); }
__device__ __forceinline__ unsigned xb_add(unsigned* p, unsigned v) { return __hip_atomic_fetch_add(p, v, __ATOMIC_RELAXED, __HIP_MEMORY_SCOPE_AGENT); }
__device__ __forceinline__ unsigned xb_xcc_id() { return (unsigned)__builtin_amdgcn_s_getreg((3 << 11) | 20) & 0xFu; }
#define XB_SPIN(cond, bar) do { unsigned _sp = 0; while (cond) { __builtin_amdgcn_s_sleep(1); \
    if ((++_sp & 255u) == 0u) { if (xb_ld(&(bar)[XB_TMO])) break; if (_sp > XB_SPIN_CAP) { atomicAdd(&(bar)[XB_TMO], 1u); break; } } } } while (0)

struct XcdBarrier {
    unsigned* bar; unsigned x;
    volatile XLAS unsigned* st;
};

__device__ __forceinline__ XcdBarrier xcd_barrier_post(unsigned* bar, volatile XLAS unsigned* st) {
    XcdBarrier b; b.bar = bar; b.x = xb_xcc_id(); b.st = st;
    if (threadIdx.x == 0) (void)xb_add(&bar[XB_XCNT(b.x)], 1u);
    return b;
}
__device__ __forceinline__ void xcd_barrier_complete(unsigned* bar, unsigned x, unsigned& nloc, unsigned& nx) {
    const unsigned G = gridDim.x * gridDim.y * gridDim.z;
    unsigned sum, cnt, mine, sp = 0u;
    for (;;) {
        sum = 0u; cnt = 0u; mine = 0u;
#pragma unroll
        for (unsigned j = 0; j < 16; ++j) { const unsigned c = xb_ld(&bar[XB_XCNT(j)]); sum += c; cnt += (c > 0u) ? 1u : 0u; mine = (j == x) ? c : mine; }
        if (sum == G) break;
        __builtin_amdgcn_s_sleep(1);
        if ((++sp & 255u) == 0u) { if (xb_ld(&bar[XB_TMO])) break; if (sp > XB_SPIN_CAP) { atomicAdd(&bar[XB_TMO], 1u); break; } }
    }
    nloc = mine > 0u ? mine : 1u; nx = cnt > 0u ? cnt : 1u;
}

__device__ __forceinline__ void xcd_barrier(const XcdBarrier& b) {
    asm volatile("s_waitcnt vmcnt(0)" ::: "memory");
    __syncthreads();
    if (threadIdx.x == 0) {
        unsigned* bar = b.bar;
        __builtin_amdgcn_s_waitcnt(0);
        unsigned nloc = b.st[0], nx = b.st[1];
        if (nloc == 0u) { xcd_barrier_complete(bar, b.x, nloc, nx); b.st[0] = nloc; b.st[1] = nx; }
        const unsigned old = xb_add(&bar[XB_XSUB(b.x)], 1u);
        const unsigned gen = old / nloc;
        if (old + 1u == (gen + 1u) * nloc) {
            __builtin_amdgcn_fence(__ATOMIC_RELEASE, "agent");
            asm volatile("s_waitcnt vmcnt(0)" ::: "memory");
            const unsigned og = xb_add(&bar[XB_TOP], 1u);
            const unsigned tg = og / nx;
            if (og + 1u == (tg + 1u) * nx) xb_add(&bar[XB_TOPGEN], 1u);
            else XB_SPIN(xb_ld(&bar[XB_TOPGEN]) == tg, bar);
            __builtin_amdgcn_fence(__ATOMIC_ACQUIRE, "agent");
            xb_add(&bar[XB_XGEN(b.x)], 1u);
            asm volatile("s_waitcnt vmcnt(0)" ::: "memory");
        } else {
            XB_SPIN(xb_ld(&bar[XB_XGEN(b.x)]) == gen, bar);
            __builtin_amdgcn_fence(__ATOMIC_ACQUIRE, "agent");
            asm volatile("s_waitcnt vmcnt(0)" ::: "memory");
        }
    }
    __syncthreads();
}

using pg8::bf16_t; using pg8::f32x4; using pg8::bf16x8;
typedef unsigned u32x4_t __attribute__((ext_vector_type(4)));
typedef unsigned u32x2_t __attribute__((ext_vector_type(2)));

constexpr int DM = 1024, NBP = 8, SEQ = 2048, NBS = 128, SSEQ = 4, NH = 4, HD = 128, MW = 512;
constexpr int MP = NBP * SEQ, MS = NBS * SSEQ, MT = MP + MS;
constexpr int NIN = 9232, N1 = 9216, DFF = 2816, NUP = 5632;
constexpr float EPS = 1e-6f;
constexpr float QSCALE = 0.08838834764831845f;

constexpr size_t O_Y = 0;
constexpr size_t O_P_GS = (size_t)MT * DM;
constexpr size_t O_P_GC = O_P_GS + (size_t)2 * 8 * 4 * 128 * 128;
constexpr size_t O_P_MC = O_P_GC + (size_t)2 * 8 * 3 * 1536;
constexpr size_t O_P_MN = O_P_MC + (size_t)2 * 8 * 4 * 128 * 128;
constexpr size_t O_P_MM = O_P_MN + (size_t)2 * 8 * 4 * 128;
constexpr size_t O_P_HS = O_P_MM + (size_t)2 * 8 * 4;
constexpr size_t O_P_FC = O_P_HS + (size_t)2 * 8 * 4 * 128 * 128;
constexpr size_t O_S_GS = O_P_FC + (size_t)2 * 8 * 2 * 5632;
constexpr size_t O_S_GC = O_S_GS + (size_t)2 * 128 * 4 * 128 * 128;
constexpr size_t O_S_MC = O_S_GC + (size_t)2 * 128 * 3 * 1536;
constexpr size_t O_S_MN = O_S_MC + (size_t)2 * 128 * 4 * 128 * 128;
constexpr size_t O_S_MM = O_S_MN + (size_t)2 * 128 * 4 * 128;
constexpr size_t O_S_HS = O_S_MM + (size_t)2 * 128 * 4;
constexpr size_t O_S_FC = O_S_HS + (size_t)2 * 128 * 4 * 128 * 128;
constexpr size_t O_END  = O_S_FC + (size_t)2 * 128 * 2 * 5632;

constexpr size_t W_WIN = 0;
constexpr size_t W_WBR = W_WIN + (size_t)N1 * 1024 * 2;
constexpr size_t W_WOUT = W_WBR + (size_t)3 * 1024 * 512 * 2;
constexpr size_t W_WUP = W_WOUT + (size_t)1024 * 1024 * 2;
constexpr size_t W_WDN = W_WUP + (size_t)NUP * 1024 * 2;
constexpr size_t W_HBF = W_WDN + (size_t)1024 * DFF * 2;
constexpr size_t W_PROJ = W_HBF + (size_t)MT * 1024 * 2;
constexpr size_t W_ACT = W_PROJ + (size_t)MT * NUP * 2;
constexpr size_t W_OUTS = W_PROJ + (size_t)MT * N1 * 2;
constexpr size_t W_GATES = W_OUTS + (size_t)3 * MT * 512 * 2;
constexpr size_t W_DEN = W_GATES + (size_t)MT * 16 * 4;
constexpr size_t W_MT = W_DEN + (size_t)MT * 4 * 4;
constexpr size_t W_BAR = W_MT + (size_t)MT * 4 * 4;
constexpr size_t W_END = W_BAR + 16384;

constexpr int LDS_MAIN = 143360;
constexpr int LDS_BYTES = LDS_MAIN + 64 + 512;

struct Params { const float* in[28]; float* out; unsigned char* ws; };
enum { I_XP = 0, I_XS, I_SGS, I_SGC, I_SMC, I_SMN, I_SMM, I_SHS, I_SFC, I_LNMIX, I_WIN, I_GCW, I_ALOG, I_DTB, I_GNORM, I_MIB, I_MFB, I_MNORM, I_HLB, I_HNORM,
       I_WBR, I_WOUT, I_LNFFN, I_WUP, I_FCW, I_FCB, I_WDN, I_LNF };

typedef const float* const __attribute__((address_space(4))) * kargp_t;
__device__ __forceinline__ const float* argp(int i) { kargp_t kp = (kargp_t)__builtin_amdgcn_kernarg_segment_ptr(); asm volatile("" : "+s"(i)); return kp[i]; }
__device__ __forceinline__ int bidx() { int b = (int)blockIdx.x; asm volatile("" : "+s"(b)); return b; }
__device__ __forceinline__ int gdim() { int g = (int)gridDim.x; asm volatile("" : "+s"(g)); return g; }
#define PIN(i) argp(i)
#define POUT ((float*)argp(28))
#define PWS ((unsigned char*)argp(29))
__device__ __forceinline__ float bf2f(bf16_t b) { return __uint_as_float(((unsigned)b) << 16); }
__device__ __forceinline__ float bflo(unsigned u) { return __uint_as_float(u << 16); }
__device__ __forceinline__ float bfhi(unsigned u) { return __uint_as_float(u & 0xffff0000u); }
__device__ __forceinline__ bf16_t f2bf(float f) { return (bf16_t)(pg8::cvt_pk_bf16(f, 0.f) & 0xffffu); }
__device__ __forceinline__ float sigm(float x) { return __builtin_amdgcn_rcpf(1.f + __expf(-x)); }
__device__ __forceinline__ float silu(float x) { return x * sigm(x); }
__device__ __forceinline__ float rdlane(float x, int l) { return __builtin_bit_cast(float, __builtin_amdgcn_readlane(__builtin_bit_cast(int, x), l)); }
template <int CTRL> __device__ __forceinline__ float dppf(float x) { return __builtin_bit_cast(float, __builtin_amdgcn_update_dpp(0, __builtin_bit_cast(int, x), CTRL, 0xf, 0xf, true)); }
__device__ __forceinline__ float grp_sum8(float x) { x += dppf<0xB1>(x); x += dppf<0x4E>(x); x += dppf<0x141>(x); return x; }
__device__ __forceinline__ float grp_sum16(float x) { x = grp_sum8(x); x += dppf<0x140>(x); return x; }
__device__ __forceinline__ float wave_sum(float x) { x = grp_sum16(x);
    x += __builtin_bit_cast(float, __builtin_amdgcn_update_dpp(0, __builtin_bit_cast(int, x), 0x142, 0xa, 0xf, false));
    x += __builtin_bit_cast(float, __builtin_amdgcn_update_dpp(0, __builtin_bit_cast(int, x), 0x143, 0xc, 0xf, false));
    return rdlane(x, 63); }
template <int CTRL> __device__ __forceinline__ float dppm(float x) { return __builtin_bit_cast(float, __builtin_amdgcn_update_dpp(__builtin_bit_cast(int, -INFINITY), __builtin_bit_cast(int, x), CTRL, 0xf, 0xf, false)); }
template <int T> __device__ __forceinline__ float grp_sum(float x) { if constexpr (T == 16) return grp_sum16(x); else return grp_sum8(x); }

__device__ __forceinline__ int win_srccol(int n0) { const int blk = n0 >> 9, r = n0 & 511; int base;
    if (blk < 4) base = blk * 512; else if (blk < 8) base = 2056 + (blk - 4) * 512; else if (blk < 12) base = 4112 + (blk - 8) * 512; else base = 6160 + (blk - 12) * 512;
    return base + r; }
__device__ __forceinline__ void conv_T(const float* __restrict__ src, int ld, bf16_t* __restrict__ dst, int K, int N, bool winmap, float* tile, int& tcount) {
    int tid_ = threadIdx.x; asm volatile("" : "+v"(tid_)); const int tid = tid_, ntn = N / 64, ntiles = ntn * (K / 64);
    for (int t = bidx() - (tcount % gdim()); t < ntiles; t += gdim()) {
        if (t < 0) continue;
        const int tn = t % ntn, tk = t / ntn, n0 = tn * 64, k0 = tk * 64, sc0 = winmap ? win_srccol(n0) : n0;
        __syncthreads();
        { const int kk = tid >> 4, n4 = (tid & 15) * 4;
#pragma unroll
          for (int pp = 0; pp < 2; ++pp) { const float4 v = *(const float4*)(src + (size_t)(k0 + kk + 32 * pp) * ld + sc0 + n4); float* tp = tile + (kk + 32 * pp) * 65 + n4; tp[0] = v.x; tp[1] = v.y; tp[2] = v.z; tp[3] = v.w; } }
        __syncthreads();
        { const int n = tid >> 3, k8 = (tid & 7) * 8; float f[8];
#pragma unroll
          for (int i = 0; i < 8; ++i) f[i] = tile[(k8 + i) * 65 + n];
          u32x4_t o; o[0] = pg8::cvt_pk_bf16(f[0], f[1]); o[1] = pg8::cvt_pk_bf16(f[2], f[3]); o[2] = pg8::cvt_pk_bf16(f[4], f[5]); o[3] = pg8::cvt_pk_bf16(f[6], f[7]);
          *(u32x4_t*)(dst + (size_t)(n0 + n) * K + k0 + k8) = o; }
    }
    tcount += ntiles;
}

__device__ __forceinline__ void phase_rmsnorm(const Params& p, int l, const float* xa, const float* xb, const float* __restrict__ gw, bf16_t* __restrict__ hout, bool do_gates, float* sm) {
    int tid_ = threadIdx.x; asm volatile("" : "+v"(tid_)); const int tid = tid_, lane = tid & 63, w = tid >> 6;
    float* wgT = sm;
    if (do_gates) {
        const float* win = PIN(I_WIN) + (size_t)l * 1024 * NIN;
        __syncthreads();
        for (int i = tid; i < 16 * 1024; i += 512) { const int k = i >> 4, j = i & 15; const int gc = j < 8 ? 2048 + j : 4104 + (j - 8); wgT[j * 1024 + k] = win[(size_t)k * NIN + gc]; }
        __syncthreads();
    }
    float4 g4[4];
#pragma unroll
    for (int i = 0; i < 4; ++i) g4[i] = *(const float4*)(gw + lane * 4 + 256 * i);
    for (int row = bidx() * 8 + w; row < MT; row += gdim() * 8) {
        const float* xr = row < MP ? xa + (size_t)row * DM : xb + (size_t)(row - MP) * DM;
        float4 v[4]; float ss = 0.f;
#pragma unroll
        for (int i = 0; i < 4; ++i) { v[i] = *(const float4*)(xr + lane * 4 + 256 * i); ss += v[i].x * v[i].x + v[i].y * v[i].y + v[i].z * v[i].z + v[i].w * v[i].w; }
        ss = wave_sum(ss);
        const float rstd = rsqrtf(ss * (1.f / 1024.f) + EPS);
#pragma unroll
        for (int i = 0; i < 4; ++i) { v[i].x *= rstd * g4[i].x; v[i].y *= rstd * g4[i].y; v[i].z *= rstd * g4[i].z; v[i].w *= rstd * g4[i].w;
            u32x2_t o; o[0] = pg8::cvt_pk_bf16(v[i].x, v[i].y); o[1] = pg8::cvt_pk_bf16(v[i].z, v[i].w);
            *(u32x2_t*)(hout + (size_t)row * DM + lane * 4 + 256 * i) = o; }
        if (do_gates) {
            float mine = 0.f;
#pragma unroll
            for (int j = 0; j < 16; ++j) { float a = 0.f;
#pragma unroll
                for (int i = 0; i < 4; ++i) { const float4 wv = *(const float4*)(wgT + j * 1024 + lane * 4 + 256 * i); a += v[i].x * wv.x + v[i].y * wv.y + v[i].z * wv.z + v[i].w * wv.w; }
                a = wave_sum(a); if (lane == j) mine = a; }
            if (lane < 16) { const int h = lane & 3, kind = lane >> 2; float r;
                if (kind == 0) r = sigm(mine);
                else if (kind == 1) { const float xx = mine + PIN(I_DTB)[l * 4 + h]; const float sp = xx > 20.f ? xx : log1pf(__expf(xx)); r = __expf(-__expf(PIN(I_ALOG)[l * 4 + h]) * sp); }
                else if (kind == 2) r = mine + PIN(I_MIB)[l * 4 + h];
                else { const float xx = -(mine + PIN(I_MFB)[l * 4 + h]); r = -(xx > 20.f ? xx : log1pf(__expf(xx))); }
                ((float*)(PWS + W_GATES))[(size_t)row * 16 + lane] = r; }
        }
    }
}

struct EpiProj {
    static constexpr bool PERM = true, AFTER_DRAIN = false;
    bf16_t* O; int ldc; int actmode;
    __device__ __forceinline__ void operator()(const f32x4 (&acc)[2][2][4][2], const pg8::Unit& u, int wr, int wc, int fr, int fq) const {
        const int row0 = u.pm * 256 + wr * 64 + fr, col0 = u.pn * 256 + wc * 32 + 8 * fq;
        int act = 0;
        if (actmode) { const int pn = u.pn; act = (pn >= 24 || pn == 14 || pn == 15) ? 2 : ((pn == 6 || pn == 7 || pn == 16 || pn == 17 || pn == 22 || pn == 23) ? 1 : 0); }
#pragma unroll
        for (int ai = 0; ai < 2; ++ai)
#pragma unroll
            for (int m = 0; m < 4; ++m) { bf16_t* rowp = O + (size_t)(row0 + ai * 128 + m * 16) * ldc + col0;
#pragma unroll
                for (int bj = 0; bj < 2; ++bj) { float v[8];
#pragma unroll
                    for (int i = 0; i < 4; ++i) { v[i] = acc[ai][bj][m][0][i]; v[4 + i] = acc[ai][bj][m][1][i]; }
                    if (act == 1) {
#pragma unroll
                        for (int i = 0; i < 8; ++i) v[i] = silu(v[i]); }
                    else if (act == 2) {
#pragma unroll
                        for (int i = 0; i < 8; ++i) v[i] = sigm(v[i]); }
                    u32x4_t o; o[0] = pg8::cvt_pk_bf16(v[0], v[1]); o[1] = pg8::cvt_pk_bf16(v[2], v[3]); o[2] = pg8::cvt_pk_bf16(v[4], v[5]); o[3] = pg8::cvt_pk_bf16(v[6], v[7]);
                    *(u32x4_t*)(rowp + bj * 128) = o; } }
    }
};
struct EpiMerge {
    static constexpr bool PERM = true, AFTER_DRAIN = false;
    const bf16_t* G; bf16_t* Mx;
    __device__ __forceinline__ void operator()(const f32x4 (&acc)[2][2][4][2], const pg8::Unit& u, int wr, int wc, int fr, int fq) const {
        const int n = u.pn >> 2, first = (n == 0);
        const int row0 = (u.pm - n * (MT / 256)) * 256 + wr * 64 + fr, col0 = (u.pn & 3) * 256 + wc * 32 + 8 * fq;
        const bf16_t* Gn = G + n * 1024 + col0; bf16_t* Mc = Mx + col0;
        u32x4_t gc[2], oc[2], gn[2], on[2];
#pragma unroll
        for (int bj = 0; bj < 2; ++bj) { gc[bj] = *(const u32x4_t*)(Gn + (size_t)row0 * N1 + bj * 128); oc[bj] = first ? (u32x4_t){0u, 0u, 0u, 0u} : *(const u32x4_t*)(Mc + (size_t)row0 * DM + bj * 128); }
#pragma unroll
        for (int gI = 0; gI < 8; ++gI) { const int ai = gI >> 2, m = gI & 3; const size_t row = (size_t)(row0 + ai * 128 + m * 16);
            if (gI < 7) { const size_t row2 = (size_t)(row0 + ((gI + 1) >> 2) * 128 + ((gI + 1) & 3) * 16);
#pragma unroll
                for (int bj = 0; bj < 2; ++bj) { gn[bj] = *(const u32x4_t*)(Gn + row2 * N1 + bj * 128); on[bj] = first ? (u32x4_t){0u, 0u, 0u, 0u} : *(const u32x4_t*)(Mc + row2 * DM + bj * 128); } }
#pragma unroll
            for (int bj = 0; bj < 2; ++bj) { float v[8];
#pragma unroll
                for (int i = 0; i < 4; ++i) { v[i] = acc[ai][bj][m][0][i]; v[4 + i] = acc[ai][bj][m][1][i]; }
#pragma unroll
                for (int i = 0; i < 4; ++i) { v[2 * i] = v[2 * i] * bflo(gc[bj][i]) + bflo(oc[bj][i]); v[2 * i + 1] = v[2 * i + 1] * bfhi(gc[bj][i]) + bfhi(oc[bj][i]); }
                u32x4_t o; o[0] = pg8::cvt_pk_bf16(v[0], v[1]); o[1] = pg8::cvt_pk_bf16(v[2], v[3]); o[2] = pg8::cvt_pk_bf16(v[4], v[5]); o[3] = pg8::cvt_pk_bf16(v[6], v[7]);
                *(u32x4_t*)(Mc + row * DM + bj * 128) = o; }
#pragma unroll
            for (int bj = 0; bj < 2; ++bj) { gc[bj] = gn[bj]; oc[bj] = on[bj]; } }
    }
};
struct EpiResid {
    static constexpr bool PERM = false, AFTER_DRAIN = false;
    float* X; const float* Sa; const float* Sb;
    __device__ __forceinline__ void operator()(const f32x4 (&acc)[2][2][4][2], const pg8::Unit& u, int wr, int wc, int fr, int fq) const {
        const int row0 = u.pm * 256 + wr * 64 + fr, col0 = u.pn * 256 + wc * 32 + 4 * fq;
        const float* S = u.pm * 256 < MP ? Sa : Sb - (size_t)MP * DM;
        f32x4 cur[4], nxt[4];
#pragma unroll
        for (int q = 0; q < 4; ++q) cur[q] = *(const f32x4*)(S + (size_t)row0 * DM + col0 + (q >> 1) * 128 + (q & 1) * 16);
#pragma unroll
        for (int gI = 0; gI < 8; ++gI) { const int ai = gI >> 2, m = gI & 3; const size_t ro = (size_t)(row0 + ai * 128 + m * 16) * DM + col0;
            if (gI < 7) { const int ai2 = (gI + 1) >> 2, m2 = (gI + 1) & 3; const size_t ro2 = (size_t)(row0 + ai2 * 128 + m2 * 16) * DM + col0;
#pragma unroll
                for (int q = 0; q < 4; ++q) nxt[q] = *(const f32x4*)(S + ro2 + (q >> 1) * 128 + (q & 1) * 16); }
#pragma unroll
            for (int q = 0; q < 4; ++q) *(f32x4*)(X + ro + (q >> 1) * 128 + (q & 1) * 16) = cur[q] + acc[ai][q >> 1][m][q & 1];
#pragma unroll
            for (int q = 0; q < 4; ++q) cur[q] = nxt[q]; }
    }
};

struct EpiAtomic {
    static constexpr bool PERM = false, AFTER_DRAIN = false;
    float* X;
    __device__ __forceinline__ void operator()(const f32x4 (&acc)[2][2][4][2], const pg8::Unit& u, int wr, int wc, int fr, int fq) const {
        const int row0 = u.pm * 256 + wr * 64 + fr, col0 = u.pn * 256 + wc * 32 + 4 * fq;
#pragma unroll
        for (int ai = 0; ai < 2; ++ai)
#pragma unroll
            for (int m = 0; m < 4; ++m) { float* rowp = X + (size_t)(row0 + ai * 128 + m * 16) * DM + col0;
#pragma unroll
                for (int bj = 0; bj < 2; ++bj)
#pragma unroll
                    for (int n = 0; n < 2; ++n)
#pragma unroll
                        for (int e = 0; e < 4; ++e) unsafeAtomicAdd(rowp + bj * 128 + n * 16 + e, acc[ai][bj][m][n][e]); }
    }
};
struct MergeOrder {
    pg8::StaticOrder base;
    __device__ void init(int G_, int c_) { base.init(MT, 1024, G_, c_); }
    __device__ bool next(int i, pg8::Unit& u) const { const int t = i / 3, n = i - 3 * t; pg8::Unit b; if (!base.next(t, b)) return false; u.pm = n * (MT / 256) + b.pm; u.pn = n * 4 + b.pn; u.pk = 0; return true; }
    __device__ __forceinline__ void a_ready(const pg8::Unit&) const {}
    __device__ __forceinline__ void done(const pg8::Unit&) const {}
};
struct PieceOrder {
    int G, c, KP;
    __device__ bool next(int i, pg8::Unit& u) const { const int L = i * G + c; if (L >= 8 * KP) return false; const int tile = L / KP; u.pk = L - tile * KP; u.pm = MP / 256 + (tile >> 2); u.pn = tile & 3; return true; }
    __device__ __forceinline__ void a_ready(const pg8::Unit&) const {}
    __device__ __forceinline__ void done(const pg8::Unit&) const {}
};
__device__ __forceinline__ void phase_gdnprep(const Params& p, int l) {
    int tid_ = threadIdx.x; asm volatile("" : "+v"(tid_)); const int tid = tid_, j = tid & 15;
    const bf16_t* proj = (const bf16_t*)(PWS + W_PROJ);
    bf16_t* qkd = (bf16_t*)(PWS + W_HBF); bf16_t* vd = (bf16_t*)(PWS + W_OUTS);
    const float* cw = PIN(I_GCW) + (size_t)l * 4 * 1536; const float* cst = PIN(I_SGC) + (size_t)l * NBS * 3 * 1536;
    const int ngroups = MT * 12;
    for (int gid = bidx() * 32 + (tid >> 4); gid < ngroups; gid += gdim() * 32) {
        const int r = gid / 12, part = gid - r * 12, col = part * 128 + 8 * j;
        const bool samp = r >= MP; const int t = samp ? ((r - MP) & 3) : (r & (SEQ - 1)), b2 = samp ? ((r - MP) >> 2) : 0;
        float y[8];
#pragma unroll
        for (int i = 0; i < 8; ++i) y[i] = 0.f;
#pragma unroll
        for (int jj = 0; jj < 4; ++jj) { const int tt = t - 3 + jj; float x[8];
            if (tt >= 0) { const u32x4_t raw = *(const u32x4_t*)(proj + (size_t)(r - 3 + jj) * N1 + col);
#pragma unroll
                for (int i = 0; i < 4; ++i) { x[2 * i] = bflo(raw[i]); x[2 * i + 1] = bfhi(raw[i]); } }
            else if (samp) { const float* cp = cst + (size_t)(b2 * 3 + 3 + tt) * 1536 + col; const float4 a0 = *(const float4*)cp, a1 = *(const float4*)(cp + 4);
                x[0] = a0.x; x[1] = a0.y; x[2] = a0.z; x[3] = a0.w; x[4] = a1.x; x[5] = a1.y; x[6] = a1.z; x[7] = a1.w; }
            else {
#pragma unroll
                for (int i = 0; i < 8; ++i) x[i] = 0.f; }
            const float4 w0 = *(const float4*)(cw + jj * 1536 + col), w1 = *(const float4*)(cw + jj * 1536 + col + 4);
            y[0] += w0.x * x[0]; y[1] += w0.y * x[1]; y[2] += w0.z * x[2]; y[3] += w0.w * x[3]; y[4] += w1.x * x[4]; y[5] += w1.y * x[5]; y[6] += w1.z * x[6]; y[7] += w1.w * x[7]; }
        float ss = 0.f;
#pragma unroll
        for (int i = 0; i < 8; ++i) { y[i] = silu(y[i]); ss += y[i] * y[i]; }
        ss = grp_sum16(ss);
        const float scl = part < 4 ? rsqrtf(ss + EPS) * QSCALE : (part < 8 ? rsqrtf(ss + EPS) : 1.f);
        u32x4_t o; o[0] = pg8::cvt_pk_bf16(y[0] * scl, y[1] * scl); o[1] = pg8::cvt_pk_bf16(y[2] * scl, y[3] * scl); o[2] = pg8::cvt_pk_bf16(y[4] * scl, y[5] * scl); o[3] = pg8::cvt_pk_bf16(y[6] * scl, y[7] * scl);
        if (part < 8) *(u32x4_t*)(qkd + (size_t)r * 1024 + col) = o; else *(u32x4_t*)(vd + (size_t)r * 512 + (col - 1024)) = o;
    }
}

typedef float f2 __attribute__((ext_vector_type(2)));
typedef float f4 __attribute__((ext_vector_type(4)));
template <int MIX>
__device__ __forceinline__ void scan_prompt_item(const Params& p, int l, int b, int h, int cgp, float* sm) {
    constexpr int T = 16, CPL = (MIX == 0) ? 1 : 2, NG = 128 / (4 * T), NP = 2 * NG, CPW = (64 / T) * CPL, CPG = 8 * CPW, TB = 32, BUFSZ = 14464, NBLK = SEQ / TB;
    int tid_ = threadIdx.x; asm volatile("" : "+v"(tid_)); const int tid = tid_, lane = tid & 63, w = tid >> 6, c = lane / T, j = lane % T;
    const int col = w * CPW + c, ecol = cgp * CPG + col;
    float* misc = sm + 2 * BUFSZ; float* gsc = misc; float* mcar = misc + 64;
    const float* gates = (const float*)(PWS + W_GATES);
    bf16_t* outp = (bf16_t*)(PWS + W_OUTS) + (size_t)MIX * MT * 512;
    const size_t rb = (size_t)b * SEQ;
    const int c8 = (tid & 31) * 8, srow = tid >> 5;
    const bf16_t* qsrc; size_t qld; const bf16_t* vsrc; size_t vld;
    if (MIX == 0) { qsrc = (const bf16_t*)(PWS + W_HBF) + rb * 1024 + (c8 < 128 ? h * 128 + c8 : 512 + h * 128 + (c8 - 128)); qld = 1024;
        vsrc = (const bf16_t*)(PWS + W_OUTS) + rb * 512 + h * 128 + cgp * 32; vld = 512; }
    else { const int base = MIX == 1 ? 2048 : 4096; qsrc = (const bf16_t*)(PWS + W_PROJ) + rb * N1 + base + (c8 < 128 ? h * 128 + c8 : 512 + h * 128 + (c8 - 128)); qld = N1;
        vsrc = (const bf16_t*)(PWS + W_PROJ) + rb * N1 + base + 1024 + h * 128 + cgp * 64; vld = N1; }
    constexpr int VPC = CPG / 8;
    const int vs = tid / VPC, vc8 = (tid % VPC) * 8; const bool vact = tid < TB * VPC;
    float lb8[8];
#pragma unroll
    for (int i = 0; i < 8; ++i) lb8[i] = 0.f;
    if (MIX == 2 && l > 0 && c8 >= 128) { const float* hl = PIN(I_HLB);
#pragma unroll
        for (int i = 0; i < 8; ++i) { const int cc = h * 128 + (c8 - 128) + i; lb8[i] = sigm(hl[512 + cc] - hl[cc]); } }
    f2 S2[CPL][NP];
#pragma unroll
    for (int cc = 0; cc < CPL; ++cc)
#pragma unroll
        for (int i = 0; i < NP; ++i) S2[cc][i] = (f2){0.f, 0.f};
    float nn = 0.f, okeep[CPL], oprev[CPL];
#pragma unroll
    for (int cc = 0; cc < CPL; ++cc) { okeep[cc] = 0.f; oprev[cc] = 0.f; }
    u32x4_t rq[2], rv; float rg0 = 0.f, rg1 = 0.f;
    rv = (u32x4_t){0u, 0u, 0u, 0u};
#define SCAN_ISSUE(t0_) do { \
        _Pragma("unroll") for (int i_ = 0; i_ < 2; ++i_) rq[i_] = *(const u32x4_t*)(qsrc + (size_t)((t0_) + srow + 16 * i_) * qld); \
        if (vact) rv = *(const u32x4_t*)(vsrc + (size_t)((t0_) + vs) * vld + vc8); \
        if (MIX != 2 && tid < TB) { const size_t r_ = rb + (t0_) + tid; rg0 = gates[r_ * 16 + (MIX == 0 ? 0 : 8) + h]; rg1 = gates[r_ * 16 + (MIX == 0 ? 4 : 12) + h]; } } while (0)
#define SCAN_FINISH(B_) do { float* qk_ = (B_); float* vv_ = (B_) + 8192; float* sc_ = (B_) + 10240; \
        _Pragma("unroll") for (int i_ = 0; i_ < 2; ++i_) { float x_[8]; \
            _Pragma("unroll") for (int e_ = 0; e_ < 4; ++e_) { x_[2 * e_] = bflo(rq[i_][e_]); x_[2 * e_ + 1] = bfhi(rq[i_][e_]); } \
            if (MIX == 2 && c8 >= 128) { _Pragma("unroll") for (int e_ = 0; e_ < 8; ++e_) x_[e_] = lb8[e_] + (1.f - lb8[e_]) * sigm(x_[e_]); } \
            float* d_ = qk_ + (srow + 16 * i_) * 256 + c8; *(f4*)d_ = (f4){x_[0], x_[1], x_[2], x_[3]}; *(f4*)(d_ + 4) = (f4){x_[4], x_[5], x_[6], x_[7]}; } \
        if (vact) { float* d_ = vv_ + vs * 64 + vc8; *(f4*)d_ = (f4){bflo(rv[0]), bfhi(rv[0]), bflo(rv[1]), bfhi(rv[1])}; *(f4*)(d_ + 4) = (f4){bflo(rv[2]), bfhi(rv[2]), bflo(rv[3]), bfhi(rv[3])}; } \
        if (MIX == 0 && tid < TB) { sc_[tid * 4] = rg0; sc_[tid * 4 + 1] = rg1; } \
        if (MIX == 1 && tid < TB) { gsc[tid * 2] = rg0; gsc[tid * 2 + 1] = rg1; } } while (0)
#define SCAN_CHAIN(B_) do { if (w == 1) { float* sc_ = (B_) + 10240; const int ls_ = lane & 31; const float m0_ = mcar[0]; \
            const float ig_ = gsc[2 * ls_], lf_ = gsc[2 * ls_ + 1]; \
            float F_ = lf_; F_ += dppf<0x111>(F_); F_ += dppf<0x112>(F_); F_ += dppf<0x114>(F_); F_ += dppf<0x118>(F_);              \
            { const float t0_ = rdlane(F_, 15); if (lane & 16) F_ += t0_; } \
            float P_ = ig_ - F_; P_ = fmaxf(P_, dppm<0x111>(P_)); P_ = fmaxf(P_, dppm<0x112>(P_)); P_ = fmaxf(P_, dppm<0x114>(P_)); P_ = fmaxf(P_, dppm<0x118>(P_)); \
            { const float t1_ = rdlane(P_, 15); if (lane & 16) P_ = fmaxf(P_, t1_); } \
            const float m_ = F_ + fmaxf(m0_, P_); \
            float mp_ = dppf<0x111>(m_); { const float t2_ = rdlane(m_, 15); if ((lane & 15) == 0) mp_ = (lane & 16) ? t2_ : m0_; } \
            const float mlast_ = rdlane(m_, 31); \
            if (lane < 32) { sc_[lane * 4] = __expf(lf_ + mp_ - m_); sc_[lane * 4 + 1] = __expf(ig_ - m_) * QSCALE; sc_[lane * 4 + 2] = m_; } \
            if (lane == 0) mcar[0] = mlast_; } } while (0)
    if (MIX == 1 && tid == 64) mcar[0] = 0.f;
    __syncthreads();
    SCAN_ISSUE(0);
    SCAN_FINISH(sm);
    __syncthreads();
    if (MIX == 1) { SCAN_CHAIN(sm); __syncthreads(); }
#pragma unroll 1
    for (int blk = 0; blk < NBLK; ++blk) {
        const int t0 = blk * TB;
        float* B = sm + (blk & 1) * BUFSZ; float* Bn = sm + ((blk & 1) ^ 1) * BUFSZ;
        const float* qk = B; const float* vv = B + 8192; const float* sc = B + 10240; float* denp = B + 10368;
        if (blk + 1 < NBLK) SCAN_ISSUE(t0 + TB);
        f4 qa[2][NG], ka[2][NG]; float va[2][CPL], sa[2], sb[2], kda[2], qda[2];
#define SCAN_LOADOPS(slot_, s_) do { const float* qs_ = qk + (s_) * 256; \
            _Pragma("unroll") for (int g_ = 0; g_ < NG; ++g_) { qa[slot_][g_] = *(const f4*)(qs_ + g_ * 4 * T + 4 * j); ka[slot_][g_] = *(const f4*)(qs_ + 128 + g_ * 4 * T + 4 * j); } \
            _Pragma("unroll") for (int cc_ = 0; cc_ < CPL; ++cc_) va[slot_][cc_] = vv[(s_) * 64 + col + 4 * cc_]; \
            if (MIX != 2) { sa[slot_] = sc[(s_) * 4]; sb[slot_] = sc[(s_) * 4 + 1]; } \
            if (MIX == 1) { const int dn_ = 16 * w + (lane & 15); kda[slot_] = qs_[128 + dn_]; qda[slot_] = qs_[dn_]; } } while (0)
        SCAN_LOADOPS(0, 0);
#pragma unroll 1
        for (int sg = 0; sg < TB; sg += T) {
#pragma unroll
            for (int ss = 0; ss < T; ++ss) {
                const int s = sg + ss; constexpr int dummy = 0; (void)dummy;
                const int cur = ss & 1, nxt = cur ^ 1;
                SCAN_LOADOPS(nxt, (s + 1) & (TB - 1));
                __builtin_amdgcn_sched_barrier(0);
                f2 qq[NP], kk[NP];
#pragma unroll
                for (int g = 0; g < NG; ++g) { qq[2 * g] = qa[cur][g].xy; qq[2 * g + 1] = qa[cur][g].zw; kk[2 * g] = ka[cur][g].xy; kk[2 * g + 1] = ka[cur][g].zw; }
                float onew[CPL];
#pragma unroll
                for (int cc = 0; cc < CPL; ++cc) {
                    const float v = va[cur][cc];
                    f2 oa = (f2){0.f, 0.f}, ob = (f2){0.f, 0.f};
                    if (MIX == 0) {
                        const float beta = sa[cur], a = sb[cur];
                        f2 ka2 = kk[0] * S2[cc][0], kb2 = kk[1] * S2[cc][1];
#pragma unroll
                        for (int i = 2; i < NP; i += 2) { ka2 = kk[i] * S2[cc][i] + ka2; kb2 = kk[i + 1] * S2[cc][i + 1] + kb2; }
                        ka2 = ka2 + kb2;
                        const float ks = grp_sum<T>(ka2.x + ka2.y);
                        const float u = beta * (v - a * ks);
                        const f2 a2 = (f2){a, a}, u2 = (f2){u, u};
#pragma unroll
                        for (int i = 0; i < NP; i += 2) { S2[cc][i] = S2[cc][i] * a2 + kk[i] * u2; S2[cc][i + 1] = S2[cc][i + 1] * a2 + kk[i + 1] * u2; oa = qq[i] * S2[cc][i] + oa; ob = qq[i + 1] * S2[cc][i + 1] + ob; }
                    } else if (MIX == 1) {
                        const float fp = sa[cur], ip = sb[cur], iv = ip * v;
                        const f2 f2v = (f2){fp, fp}, iv2 = (f2){iv, iv};
#pragma unroll
                        for (int i = 0; i < NP; i += 2) { S2[cc][i] = S2[cc][i] * f2v + kk[i] * iv2; S2[cc][i + 1] = S2[cc][i + 1] * f2v + kk[i + 1] * iv2; oa = qq[i] * S2[cc][i] + oa; ob = qq[i + 1] * S2[cc][i + 1] + ob; }
                    } else {
                        const f2 v2 = (f2){v, v};
#pragma unroll
                        for (int i = 0; i < NP; i += 2) { S2[cc][i] = kk[i] * (S2[cc][i] - v2) + v2; S2[cc][i + 1] = kk[i + 1] * (S2[cc][i + 1] - v2) + v2; oa = qq[i] * S2[cc][i] + oa; ob = qq[i + 1] * S2[cc][i + 1] + ob; }
                    }
                    oa = oa + ob; onew[cc] = oa.x + oa.y;
                }
                if (MIX == 1) { const float fp = sa[cur], ip = sb[cur];
                    nn = fp * nn + ip * kda[cur];
                    denp[s * 128 + 16 * w + (lane & 15)] = qda[cur] * nn; }
#pragma unroll
                for (int cc = 0; cc < CPL; ++cc) {
                    if (ss > 0) { const float o = grp_sum<T>(oprev[cc]); okeep[cc] = (ss - 1 == j) ? o : okeep[cc]; }
                    oprev[cc] = onew[cc]; }
            }
#pragma unroll
            for (int cc = 0; cc < CPL; ++cc) { const float o = grp_sum<T>(oprev[cc]); okeep[cc] = (T - 1 == j) ? o : okeep[cc];
                outp[(rb + t0 + sg + j) * 512 + h * 128 + ecol + 4 * cc] = f2bf(okeep[cc]); }
        }
#undef SCAN_LOADOPS
        if (blk + 1 < NBLK) SCAN_FINISH(Bn);
        __syncthreads();
        if (MIX == 1) {
            if (cgp == 0) { const int sr = tid >> 4, jl = tid & 15; const f4 a0 = *(const f4*)(denp + sr * 128 + 8 * jl), a1 = *(const f4*)(denp + sr * 128 + 8 * jl + 4);
                const float d = grp_sum16((a0.x + a0.y) + (a0.z + a0.w) + (a1.x + a1.y) + (a1.z + a1.w));
                if (jl == 0) { const size_t r = rb + t0 + sr; ((float*)(PWS + W_DEN))[r * 4 + h] = d; ((float*)(PWS + W_MT))[r * 4 + h] = sc[sr * 4 + 2]; } }
            if (blk + 1 < NBLK) SCAN_CHAIN(Bn);
            __syncthreads();
        }
    }
#undef SCAN_ISSUE
#undef SCAN_FINISH
#undef SCAN_CHAIN
    const size_t sidx = ((size_t)(l * NBP + b) * NH + h);
    float* So = POUT + (MIX == 0 ? O_P_GS : (MIX == 1 ? O_P_MC : O_P_HS)) + sidx * 16384;
#pragma unroll
    for (int cc = 0; cc < CPL; ++cc)
#pragma unroll
        for (int g = 0; g < NG; ++g) { const int d0 = g * 4 * T + 4 * j, ec = ecol + 4 * cc;
            So[(size_t)(d0 + 0) * 128 + ec] = S2[cc][2 * g].x; So[(size_t)(d0 + 1) * 128 + ec] = S2[cc][2 * g].y; So[(size_t)(d0 + 2) * 128 + ec] = S2[cc][2 * g + 1].x; So[(size_t)(d0 + 3) * 128 + ec] = S2[cc][2 * g + 1].y; }
    if (MIX == 1 && cgp == 0) {
        if (lane < 16) POUT[O_P_MN + sidx * 128 + 16 * w + lane] = nn;
        if (tid == 64) POUT[O_P_MM + sidx] = mcar[0];
    }
    __syncthreads();
}

template <int MIX>
__device__ __forceinline__ void scan_prompt_lin(const Params& p, int l, int b, int h, int cgp, float* sm) {
    constexpr int TB = 32, NBLK = SEQ / TB;
    int tid_ = threadIdx.x; asm volatile("" : "+v"(tid_)); const int tid = tid_, lane = tid & 63, w = tid >> 6;
    float* qk = sm; float* vv = sm + 8192; float* denp = sm + 10240; float* opart = sm + 14336; float* scall = sm + 30720;
    const float* gates = (const float*)(PWS + W_GATES);
    bf16_t* outp = (bf16_t*)(PWS + W_OUTS) + (size_t)MIX * MT * 512;
    const size_t rb = (size_t)b * SEQ;
    const int c8 = (tid & 31) * 8, srow = tid >> 5;
    const int base = MIX == 1 ? 2048 : 4096;
    const bf16_t* qsrc = (const bf16_t*)(PWS + W_PROJ) + rb * N1 + base + (c8 < 128 ? h * 128 + c8 : 512 + h * 128 + (c8 - 128));
    const bf16_t* vsrc = (const bf16_t*)(PWS + W_PROJ) + rb * N1 + base + 1024 + h * 128 + cgp * 64;
    const int vs = tid >> 3, vc8 = (tid & 7) * 8; const bool vact = tid < TB * 8;
    float lb8[8];
#pragma unroll
    for (int i = 0; i < 8; ++i) lb8[i] = 0.f;
    if (MIX == 2 && l > 0 && c8 >= 128) { const float* hl = PIN(I_HLB);
#pragma unroll
        for (int i = 0; i < 8; ++i) { const int cc = h * 128 + (c8 - 128) + i; lb8[i] = sigm(hl[512 + cc] - hl[cc]); } }
    __syncthreads();
    float mfinal = 0.f;
    if (MIX == 1) {
        float* graw = opart;
        for (int i = tid; i < SEQ; i += 512) { const size_t r = rb + i; graw[2 * i] = gates[r * 16 + 8 + h]; graw[2 * i + 1] = gates[r * 16 + 12 + h]; }
        __syncthreads();
        if (w == 1) { float m0 = 0.f; const int ls = lane & 31;
            for (int t0 = 0; t0 < SEQ; t0 += 32) {
                const float ig = graw[2 * (t0 + ls)], lf = graw[2 * (t0 + ls) + 1];
                float F = lf; F += dppf<0x111>(F); F += dppf<0x112>(F); F += dppf<0x114>(F); F += dppf<0x118>(F);
                { const float t0v = rdlane(F, 15); if (lane & 16) F += t0v; }
                float P = ig - F; P = fmaxf(P, dppm<0x111>(P)); P = fmaxf(P, dppm<0x112>(P)); P = fmaxf(P, dppm<0x114>(P)); P = fmaxf(P, dppm<0x118>(P));
                { const float t1v = rdlane(P, 15); if (lane & 16) P = fmaxf(P, t1v); }
                const float m = F + fmaxf(m0, P);
                float mp = dppf<0x111>(m); { const float t2v = rdlane(m, 15); if ((lane & 15) == 0) mp = (lane & 16) ? t2v : m0; }
                if (lane < 32) { scall[2 * (t0 + lane)] = __expf(lf + mp - m); scall[2 * (t0 + lane) + 1] = __expf(ig - m) * QSCALE;
                    if (cgp == 0) ((float*)(PWS + W_MT))[(rb + t0 + lane) * 4 + h] = m; }
                m0 = rdlane(m, 31); }
            mfinal = m0; }
        __syncthreads();
    }
    f2 S2[8];
#pragma unroll
    for (int i = 0; i < 8; ++i) S2[i] = (f2){0.f, 0.f};
    float nn = 0.f;
    u32x4_t rq[2], rv; rv = (u32x4_t){0u, 0u, 0u, 0u};
#define LIN_ISSUE(t0_) do { \
        _Pragma("unroll") for (int i_ = 0; i_ < 2; ++i_) rq[i_] = *(const u32x4_t*)(qsrc + (size_t)((t0_) + srow + 16 * i_) * N1); \
        if (vact) rv = *(const u32x4_t*)(vsrc + (size_t)((t0_) + vs) * N1 + vc8); } while (0)
#define LIN_FINISH() do { \
        _Pragma("unroll") for (int i_ = 0; i_ < 2; ++i_) { float x_[8]; \
            _Pragma("unroll") for (int e_ = 0; e_ < 4; ++e_) { x_[2 * e_] = bflo(rq[i_][e_]); x_[2 * e_ + 1] = bfhi(rq[i_][e_]); } \
            if (MIX == 2 && c8 >= 128) { _Pragma("unroll") for (int e_ = 0; e_ < 8; ++e_) x_[e_] = lb8[e_] + (1.f - lb8[e_]) * sigm(x_[e_]); } \
            float* d_ = qk + (srow + 16 * i_) * 256 + c8; *(f4*)d_ = (f4){x_[0], x_[1], x_[2], x_[3]}; *(f4*)(d_ + 4) = (f4){x_[4], x_[5], x_[6], x_[7]}; } \
        if (vact) { float* d_ = vv + vs * 64 + vc8; *(f4*)d_ = (f4){bflo(rv[0]), bfhi(rv[0]), bflo(rv[1]), bfhi(rv[1])}; *(f4*)(d_ + 4) = (f4){bflo(rv[2]), bfhi(rv[2]), bflo(rv[3]), bfhi(rv[3])}; } } while (0)
    LIN_ISSUE(0);
    LIN_FINISH();
    __syncthreads();
#pragma unroll 1
    for (int blk = 0; blk < NBLK; ++blk) {
        const int t0 = blk * TB;
        if (blk + 1 < NBLK) LIN_ISSUE(t0 + TB);
        f4 qa[2][4], ka[2][4]; float va[2], kda[2], qda[2]; f2 sca[2];
#define LIN_LOADOPS(slot_, s_) do { const float* qs_ = qk + (s_) * 256 + 16 * w; \
            _Pragma("unroll") for (int g_ = 0; g_ < 4; ++g_) { qa[slot_][g_] = *(const f4*)(qs_ + 4 * g_); ka[slot_][g_] = *(const f4*)(qs_ + 128 + 4 * g_); } \
            va[slot_] = vv[(s_) * 64 + lane]; \
            if (MIX == 1) { sca[slot_] = *(const f2*)(scall + 2 * (t0 + (s_))); kda[slot_] = qs_[128 + (lane & 15)]; qda[slot_] = qs_[lane & 15]; } } while (0)
        LIN_LOADOPS(0, 0);
#pragma unroll 1
        for (int sg = 0; sg < TB; sg += 4) {
#pragma unroll
            for (int ss = 0; ss < 4; ++ss) {
                const int s = sg + ss, cur = ss & 1, nxt = cur ^ 1;
                LIN_LOADOPS(nxt, (s + 1) & (TB - 1));
                __builtin_amdgcn_sched_barrier(0);
                f2 qq[8], kk[8];
#pragma unroll
                for (int g = 0; g < 4; ++g) { qq[2 * g] = qa[cur][g].xy; qq[2 * g + 1] = qa[cur][g].zw; kk[2 * g] = ka[cur][g].xy; kk[2 * g + 1] = ka[cur][g].zw; }
                const float v = va[cur];
                f2 oa = (f2){0.f, 0.f}, ob = (f2){0.f, 0.f};
                if (MIX == 1) {
                    const float fp = sca[cur].x, ip = sca[cur].y, iv = ip * v;
                    const f2 f2v = (f2){fp, fp}, iv2 = (f2){iv, iv};
#pragma unroll
                    for (int i = 0; i < 8; i += 2) { S2[i] = S2[i] * f2v + kk[i] * iv2; S2[i + 1] = S2[i + 1] * f2v + kk[i + 1] * iv2; oa = qq[i] * S2[i] + oa; ob = qq[i + 1] * S2[i + 1] + ob; }
                    nn = fp * nn + ip * kda[cur];
                    denp[s * 128 + 16 * w + (lane & 15)] = qda[cur] * nn;
                } else {
                    const f2 v2 = (f2){v, v};
#pragma unroll
                    for (int i = 0; i < 8; i += 2) { S2[i] = kk[i] * (S2[i] - v2) + v2; S2[i + 1] = kk[i + 1] * (S2[i + 1] - v2) + v2; oa = qq[i] * S2[i] + oa; ob = qq[i + 1] * S2[i + 1] + ob; }
                }
                oa = oa + ob;
                opart[(s * 8 + w) * 64 + lane] = oa.x + oa.y;
            }
        }
#undef LIN_LOADOPS
        __syncthreads();
        { const int s = tid >> 5, e2 = (tid & 31) * 2; f2 acc2 = (f2){0.f, 0.f};
#pragma unroll
            for (int ww = 0; ww < 8; ++ww) acc2 = acc2 + *(const f2*)(opart + (s * 8 + ww) * 64 + e2);
            const int s2 = s + 16; f2 acc3 = (f2){0.f, 0.f};
#pragma unroll
            for (int ww = 0; ww < 8; ++ww) acc3 = acc3 + *(const f2*)(opart + (s2 * 8 + ww) * 64 + e2);
            *(unsigned*)(outp + (rb + t0 + s) * 512 + h * 128 + cgp * 64 + e2) = pg8::cvt_pk_bf16(acc2.x, acc2.y);
            *(unsigned*)(outp + (rb + t0 + s2) * 512 + h * 128 + cgp * 64 + e2) = pg8::cvt_pk_bf16(acc3.x, acc3.y); }
        if (MIX == 1 && cgp == 0) { const int sr = tid >> 4, jl = tid & 15; const f4 a0 = *(const f4*)(denp + sr * 128 + 8 * jl), a1 = *(const f4*)(denp + sr * 128 + 8 * jl + 4);
            const float d = grp_sum16((a0.x + a0.y) + (a0.z + a0.w) + (a1.x + a1.y) + (a1.z + a1.w));
            if (jl == 0) ((float*)(PWS + W_DEN))[(rb + t0 + sr) * 4 + h] = d; }
        if (blk + 1 < NBLK) LIN_FINISH();
        __syncthreads();
    }
#undef LIN_ISSUE
#undef LIN_FINISH
    const size_t sidx = ((size_t)(l * NBP + b) * NH + h);
    float* So = POUT + (MIX == 1 ? O_P_MC : O_P_HS) + sidx * 16384;
#pragma unroll
    for (int i = 0; i < 8; ++i) { So[(size_t)(16 * w + 2 * i) * 128 + cgp * 64 + lane] = S2[i].x; So[(size_t)(16 * w + 2 * i + 1) * 128 + cgp * 64 + lane] = S2[i].y; }
    if (MIX == 1 && cgp == 0) {
        if (lane < 16) POUT[O_P_MN + sidx * 128 + 16 * w + lane] = nn;
        if (tid == 64) POUT[O_P_MM + sidx] = mfinal;
    }
    __syncthreads();
}

__device__ __forceinline__ void scan_sample_item(const Params& p, int l, int mix, int b, int h, float* sm) {
    int tid_ = threadIdx.x; asm volatile("" : "+v"(tid_)); const int tid = tid_, lane = tid & 63, w = tid >> 6, e = tid & 127, dg = tid >> 7;
    float* qk = sm; float* vv = sm + 1024; float* gs = sm + 1536; float* red = sm + 1600; float* dpart = sm + 1600 + 4096;
    const bf16_t* proj = (const bf16_t*)(PWS + W_PROJ);
    const float* gates = (const float*)(PWS + W_GATES);
    bf16_t* outp = (bf16_t*)(PWS + W_OUTS) + (size_t)mix * MT * 512;
    const size_t rs = (size_t)MP + (size_t)b * SSEQ;
    const size_t sidx = ((size_t)(l * NBS + b) * NH + h);
    const float* Sin = (mix == 0 ? PIN(I_SGS) : (mix == 1 ? PIN(I_SMC) : PIN(I_SHS))) + sidx * 16384;
    float S[32];
#pragma unroll
    for (int i = 0; i < 32; ++i) S[i] = Sin[(size_t)(32 * dg + i) * 128 + e];
    __syncthreads();
    for (int idx = tid; idx < 4 * 384; idx += 512) { const int s = idx / 384, ch = idx - s * 384; float val;
        if (mix == 0) { val = ch < 256 ? bf2f(((const bf16_t*)(PWS + W_HBF))[(rs + s) * 1024 + (ch >> 7) * 512 + h * 128 + (ch & 127)]) : bf2f(outp[(rs + s) * 512 + h * 128 + (ch - 256)]);
        } else if (mix == 1) { const int colx = 2048 + (ch >> 7) * 512 + h * 128 + (ch & 127); val = bf2f(proj[(rs + s) * N1 + colx]); }
        else { const int colx = 4096 + (ch >> 7) * 512 + h * 128 + (ch & 127); val = bf2f(proj[(rs + s) * N1 + colx]);
            if (ch >= 128 && ch < 256) { float lbv = 0.f; if (l > 0) { const float* hl = PIN(I_HLB); const int cc = h * 128 + (ch & 127); lbv = sigm(hl[512 + cc] - hl[cc]); } val = lbv + (1.f - lbv) * sigm(val); } }
        if (ch < 256) qk[s * 256 + ch] = val; else vv[s * 128 + ch - 256] = val; }
    if (tid < 4) { const size_t r = rs + tid;
        if (mix == 0) { gs[tid * 4] = gates[r * 16 + h]; gs[tid * 4 + 1] = gates[r * 16 + 4 + h]; }
        else if (mix == 1) { gs[tid * 4] = gates[r * 16 + 8 + h]; gs[tid * 4 + 1] = gates[r * 16 + 12 + h]; } }
    __syncthreads();
    float m = 0.f, nn = 0.f, mts[4] = {0.f, 0.f, 0.f, 0.f};
    if (mix == 1) { m = PIN(I_SMM)[sidx]; if (dg == 0) nn = PIN(I_SMN)[sidx * 128 + e]; }
#pragma unroll
    for (int s = 0; s < 4; ++s) {
        const float* qs = qk + s * 256 + 32 * dg; const float* ksp = qs + 128;
        const float v = vv[s * 128 + e];
        float po = 0.f;
        if (mix == 0) {
            const float beta = gs[s * 4], a = gs[s * 4 + 1];
            float pk = 0.f;
#pragma unroll
            for (int i = 0; i < 32; ++i) pk += ksp[i] * S[i];
            red[((s * 2) * 4 + dg) * 128 + e] = pk;
            __syncthreads();
            const float ks = red[((s * 2) * 4 + 0) * 128 + e] + red[((s * 2) * 4 + 1) * 128 + e] + red[((s * 2) * 4 + 2) * 128 + e] + red[((s * 2) * 4 + 3) * 128 + e];
            const float u = beta * (v - a * ks);
#pragma unroll
            for (int i = 0; i < 32; ++i) { S[i] = a * S[i] + ksp[i] * u; po += qs[i] * S[i]; }
        } else if (mix == 1) {
            const float ig = gs[s * 4], lf = gs[s * 4 + 1]; const float mn = fmaxf(lf + m, ig); const float fp = __expf(lf + m - mn), ip = __expf(ig - mn) * QSCALE; m = mn; mts[s] = mn;
            const float iv = ip * v;
#pragma unroll
            for (int i = 0; i < 32; ++i) { S[i] = fp * S[i] + ksp[i] * iv; po += qs[i] * S[i]; }
            if (dg == 0) { nn = fp * nn + ip * qk[s * 256 + 128 + e]; const float dp = wave_sum(qk[s * 256 + e] * nn); if (lane == 0) dpart[s * 2 + w] = dp; }
        } else {
#pragma unroll
            for (int i = 0; i < 32; ++i) { S[i] = ksp[i] * (S[i] - v) + v; po += qs[i] * S[i]; }
        }
        red[((s * 2 + 1) * 4 + dg) * 128 + e] = po;
    }
    __syncthreads();
    if (tid < 128) {
#pragma unroll
        for (int s = 0; s < 4; ++s) { const float o = red[((s * 2 + 1) * 4 + 0) * 128 + e] + red[((s * 2 + 1) * 4 + 1) * 128 + e] + red[((s * 2 + 1) * 4 + 2) * 128 + e] + red[((s * 2 + 1) * 4 + 3) * 128 + e];
            outp[(rs + s) * 512 + h * 128 + e] = f2bf(o); } }
    if (mix == 1 && tid == 0) {
#pragma unroll
        for (int s = 0; s < 4; ++s) { ((float*)(PWS + W_DEN))[(rs + s) * 4 + h] = dpart[s * 2] + dpart[s * 2 + 1]; ((float*)(PWS + W_MT))[(rs + s) * 4 + h] = mts[s]; }
        POUT[O_S_MM + sidx] = m; }
    float* So = POUT + (mix == 0 ? O_S_GS : (mix == 1 ? O_S_MC : O_S_HS)) + sidx * 16384;
#pragma unroll
    for (int i = 0; i < 32; ++i) So[(size_t)(32 * dg + i) * 128 + e] = S[i];
    if (mix == 1 && dg == 0) POUT[O_S_MN + sidx * 128 + e] = nn;
}
__device__ __forceinline__ void phase_postnorm(const Params& p, int l) {
    int tid_ = threadIdx.x; asm volatile("" : "+v"(tid_)); const int tid = tid_, j = tid & 15;
    bf16_t* outs = (bf16_t*)(PWS + W_OUTS);
    const bf16_t* proj = (const bf16_t*)(PWS + W_PROJ);
    const float* den = (const float*)(PWS + W_DEN); const float* mt = (const float*)(PWS + W_MT);
    const int ngroups = MT * 12;
    for (int gid = bidx() * 32 + (tid >> 4); gid < ngroups; gid += gdim() * 32) {
        const int r = gid / 12, mh = gid - r * 12, mix = mh >> 2, h = mh & 3;
        bf16_t* op = outs + (size_t)mix * MT * 512 + (size_t)r * 512 + h * 128 + 8 * j;
        const u32x4_t raw = *(const u32x4_t*)op;
        float v[8];
#pragma unroll
        for (int i = 0; i < 4; ++i) { v[2 * i] = bflo(raw[i]); v[2 * i + 1] = bfhi(raw[i]); }
        if (mix == 1) { const float dn = fmaxf(fabsf(den[(size_t)r * 4 + h]), __expf(-mt[(size_t)r * 4 + h])); const float inv = 1.f / dn;
#pragma unroll
            for (int i = 0; i < 8; ++i) v[i] *= inv; }
        float ss = 0.f;
#pragma unroll
        for (int i = 0; i < 8; ++i) ss += v[i] * v[i];
        ss = grp_sum16(ss);
        const float rstd = rsqrtf(ss * (1.f / 128.f) + EPS);
        const int gcol = (mix == 0 ? 1536 : (mix == 1 ? 3584 : 5632)) + h * 128 + 8 * j;
        const u32x4_t gr = *(const u32x4_t*)(proj + (size_t)r * N1 + gcol);
        const float* nw = (mix == 0 ? PIN(I_GNORM) : (mix == 1 ? PIN(I_MNORM) : PIN(I_HNORM))) + l * 512 + h * 128 + 8 * j;
        const float4 n0 = *(const float4*)nw, n1 = *(const float4*)(nw + 4);
        const float nwv[8] = {n0.x, n0.y, n0.z, n0.w, n1.x, n1.y, n1.z, n1.w};
#pragma unroll
        for (int i = 0; i < 4; ++i) { v[2 * i] *= rstd * nwv[2 * i] * bflo(gr[i]); v[2 * i + 1] *= rstd * nwv[2 * i + 1] * bfhi(gr[i]); }
        u32x4_t o; o[0] = pg8::cvt_pk_bf16(v[0], v[1]); o[1] = pg8::cvt_pk_bf16(v[2], v[3]); o[2] = pg8::cvt_pk_bf16(v[4], v[5]); o[3] = pg8::cvt_pk_bf16(v[6], v[7]);
        *(u32x4_t*)op = o;
    }
    const int ncs = (NBP + NBS) * 3 * 1536;
    for (int i = bidx() * 512 + tid; i < ncs; i += gdim() * 512) {
        const int cc = i % 1536, ri = (i / 1536) % 3, bb = i / (3 * 1536);
        if (bb < NBP) POUT[O_P_GC + ((size_t)(l * NBP + bb) * 3 + ri) * 1536 + cc] = bf2f(proj[((size_t)bb * SEQ + SEQ - 3 + ri) * N1 + cc]);
        else { const int b2 = bb - NBP; POUT[O_S_GC + ((size_t)(l * NBS + b2) * 3 + ri) * 1536 + cc] = bf2f(proj[((size_t)MP + (size_t)b2 * SSEQ + 1 + ri) * N1 + cc]); }
    }
}

__device__ __forceinline__ void phase_convffn(const Params& p, int l) {
    int tid_ = threadIdx.x; asm volatile("" : "+v"(tid_)); const int tid = tid_;
    const bf16_t* u = (const bf16_t*)(PWS + W_PROJ);
    bf16_t* act = (bf16_t*)(PWS + W_ACT);
    const float* cw = PIN(I_FCW) + (size_t)l * 3 * NUP; const float* cb = PIN(I_FCB) + (size_t)l * NUP;
    const int nitems = (MT / 4) * (DFF / 8);
    for (int it = bidx() * 512 + tid; it < nitems; it += gdim() * 512) {
        const int jg = it % (DFF / 8), rbk = it / (DFF / 8), r0 = rbk * 4, jc = jg * 8;
        const bool samp = r0 >= MP; const int tf = samp ? 0 : (r0 & (SEQ - 1));
        float wa[3][8], wb[3][8], ba[8], bb[8];
#pragma unroll
        for (int i = 0; i < 3; ++i) { const float4 a0 = *(const float4*)(cw + i * NUP + jc), a1 = *(const float4*)(cw + i * NUP + jc + 4), b0 = *(const float4*)(cw + i * NUP + DFF + jc), b1 = *(const float4*)(cw + i * NUP + DFF + jc + 4);
            wa[i][0] = a0.x; wa[i][1] = a0.y; wa[i][2] = a0.z; wa[i][3] = a0.w; wa[i][4] = a1.x; wa[i][5] = a1.y; wa[i][6] = a1.z; wa[i][7] = a1.w;
            wb[i][0] = b0.x; wb[i][1] = b0.y; wb[i][2] = b0.z; wb[i][3] = b0.w; wb[i][4] = b1.x; wb[i][5] = b1.y; wb[i][6] = b1.z; wb[i][7] = b1.w; }
        { const float4 a0 = *(const float4*)(cb + jc), a1 = *(const float4*)(cb + jc + 4), b0 = *(const float4*)(cb + DFF + jc), b1 = *(const float4*)(cb + DFF + jc + 4);
            ba[0] = a0.x; ba[1] = a0.y; ba[2] = a0.z; ba[3] = a0.w; ba[4] = a1.x; ba[5] = a1.y; ba[6] = a1.z; ba[7] = a1.w;
            bb[0] = b0.x; bb[1] = b0.y; bb[2] = b0.z; bb[3] = b0.w; bb[4] = b1.x; bb[5] = b1.y; bb[6] = b1.z; bb[7] = b1.w; }
        float xa[6][8], xb[6][8];
#pragma unroll
        for (int rr = 0; rr < 6; ++rr) {
            if (rr < 2 && tf == 0) {
                if (samp) { const float* st = PIN(I_SFC) + ((size_t)(l * NBS + (r0 - MP) / 4) * 2 + rr) * NUP;
#pragma unroll
                    for (int i = 0; i < 8; ++i) { xa[rr][i] = st[jc + i]; xb[rr][i] = st[DFF + jc + i]; } }
                else {
#pragma unroll
                    for (int i = 0; i < 8; ++i) { xa[rr][i] = 0.f; xb[rr][i] = 0.f; } }
            } else { const bf16_t* ur = u + (size_t)(r0 - 2 + rr) * NUP; const u32x4_t ra = *(const u32x4_t*)(ur + jc), rbv = *(const u32x4_t*)(ur + DFF + jc);
#pragma unroll
                for (int i = 0; i < 4; ++i) { xa[rr][2 * i] = bflo(ra[i]); xa[rr][2 * i + 1] = bfhi(ra[i]); xb[rr][2 * i] = bflo(rbv[i]); xb[rr][2 * i + 1] = bfhi(rbv[i]); } }
        }
#pragma unroll
        for (int t = 0; t < 4; ++t) { float o[8];
#pragma unroll
            for (int i = 0; i < 8; ++i) { const float ya = wa[0][i] * xa[t][i] + wa[1][i] * xa[t + 1][i] + wa[2][i] * xa[t + 2][i] + ba[i]; const float yb = wb[0][i] * xb[t][i] + wb[1][i] * xb[t + 1][i] + wb[2][i] * xb[t + 2][i] + bb[i]; o[i] = silu(ya) * yb; }
            u32x4_t ov; ov[0] = pg8::cvt_pk_bf16(o[0], o[1]); ov[1] = pg8::cvt_pk_bf16(o[2], o[3]); ov[2] = pg8::cvt_pk_bf16(o[4], o[5]); ov[3] = pg8::cvt_pk_bf16(o[6], o[7]);
            *(u32x4_t*)(act + (size_t)(r0 + t) * DFF + jc) = ov; }
        if (samp || tf == SEQ - 4) {
            float* dst = samp ? POUT + O_S_FC + (size_t)(l * NBS + (r0 - MP) / 4) * 2 * NUP : POUT + O_P_FC + (size_t)(l * NBP + r0 / SEQ) * 2 * NUP;
#pragma unroll
            for (int rr = 0; rr < 2; ++rr)
#pragma unroll
                for (int i = 0; i < 8; ++i) { dst[(size_t)rr * NUP + jc + i] = xa[4 + rr][i]; dst[(size_t)rr * NUP + DFF + jc + i] = xb[4 + rr][i]; }
        }
    }
}

__device__ __forceinline__ void phase_final_norm(const Params& p) {
    int tid_ = threadIdx.x; asm volatile("" : "+v"(tid_)); const int tid = tid_, lane = tid & 63, w = tid >> 6;
    const float* gw = PIN(I_LNF);
    float4 g4[4];
#pragma unroll
    for (int i = 0; i < 4; ++i) g4[i] = *(const float4*)(gw + lane * 4 + 256 * i);
    for (int row = bidx() * 8 + w; row < MT; row += gdim() * 8) {
        float* xr = POUT + (size_t)row * DM; float4 v[4]; float ss = 0.f;
#pragma unroll
        for (int i = 0; i < 4; ++i) { v[i] = *(const float4*)(xr + lane * 4 + 256 * i); ss += v[i].x * v[i].x + v[i].y * v[i].y + v[i].z * v[i].z + v[i].w * v[i].w; }
        ss = wave_sum(ss); const float rstd = rsqrtf(ss * (1.f / 1024.f) + EPS);
#pragma unroll
        for (int i = 0; i < 4; ++i) { v[i].x *= rstd * g4[i].x; v[i].y *= rstd * g4[i].y; v[i].z *= rstd * g4[i].z; v[i].w *= rstd * g4[i].w; *(float4*)(xr + lane * 4 + 256 * i) = v[i]; }
    }
}

#ifndef PHM
#define PHM 0xFFFF
#endif
#ifndef DUPB
#define DUPB 1
#endif
#ifndef DUPC
#define DUPC 1
#endif
#ifndef DUPS
#define DUPS 1
#endif
#ifndef DUPH
#define DUPH 1
#endif
#ifndef DUPY
#define DUPY 1
#endif
#ifndef DUPA
#define DUPA 1
#endif
#ifndef DUPI
#define DUPI 1
#endif
#define GSYNC() do { for (int y_ = 0; y_ < DUPY; ++y_) xcd_barrier(xb); } while (0)
__global__ void __launch_bounds__(512, 2) fwd_megakernel(Params p) {
    extern __shared__ __attribute__((aligned(16))) unsigned char shm[];
    cg::grid_group grid = cg::this_grid();
    float* smf = (float*)shm;
    PG8_LAS unsigned char* lds = (PG8_LAS unsigned char*)shm;
    int tid_ = threadIdx.x; asm volatile("" : "+v"(tid_)); const int tid = tid_;
    float* X = POUT;
    volatile XLAS unsigned* xst = (volatile XLAS unsigned*)(lds + LDS_MAIN);
    if (tid == 0) { xst[0] = 0u; xst[1] = 0u; xst[2] = 0u; xst[3] = 0u; }
    __syncthreads();
    XcdBarrier xb = xcd_barrier_post((unsigned*)(PWS + W_BAR), xst);
    bool first_sync = true;
#ifdef TPROBE1
    volatile XLAS unsigned long long* stp = (volatile XLAS unsigned long long*)(lds + LDS_MAIN + 64);
    int nst = 0;
#define STAMP() do { if (blockIdx.x == TPROBE_WG && threadIdx.x == 0) stp[nst] = __builtin_amdgcn_s_memrealtime(); ++nst; } while (0)
#else
#define STAMP() do {} while (0)
#endif
    STAMP();
    bf16_t* hbf = (bf16_t*)(PWS + W_HBF);
    bf16_t* proj = (bf16_t*)(PWS + W_PROJ);

    for (int l = 0; l < 2; ++l) {
        const int G = gdim(), bid = bidx();
        for (int repa = 0; repa < DUPA; ++repa) { if (PHM & 1) { int tc = 0;
          conv_T(PIN(I_WIN) + (size_t)l * 1024 * NIN, NIN, (bf16_t*)(PWS + W_WIN), 1024, N1, true, smf, tc);
          for (int n = 0; n < 3; ++n) conv_T(PIN(I_WBR) + ((size_t)l * 3 + n) * 512 * 1024, 1024, (bf16_t*)(PWS + W_WBR) + (size_t)n * 1024 * 512, 512, 1024, false, smf, tc);
          conv_T(PIN(I_WOUT) + (size_t)l * 1024 * 1024, 1024, (bf16_t*)(PWS + W_WOUT), 1024, 1024, false, smf, tc);
          conv_T(PIN(I_WUP) + (size_t)l * 1024 * NUP, NUP, (bf16_t*)(PWS + W_WUP), 1024, NUP, false, smf, tc);
          conv_T(PIN(I_WDN) + (size_t)l * DFF * 1024, 1024, (bf16_t*)(PWS + W_WDN), DFF, 1024, false, smf, tc);
          __syncthreads(); }
        if (PHM & 2) {
        if (l == 0) { int tq_ = threadIdx.x; asm volatile("" : "+v"(tq_)); const float4* s1 = (const float4*)PIN(I_XS); float4* d1 = (float4*)(X + (size_t)MP * DM);
            for (int i = bid * 512 + tq_; i < MS * DM / 4; i += G * 512) d1[i] = s1[i]; }
        phase_rmsnorm(p, l, l == 0 ? PIN(I_XP) : X, l == 0 ? PIN(I_XS) : X + (size_t)MP * DM, PIN(I_LNMIX) + l * DM, hbf, true, smf); } }
        if (first_sync) { grid.sync(); first_sync = false; }
        else GSYNC();
        STAMP();
        for (int rep = 0; rep < DUPB; ++rep) { pg8::Gemm g{hbf, (const bf16_t*)(PWS + W_WIN), MT, N1, 1024, 1024}; pg8::StaticOrder S; S.init(MT, N1, G, bid); EpiProj E{proj, N1, 1}; pg8::gemm_phase(lds, g, S, E); }
        GSYNC(); STAMP();
        phase_gdnprep(p, l);
        GSYNC(); STAMP();
        for (int rep = 0; rep < DUPC; ++rep) for (int it = bid; it < 256; it += G) {
            if (it < 128) scan_prompt_item<0>(p, l, (it >> 2) >> 2, (it >> 2) & 3, it & 3, smf);
            else if (it < 192) { const int q = it - 128; scan_prompt_lin<1>(p, l, (q >> 1) >> 2, (q >> 1) & 3, q & 1, smf); }
            else { const int q = it - 192; scan_prompt_lin<2>(p, l, (q >> 1) >> 2, (q >> 1) & 3, q & 1, smf); }
        }
        STAMP();
        {
            unsigned* qctr = (unsigned*)(PWS + W_BAR) + 64 * l;
            volatile int* qslot = (volatile int*)(smf + 34816);
            for (;;) {
                __syncthreads();
                if (threadIdx.x == 0) *qslot = (int)__hip_atomic_fetch_add(qctr, 1u, __ATOMIC_RELAXED, __HIP_MEMORY_SCOPE_AGENT);
                __syncthreads();
                const int it = *qslot;
                if (it >= 3 * NBS * NH) break;
                const int mix = it / (NBS * NH), r = it - mix * (NBS * NH); scan_sample_item(p, l, mix, r >> 2, r & 3, smf);
            } }
        GSYNC(); STAMP();
        if (PHM & 32) phase_postnorm(p, l);
        GSYNC(); STAMP();
        if (PHM & 64) { pg8::Gemm g{(const bf16_t*)(PWS + W_OUTS), (const bf16_t*)(PWS + W_WBR), 3 * MT, 3 * 1024, 512, 512};
            MergeOrder S; S.init(G, bid); EpiMerge E{proj + 6144, hbf}; pg8::gemm_phase(lds, g, S, E); }
        GSYNC(); STAMP();
        if (PHM & 128) { { pg8::Gemm g{hbf, (const bf16_t*)(PWS + W_WOUT), MP, 1024, 1024, 1024}; pg8::StaticOrder S; S.init(MP, 1024, G, bid); EpiResid E{X, l == 0 ? PIN(I_XP) : X, X + (size_t)MP * DM}; pg8::gemm_phase(lds, g, S, E); }
            { pg8::Gemm g{hbf, (const bf16_t*)(PWS + W_WOUT), MT, 1024, 256, 1024}; PieceOrder S{G, (bid + G / 2) % G, 4}; EpiAtomic E{X}; pg8::gemm_phase(lds, g, S, E); } }
        GSYNC(); STAMP();
        if (PHM & 256) phase_rmsnorm(p, l, X, X + (size_t)MP * DM, PIN(I_LNFFN) + l * DM, hbf, false, smf);
        GSYNC(); STAMP();
        for (int rep = 0; rep < DUPH; ++rep) { pg8::Gemm g{hbf, (const bf16_t*)(PWS + W_WUP), MT, NUP, 1024, 1024}; pg8::StaticOrder S; S.init(MT, NUP, G, bid); EpiProj E{proj, NUP, 0}; pg8::gemm_phase(lds, g, S, E); }
        GSYNC(); STAMP();
        for (int repi = 0; repi < DUPI; ++repi) phase_convffn(p, l);
        GSYNC(); STAMP();
        if (PHM & 2048) { { pg8::Gemm g{(const bf16_t*)(PWS + W_ACT), (const bf16_t*)(PWS + W_WDN), MP, 1024, DFF, DFF}; pg8::StaticOrder S; S.init(MP, 1024, G, bid); EpiResid E{X, X, X + (size_t)MP * DM}; pg8::gemm_phase(lds, g, S, E); }
            { pg8::Gemm g{(const bf16_t*)(PWS + W_ACT), (const bf16_t*)(PWS + W_WDN), MT, 1024, 256, DFF}; PieceOrder S{G, (bid + G / 2) % G, 11}; EpiAtomic E{X}; pg8::gemm_phase(lds, g, S, E); } }
        GSYNC(); STAMP();
    }
    if (PHM & 4096) phase_final_norm(p);
#ifdef TPROBE1
    if (blockIdx.x == TPROBE_WG && threadIdx.x == 0) {
        const int per = (nst - 1) / 2;
        unsigned long long d1 = 0, d2 = 0;
        for (int l2 = 0; l2 < 2; ++l2) { d1 += stp[l2 * per + TPROBE1E] - stp[l2 * per + TPROBE1]; d2 += stp[l2 * per + TPROBE2E] - stp[l2 * per + TPROBE2]; }
        unsigned long long q1 = (d1 + 1000) / 2000, q2 = (d2 + 500) / 1000;
        const unsigned long long wait = (q1 * 100 + q2) * 2000ull, t0 = __builtin_amdgcn_s_memrealtime();
        while (__builtin_amdgcn_s_memrealtime() - t0 < wait) __builtin_amdgcn_s_sleep(32);
    }
#endif
}

extern "C" void kernel_launch(void* const* d_in, const int* in_sizes, int n_in, void* d_out, int out_size, void* d_ws, size_t ws_size, hipStream_t stream) {
    static int grid_blocks = 0;
    if (grid_blocks == 0) {
        if (n_in != 28 || (size_t)out_size != O_END || ws_size < W_END) { fprintf(stderr, "kernel_launch: unexpected shapes: n_in %d out %d (want %zu) ws %zu (need %zu)\n", n_in, out_size, (size_t)O_END, ws_size, (size_t)W_END); grid_blocks = -1; return; }
        int dev = 0, cus = 0, per_cu = 0;
        hipGetDevice(&dev); hipDeviceGetAttribute(&cus, hipDeviceAttributeMultiprocessorCount, dev);
        if (hipFuncSetAttribute((const void*)fwd_megakernel, hipFuncAttributeMaxDynamicSharedMemorySize, LDS_BYTES) != hipSuccess) { fprintf(stderr, "kernel_launch: hipFuncSetAttribute failed\n"); grid_blocks = -1; return; }
        if (hipOccupancyMaxActiveBlocksPerMultiprocessor(&per_cu, (const void*)fwd_megakernel, 512, LDS_BYTES) != hipSuccess || per_cu < 1) { fprintf(stderr, "kernel_launch: occupancy query gave %d\n", per_cu); per_cu = 1; (void)hipGetLastError(); }
        grid_blocks = cus * per_cu;
    }
    if (grid_blocks < 0) return;
    if (hipMemsetAsync((unsigned char*)d_ws + W_BAR, 0, XCD_BAR_WORDS * 4, stream) != hipSuccess) { fprintf(stderr, "kernel_launch: memset of barrier words failed\n"); return; }
    Params p{};
    for (int i = 0; i < 28; ++i) p.in[i] = (const float*)d_in[i];
    p.out = (float*)d_out; p.ws = (unsigned char*)d_ws;
    void* args[] = {&p};
    hipError_t e = hipLaunchCooperativeKernel((const void*)fwd_megakernel, dim3(grid_blocks), dim3(512), args, LDS_BYTES, stream);
    if (e != hipSuccess) fprintf(stderr, "kernel_launch: cooperative launch failed: %s (grid %d)\n", hipGetErrorString(e), grid_blocks);
}
```

```cpp
#include <hip/hip_runtime.h>
#include <hip/hip_cooperative_groups.h>
#include <cstdio>
namespace cg = cooperative_groups;
namespace pg8 {
#define PG8_LAS __attribute__((address_space(3)))
typedef unsigned short bf16_t;
typedef short bf16x8 __attribute__((ext_vector_type(8)));
typedef float f32x4 __attribute__((ext_vector_type(4)));
typedef unsigned u32x4 __attribute__((ext_vector_type(4)));
constexpr int BM = 256, BK = 64, HALF = 128, HTB = HALF * BK * 2  , STAGE_BYTES = 8 * HTB, NXCD = 8, WGM = 8;

__host__ __device__ __forceinline__ int lds_byte(int r, int c) { const int st = (r >> 4) * 2 + (c >> 5), rr = r & 15, cc = c & 31, ob = rr * 64 + cc * 2; return st * 1024 + (ob ^ (((ob >> 9) & 1) << 5)); }
__host__ __device__ __forceinline__ void stage_rc(int b, int& R, int& C) { const int st = b / 1024, sb = b % 1024, swz = sb ^ (((sb >> 9) & 1) << 5); R = (st >> 1) * 16 + swz / 64; C = (st & 1) * 32 + (swz % 64) / 2; }
__host__ __device__ __forceinline__ int perm32(int rho) { const int n = rho >> 4, i = rho & 15; return 8 * (i >> 2) + 4 * n + (i & 3); }

struct Unit { int pm, pn, pk; };
struct Gemm { const bf16_t* A; const bf16_t* Bt; int M, N, K, ld; };

struct StaticOrder {
    int nM, nN, nwg, G, c;
    __host__ __device__ void init(int M, int N, int G_, int c_) { nM = M / BM; nN = N / BM; nwg = nM * nN; G = G_; c = c_; }
    __host__ __device__ bool next(int i, Unit& u) const {
        const long L = (long)i * G + c; if (L >= nwg) return false;
        int wgid = (int)L; { const int q = nwg / NXCD, r = nwg % NXCD, xcd = wgid % NXCD, off = wgid / NXCD; wgid = (xcd < r ? xcd * (q + 1) : r * (q + 1) + (xcd - r) * q) + off; }
        const int nig = WGM * nN, gid = wgid / nig, fm = gid * WGM, gsz = (nM - fm) < WGM ? (nM - fm) : WGM;
        u.pm = fm + ((wgid % nig) % gsz); u.pn = (wgid % nig) / gsz; u.pk = 0; return true;
    }
    __device__ __forceinline__ void a_ready(const Unit&) const {}
    __device__ __forceinline__ void done(const Unit&) const {}
};
__device__ __forceinline__ unsigned cvt_pk_bf16(float lo, float hi) { unsigned r; asm volatile("v_cvt_pk_bf16_f32 %0, %1, %2" : "=v"(r) : "v"(lo), "v"(hi)); return r; }
template <class Epi, class Sched>
__device__ __forceinline__ void gemm_phase(PG8_LAS unsigned char* lds, const Gemm g, const Sched& S, const Epi& E) {
    int tid_ = threadIdx.x; asm volatile("" : "+v"(tid_));
    const int tid = tid_, wid = __builtin_amdgcn_readfirstlane(tid >> 6), lane = tid & 63, wr = wid >> 2, wc = wid & 3, fr = lane & 15, fq = lane >> 4;
    const int K = g.K, nt = K / BK, ld = g.ld;
    unsigned voffA[2], voffB[2];
#pragma unroll
    for (int i = 0; i < 2; ++i) { int R, C; stage_rc(tid * 16 + i * 8192, R, C); const int Rb = Epi::PERM ? ((R & ~31) + perm32(R & 31)) : R;
        voffA[i] = (unsigned)(R * ld + C) * 2u; voffB[i] = (unsigned)(Rb * ld + C) * 2u; }
    const size_t kstep = (size_t)(BK * 2);
    const size_t hstep = (size_t)HALF * ld * 2;
    const size_t tstep = 2 * hstep;
    const unsigned ldsw = (unsigned)wid * 1024u;
    const int aoff = lds_byte(wr * 64 + fr, fq * 8), boff = lds_byte(wc * 32 + fr, fq * 8);
#define PG8_SA(b, h) (((b) * 2 + (h)) * HTB)
#define PG8_SB(b, h) ((4 + (b) * 2 + (h)) * HTB)
#define PG8_STAGE(bufoff, gbase, voff) do { _Pragma("unroll") for (int _i = 0; _i < 2; ++_i) \
        __builtin_amdgcn_global_load_lds((const unsigned*)((const char*)(gbase) + (voff)[_i]), (PG8_LAS unsigned*)(lds + (bufoff) + ldsw + _i * 8192), 16, 0, 0); } while (0)
#define PG8_LDA(dst, b, h) do { _Pragma("unroll") for (int m = 0; m < 4; ++m) _Pragma("unroll") for (int k = 0; k < 2; ++k) dst[m][k] = *(const PG8_LAS bf16x8*)(lds + PG8_SA(b, h) + aoff + m * 2048 + k * 1024); } while (0)
#define PG8_LDB(dst, b, h) do { _Pragma("unroll") for (int n = 0; n < 2; ++n) _Pragma("unroll") for (int k = 0; k < 2; ++k) dst[n][k] = *(const PG8_LAS bf16x8*)(lds + PG8_SB(b, h) + boff + n * 2048 + k * 1024); } while (0)
#define PG8_MMA(ai, bj, At, Bt) do { __builtin_amdgcn_s_setprio(1); _Pragma("unroll") for (int m = 0; m < 4; ++m) _Pragma("unroll") for (int n = 0; n < 2; ++n) _Pragma("unroll") for (int k = 0; k < 2; ++k) \
        acc[ai][bj][m][n] = __builtin_amdgcn_mfma_f32_16x16x32_bf16(Bt[n][k], At[m][k], acc[ai][bj][m][n], 0, 0, 0); __builtin_amdgcn_s_setprio(0); } while (0)
#define PG8_WAIT_V(n) asm volatile("s_waitcnt vmcnt(" #n ")" ::: "memory")
#define PG8_WAIT_L(n) asm volatile("s_waitcnt lgkmcnt(" #n ")" ::: "memory")
#define PG8_BAR __builtin_amdgcn_s_barrier()
#define PG8_SCHED __builtin_amdgcn_sched_barrier(0)
    Unit cur, nxt; int ui = 0;
    if (!S.next(0, cur)) return;
    f32x4 acc[2][2][4][2];
#pragma unroll
    for (int a = 0; a < 2; ++a)
#pragma unroll
        for (int b = 0; b < 2; ++b)
#pragma unroll
            for (int m = 0; m < 4; ++m)
#pragma unroll
                for (int n = 0; n < 2; ++n) acc[a][b][m][n] = (f32x4){0.f, 0.f, 0.f, 0.f};
    bf16x8 At[4][2], B0[2][2], B1[2][2];
    const char* cA = (const char*)g.A + (size_t)cur.pm * tstep + (size_t)cur.pk * K * 2; const char* cB = (const char*)g.Bt + (size_t)cur.pn * tstep + (size_t)cur.pk * K * 2;
    S.a_ready(cur);
    PG8_STAGE(PG8_SB(0, 0), cB, voffB); PG8_STAGE(PG8_SA(0, 0), cA, voffA); PG8_STAGE(PG8_SB(0, 1), cB + hstep, voffB); PG8_STAGE(PG8_SA(0, 1), cA + hstep, voffA);
    if (wr == 1) PG8_BAR;
    PG8_WAIT_V(4); PG8_BAR;
    PG8_STAGE(PG8_SB(1, 0), cB + kstep, voffB); PG8_STAGE(PG8_SA(1, 0), cA + kstep, voffA); PG8_STAGE(PG8_SB(1, 1), cB + hstep + kstep, voffB);
    PG8_WAIT_V(6); PG8_BAR;
    for (;;) {
        const bool has_next = S.next(ui + 1, nxt);
        const char* nA = has_next ? (const char*)g.A + (size_t)nxt.pm * tstep + (size_t)nxt.pk * K * 2 : cA; const char* nB = has_next ? (const char*)g.Bt + (size_t)nxt.pn * tstep + (size_t)nxt.pk * K * 2 : cB;
        for (int t = 0; t < nt; t += 2) {
            const bool last = (t == nt - 2);
            const char* a1 = cA + (size_t)(t + 1) * kstep;
            const char* a2 = last ? nA : cA + (size_t)(t + 2) * kstep; const char* b2 = last ? nB : cB + (size_t)(t + 2) * kstep;
            const char* a3 = a2 + kstep; const char* b3 = b2 + kstep;
            if (last && has_next) S.a_ready(nxt);
            PG8_LDB(B0, 0, 0); PG8_SCHED; PG8_LDA(At, 0, 0); PG8_STAGE(PG8_SA(1, 1), a1 + hstep, voffA);
            PG8_WAIT_L(8); PG8_BAR; PG8_WAIT_L(0); PG8_MMA(0, 0, At, B0); PG8_BAR; PG8_SCHED;
            PG8_LDB(B1, 0, 1); PG8_STAGE(PG8_SB(0, 0), b2, voffB);
            PG8_BAR; PG8_WAIT_L(0); PG8_MMA(0, 1, At, B1); PG8_BAR;
            PG8_LDA(At, 0, 1); PG8_STAGE(PG8_SA(0, 0), a2, voffA);
            PG8_BAR; PG8_WAIT_L(0); PG8_MMA(1, 0, At, B0); PG8_BAR; PG8_SCHED;
            PG8_STAGE(PG8_SB(0, 1), b2 + hstep, voffB);
            PG8_WAIT_V(6); PG8_BAR; PG8_MMA(1, 1, At, B1); PG8_BAR;
            PG8_LDB(B0, 1, 0); PG8_SCHED; PG8_LDA(At, 1, 0); PG8_STAGE(PG8_SA(0, 1), a2 + hstep, voffA);
            PG8_WAIT_L(8); PG8_BAR; PG8_WAIT_L(0); PG8_MMA(0, 0, At, B0); PG8_BAR; PG8_SCHED;
            PG8_LDB(B1, 1, 1); PG8_STAGE(PG8_SB(1, 0), b3, voffB);
            PG8_BAR; PG8_WAIT_L(0); PG8_MMA(0, 1, At, B1); PG8_BAR;
            PG8_LDA(At, 1, 1); PG8_STAGE(PG8_SA(1, 0), a3, voffA);
            PG8_BAR; PG8_WAIT_L(0); PG8_MMA(1, 0, At, B0); PG8_BAR; PG8_SCHED;
            PG8_STAGE(PG8_SB(1, 1), b3 + hstep, voffB);
            PG8_WAIT_V(6); PG8_BAR; PG8_MMA(1, 1, At, B1); PG8_BAR;
        }
        if constexpr (!Epi::AFTER_DRAIN) { E(acc, cur, wr, wc, fr, fq); S.done(cur); }
        if (!has_next) break;
#pragma unroll
        for (int a = 0; a < 2; ++a)
#pragma unroll
            for (int b = 0; b < 2; ++b)
#pragma unroll
                for (int m = 0; m < 4; ++m)
#pragma unroll
                    for (int n = 0; n < 2; ++n) acc[a][b][m][n] = (f32x4){0.f, 0.f, 0.f, 0.f};
        cur = nxt; cA = nA; cB = nB; ++ui;
    }
    PG8_WAIT_V(0);
    if (wr == 0) PG8_BAR;
    PG8_BAR;
    if constexpr (Epi::AFTER_DRAIN) { E.fused(acc, cur, wr, wc, fr, fq, lds, wid, lane); S.done(cur); }
#undef PG8_SA
#undef PG8_SB
#undef PG8_STAGE
#undef PG8_LDA
#undef PG8_LDB
#undef PG8_MMA
#undef PG8_WAIT_V
#undef PG8_WAIT_L
#undef PG8_BAR
#undef PG8_SCHED
}
}

#define XB_TMO      128
#define XB_XCNT(j)  (256  + 64 * (j))
#define XB_XSUB(j)  (1280 + 64 * (j))
#define XB_XGEN(j)  (2304 + 64 * (j))
#define XB_TOP      3328
#define XB_TOPGEN   3392
#define XCD_BAR_WORDS 3456
#define XB_SPIN_CAP (1u << 18)
#define XLAS __attribute__((address_space(3)))

__device__ __forceinline__ unsigned xb_ld(unsigned* p)              { return __hip_atomic_load(p, __ATOMIC_RELAXED, __HIP_MEMORY_SCOPE_AGENT); }
__device__ __forceinline__ unsigned xb_add(unsigned* p, unsigned v) { return __hip_atomic_fetch_add(p, v, __ATOMIC_RELAXED, __HIP_MEMORY_SCOPE_AGENT); }
__device__ __forceinline__ unsigned xb_xcc_id() { return (unsigned)__builtin_amdgcn_s_getreg((3 << 11) | 20) & 0xFu; }
#define XB_SPIN(cond, bar) do { unsigned _sp = 0; while (cond) { __builtin_amdgcn_s_sleep(1); \
    if ((++_sp & 255u) == 0u) { if (xb_ld(&(bar)[XB_TMO])) break; if (_sp > XB_SPIN_CAP) { atomicAdd(&(bar)[XB_TMO], 1u); break; } } } } while (0)

struct XcdBarrier {
    unsigned* bar; unsigned x;
    volatile XLAS unsigned* st;
};

__device__ __forceinline__ XcdBarrier xcd_barrier_post(unsigned* bar, volatile XLAS unsigned* st) {
    XcdBarrier b; b.bar = bar; b.x = xb_xcc_id(); b.st = st;
    if (threadIdx.x == 0) (void)xb_add(&bar[XB_XCNT(b.x)], 1u);
    return b;
}
__device__ __forceinline__ void xcd_barrier_complete(unsigned* bar, unsigned x, unsigned& nloc, unsigned& nx) {
    const unsigned G = gridDim.x * gridDim.y * gridDim.z;
    unsigned sum, cnt, mine, sp = 0u;
    for (;;) {
        sum = 0u; cnt = 0u; mine = 0u;
#pragma unroll
        for (unsigned j = 0; j < 16; ++j) { const unsigned c = xb_ld(&bar[XB_XCNT(j)]); sum += c; cnt += (c > 0u) ? 1u : 0u; mine = (j == x) ? c : mine; }
        if (sum == G) break;
        __builtin_amdgcn_s_sleep(1);
        if ((++sp & 255u) == 0u) { if (xb_ld(&bar[XB_TMO])) break; if (sp > XB_SPIN_CAP) { atomicAdd(&bar[XB_TMO], 1u); break; } }
    }
    nloc = mine > 0u ? mine : 1u; nx = cnt > 0u ? cnt : 1u;
}

__device__ __forceinline__ void xcd_barrier(const XcdBarrier& b) {
    asm volatile("s_waitcnt vmcnt(0)" ::: "memory");
    __syncthreads();
    if (threadIdx.x == 0) {
        unsigned* bar = b.bar;
        __builtin_amdgcn_s_waitcnt(0);
        unsigned nloc = b.st[0], nx = b.st[1];
        if (nloc == 0u) { xcd_barrier_complete(bar, b.x, nloc, nx); b.st[0] = nloc; b.st[1] = nx; }
        const unsigned old = xb_add(&bar[XB_XSUB(b.x)], 1u);
        const unsigned gen = old / nloc;
        if (old + 1u == (gen + 1u) * nloc) {
            __builtin_amdgcn_fence(__ATOMIC_RELEASE, "agent");
            asm volatile("s_waitcnt vmcnt(0)" ::: "memory");
            const unsigned og = xb_add(&bar[XB_TOP], 1u);
            const unsigned tg = og / nx;
            if (og + 1u == (tg + 1u) * nx) xb_add(&bar[XB_TOPGEN], 1u);
            else XB_SPIN(xb_ld(&bar[XB_TOPGEN]) == tg, bar);
            __builtin_amdgcn_fence(__ATOMIC_ACQUIRE, "agent");
            xb_add(&bar[XB_XGEN(b.x)], 1u);
            asm volatile("s_waitcnt vmcnt(0)" ::: "memory");
        } else {
            XB_SPIN(xb_ld(&bar[XB_XGEN(b.x)]) == gen, bar);
            __builtin_amdgcn_fence(__ATOMIC_ACQUIRE, "agent");
            asm volatile("s_waitcnt vmcnt(0)" ::: "memory");
        }
    }
    __syncthreads();
}

using pg8::bf16_t; using pg8::f32x4; using pg8::bf16x8;
typedef unsigned u32x4_t __attribute__((ext_vector_type(4)));
typedef unsigned u32x2_t __attribute__((ext_vector_type(2)));

constexpr int DM = 1024, NBP = 8, SEQ = 2048, NBS = 128, SSEQ = 4, NH = 4, HD = 128, MW = 512;
constexpr int MP = NBP * SEQ, MS = NBS * SSEQ, MT = MP + MS;
constexpr int NIN = 9232, N1 = 9216, DFF = 2816, NUP = 5632;
constexpr float EPS = 1e-6f;
constexpr float QSCALE = 0.08838834764831845f;

constexpr size_t O_Y = 0;
constexpr size_t O_P_GS = (size_t)MT * DM;
constexpr size_t O_P_GC = O_P_GS + (size_t)2 * 8 * 4 * 128 * 128;
constexpr size_t O_P_MC = O_P_GC + (size_t)2 * 8 * 3 * 1536;
constexpr size_t O_P_MN = O_P_MC + (size_t)2 * 8 * 4 * 128 * 128;
constexpr size_t O_P_MM = O_P_MN + (size_t)2 * 8 * 4 * 128;
constexpr size_t O_P_HS = O_P_MM + (size_t)2 * 8 * 4;
constexpr size_t O_P_FC = O_P_HS + (size_t)2 * 8 * 4 * 128 * 128;
constexpr size_t O_S_GS = O_P_FC + (size_t)2 * 8 * 2 * 5632;
constexpr size_t O_S_GC = O_S_GS + (size_t)2 * 128 * 4 * 128 * 128;
constexpr size_t O_S_MC = O_S_GC + (size_t)2 * 128 * 3 * 1536;
constexpr size_t O_S_MN = O_S_MC + (size_t)2 * 128 * 4 * 128 * 128;
constexpr size_t O_S_MM = O_S_MN + (size_t)2 * 128 * 4 * 128;
constexpr size_t O_S_HS = O_S_MM + (size_t)2 * 128 * 4;
constexpr size_t O_S_FC = O_S_HS + (size_t)2 * 128 * 4 * 128 * 128;
constexpr size_t O_END  = O_S_FC + (size_t)2 * 128 * 2 * 5632;

constexpr size_t W_WIN = 0;
constexpr size_t W_WBR = W_WIN + (size_t)N1 * 1024 * 2;
constexpr size_t W_WOUT = W_WBR + (size_t)3 * 1024 * 512 * 2;
constexpr size_t W_WUP = W_WOUT + (size_t)1024 * 1024 * 2;
constexpr size_t W_WDN = W_WUP + (size_t)NUP * 1024 * 2;
constexpr size_t W_HBF = W_WDN + (size_t)1024 * DFF * 2;
constexpr size_t W_PROJ = W_HBF + (size_t)MT * 1024 * 2;
constexpr size_t W_ACT = W_PROJ + (size_t)MT * NUP * 2;
constexpr size_t W_OUTS = W_PROJ + (size_t)MT * N1 * 2;
constexpr size_t W_GATES = W_OUTS + (size_t)3 * MT * 512 * 2;
constexpr size_t W_DEN = W_GATES + (size_t)MT * 16 * 4;
constexpr size_t W_MT = W_DEN + (size_t)MT * 4 * 4;
constexpr size_t W_BAR = W_MT + (size_t)MT * 4 * 4;
constexpr size_t W_END = W_BAR + 16384;

constexpr int LDS_MAIN = 143360;
constexpr int LDS_BYTES = LDS_MAIN + 64 + 512;

struct Params { const float* in[28]; float* out; unsigned char* ws; };
enum { I_XP = 0, I_XS, I_SGS, I_SGC, I_SMC, I_SMN, I_SMM, I_SHS, I_SFC, I_LNMIX, I_WIN, I_GCW, I_ALOG, I_DTB, I_GNORM, I_MIB, I_MFB, I_MNORM, I_HLB, I_HNORM,
       I_WBR, I_WOUT, I_LNFFN, I_WUP, I_FCW, I_FCB, I_WDN, I_LNF };

typedef const float* const __attribute__((address_space(4))) * kargp_t;
__device__ __forceinline__ const float* argp(int i) { kargp_t kp = (kargp_t)__builtin_amdgcn_kernarg_segment_ptr(); asm volatile("" : "+s"(i)); return kp[i]; }
__device__ __forceinline__ int bidx() { int b = (int)blockIdx.x; asm volatile("" : "+s"(b)); return b; }
__device__ __forceinline__ int gdim() { int g = (int)gridDim.x; asm volatile("" : "+s"(g)); return g; }
#define PIN(i) argp(i)
#define POUT ((float*)argp(28))
#define PWS ((unsigned char*)argp(29))
__device__ __forceinline__ float bf2f(bf16_t b) { return __uint_as_float(((unsigned)b) << 16); }
__device__ __forceinline__ float bflo(unsigned u) { return __uint_as_float(u << 16); }
__device__ __forceinline__ float bfhi(unsigned u) { return __uint_as_float(u & 0xffff0000u); }
__device__ __forceinline__ bf16_t f2bf(float f) { return (bf16_t)(pg8::cvt_pk_bf16(f, 0.f) & 0xffffu); }
__device__ __forceinline__ float sigm(float x) { return __builtin_amdgcn_rcpf(1.f + __expf(-x)); }
__device__ __forceinline__ float silu(float x) { return x * sigm(x); }
__device__ __forceinline__ float rdlane(float x, int l) { return __builtin_bit_cast(float, __builtin_amdgcn_readlane(__builtin_bit_cast(int, x), l)); }
template <int CTRL> __device__ __forceinline__ float dppf(float x) { return __builtin_bit_cast(float, __builtin_amdgcn_update_dpp(0, __builtin_bit_cast(int, x), CTRL, 0xf, 0xf, true)); }
__device__ __forceinline__ float grp_sum8(float x) { x += dppf<0xB1>(x); x += dppf<0x4E>(x); x += dppf<0x141>(x); return x; }
__device__ __forceinline__ float grp_sum16(float x) { x = grp_sum8(x); x += dppf<0x140>(x); return x; }
__device__ __forceinline__ float wave_sum(float x) { x = grp_sum16(x);
    x += __builtin_bit_cast(float, __builtin_amdgcn_update_dpp(0, __builtin_bit_cast(int, x), 0x142, 0xa, 0xf, false));
    x += __builtin_bit_cast(float, __builtin_amdgcn_update_dpp(0, __builtin_bit_cast(int, x), 0x143, 0xc, 0xf, false));
    return rdlane(x, 63); }
template <int CTRL> __device__ __forceinline__ float dppm(float x) { return __builtin_bit_cast(float, __builtin_amdgcn_update_dpp(__builtin_bit_cast(int, -INFINITY), __builtin_bit_cast(int, x), CTRL, 0xf, 0xf, false)); }
template <int T> __device__ __forceinline__ float grp_sum(float x) { if constexpr (T == 16) return grp_sum16(x); else return grp_sum8(x); }

__device__ __forceinline__ int win_srccol(int n0) { const int blk = n0 >> 9, r = n0 & 511; int base;
    if (blk < 4) base = blk * 512; else if (blk < 8) base = 2056 + (blk - 4) * 512; else if (blk < 12) base = 4112 + (blk - 8) * 512; else base = 6160 + (blk - 12) * 512;
    return base + r; }
__device__ __forceinline__ void conv_T(const float* __restrict__ src, int ld, bf16_t* __restrict__ dst, int K, int N, bool winmap, float* tile, int& tcount) {
    int tid_ = threadIdx.x; asm volatile("" : "+v"(tid_)); const int tid = tid_, ntn = N / 64, ntiles = ntn * (K / 64);
    for (int t = bidx() - (tcount % gdim()); t < ntiles; t += gdim()) {
        if (t < 0) continue;
        const int tn = t % ntn, tk = t / ntn, n0 = tn * 64, k0 = tk * 64, sc0 = winmap ? win_srccol(n0) : n0;
        __syncthreads();
        { const int kk = tid >> 4, n4 = (tid & 15) * 4;
#pragma unroll
          for (int pp = 0; pp < 2; ++pp) { const float4 v = *(const float4*)(src + (size_t)(k0 + kk + 32 * pp) * ld + sc0 + n4); float* tp = tile + (kk + 32 * pp) * 65 + n4; tp[0] = v.x; tp[1] = v.y; tp[2] = v.z; tp[3] = v.w; } }
        __syncthreads();
        { const int n = tid >> 3, k8 = (tid & 7) * 8; float f[8];
#pragma unroll
          for (int i = 0; i < 8; ++i) f[i] = tile[(k8 + i) * 65 + n];
          u32x4_t o; o[0] = pg8::cvt_pk_bf16(f[0], f[1]); o[1] = pg8::cvt_pk_bf16(f[2], f[3]); o[2] = pg8::cvt_pk_bf16(f[4], f[5]); o[3] = pg8::cvt_pk_bf16(f[6], f[7]);
          *(u32x4_t*)(dst + (size_t)(n0 + n) * K + k0 + k8) = o; }
    }
    tcount += ntiles;
}

__device__ __forceinline__ void phase_rmsnorm(const Params& p, int l, const float* xa, const float* xb, const float* __restrict__ gw, bf16_t* __restrict__ hout, bool do_gates, float* sm) {
    int tid_ = threadIdx.x; asm volatile("" : "+v"(tid_)); const int tid = tid_, lane = tid & 63, w = tid >> 6;
    float* wgT = sm;
    if (do_gates) {
        const float* win = PIN(I_WIN) + (size_t)l * 1024 * NIN;
        __syncthreads();
        for (int i = tid; i < 16 * 1024; i += 512) { const int k = i >> 4, j = i & 15; const int gc = j < 8 ? 2048 + j : 4104 + (j - 8); wgT[j * 1024 + k] = win[(size_t)k * NIN + gc]; }
        __syncthreads();
    }
    float4 g4[4];
#pragma unroll
    for (int i = 0; i < 4; ++i) g4[i] = *(const float4*)(gw + lane * 4 + 256 * i);
    for (int row = bidx() * 8 + w; row < MT; row += gdim() * 8) {
        const float* xr = row < MP ? xa + (size_t)row * DM : xb + (size_t)(row - MP) * DM;
        float4 v[4]; float ss = 0.f;
#pragma unroll
        for (int i = 0; i < 4; ++i) { v[i] = *(const float4*)(xr + lane * 4 + 256 * i); ss += v[i].x * v[i].x + v[i].y * v[i].y + v[i].z * v[i].z + v[i].w * v[i].w; }
        ss = wave_sum(ss);
        const float rstd = rsqrtf(ss * (1.f / 1024.f) + EPS);
#pragma unroll
        for (int i = 0; i < 4; ++i) { v[i].x *= rstd * g4[i].x; v[i].y *= rstd * g4[i].y; v[i].z *= rstd * g4[i].z; v[i].w *= rstd * g4[i].w;
            u32x2_t o; o[0] = pg8::cvt_pk_bf16(v[i].x, v[i].y); o[1] = pg8::cvt_pk_bf16(v[i].z, v[i].w);
            *(u32x2_t*)(hout + (size_t)row * DM + lane * 4 + 256 * i) = o; }
        if (do_gates) {
            float mine = 0.f;
#pragma unroll
            for (int j = 0; j < 16; ++j) { float a = 0.f;
#pragma unroll
                for (int i = 0; i < 4; ++i) { const float4 wv = *(const float4*)(wgT + j * 1024 + lane * 4 + 256 * i); a += v[i].x * wv.x + v[i].y * wv.y + v[i].z * wv.z + v[i].w * wv.w; }
                a = wave_sum(a); if (lane == j) mine = a; }
            if (lane < 16) { const int h = lane & 3, kind = lane >> 2; float r;
                if (kind == 0) r = sigm(mine);
                else if (kind == 1) { const float xx = mine + PIN(I_DTB)[l * 4 + h]; const float sp = xx > 20.f ? xx : __logf(1.f + __expf(xx)); r = __expf(-__expf(PIN(I_ALOG)[l * 4 + h]) * sp); }
                else if (kind == 2) r = mine + PIN(I_MIB)[l * 4 + h];
                else { const float xx = -(mine + PIN(I_MFB)[l * 4 + h]); r = -(xx > 20.f ? xx : __logf(1.f + __expf(xx))); }
                ((float*)(PWS + W_GATES))[(size_t)row * 16 + lane] = r; }
        }
    }
}

struct EpiProj {
    static constexpr bool PERM = true, AFTER_DRAIN = false;
    bf16_t* O; int ldc; int actmode;
    __device__ __forceinline__ void operator()(const f32x4 (&acc)[2][2][4][2], const pg8::Unit& u, int wr, int wc, int fr, int fq) const {
        const int row0 = u.pm * 256 + wr * 64 + fr, col0 = u.pn * 256 + wc * 32 + 8 * fq;
        int act = 0;
        if (actmode) { const int pn = u.pn; act = (pn >= 24 || pn == 14 || pn == 15) ? 2 : ((pn == 6 || pn == 7 || pn == 16 || pn == 17 || pn == 22 || pn == 23) ? 1 : 0); }
#pragma unroll
        for (int ai = 0; ai < 2; ++ai)
#pragma unroll
            for (int m = 0; m < 4; ++m) { bf16_t* rowp = O + (size_t)(row0 + ai * 128 + m * 16) * ldc + col0;
#pragma unroll
                for (int bj = 0; bj < 2; ++bj) { float v[8];
#pragma unroll
                    for (int i = 0; i < 4; ++i) { v[i] = acc[ai][bj][m][0][i]; v[4 + i] = acc[ai][bj][m][1][i]; }
                    if (act == 1) {
#pragma unroll
                        for (int i = 0; i < 8; ++i) v[i] = silu(v[i]); }
                    else if (act == 2) {
#pragma unroll
                        for (int i = 0; i < 8; ++i) v[i] = sigm(v[i]); }
                    u32x4_t o; o[0] = pg8::cvt_pk_bf16(v[0], v[1]); o[1] = pg8::cvt_pk_bf16(v[2], v[3]); o[2] = pg8::cvt_pk_bf16(v[4], v[5]); o[3] = pg8::cvt_pk_bf16(v[6], v[7]);
                    *(u32x4_t*)(rowp + bj * 128) = o; } }
    }
};
struct EpiMerge {
    static constexpr bool PERM = true, AFTER_DRAIN = false;
    const bf16_t* G; bf16_t* Mx;
    __device__ __forceinline__ void operator()(const f32x4 (&acc)[2][2][4][2], const pg8::Unit& u, int wr, int wc, int fr, int fq) const {
        const int n = u.pn >> 2, first = (n == 0);
        const int row0 = (u.pm - n * (MT / 256)) * 256 + wr * 64 + fr, col0 = (u.pn & 3) * 256 + wc * 32 + 8 * fq;
        const bf16_t* Gn = G + n * 1024 + col0; bf16_t* Mc = Mx + col0;
        u32x4_t gc[2], oc[2], gn[2], on[2];
#pragma unroll
        for (int bj = 0; bj < 2; ++bj) { gc[bj] = *(const u32x4_t*)(Gn + (size_t)row0 * N1 + bj * 128); oc[bj] = first ? (u32x4_t){0u, 0u, 0u, 0u} : *(const u32x4_t*)(Mc + (size_t)row0 * DM + bj * 128); }
#pragma unroll
        for (int gI = 0; gI < 8; ++gI) { const int ai = gI >> 2, m = gI & 3; const size_t row = (size_t)(row0 + ai * 128 + m * 16);
            if (gI < 7) { const size_t row2 = (size_t)(row0 + ((gI + 1) >> 2) * 128 + ((gI + 1) & 3) * 16);
#pragma unroll
                for (int bj = 0; bj < 2; ++bj) { gn[bj] = *(const u32x4_t*)(Gn + row2 * N1 + bj * 128); on[bj] = first ? (u32x4_t){0u, 0u, 0u, 0u} : *(const u32x4_t*)(Mc + row2 * DM + bj * 128); } }
#pragma unroll
            for (int bj = 0; bj < 2; ++bj) { float v[8];
#pragma unroll
                for (int i = 0; i < 4; ++i) { v[i] = acc[ai][bj][m][0][i]; v[4 + i] = acc[ai][bj][m][1][i]; }
#pragma unroll
                for (int i = 0; i < 4; ++i) { v[2 * i] = v[2 * i] * bflo(gc[bj][i]) + bflo(oc[bj][i]); v[2 * i + 1] = v[2 * i + 1] * bfhi(gc[bj][i]) + bfhi(oc[bj][i]); }
                u32x4_t o; o[0] = pg8::cvt_pk_bf16(v[0], v[1]); o[1] = pg8::cvt_pk_bf16(v[2], v[3]); o[2] = pg8::cvt_pk_bf16(v[4], v[5]); o[3] = pg8::cvt_pk_bf16(v[6], v[7]);
                *(u32x4_t*)(Mc + row * DM + bj * 128) = o; }
#pragma unroll
            for (int bj = 0; bj < 2; ++bj) { gc[bj] = gn[bj]; oc[bj] = on[bj]; } }
    }
};
struct EpiResid {
    static constexpr bool PERM = false, AFTER_DRAIN = false;
    float* X; const float* Sa; const float* Sb;
    __device__ __forceinline__ void operator()(const f32x4 (&acc)[2][2][4][2], const pg8::Unit& u, int wr, int wc, int fr, int fq) const {
        const int row0 = u.pm * 256 + wr * 64 + fr, col0 = u.pn * 256 + wc * 32 + 4 * fq;
        const float* S = u.pm * 256 < MP ? Sa : Sb - (size_t)MP * DM;
        f32x4 cur[4], nxt[4];
#pragma unroll
        for (int q = 0; q < 4; ++q) cur[q] = *(const f32x4*)(S + (size_t)row0 * DM + col0 + (q >> 1) * 128 + (q & 1) * 16);
#pragma unroll
        for (int gI = 0; gI < 8; ++gI) { const int ai = gI >> 2, m = gI & 3; const size_t ro = (size_t)(row0 + ai * 128 + m * 16) * DM + col0;
            if (gI < 7) { const int ai2 = (gI + 1) >> 2, m2 = (gI + 1) & 3; const size_t ro2 = (size_t)(row0 + ai2 * 128 + m2 * 16) * DM + col0;
#pragma unroll
                for (int q = 0; q < 4; ++q) nxt[q] = *(const f32x4*)(S + ro2 + (q >> 1) * 128 + (q & 1) * 16); }
#pragma unroll
            for (int q = 0; q < 4; ++q) *(f32x4*)(X + ro + (q >> 1) * 128 + (q & 1) * 16) = cur[q] + acc[ai][q >> 1][m][q & 1];
#pragma unroll
            for (int q = 0; q < 4; ++q) cur[q] = nxt[q]; }
    }
};

struct EpiAtomic {
    static constexpr bool PERM = false, AFTER_DRAIN = false;
    float* X;
    __device__ __forceinline__ void operator()(const f32x4 (&acc)[2][2][4][2], const pg8::Unit& u, int wr, int wc, int fr, int fq) const {
        const int row0 = u.pm * 256 + wr * 64 + fr, col0 = u.pn * 256 + wc * 32 + 4 * fq;
#pragma unroll
        for (int ai = 0; ai < 2; ++ai)
#pragma unroll
            for (int m = 0; m < 4; ++m) { float* rowp = X + (size_t)(row0 + ai * 128 + m * 16) * DM + col0;
#pragma unroll
                for (int bj = 0; bj < 2; ++bj)
#pragma unroll
                    for (int n = 0; n < 2; ++n)
#pragma unroll
                        for (int e = 0; e < 4; ++e) unsafeAtomicAdd(rowp + bj * 128 + n * 16 + e, acc[ai][bj][m][n][e]); }
    }
};
struct MergeOrder {
    pg8::StaticOrder base;
    __device__ void init(int G_, int c_) { base.init(MT, 1024, G_, c_); }
    __device__ bool next(int i, pg8::Unit& u) const { const int t = i / 3, n = i - 3 * t; pg8::Unit b; if (!base.next(t, b)) return false; u.pm = n * (MT / 256) + b.pm; u.pn = n * 4 + b.pn; u.pk = 0; return true; }
    __device__ __forceinline__ void a_ready(const pg8::Unit&) const {}
    __device__ __forceinline__ void done(const pg8::Unit&) const {}
};
struct PieceOrder {
    int G, c, KP;
    __device__ bool next(int i, pg8::Unit& u) const { const int L = i * G + c; if (L >= 8 * KP) return false; const int tile = L / KP; u.pk = L - tile * KP; u.pm = MP / 256 + (tile >> 2); u.pn = tile & 3; return true; }
    __device__ __forceinline__ void a_ready(const pg8::Unit&) const {}
    __device__ __forceinline__ void done(const pg8::Unit&) const {}
};
__device__ __forceinline__ void phase_gdnprep(const Params& p, int l) {
    int tid_ = threadIdx.x; asm volatile("" : "+v"(tid_)); const int tid = tid_, j = tid & 15;
    const bf16_t* proj = (const bf16_t*)(PWS + W_PROJ);
    bf16_t* qkd = (bf16_t*)(PWS + W_HBF); bf16_t* vd = (bf16_t*)(PWS + W_OUTS);
    const float* cw = PIN(I_GCW) + (size_t)l * 4 * 1536; const float* cst = PIN(I_SGC) + (size_t)l * NBS * 3 * 1536;
    const int ngroups = MT * 12;
    for (int gid = bidx() * 32 + (tid >> 4); gid < ngroups; gid += gdim() * 32) {
        const int r = gid / 12, part = gid - r * 12, col = part * 128 + 8 * j;
        const bool samp = r >= MP; const int t = samp ? ((r - MP) & 3) : (r & (SEQ - 1)), b2 = samp ? ((r - MP) >> 2) : 0;
        float y[8];
#pragma unroll
        for (int i = 0; i < 8; ++i) y[i] = 0.f;
#pragma unroll
        for (int jj = 0; jj < 4; ++jj) { const int tt = t - 3 + jj; float x[8];
            if (tt >= 0) { const u32x4_t raw = *(const u32x4_t*)(proj + (size_t)(r - 3 + jj) * N1 + col);
#pragma unroll
                for (int i = 0; i < 4; ++i) { x[2 * i] = bflo(raw[i]); x[2 * i + 1] = bfhi(raw[i]); } }
            else if (samp) { const float* cp = cst + (size_t)(b2 * 3 + 3 + tt) * 1536 + col; const float4 a0 = *(const float4*)cp, a1 = *(const float4*)(cp + 4);
                x[0] = a0.x; x[1] = a0.y; x[2] = a0.z; x[3] = a0.w; x[4] = a1.x; x[5] = a1.y; x[6] = a1.z; x[7] = a1.w; }
            else {
#pragma unroll
                for (int i = 0; i < 8; ++i) x[i] = 0.f; }
            const float4 w0 = *(const float4*)(cw + jj * 1536 + col), w1 = *(const float4*)(cw + jj * 1536 + col + 4);
            y[0] += w0.x * x[0]; y[1] += w0.y * x[1]; y[2] += w0.z * x[2]; y[3] += w0.w * x[3]; y[4] += w1.x * x[4]; y[5] += w1.y * x[5]; y[6] += w1.z * x[6]; y[7] += w1.w * x[7]; }
        float ss = 0.f;
#pragma unroll
        for (int i = 0; i < 8; ++i) { y[i] = silu(y[i]); ss += y[i] * y[i]; }
        ss = grp_sum16(ss);
        const float scl = part < 4 ? rsqrtf(ss + EPS) * QSCALE : (part < 8 ? rsqrtf(ss + EPS) : 1.f);
        u32x4_t o; o[0] = pg8::cvt_pk_bf16(y[0] * scl, y[1] * scl); o[1] = pg8::cvt_pk_bf16(y[2] * scl, y[3] * scl); o[2] = pg8::cvt_pk_bf16(y[4] * scl, y[5] * scl); o[3] = pg8::cvt_pk_bf16(y[6] * scl, y[7] * scl);
        if (part < 8) *(u32x4_t*)(qkd + (size_t)r * 1024 + col) = o; else *(u32x4_t*)(vd + (size_t)r * 512 + (col - 1024)) = o;
    }
}

__device__ __forceinline__ void lds_barrier() { asm volatile("s_waitcnt lgkmcnt(0)" ::: "memory"); __builtin_amdgcn_s_barrier(); asm volatile("" ::: "memory"); }
typedef float f2 __attribute__((ext_vector_type(2)));
typedef float f4 __attribute__((ext_vector_type(4)));
template <int MIX>
__device__ __forceinline__ void scan_prompt_item(const Params& p, int l, int b, int h, int cgp, float* sm) {
    constexpr int T = 16, CPL = (MIX == 0) ? 1 : 2, NG = 128 / (4 * T), NP = 2 * NG, CPW = (64 / T) * CPL, CPG = 8 * CPW, TB = 32, BUFSZ = 14464, NBLK = SEQ / TB;
    int tid_ = threadIdx.x; asm volatile("" : "+v"(tid_)); const int tid = tid_, lane = tid & 63, w = tid >> 6, c = lane / T, j = lane % T;
    const int col = w * CPW + c, ecol = cgp * CPG + col;
    float* misc = sm + 2 * BUFSZ; float* gsc = misc; float* mcar = misc + 64;
    const float* gates = (const float*)(PWS + W_GATES);
    bf16_t* outp = (bf16_t*)(PWS + W_OUTS) + (size_t)MIX * MT * 512;
    const size_t rb = (size_t)b * SEQ;
    const int c8 = (tid & 31) * 8, srow = tid >> 5;
    const bf16_t* qsrc; size_t qld; const bf16_t* vsrc; size_t vld;
    if (MIX == 0) { qsrc = (const bf16_t*)(PWS + W_HBF) + rb * 1024 + (c8 < 128 ? h * 128 + c8 : 512 + h * 128 + (c8 - 128)); qld = 1024;
        vsrc = (const bf16_t*)(PWS + W_OUTS) + rb * 512 + h * 128 + cgp * 32; vld = 512; }
    else { const int base = MIX == 1 ? 2048 : 4096; qsrc = (const bf16_t*)(PWS + W_PROJ) + rb * N1 + base + (c8 < 128 ? h * 128 + c8 : 512 + h * 128 + (c8 - 128)); qld = N1;
        vsrc = (const bf16_t*)(PWS + W_PROJ) + rb * N1 + base + 1024 + h * 128 + cgp * 64; vld = N1; }
    constexpr int VPC = CPG / 8;
    const int vs = tid / VPC, vc8 = (tid % VPC) * 8; const bool vact = tid < TB * VPC;
    float lb8[8];
#pragma unroll
    for (int i = 0; i < 8; ++i) lb8[i] = 0.f;
    if (MIX == 2 && l > 0 && c8 >= 128) { const float* hl = PIN(I_HLB);
#pragma unroll
        for (int i = 0; i < 8; ++i) { const int cc = h * 128 + (c8 - 128) + i; lb8[i] = sigm(hl[512 + cc] - hl[cc]); } }
    f2 S2[CPL][NP];
#pragma unroll
    for (int cc = 0; cc < CPL; ++cc)
#pragma unroll
        for (int i = 0; i < NP; ++i) S2[cc][i] = (f2){0.f, 0.f};
    float nn = 0.f, okeep[CPL], oprev[CPL];
#pragma unroll
    for (int cc = 0; cc < CPL; ++cc) { okeep[cc] = 0.f; oprev[cc] = 0.f; }
    u32x4_t rq[2][2], rv[2]; float rg0[2] = {0.f, 0.f}, rg1[2] = {0.f, 0.f};
    rv[0] = (u32x4_t){0u, 0u, 0u, 0u}; rv[1] = rv[0];
#define SCAN_ISSUE(t0_, st_) do { \
        _Pragma("unroll") for (int i_ = 0; i_ < 2; ++i_) rq[st_][i_] = *(const u32x4_t*)(qsrc + (size_t)((t0_) + srow + 16 * i_) * qld); \
        if (vact) rv[st_] = *(const u32x4_t*)(vsrc + (size_t)((t0_) + vs) * vld + vc8); \
        if (MIX != 2 && tid < TB) { const size_t r_ = rb + (t0_) + tid; rg0[st_] = gates[r_ * 16 + (MIX == 0 ? 0 : 8) + h]; rg1[st_] = gates[r_ * 16 + (MIX == 0 ? 4 : 12) + h]; } } while (0)
#define SCAN_FINISH(B_, st_) do { float* qk_ = (B_); float* vv_ = (B_) + 8192; float* sc_ = (B_) + 10240; \
        _Pragma("unroll") for (int i_ = 0; i_ < 2; ++i_) { float x_[8]; \
            _Pragma("unroll") for (int e_ = 0; e_ < 4; ++e_) { x_[2 * e_] = bflo(rq[st_][i_][e_]); x_[2 * e_ + 1] = bfhi(rq[st_][i_][e_]); } \
            if (MIX == 2 && c8 >= 128) { _Pragma("unroll") for (int e_ = 0; e_ < 8; ++e_) x_[e_] = lb8[e_] + (1.f - lb8[e_]) * sigm(x_[e_]); } \
            float* d_ = qk_ + (srow + 16 * i_) * 256 + c8; *(f4*)d_ = (f4){x_[0], x_[1], x_[2], x_[3]}; *(f4*)(d_ + 4) = (f4){x_[4], x_[5], x_[6], x_[7]}; } \
        if (vact) { float* d_ = vv_ + vs * 64 + vc8; *(f4*)d_ = (f4){bflo(rv[st_][0]), bfhi(rv[st_][0]), bflo(rv[st_][1]), bfhi(rv[st_][1])}; *(f4*)(d_ + 4) = (f4){bflo(rv[st_][2]), bfhi(rv[st_][2]), bflo(rv[st_][3]), bfhi(rv[st_][3])}; } \
        if (MIX == 0 && tid < TB) { sc_[tid * 4] = rg0[st_]; sc_[tid * 4 + 1] = rg1[st_]; } \
        if (MIX == 1 && tid < TB) { gsc[tid * 2] = rg0[st_]; gsc[tid * 2 + 1] = rg1[st_]; } } while (0)
#define SCAN_CHAIN(B_) do { if (w == 1) { float* sc_ = (B_) + 10240; const int ls_ = lane & 31; const float m0_ = mcar[0]; \
            const float ig_ = gsc[2 * ls_], lf_ = gsc[2 * ls_ + 1]; \
            float F_ = lf_; F_ += dppf<0x111>(F_); F_ += dppf<0x112>(F_); F_ += dppf<0x114>(F_); F_ += dppf<0x118>(F_);              \
            { const float t0_ = rdlane(F_, 15); if (lane & 16) F_ += t0_; } \
            float P_ = ig_ - F_; P_ = fmaxf(P_, dppm<0x111>(P_)); P_ = fmaxf(P_, dppm<0x112>(P_)); P_ = fmaxf(P_, dppm<0x114>(P_)); P_ = fmaxf(P_, dppm<0x118>(P_)); \
            { const float t1_ = rdlane(P_, 15); if (lane & 16) P_ = fmaxf(P_, t1_); } \
            const float m_ = F_ + fmaxf(m0_, P_); \
            float mp_ = dppf<0x111>(m_); { const float t2_ = rdlane(m_, 15); if ((lane & 15) == 0) mp_ = (lane & 16) ? t2_ : m0_; } \
            const float mlast_ = rdlane(m_, 31); \
            if (lane < 32) { sc_[lane * 4] = __expf(lf_ + mp_ - m_); sc_[lane * 4 + 1] = __expf(ig_ - m_) * QSCALE; sc_[lane * 4 + 2] = m_; } \
            if (lane == 0) mcar[0] = mlast_; } } while (0)
    if (MIX == 1 && tid == 64) mcar[0] = 0.f;
    __syncthreads();
    SCAN_ISSUE(0, 0);
    SCAN_FINISH(sm, 0);
    SCAN_ISSUE(TB, 1);
    __syncthreads();
    if (MIX == 1) { SCAN_CHAIN(sm); __syncthreads(); }
#pragma unroll 1
    for (int blk2 = 0; blk2 < NBLK; blk2 += 2) {
#pragma unroll
      for (int par = 0; par < 2; ++par) {
        const int blk = blk2 + par;
        const int t0 = blk * TB;
        float* B = sm + (blk & 1) * BUFSZ; float* Bn = sm + ((blk & 1) ^ 1) * BUFSZ;
        const float* qk = B; const float* vv = B + 8192; const float* sc = B + 10240; float* denp = B + 10368;
        if (blk + 2 < NBLK) SCAN_ISSUE(t0 + 2 * TB, par);
        f4 qa[2][NG], ka[2][NG]; float va[2][CPL], sa[2], sb[2], kda[2], qda[2];
#define SCAN_LOADOPS(slot_, s_) do { const float* qs_ = qk + (s_) * 256; \
            _Pragma("unroll") for (int g_ = 0; g_ < NG; ++g_) { qa[slot_][g_] = *(const f4*)(qs_ + g_ * 4 * T + 4 * j); ka[slot_][g_] = *(const f4*)(qs_ + 128 + g_ * 4 * T + 4 * j); } \
            _Pragma("unroll") for (int cc_ = 0; cc_ < CPL; ++cc_) va[slot_][cc_] = vv[(s_) * 64 + col + 4 * cc_]; \
            if (MIX != 2) { sa[slot_] = sc[(s_) * 4]; sb[slot_] = sc[(s_) * 4 + 1]; } \
            if (MIX == 1) { const int dn_ = 16 * w + (lane & 15); kda[slot_] = qs_[128 + dn_]; qda[slot_] = qs_[dn_]; } } while (0)
        SCAN_LOADOPS(0, 0);
#pragma unroll 1
        for (int sg = 0; sg < TB; sg += T) {
#pragma unroll
            for (int ss = 0; ss < T; ++ss) {
                const int s = sg + ss; constexpr int dummy = 0; (void)dummy;
                const int cur = ss & 1, nxt = cur ^ 1;
                SCAN_LOADOPS(nxt, (s + 1) & (TB - 1));
                __builtin_amdgcn_sched_barrier(0);
                f2 qq[NP], kk[NP];
#pragma unroll
                for (int g = 0; g < NG; ++g) { qq[2 * g] = qa[cur][g].xy; qq[2 * g + 1] = qa[cur][g].zw; kk[2 * g] = ka[cur][g].xy; kk[2 * g + 1] = ka[cur][g].zw; }
                float onew[CPL];
#pragma unroll
                for (int cc = 0; cc < CPL; ++cc) {
                    const float v = va[cur][cc];
                    f2 oa = (f2){0.f, 0.f}, ob = (f2){0.f, 0.f};
                    if (MIX == 0) {
                        const float beta = sa[cur], a = sb[cur];
                        f2 ka2 = kk[0] * S2[cc][0], kb2 = kk[1] * S2[cc][1];
#pragma unroll
                        for (int i = 2; i < NP; i += 2) { ka2 = kk[i] * S2[cc][i] + ka2; kb2 = kk[i + 1] * S2[cc][i + 1] + kb2; }
                        ka2 = ka2 + kb2;
                        const float ks = grp_sum<T>(ka2.x + ka2.y);
                        const float u = beta * (v - a * ks);
                        const f2 a2 = (f2){a, a}, u2 = (f2){u, u};
#pragma unroll
                        for (int i = 0; i < NP; i += 2) { S2[cc][i] = S2[cc][i] * a2 + kk[i] * u2; S2[cc][i + 1] = S2[cc][i + 1] * a2 + kk[i + 1] * u2; oa = qq[i] * S2[cc][i] + oa; ob = qq[i + 1] * S2[cc][i + 1] + ob; }
                    } else if (MIX == 1) {
                        const float fp = sa[cur], ip = sb[cur], iv = ip * v;
                        const f2 f2v = (f2){fp, fp}, iv2 = (f2){iv, iv};
#pragma unroll
                        for (int i = 0; i < NP; i += 2) { S2[cc][i] = S2[cc][i] * f2v + kk[i] * iv2; S2[cc][i + 1] = S2[cc][i + 1] * f2v + kk[i + 1] * iv2; oa = qq[i] * S2[cc][i] + oa; ob = qq[i + 1] * S2[cc][i + 1] + ob; }
                    } else {
                        const f2 v2 = (f2){v, v};
#pragma unroll
                        for (int i = 0; i < NP; i += 2) { S2[cc][i] = kk[i] * (S2[cc][i] - v2) + v2; S2[cc][i + 1] = kk[i + 1] * (S2[cc][i + 1] - v2) + v2; oa = qq[i] * S2[cc][i] + oa; ob = qq[i + 1] * S2[cc][i + 1] + ob; }
                    }
                    oa = oa + ob; onew[cc] = oa.x + oa.y;
                }
                if (MIX == 1) { const float fp = sa[cur], ip = sb[cur];
                    nn = fp * nn + ip * kda[cur];
                    denp[s * 128 + 16 * w + (lane & 15)] = qda[cur] * nn; }
#pragma unroll
                for (int cc = 0; cc < CPL; ++cc) {
                    if (ss > 0) { const float o = grp_sum<T>(oprev[cc]); okeep[cc] = (ss - 1 == j) ? o : okeep[cc]; }
                    oprev[cc] = onew[cc]; }
            }
#pragma unroll
            for (int cc = 0; cc < CPL; ++cc) { const float o = grp_sum<T>(oprev[cc]); okeep[cc] = (T - 1 == j) ? o : okeep[cc];
                denp[(sg + j) * 32 + col + 4 * cc] = okeep[cc]; }
        }
#undef SCAN_LOADOPS
        if (blk + 1 < NBLK) SCAN_FINISH(Bn, par ^ 1);
        __syncthreads();
        if (MIX == 0 && tid < 128) { const int orow = tid >> 2, oc8 = (tid & 3) * 8; const f4 o0 = *(const f4*)(denp + orow * 32 + oc8), o1 = *(const f4*)(denp + orow * 32 + oc8 + 4);
            u32x4_t ov; ov[0] = pg8::cvt_pk_bf16(o0.x, o0.y); ov[1] = pg8::cvt_pk_bf16(o0.z, o0.w); ov[2] = pg8::cvt_pk_bf16(o1.x, o1.y); ov[3] = pg8::cvt_pk_bf16(o1.z, o1.w);
            *(u32x4_t*)(outp + (rb + t0 + orow) * 512 + h * 128 + cgp * 32 + oc8) = ov; }
        if (MIX == 1) {
            if (cgp == 0) { const int sr = tid >> 4, jl = tid & 15; const f4 a0 = *(const f4*)(denp + sr * 128 + 8 * jl), a1 = *(const f4*)(denp + sr * 128 + 8 * jl + 4);
                const float d = grp_sum16((a0.x + a0.y) + (a0.z + a0.w) + (a1.x + a1.y) + (a1.z + a1.w));
                if (jl == 0) { const size_t r = rb + t0 + sr; ((float*)(PWS + W_DEN))[r * 4 + h] = d; ((float*)(PWS + W_MT))[r * 4 + h] = sc[sr * 4 + 2]; } }
            if (blk + 1 < NBLK) SCAN_CHAIN(Bn);
            __syncthreads();
        }
      }
    }
#undef SCAN_ISSUE
#undef SCAN_FINISH
#undef SCAN_CHAIN
    const size_t sidx = ((size_t)(l * NBP + b) * NH + h);
    float* So = POUT + (MIX == 0 ? O_P_GS : (MIX == 1 ? O_P_MC : O_P_HS)) + sidx * 16384;
#pragma unroll
    for (int cc = 0; cc < CPL; ++cc)
#pragma unroll
        for (int g = 0; g < NG; ++g) { const int d0 = g * 4 * T + 4 * j, ec = ecol + 4 * cc;
            So[(size_t)(d0 + 0) * 128 + ec] = S2[cc][2 * g].x; So[(size_t)(d0 + 1) * 128 + ec] = S2[cc][2 * g].y; So[(size_t)(d0 + 2) * 128 + ec] = S2[cc][2 * g + 1].x; So[(size_t)(d0 + 3) * 128 + ec] = S2[cc][2 * g + 1].y; }
    if (MIX == 1 && cgp == 0) {
        if (lane < 16) POUT[O_P_MN + sidx * 128 + 16 * w + lane] = nn;
        if (tid == 64) POUT[O_P_MM + sidx] = mcar[0];
    }
    __syncthreads();
}

template <int MIX>
__device__ __forceinline__ void scan_prompt_lin(const Params& p, int l, int b, int h, int cgp, float* sm) {
    constexpr int TB = 32, NBLK = SEQ / TB;
    int tid_ = threadIdx.x; asm volatile("" : "+v"(tid_)); const int tid = tid_, lane = tid & 63, w = tid >> 6;
    float* qk = sm; float* vv = sm + 8192; float* denp = sm + 10240; float* opart = sm + 14336; float* scall = sm + 30720;
    const float* gates = (const float*)(PWS + W_GATES);
    bf16_t* outp = (bf16_t*)(PWS + W_OUTS) + (size_t)MIX * MT * 512;
    const size_t rb = (size_t)b * SEQ;
    const int c8 = (tid & 31) * 8, srow = tid >> 5;
    const int base = MIX == 1 ? 2048 : 4096;
    const bf16_t* qsrc = (const bf16_t*)(PWS + W_PROJ) + rb * N1 + base + (c8 < 128 ? h * 128 + c8 : 512 + h * 128 + (c8 - 128));
    const bf16_t* vsrc = (const bf16_t*)(PWS + W_PROJ) + rb * N1 + base + 1024 + h * 128 + cgp * 64;
    const int vs = tid >> 3, vc8 = (tid & 7) * 8; const bool vact = tid < TB * 8;
    float lb8[8];
#pragma unroll
    for (int i = 0; i < 8; ++i) lb8[i] = 0.f;
    if (MIX == 2 && l > 0 && c8 >= 128) { const float* hl = PIN(I_HLB);
#pragma unroll
        for (int i = 0; i < 8; ++i) { const int cc = h * 128 + (c8 - 128) + i; lb8[i] = sigm(hl[512 + cc] - hl[cc]); } }
    __syncthreads();
    float mfinal = 0.f;
    if (MIX == 1) {
        float* graw = opart;
        for (int i = tid; i < SEQ; i += 512) { const size_t r = rb + i; graw[2 * i] = gates[r * 16 + 8 + h]; graw[2 * i + 1] = gates[r * 16 + 12 + h]; }
        __syncthreads();
        if (w == 1) { float m0 = 0.f; const int ls = lane & 31;
            for (int t0 = 0; t0 < SEQ; t0 += 32) {
                const float ig = graw[2 * (t0 + ls)], lf = graw[2 * (t0 + ls) + 1];
                float F = lf; F += dppf<0x111>(F); F += dppf<0x112>(F); F += dppf<0x114>(F); F += dppf<0x118>(F);
                { const float t0v = rdlane(F, 15); if (lane & 16) F += t0v; }
                float P = ig - F; P = fmaxf(P, dppm<0x111>(P)); P = fmaxf(P, dppm<0x112>(P)); P = fmaxf(P, dppm<0x114>(P)); P = fmaxf(P, dppm<0x118>(P));
                { const float t1v = rdlane(P, 15); if (lane & 16) P = fmaxf(P, t1v); }
                const float m = F + fmaxf(m0, P);
                float mp = dppf<0x111>(m); { const float t2v = rdlane(m, 15); if ((lane & 15) == 0) mp = (lane & 16) ? t2v : m0; }
                if (lane < 32) { scall[2 * (t0 + lane)] = __expf(lf + mp - m); scall[2 * (t0 + lane) + 1] = __expf(ig - m) * QSCALE;
                    if (cgp == 0) ((float*)(PWS + W_MT))[(rb + t0 + lane) * 4 + h] = m; }
                m0 = rdlane(m, 31); }
            mfinal = m0; }
        __syncthreads();
    }
    f2 S2[8];
#pragma unroll
    for (int i = 0; i < 8; ++i) S2[i] = (f2){0.f, 0.f};
    float nn = 0.f;
    u32x4_t rq[2][2], rv[2]; rv[0] = (u32x4_t){0u, 0u, 0u, 0u}; rv[1] = rv[0];
#define LIN_ISSUE(t0_, st_) do { \
        _Pragma("unroll") for (int i_ = 0; i_ < 2; ++i_) rq[st_][i_] = *(const u32x4_t*)(qsrc + (size_t)((t0_) + srow + 16 * i_) * N1); \
        if (vact) rv[st_] = *(const u32x4_t*)(vsrc + (size_t)((t0_) + vs) * N1 + vc8); } while (0)
#define LIN_FINISH(st_) do { \
        _Pragma("unroll") for (int i_ = 0; i_ < 2; ++i_) { float x_[8]; \
            _Pragma("unroll") for (int e_ = 0; e_ < 4; ++e_) { x_[2 * e_] = bflo(rq[st_][i_][e_]); x_[2 * e_ + 1] = bfhi(rq[st_][i_][e_]); } \
            if (MIX == 2 && c8 >= 128) { _Pragma("unroll") for (int e_ = 0; e_ < 8; ++e_) x_[e_] = lb8[e_] + (1.f - lb8[e_]) * sigm(x_[e_]); } \
            float* d_ = qk + (srow + 16 * i_) * 256 + c8; *(f4*)d_ = (f4){x_[0], x_[1], x_[2], x_[3]}; *(f4*)(d_ + 4) = (f4){x_[4], x_[5], x_[6], x_[7]}; } \
        if (vact) { float* d_ = vv + vs * 64 + vc8; *(f4*)d_ = (f4){bflo(rv[st_][0]), bfhi(rv[st_][0]), bflo(rv[st_][1]), bfhi(rv[st_][1])}; *(f4*)(d_ + 4) = (f4){bflo(rv[st_][2]), bfhi(rv[st_][2]), bflo(rv[st_][3]), bfhi(rv[st_][3])}; } } while (0)
    LIN_ISSUE(0, 0);
    LIN_FINISH(0);
    LIN_ISSUE(TB, 1);
    __syncthreads();
#pragma unroll 1
    for (int blk2 = 0; blk2 < NBLK; blk2 += 2) {
#pragma unroll
      for (int par = 0; par < 2; ++par) {
        const int blk = blk2 + par;
        const int t0 = blk * TB;
        if (blk + 2 < NBLK) LIN_ISSUE(t0 + 2 * TB, par);
        f4 qa[2][4], ka[2][4]; float va[2], kda[2], qda[2]; f2 sca[2];
#define LIN_LOADOPS(slot_, s_) do { const float* qs_ = qk + (s_) * 256 + 16 * w; \
            _Pragma("unroll") for (int g_ = 0; g_ < 4; ++g_) { qa[slot_][g_] = *(const f4*)(qs_ + 4 * g_); ka[slot_][g_] = *(const f4*)(qs_ + 128 + 4 * g_); } \
            va[slot_] = vv[(s_) * 64 + lane]; \
            if (MIX == 1) { sca[slot_] = *(const f2*)(scall + 2 * (t0 + (s_))); kda[slot_] = qs_[128 + (lane & 15)]; qda[slot_] = qs_[lane & 15]; } } while (0)
        LIN_LOADOPS(0, 0);
#pragma unroll 1
        for (int sg = 0; sg < TB; sg += 4) {
#pragma unroll
            for (int ss = 0; ss < 4; ++ss) {
                const int s = sg + ss, cur = ss & 1, nxt = cur ^ 1;
                LIN_LOADOPS(nxt, (s + 1) & (TB - 1));
                __builtin_amdgcn_sched_barrier(0);
                f2 qq[8], kk[8];
#pragma unroll
                for (int g = 0; g < 4; ++g) { qq[2 * g] = qa[cur][g].xy; qq[2 * g + 1] = qa[cur][g].zw; kk[2 * g] = ka[cur][g].xy; kk[2 * g + 1] = ka[cur][g].zw; }
                const float v = va[cur];
                f2 oa = (f2){0.f, 0.f}, ob = (f2){0.f, 0.f};
                if (MIX == 1) {
                    const float fp = sca[cur].x, ip = sca[cur].y, iv = ip * v;
                    const f2 f2v = (f2){fp, fp}, iv2 = (f2){iv, iv};
#pragma unroll
                    for (int i = 0; i < 8; i += 2) { S2[i] = S2[i] * f2v + kk[i] * iv2; S2[i + 1] = S2[i + 1] * f2v + kk[i + 1] * iv2; oa = qq[i] * S2[i] + oa; ob = qq[i + 1] * S2[i + 1] + ob; }
                    nn = fp * nn + ip * kda[cur];
                    denp[s * 128 + 16 * w + (lane & 15)] = qda[cur] * nn;
                } else {
                    const f2 v2 = (f2){v, v};
#pragma unroll
                    for (int i = 0; i < 8; i += 2) { S2[i] = kk[i] * (S2[i] - v2) + v2; S2[i + 1] = kk[i + 1] * (S2[i + 1] - v2) + v2; oa = qq[i] * S2[i] + oa; ob = qq[i + 1] * S2[i + 1] + ob; }
                }
                oa = oa + ob;
                opart[(s * 8 + w) * 64 + lane] = oa.x + oa.y;
            }
        }
#undef LIN_LOADOPS
        __syncthreads();
        { const int s = tid >> 5, e2 = (tid & 31) * 2; f2 acc2 = (f2){0.f, 0.f};
#pragma unroll
            for (int ww = 0; ww < 8; ++ww) acc2 = acc2 + *(const f2*)(opart + (s * 8 + ww) * 64 + e2);
            const int s2 = s + 16; f2 acc3 = (f2){0.f, 0.f};
#pragma unroll
            for (int ww = 0; ww < 8; ++ww) acc3 = acc3 + *(const f2*)(opart + (s2 * 8 + ww) * 64 + e2);
            *(unsigned*)(outp + (rb + t0 + s) * 512 + h * 128 + cgp * 64 + e2) = pg8::cvt_pk_bf16(acc2.x, acc2.y);
            *(unsigned*)(outp + (rb + t0 + s2) * 512 + h * 128 + cgp * 64 + e2) = pg8::cvt_pk_bf16(acc3.x, acc3.y); }
        if (MIX == 1 && cgp == 0) { const int sr = tid >> 4, jl = tid & 15; const f4 a0 = *(const f4*)(denp + sr * 128 + 8 * jl), a1 = *(const f4*)(denp + sr * 128 + 8 * jl + 4);
            const float d = grp_sum16((a0.x + a0.y) + (a0.z + a0.w) + (a1.x + a1.y) + (a1.z + a1.w));
            if (jl == 0) ((float*)(PWS + W_DEN))[(rb + t0 + sr) * 4 + h] = d; }
        if (blk + 1 < NBLK) LIN_FINISH(par ^ 1);
        __syncthreads();
      }
    }
#undef LIN_ISSUE
#undef LIN_FINISH
    const size_t sidx = ((size_t)(l * NBP + b) * NH + h);
    float* So = POUT + (MIX == 1 ? O_P_MC : O_P_HS) + sidx * 16384;
#pragma unroll
    for (int i = 0; i < 8; ++i) { So[(size_t)(16 * w + 2 * i) * 128 + cgp * 64 + lane] = S2[i].x; So[(size_t)(16 * w + 2 * i + 1) * 128 + cgp * 64 + lane] = S2[i].y; }
    if (MIX == 1 && cgp == 0) {
        if (lane < 16) POUT[O_P_MN + sidx * 128 + 16 * w + lane] = nn;
        if (tid == 64) POUT[O_P_MM + sidx] = mfinal;
    }
    __syncthreads();
}

__device__ __forceinline__ void scan_sample_item(const Params& p, int l, int mix, int b, int h, float* sm) {
    int tid_ = threadIdx.x; asm volatile("" : "+v"(tid_)); const int tid = tid_, lane = tid & 63, w = tid >> 6, e = tid & 127, dg = tid >> 7;
    float* qk = sm; float* vv = sm + 1024; float* gs = sm + 1536; float* red = sm + 1600; float* dpart = sm + 1600 + 4096;
    const bf16_t* proj = (const bf16_t*)(PWS + W_PROJ);
    const float* gates = (const float*)(PWS + W_GATES);
    bf16_t* outp = (bf16_t*)(PWS + W_OUTS) + (size_t)mix * MT * 512;
    const size_t rs = (size_t)MP + (size_t)b * SSEQ;
    const size_t sidx = ((size_t)(l * NBS + b) * NH + h);
    const float* Sin = (mix == 0 ? PIN(I_SGS) : (mix == 1 ? PIN(I_SMC) : PIN(I_SHS))) + sidx * 16384;
    float S[32];
#pragma unroll
    for (int i = 0; i < 32; ++i) S[i] = Sin[(size_t)(32 * dg + i) * 128 + e];
    __syncthreads();
    for (int idx = tid; idx < 4 * 384; idx += 512) { const int s = idx / 384, ch = idx - s * 384; float val;
        if (mix == 0) { val = ch < 256 ? bf2f(((const bf16_t*)(PWS + W_HBF))[(rs + s) * 1024 + (ch >> 7) * 512 + h * 128 + (ch & 127)]) : bf2f(outp[(rs + s) * 512 + h * 128 + (ch - 256)]);
        } else if (mix == 1) { const int colx = 2048 + (ch >> 7) * 512 + h * 128 + (ch & 127); val = bf2f(proj[(rs + s) * N1 + colx]); }
        else { const int colx = 4096 + (ch >> 7) * 512 + h * 128 + (ch & 127); val = bf2f(proj[(rs + s) * N1 + colx]);
            if (ch >= 128 && ch < 256) { float lbv = 0.f; if (l > 0) { const float* hl = PIN(I_HLB); const int cc = h * 128 + (ch & 127); lbv = sigm(hl[512 + cc] - hl[cc]); } val = lbv + (1.f - lbv) * sigm(val); } }
        if (ch < 256) qk[s * 256 + ch] = val; else vv[s * 128 + ch - 256] = val; }
    if (tid < 4) { const size_t r = rs + tid;
        if (mix == 0) { gs[tid * 4] = gates[r * 16 + h]; gs[tid * 4 + 1] = gates[r * 16 + 4 + h]; }
        else if (mix == 1) { gs[tid * 4] = gates[r * 16 + 8 + h]; gs[tid * 4 + 1] = gates[r * 16 + 12 + h]; } }
    __syncthreads();
    float m = 0.f, nn = 0.f, mts[4] = {0.f, 0.f, 0.f, 0.f};
    if (mix == 1) { m = PIN(I_SMM)[sidx]; if (dg == 0) nn = PIN(I_SMN)[sidx * 128 + e]; }
#pragma unroll
    for (int s = 0; s < 4; ++s) {
        const float* qs = qk + s * 256 + 32 * dg; const float* ksp = qs + 128;
        const float v = vv[s * 128 + e];
        float po = 0.f;
        if (mix == 0) {
            const float beta = gs[s * 4], a = gs[s * 4 + 1];
            float pk = 0.f;
#pragma unroll
            for (int i = 0; i < 32; ++i) pk += ksp[i] * S[i];
            red[((s * 2) * 4 + dg) * 128 + e] = pk;
            __syncthreads();
            const float ks = red[((s * 2) * 4 + 0) * 128 + e] + red[((s * 2) * 4 + 1) * 128 + e] + red[((s * 2) * 4 + 2) * 128 + e] + red[((s * 2) * 4 + 3) * 128 + e];
            const float u = beta * (v - a * ks);
#pragma unroll
            for (int i = 0; i < 32; ++i) { S[i] = a * S[i] + ksp[i] * u; po += qs[i] * S[i]; }
        } else if (mix == 1) {
            const float ig = gs[s * 4], lf = gs[s * 4 + 1]; const float mn = fmaxf(lf + m, ig); const float fp = __expf(lf + m - mn), ip = __expf(ig - mn) * QSCALE; m = mn; mts[s] = mn;
            const float iv = ip * v;
#pragma unroll
            for (int i = 0; i < 32; ++i) { S[i] = fp * S[i] + ksp[i] * iv; po += qs[i] * S[i]; }
            if (dg == 0) { nn = fp * nn + ip * qk[s * 256 + 128 + e]; const float dp = wave_sum(qk[s * 256 + e] * nn); if (lane == 0) dpart[s * 2 + w] = dp; }
        } else {
#pragma unroll
            for (int i = 0; i < 32; ++i) { S[i] = ksp[i] * (S[i] - v) + v; po += qs[i] * S[i]; }
        }
        red[((s * 2 + 1) * 4 + dg) * 128 + e] = po;
    }
    __syncthreads();
    if (tid < 128) {
#pragma unroll
        for (int s = 0; s < 4; ++s) { const float o = red[((s * 2 + 1) * 4 + 0) * 128 + e] + red[((s * 2 + 1) * 4 + 1) * 128 + e] + red[((s * 2 + 1) * 4 + 2) * 128 + e] + red[((s * 2 + 1) * 4 + 3) * 128 + e];
            outp[(rs + s) * 512 + h * 128 + e] = f2bf(o); } }
    if (mix == 1 && tid == 0) {
#pragma unroll
        for (int s = 0; s < 4; ++s) { ((float*)(PWS + W_DEN))[(rs + s) * 4 + h] = dpart[s * 2] + dpart[s * 2 + 1]; ((float*)(PWS + W_MT))[(rs + s) * 4 + h] = mts[s]; }
        POUT[O_S_MM + sidx] = m; }
    float* So = POUT + (mix == 0 ? O_S_GS : (mix == 1 ? O_S_MC : O_S_HS)) + sidx * 16384;
#pragma unroll
    for (int i = 0; i < 32; ++i) So[(size_t)(32 * dg + i) * 128 + e] = S[i];
    if (mix == 1 && dg == 0) POUT[O_S_MN + sidx * 128 + e] = nn;
}

__device__ __forceinline__ void scan_sample_all(const Params& p, int l, float* sm) {
    int tid_ = threadIdx.x; asm volatile("" : "+v"(tid_)); const int tid = tid_, lane = tid & 63, w = tid >> 6, e = tid & 127, dg = tid >> 7;
    float* qk = sm; float* vv = sm + 1024; float* gs = sm + 1536; float* red = sm + 1600; float* dpart = sm + 1600 + 4096; volatile int* qslot = (volatile int*)(sm + 5760);
    float* simg = sm + 6144;
    PG8_LAS unsigned char* simg_l = (PG8_LAS unsigned char*)simg;
    const bf16_t* proj = (const bf16_t*)(PWS + W_PROJ); const bf16_t* hbf = (const bf16_t*)(PWS + W_HBF);
    const float* gates = (const float*)(PWS + W_GATES);
    bf16_t* outs = (bf16_t*)(PWS + W_OUTS);
    unsigned* qctr = (unsigned*)(PWS + W_BAR) + 64 * l;
    constexpr int NIT = 3 * NBS * NH;
    const float* hl = PIN(I_HLB);
    __syncthreads();
    if (tid == 0) { qslot[0] = (int)__hip_atomic_fetch_add(qctr, 1u, __ATOMIC_RELAXED, __HIP_MEMORY_SCOPE_AGENT); qslot[1] = (int)__hip_atomic_fetch_add(qctr, 1u, __ATOMIC_RELAXED, __HIP_MEMORY_SCOPE_AGENT); }
    __syncthreads();
    int it0 = qslot[0], it1 = qslot[1];
    float stg[3], gn0 = 0.f, gn1 = 0.f, mn_in = 0.f, nn_in = 0.f;
    stg[0] = stg[1] = stg[2] = 0.f;
#define SMP_ISSUE(it_) do { const int mix_ = (it_) / (NBS * NH), r_ = (it_) - mix_ * (NBS * NH), b_ = r_ >> 2, h_ = r_ & 3; \
        const size_t sidx_ = ((size_t)(l * NBS + b_) * NH + h_), rs_ = (size_t)MP + (size_t)b_ * SSEQ; \
        const float* Sin_ = (mix_ == 0 ? PIN(I_SGS) : (mix_ == 1 ? PIN(I_SMC) : PIN(I_SHS))) + sidx_ * 16384; \
        _Pragma("unroll") for (int k_ = 0; k_ < 8; ++k_) __builtin_amdgcn_global_load_lds((const unsigned*)((const char*)Sin_ + (size_t)((w * 8 + k_) * 1024 + lane * 16)), (PG8_LAS unsigned*)(simg_l + (w * 8 + k_) * 1024), 16, 0, 0); \
        int tq_ = tid; asm volatile("" : "+v"(tq_)); \
        _Pragma("unroll") for (int k_ = 0; k_ < 3; ++k_) { const int idx_ = tq_ + 512 * k_, s_ = idx_ / 384, ch_ = idx_ - s_ * 384; unsigned short raw_; \
            if (mix_ == 0) raw_ = ch_ < 256 ? hbf[(rs_ + s_) * 1024 + (ch_ >> 7) * 512 + h_ * 128 + (ch_ & 127)] : outs[(rs_ + s_) * 512 + h_ * 128 + (ch_ - 256)]; \
            else raw_ = proj[(rs_ + s_) * N1 + (mix_ == 1 ? 2048 : 4096) + (ch_ >> 7) * 512 + h_ * 128 + (ch_ & 127)]; \
            stg[k_] = bf2f(raw_); } \
        if (tid < 4 && mix_ != 2) { const size_t rr_ = rs_ + tid; gn0 = gates[rr_ * 16 + (mix_ == 0 ? 0 : 8) + h_]; gn1 = gates[rr_ * 16 + (mix_ == 0 ? 4 : 12) + h_]; } \
        if (mix_ == 1) { mn_in = PIN(I_SMM)[sidx_]; if (dg == 0) nn_in = PIN(I_SMN)[sidx_ * 128 + e]; } } while (0)
    if (it0 < NIT) SMP_ISSUE(it0);
    while (it0 < NIT) {
#ifdef TPROBE_ITEM
        const unsigned long long tst_ = __builtin_amdgcn_s_memrealtime();
#endif
        const int mix = it0 / (NBS * NH), r = it0 - mix * (NBS * NH), b = r >> 2, h = r & 3;
        const size_t sidx = ((size_t)(l * NBS + b) * NH + h), rs = (size_t)MP + (size_t)b * SSEQ;
        bf16_t* outp = outs + (size_t)mix * MT * 512;
        asm volatile("s_waitcnt vmcnt(0)" ::: "memory");
        lds_barrier();
        float S[32];
#pragma unroll
        for (int i = 0; i < 32; ++i) S[i] = simg[(32 * dg + i) * 128 + e];
        float m = mn_in, nn = nn_in;
#pragma unroll
        for (int k = 0; k < 3; ++k) { const int idx = tid + 512 * k, s = idx / 384, ch = idx - s * 384; float val = stg[k];
            if (mix == 2 && ch >= 128 && ch < 256) { float lbv = 0.f; if (l > 0) { const int cc = h * 128 + (ch & 127); lbv = sigm(hl[512 + cc] - hl[cc]); } val = lbv + (1.f - lbv) * sigm(val); }
            if (ch < 256) qk[s * 256 + ch] = val; else vv[s * 128 + ch - 256] = val; }
        if (tid < 4 && mix != 2) { gs[tid * 4] = gn0; gs[tid * 4 + 1] = gn1; }
        int it2 = NIT;
        if (tid == 0) it2 = (int)__hip_atomic_fetch_add(qctr, 1u, __ATOMIC_RELAXED, __HIP_MEMORY_SCOPE_AGENT);
        lds_barrier();
        if (it1 < NIT) SMP_ISSUE(it1);
#pragma unroll 1
        for (int s = 0; s < 4; ++s) {
            const float* qs = qk + s * 256 + 32 * dg; const float* ksp = qs + 128;
            const float v = vv[s * 128 + e];
            float po = 0.f;
            if (mix == 0) {
                const float beta = gs[s * 4], a = gs[s * 4 + 1];
                float pk = 0.f;
#pragma unroll
                for (int c4 = 0; c4 < 4; ++c4) {
#pragma unroll
                    for (int i = 8 * c4; i < 8 * c4 + 8; ++i) pk += ksp[i] * S[i];
                    __builtin_amdgcn_sched_barrier(0); }
                red[((s * 2) * 4 + dg) * 128 + e] = pk;
                lds_barrier();
                const float ks = red[((s * 2) * 4 + 0) * 128 + e] + red[((s * 2) * 4 + 1) * 128 + e] + red[((s * 2) * 4 + 2) * 128 + e] + red[((s * 2) * 4 + 3) * 128 + e];
                const float u = beta * (v - a * ks);
#pragma unroll
                for (int c4 = 0; c4 < 4; ++c4) {
#pragma unroll
                    for (int i = 8 * c4; i < 8 * c4 + 8; ++i) { S[i] = a * S[i] + ksp[i] * u; po += qs[i] * S[i]; }
                    __builtin_amdgcn_sched_barrier(0); }
            } else if (mix == 1) {
                const float ig = gs[s * 4], lf = gs[s * 4 + 1]; const float mn = fmaxf(lf + m, ig); const float fp = __expf(lf + m - mn), ip = __expf(ig - mn) * QSCALE; m = mn; if (tid == 0) ((float*)(PWS + W_MT))[(rs + s) * 4 + h] = mn;
                const float iv = ip * v;
#pragma unroll
                for (int c4 = 0; c4 < 4; ++c4) {
#pragma unroll
                    for (int i = 8 * c4; i < 8 * c4 + 8; ++i) { S[i] = fp * S[i] + ksp[i] * iv; po += qs[i] * S[i]; }
                    __builtin_amdgcn_sched_barrier(0); }
                if (dg == 0) { nn = fp * nn + ip * qk[s * 256 + 128 + e]; const float dp = wave_sum(qk[s * 256 + e] * nn); if (lane == 0) dpart[s * 2 + w] = dp; }
            } else {
#pragma unroll
                for (int c4 = 0; c4 < 4; ++c4) {
#pragma unroll
                    for (int i = 8 * c4; i < 8 * c4 + 8; ++i) { S[i] = ksp[i] * (S[i] - v) + v; po += qs[i] * S[i]; }
                    __builtin_amdgcn_sched_barrier(0); }
            }
            red[((s * 2 + 1) * 4 + dg) * 128 + e] = po;
        }
        if (tid == 0) qslot[0] = it2;
        lds_barrier();
        if (tid < 128) {
#pragma unroll
            for (int s = 0; s < 4; ++s) { const float o = red[((s * 2 + 1) * 4 + 0) * 128 + e] + red[((s * 2 + 1) * 4 + 1) * 128 + e] + red[((s * 2 + 1) * 4 + 2) * 128 + e] + red[((s * 2 + 1) * 4 + 3) * 128 + e];
                outp[(rs + s) * 512 + h * 128 + e] = f2bf(o); } }
        if (mix == 1 && tid == 0) {
#pragma unroll
            for (int s = 0; s < 4; ++s) { ((float*)(PWS + W_DEN))[(rs + s) * 4 + h] = dpart[s * 2] + dpart[s * 2 + 1]; }
            POUT[O_S_MM + sidx] = m; }
        float* So = POUT + (mix == 0 ? O_S_GS : (mix == 1 ? O_S_MC : O_S_HS)) + sidx * 16384;
#ifndef DUPST
#define DUPST 1
#endif
        for (int rst = 0; rst < DUPST; ++rst) {
#pragma unroll
        for (int i = 0; i < 32; ++i) So[(size_t)(32 * dg + i) * 128 + e] = S[i];
        if (DUPST > 1) { asm volatile("s_waitcnt vmcnt(0)" ::: "memory"); } }
        if (mix == 1 && dg == 0) POUT[O_S_MN + sidx * 128 + e] = nn;
        it0 = it1; it1 = qslot[0];
        lds_barrier();
#ifdef TPROBE_ITEM
        if (blockIdx.x == TPROBE_WG && threadIdx.x == 0) { volatile unsigned long long* sp_ = (volatile unsigned long long*)((unsigned char*)sm + LDS_MAIN + 64); sp_[40] += __builtin_amdgcn_s_memrealtime() - tst_; sp_[41] += 1; }
#endif
    }
#undef SMP_ISSUE
}
__device__ __forceinline__ void phase_postnorm(const Params& p, int l) {
    int tid_ = threadIdx.x; asm volatile("" : "+v"(tid_)); const int tid = tid_, j = tid & 15;
    bf16_t* outs = (bf16_t*)(PWS + W_OUTS);
    const bf16_t* proj = (const bf16_t*)(PWS + W_PROJ);
    const float* den = (const float*)(PWS + W_DEN); const float* mt = (const float*)(PWS + W_MT);
    const int ngroups = MT * 12;
    for (int gid = bidx() * 32 + (tid >> 4); gid < ngroups; gid += gdim() * 32) {
        const int r = gid / 12, mh = gid - r * 12, mix = mh >> 2, h = mh & 3;
        bf16_t* op = outs + (size_t)mix * MT * 512 + (size_t)r * 512 + h * 128 + 8 * j;
        const u32x4_t raw = *(const u32x4_t*)op;
        float v[8];
#pragma unroll
        for (int i = 0; i < 4; ++i) { v[2 * i] = bflo(raw[i]); v[2 * i + 1] = bfhi(raw[i]); }
        if (mix == 1) { const float dn = fmaxf(fabsf(den[(size_t)r * 4 + h]), __expf(-mt[(size_t)r * 4 + h])); const float inv = 1.f / dn;
#pragma unroll
            for (int i = 0; i < 8; ++i) v[i] *= inv; }
        float ss = 0.f;
#pragma unroll
        for (int i = 0; i < 8; ++i) ss += v[i] * v[i];
        ss = grp_sum16(ss);
        const float rstd = rsqrtf(ss * (1.f / 128.f) + EPS);
        const int gcol = (mix == 0 ? 1536 : (mix == 1 ? 3584 : 5632)) + h * 128 + 8 * j;
        const u32x4_t gr = *(const u32x4_t*)(proj + (size_t)r * N1 + gcol);
        const float* nw = (mix == 0 ? PIN(I_GNORM) : (mix == 1 ? PIN(I_MNORM) : PIN(I_HNORM))) + l * 512 + h * 128 + 8 * j;
        const float4 n0 = *(const float4*)nw, n1 = *(const float4*)(nw + 4);
        const float nwv[8] = {n0.x, n0.y, n0.z, n0.w, n1.x, n1.y, n1.z, n1.w};
#pragma unroll
        for (int i = 0; i < 4; ++i) { v[2 * i] *= rstd * nwv[2 * i] * bflo(gr[i]); v[2 * i + 1] *= rstd * nwv[2 * i + 1] * bfhi(gr[i]); }
        u32x4_t o; o[0] = pg8::cvt_pk_bf16(v[0], v[1]); o[1] = pg8::cvt_pk_bf16(v[2], v[3]); o[2] = pg8::cvt_pk_bf16(v[4], v[5]); o[3] = pg8::cvt_pk_bf16(v[6], v[7]);
        *(u32x4_t*)op = o;
    }
    const int ncs = (NBP + NBS) * 3 * 1536;
    for (int i = bidx() * 512 + tid; i < ncs; i += gdim() * 512) {
        const int cc = i % 1536, ri = (i / 1536) % 3, bb = i / (3 * 1536);
        if (bb < NBP) POUT[O_P_GC + ((size_t)(l * NBP + bb) * 3 + ri) * 1536 + cc] = bf2f(proj[((size_t)bb * SEQ + SEQ - 3 + ri) * N1 + cc]);
        else { const int b2 = bb - NBP; POUT[O_S_GC + ((size_t)(l * NBS + b2) * 3 + ri) * 1536 + cc] = bf2f(proj[((size_t)MP + (size_t)b2 * SSEQ + 1 + ri) * N1 + cc]); }
    }
}

__device__ __forceinline__ void phase_convffn(const Params& p, int l) {
    int tid_ = threadIdx.x; asm volatile("" : "+v"(tid_)); const int tid = tid_;
    const bf16_t* u = (const bf16_t*)(PWS + W_PROJ);
    bf16_t* act = (bf16_t*)(PWS + W_ACT);
    const float* cw = PIN(I_FCW) + (size_t)l * 3 * NUP; const float* cb = PIN(I_FCB) + (size_t)l * NUP;
    const int nitems = (MT / 4) * (DFF / 8);
    for (int it = bidx() * 512 + tid; it < nitems; it += gdim() * 512) {
        const int jg = it % (DFF / 8), rbk = it / (DFF / 8), r0 = rbk * 4, jc = jg * 8;
        const bool samp = r0 >= MP; const int tf = samp ? 0 : (r0 & (SEQ - 1));
        float wa[3][8], wb[3][8], ba[8], bb[8];
#pragma unroll
        for (int i = 0; i < 3; ++i) { const float4 a0 = *(const float4*)(cw + i * NUP + jc), a1 = *(const float4*)(cw + i * NUP + jc + 4), b0 = *(const float4*)(cw + i * NUP + DFF + jc), b1 = *(const float4*)(cw + i * NUP + DFF + jc + 4);
            wa[i][0] = a0.x; wa[i][1] = a0.y; wa[i][2] = a0.z; wa[i][3] = a0.w; wa[i][4] = a1.x; wa[i][5] = a1.y; wa[i][6] = a1.z; wa[i][7] = a1.w;
            wb[i][0] = b0.x; wb[i][1] = b0.y; wb[i][2] = b0.z; wb[i][3] = b0.w; wb[i][4] = b1.x; wb[i][5] = b1.y; wb[i][6] = b1.z; wb[i][7] = b1.w; }
        { const float4 a0 = *(const float4*)(cb + jc), a1 = *(const float4*)(cb + jc + 4), b0 = *(const float4*)(cb + DFF + jc), b1 = *(const float4*)(cb + DFF + jc + 4);
            ba[0] = a0.x; ba[1] = a0.y; ba[2] = a0.z; ba[3] = a0.w; ba[4] = a1.x; ba[5] = a1.y; ba[6] = a1.z; ba[7] = a1.w;
            bb[0] = b0.x; bb[1] = b0.y; bb[2] = b0.z; bb[3] = b0.w; bb[4] = b1.x; bb[5] = b1.y; bb[6] = b1.z; bb[7] = b1.w; }
        float xa[6][8], xb[6][8];
#pragma unroll
        for (int rr = 0; rr < 6; ++rr) {
            if (rr < 2 && tf == 0) {
                if (samp) { const float* st = PIN(I_SFC) + ((size_t)(l * NBS + (r0 - MP) / 4) * 2 + rr) * NUP;
#pragma unroll
                    for (int i = 0; i < 8; ++i) { xa[rr][i] = st[jc + i]; xb[rr][i] = st[DFF + jc + i]; } }
                else {
#pragma unroll
                    for (int i = 0; i < 8; ++i) { xa[rr][i] = 0.f; xb[rr][i] = 0.f; } }
            } else { const bf16_t* ur = u + (size_t)(r0 - 2 + rr) * NUP; const u32x4_t ra = *(const u32x4_t*)(ur + jc), rbv = *(const u32x4_t*)(ur + DFF + jc);
#pragma unroll
                for (int i = 0; i < 4; ++i) { xa[rr][2 * i] = bflo(ra[i]); xa[rr][2 * i + 1] = bfhi(ra[i]); xb[rr][2 * i] = bflo(rbv[i]); xb[rr][2 * i + 1] = bfhi(rbv[i]); } }
        }
#pragma unroll
        for (int t = 0; t < 4; ++t) { float o[8];
#pragma unroll
            for (int i = 0; i < 8; ++i) { const float ya = wa[0][i] * xa[t][i] + wa[1][i] * xa[t + 1][i] + wa[2][i] * xa[t + 2][i] + ba[i]; const float yb = wb[0][i] * xb[t][i] + wb[1][i] * xb[t + 1][i] + wb[2][i] * xb[t + 2][i] + bb[i]; o[i] = silu(ya) * yb; }
            u32x4_t ov; ov[0] = pg8::cvt_pk_bf16(o[0], o[1]); ov[1] = pg8::cvt_pk_bf16(o[2], o[3]); ov[2] = pg8::cvt_pk_bf16(o[4], o[5]); ov[3] = pg8::cvt_pk_bf16(o[6], o[7]);
            *(u32x4_t*)(act + (size_t)(r0 + t) * DFF + jc) = ov; }
        if (samp || tf == SEQ - 4) {
            float* dst = samp ? POUT + O_S_FC + (size_t)(l * NBS + (r0 - MP) / 4) * 2 * NUP : POUT + O_P_FC + (size_t)(l * NBP + r0 / SEQ) * 2 * NUP;
#pragma unroll
            for (int rr = 0; rr < 2; ++rr)
#pragma unroll
                for (int i = 0; i < 8; ++i) { dst[(size_t)rr * NUP + jc + i] = xa[4 + rr][i]; dst[(size_t)rr * NUP + DFF + jc + i] = xb[4 + rr][i]; }
        }
    }
}

__device__ __forceinline__ void phase_final_norm(const Params& p) {
    int tid_ = threadIdx.x; asm volatile("" : "+v"(tid_)); const int tid = tid_, lane = tid & 63, w = tid >> 6;
    const float* gw = PIN(I_LNF);
    float4 g4[4];
#pragma unroll
    for (int i = 0; i < 4; ++i) g4[i] = *(const float4*)(gw + lane * 4 + 256 * i);
    for (int row = bidx() * 8 + w; row < MT; row += gdim() * 8) {
        float* xr = POUT + (size_t)row * DM; float4 v[4]; float ss = 0.f;
#pragma unroll
        for (int i = 0; i < 4; ++i) { v[i] = *(const float4*)(xr + lane * 4 + 256 * i); ss += v[i].x * v[i].x + v[i].y * v[i].y + v[i].z * v[i].z + v[i].w * v[i].w; }
        ss = wave_sum(ss); const float rstd = rsqrtf(ss * (1.f / 1024.f) + EPS);
#pragma unroll
        for (int i = 0; i < 4; ++i) { v[i].x *= rstd * g4[i].x; v[i].y *= rstd * g4[i].y; v[i].z *= rstd * g4[i].z; v[i].w *= rstd * g4[i].w; *(float4*)(xr + lane * 4 + 256 * i) = v[i]; }
    }
}

#ifndef PHM
#define PHM 0xFFFF
#endif
#ifndef DUPB
#define DUPB 1
#endif
#ifndef DUPC
#define DUPC 1
#endif
#ifndef DUPS
#define DUPS 1
#endif
#ifndef DUPH
#define DUPH 1
#endif
#ifndef DUPY
#define DUPY 1
#endif
#ifndef DUPA
#define DUPA 1
#endif
#ifndef DUPI
#define DUPI 1
#endif
#define GSYNC() do { for (int y_ = 0; y_ < DUPY; ++y_) xcd_barrier(xb); } while (0)
__global__ void __launch_bounds__(512, 2) fwd_megakernel(Params p) {
    extern __shared__ __attribute__((aligned(16))) unsigned char shm[];
    cg::grid_group grid = cg::this_grid();
    float* smf = (float*)shm;
    PG8_LAS unsigned char* lds = (PG8_LAS unsigned char*)shm;
    int tid_ = threadIdx.x; asm volatile("" : "+v"(tid_)); const int tid = tid_;
    float* X = POUT;
    volatile XLAS unsigned* xst = (volatile XLAS unsigned*)(lds + LDS_MAIN);
    if (tid == 0) { xst[0] = 0u; xst[1] = 0u; xst[2] = 0u; xst[3] = 0u; }
    __syncthreads();
    XcdBarrier xb = xcd_barrier_post((unsigned*)(PWS + W_BAR), xst);
    bool first_sync = true;
#ifdef TPROBE1
    volatile XLAS unsigned long long* stp = (volatile XLAS unsigned long long*)(lds + LDS_MAIN + 64);
    int nst = 0;
#define STAMP() do { if (blockIdx.x == TPROBE_WG && threadIdx.x == 0) stp[nst] = __builtin_amdgcn_s_memrealtime(); ++nst; } while (0)
#else
#define STAMP() do {} while (0)
#endif
    STAMP();
#ifdef TPROBE_ITEM
    if (blockIdx.x == TPROBE_WG && threadIdx.x == 0) { stp[40] = 0; stp[41] = 0; }
#endif
    bf16_t* hbf = (bf16_t*)(PWS + W_HBF);
    bf16_t* proj = (bf16_t*)(PWS + W_PROJ);

    for (int l = 0; l < 2; ++l) {
        const int G = gdim(), bid = bidx();
        for (int repa = 0; repa < DUPA; ++repa) { if (PHM & 1) { int tc = 0;
          conv_T(PIN(I_WIN) + (size_t)l * 1024 * NIN, NIN, (bf16_t*)(PWS + W_WIN), 1024, N1, true, smf, tc);
          for (int n = 0; n < 3; ++n) conv_T(PIN(I_WBR) + ((size_t)l * 3 + n) * 512 * 1024, 1024, (bf16_t*)(PWS + W_WBR) + (size_t)n * 1024 * 512, 512, 1024, false, smf, tc);
          conv_T(PIN(I_WOUT) + (size_t)l * 1024 * 1024, 1024, (bf16_t*)(PWS + W_WOUT), 1024, 1024, false, smf, tc);
          conv_T(PIN(I_WUP) + (size_t)l * 1024 * NUP, NUP, (bf16_t*)(PWS + W_WUP), 1024, NUP, false, smf, tc);
          conv_T(PIN(I_WDN) + (size_t)l * DFF * 1024, 1024, (bf16_t*)(PWS + W_WDN), DFF, 1024, false, smf, tc);
          __syncthreads(); }
        if (PHM & 2) {
        if (l == 0) { int tq_ = threadIdx.x; asm volatile("" : "+v"(tq_)); const float4* s1 = (const float4*)PIN(I_XS); float4* d1 = (float4*)(X + (size_t)MP * DM);
            for (int i = bid * 512 + tq_; i < MS * DM / 4; i += G * 512) d1[i] = s1[i]; }
        phase_rmsnorm(p, l, l == 0 ? PIN(I_XP) : X, l == 0 ? PIN(I_XS) : X + (size_t)MP * DM, PIN(I_LNMIX) + l * DM, hbf, true, smf); } }
        if (first_sync) { grid.sync(); first_sync = false; }
        else GSYNC();
        STAMP();
        for (int rep = 0; rep < DUPB; ++rep) { pg8::Gemm g{hbf, (const bf16_t*)(PWS + W_WIN), MT, N1, 1024, 1024}; pg8::StaticOrder S; S.init(MT, N1, G, bid); EpiProj E{proj, N1, 1}; pg8::gemm_phase(lds, g, S, E); }
        GSYNC(); STAMP();
        phase_gdnprep(p, l);
        GSYNC(); STAMP();
#ifdef TPROBE_MAX
        const unsigned long long tb_ = __builtin_amdgcn_s_memrealtime();
#endif
        for (int rep = 0; rep < DUPC; ++rep) for (int it = bid; it < 256; it += G) {
            if (it < 128) scan_prompt_item<0>(p, l, (it >> 2) >> 2, (it >> 2) & 3, it & 3, smf);
            else if (it < 192) { const int q = it - 128; scan_prompt_lin<1>(p, l, (q >> 1) >> 2, (q >> 1) & 3, q & 1, smf); }
            else { const int q = it - 192; scan_prompt_lin<2>(p, l, (q >> 1) >> 2, (q >> 1) & 3, q & 1, smf); }
        }
#ifdef TPROBE_MAX
        if (l == TPROBE_MAX - 1 && threadIdx.x == 0) { const unsigned dt_ = (unsigned)(__builtin_amdgcn_s_memrealtime() - tb_); atomicMax((unsigned*)(PWS + W_BAR) + 32, (dt_ << 8) | (unsigned)blockIdx.x); if (dt_ > 40000u) atomicAdd((unsigned*)(PWS + W_BAR) + 33, 1u); if (dt_ > 30000u) atomicAdd((unsigned*)(PWS + W_BAR) + 34, 1u); if (dt_ > 20000u) atomicAdd((unsigned*)(PWS + W_BAR) + 35, 1u); }
#endif
        STAMP();
#ifdef SEQ_SAMPLE
        GSYNC();
#endif
        scan_sample_all(p, l, smf);
        GSYNC(); STAMP();
        if (PHM & 32) phase_postnorm(p, l);
        GSYNC(); STAMP();
        if (PHM & 64) { pg8::Gemm g{(const bf16_t*)(PWS + W_OUTS), (const bf16_t*)(PWS + W_WBR), 3 * MT, 3 * 1024, 512, 512};
            MergeOrder S; S.init(G, bid); EpiMerge E{proj + 6144, hbf}; pg8::gemm_phase(lds, g, S, E); }
        GSYNC(); STAMP();
        if (PHM & 128) { { pg8::Gemm g{hbf, (const bf16_t*)(PWS + W_WOUT), MP, 1024, 1024, 1024}; pg8::StaticOrder S; S.init(MP, 1024, G, bid); EpiResid E{X, l == 0 ? PIN(I_XP) : X, X + (size_t)MP * DM}; pg8::gemm_phase(lds, g, S, E); }
            { pg8::Gemm g{hbf, (const bf16_t*)(PWS + W_WOUT), MT, 1024, 256, 1024}; PieceOrder S{G, (bid + G / 2) % G, 4}; EpiAtomic E{X}; pg8::gemm_phase(lds, g, S, E); } }
        GSYNC(); STAMP();
        if (PHM & 256) phase_rmsnorm(p, l, X, X + (size_t)MP * DM, PIN(I_LNFFN) + l * DM, hbf, false, smf);
        GSYNC(); STAMP();
        for (int rep = 0; rep < DUPH; ++rep) { pg8::Gemm g{hbf, (const bf16_t*)(PWS + W_WUP), MT, NUP, 1024, 1024}; pg8::StaticOrder S; S.init(MT, NUP, G, bid); EpiProj E{proj, NUP, 0}; pg8::gemm_phase(lds, g, S, E); }
        GSYNC(); STAMP();
        for (int repi = 0; repi < DUPI; ++repi) phase_convffn(p, l);
        GSYNC(); STAMP();
        if (PHM & 2048) { { pg8::Gemm g{(const bf16_t*)(PWS + W_ACT), (const bf16_t*)(PWS + W_WDN), MP, 1024, DFF, DFF}; pg8::StaticOrder S; S.init(MP, 1024, G, bid); EpiResid E{X, X, X + (size_t)MP * DM}; pg8::gemm_phase(lds, g, S, E); }
            { pg8::Gemm g{(const bf16_t*)(PWS + W_ACT), (const bf16_t*)(PWS + W_WDN), MT, 1024, 256, DFF}; PieceOrder S{G, (bid + G / 2) % G, 11}; EpiAtomic E{X}; pg8::gemm_phase(lds, g, S, E); } }
        GSYNC(); STAMP();
    }
    if (PHM & 4096) phase_final_norm(p);
#ifdef TPROBE1
    if (blockIdx.x == TPROBE_WG && threadIdx.x == 0) {
        const int per = (nst - 1) / 2;
        unsigned long long d1 = 0, d2 = 0;
        for (int l2 = 0; l2 < 2; ++l2) { d1 += stp[l2 * per + TPROBE1E] - stp[l2 * per + TPROBE1]; d2 += stp[l2 * per + TPROBE2E] - stp[l2 * per + TPROBE2]; }
        unsigned long long cntcode_ = 0;
        unsigned long long q1 = (d1 + 1000) / 2000, q2 = (d2 + 500) / 1000;
#ifdef TPROBE_MAX
        { const unsigned mx_ = __hip_atomic_load((unsigned*)(PWS + W_BAR) + 32, __ATOMIC_RELAXED, __HIP_MEMORY_SCOPE_AGENT); q1 = ((mx_ >> 8) + 1000) / 2000 * 10 + (mx_ & 255) / 100; q2 = (mx_ & 255) % 100;
#ifdef TPROBE_CNT
          const unsigned c4_ = __hip_atomic_load((unsigned*)(PWS + W_BAR) + 33, __ATOMIC_RELAXED, __HIP_MEMORY_SCOPE_AGENT), c3_ = __hip_atomic_load((unsigned*)(PWS + W_BAR) + 34, __ATOMIC_RELAXED, __HIP_MEMORY_SCOPE_AGENT), c2_ = __hip_atomic_load((unsigned*)(PWS + W_BAR) + 35, __ATOMIC_RELAXED, __HIP_MEMORY_SCOPE_AGENT);
          q1 = 0; q2 = 0; cntcode_ = c4_ * 300 + c3_; (void)c2_;
#endif
 }
#endif
#ifdef TPROBE_ITEM
        q1 = stp[41] ? (stp[40] / stp[41] + 50) / 100 : 0; q2 = stp[41];
#endif if (q2 > 99) q2 = 99;
#ifndef TPROBE_MAX
        if (q1 > 99) q1 = 99;
#endif
        const unsigned long long wait = (q1 * 100 + q2) * 2000ull + cntcode_ * 200ull, t0 = __builtin_amdgcn_s_memrealtime();
        while (__builtin_amdgcn_s_memrealtime() - t0 < wait) __builtin_amdgcn_s_sleep(32);
    }
#endif
}

extern "C" void kernel_launch(void* const* d_in, const int* in_sizes, int n_in, void* d_out, int out_size, void* d_ws, size_t ws_size, hipStream_t stream) {
    static int grid_blocks = 0;
    if (grid_blocks == 0) {
        if (n_in != 28 || (size_t)out_size != O_END || ws_size < W_END) { fprintf(stderr, "kernel_launch: unexpected shapes: n_in %d out %d (want %zu) ws %zu (need %zu)\n", n_in, out_size, (size_t)O_END, ws_size, (size_t)W_END); grid_blocks = -1; return; }
        int dev = 0, cus = 0, per_cu = 0;
        hipGetDevice(&dev); hipDeviceGetAttribute(&cus, hipDeviceAttributeMultiprocessorCount, dev);
        if (hipFuncSetAttribute((const void*)fwd_megakernel, hipFuncAttributeMaxDynamicSharedMemorySize, LDS_BYTES) != hipSuccess) { fprintf(stderr, "kernel_launch: hipFuncSetAttribute failed\n"); grid_blocks = -1; return; }
        if (hipOccupancyMaxActiveBlocksPerMultiprocessor(&per_cu, (const void*)fwd_megakernel, 512, LDS_BYTES) != hipSuccess || per_cu < 1) { fprintf(stderr, "kernel_launch: occupancy query gave %d\n", per_cu); per_cu = 1; (void)hipGetLastError(); }
        grid_blocks = cus * per_cu;
    }
    if (grid_blocks < 0) return;
    if (hipMemsetAsync((unsigned char*)d_ws + W_BAR, 0, XCD_BAR_WORDS * 4, stream) != hipSuccess) { fprintf(stderr, "kernel_launch: memset of barrier words failed\n"); return; }
    Params p{};
    for (int i = 0; i < 28; ++i) p.in[i] = (const float*)d_in[i];
    p.out = (float*)d_out; p.ws = (unsigned char*)d_ws;
    void* args[] = {&p};
    hipError_t e = hipLaunchCooperativeKernel((const void*)fwd_megakernel, dim3(grid_blocks), dim3(512), args, LDS_BYTES, stream);
    if (e != hipSuccess) fprintf(stderr, "kernel_launch: cooperative launch failed: %s (grid %d)\n", hipGetErrorString(e), grid_blocks);
}
```

```cpp
#include <hip/hip_runtime.h>
#include <hip/hip_cooperative_groups.h>
#include <cstdio>
namespace cg = cooperative_groups;
namespace pg8 {
#define PG8_LAS __attribute__((address_space(3)))
typedef unsigned short bf16_t;
typedef short bf16x8 __attribute__((ext_vector_type(8)));
typedef float f32x4 __attribute__((ext_vector_type(4)));
typedef unsigned u32x4 __attribute__((ext_vector_type(4)));
constexpr int BM = 256, BK = 64, HALF = 128, HTB = HALF * BK * 2  , STAGE_BYTES = 8 * HTB, NXCD = 8, WGM = 8;

__host__ __device__ __forceinline__ int lds_byte(int r, int c) { const int st = (r >> 4) * 2 + (c >> 5), rr = r & 15, cc = c & 31, ob = rr * 64 + cc * 2; return st * 1024 + (ob ^ (((ob >> 9) & 1) << 5)); }
__host__ __device__ __forceinline__ void stage_rc(int b, int& R, int& C) { const int st = b / 1024, sb = b % 1024, swz = sb ^ (((sb >> 9) & 1) << 5); R = (st >> 1) * 16 + swz / 64; C = (st & 1) * 32 + (swz % 64) / 2; }
__host__ __device__ __forceinline__ int perm32(int rho) { const int n = rho >> 4, i = rho & 15; return 8 * (i >> 2) + 4 * n + (i & 3); }

struct Unit { int pm, pn, pk; };
struct Gemm { const bf16_t* A; const bf16_t* Bt; int M, N, K, ld; };

struct StaticOrder {
    int nM, nN, nwg, G, c;
    __host__ __device__ void init(int M, int N, int G_, int c_) { nM = M / BM; nN = N / BM; nwg = nM * nN; G = G_; c = c_; }
    __host__ __device__ bool next(int i, Unit& u) const {
        const long L = (long)i * G + c; if (L >= nwg) return false;
        int wgid = (int)L; { const int q = nwg / NXCD, r = nwg % NXCD, xcd = wgid % NXCD, off = wgid / NXCD; wgid = (xcd < r ? xcd * (q + 1) : r * (q + 1) + (xcd - r) * q) + off; }
        const int nig = WGM * nN, gid = wgid / nig, fm = gid * WGM, gsz = (nM - fm) < WGM ? (nM - fm) : WGM;
        u.pm = fm + ((wgid % nig) % gsz); u.pn = (wgid % nig) / gsz; u.pk = 0; return true;
    }
    __device__ __forceinline__ void a_ready(const Unit&) const {}
    __device__ __forceinline__ void done(const Unit&) const {}
};
__device__ __forceinline__ unsigned cvt_pk_bf16(float lo, float hi) { unsigned r; asm volatile("v_cvt_pk_bf16_f32 %0, %1, %2" : "=v"(r) : "v"(lo), "v"(hi)); return r; }
template <class Epi, class Sched>
__device__ __forceinline__ void gemm_phase(PG8_LAS unsigned char* lds, const Gemm g, const Sched& S, const Epi& E) {
    int tid_ = threadIdx.x; asm volatile("" : "+v"(tid_));
    const int tid = tid_, wid = __builtin_amdgcn_readfirstlane(tid >> 6), lane = tid & 63, wr = wid >> 2, wc = wid & 3, fr = lane & 15, fq = lane >> 4;
    const int K = g.K, nt = K / BK, ld = g.ld;
    unsigned voffA[2], voffB[2];
#pragma unroll
    for (int i = 0; i < 2; ++i) { int R, C; stage_rc(tid * 16 + i * 8192, R, C); const int Rb = Epi::PERM ? ((R & ~31) + perm32(R & 31)) : R;
        voffA[i] = (unsigned)(R * ld + C) * 2u; voffB[i] = (unsigned)(Rb * ld + C) * 2u; }
    const size_t kstep = (size_t)(BK * 2);
    const size_t hstep = (size_t)HALF * ld * 2;
    const size_t tstep = 2 * hstep;
    const unsigned ldsw = (unsigned)wid * 1024u;
    const int aoff = lds_byte(wr * 64 + fr, fq * 8), boff = lds_byte(wc * 32 + fr, fq * 8);
#define PG8_SA(b, h) (((b) * 2 + (h)) * HTB)
#define PG8_SB(b, h) ((4 + (b) * 2 + (h)) * HTB)
#define PG8_STAGE(bufoff, gbase, voff) do { _Pragma("unroll") for (int _i = 0; _i < 2; ++_i) \
        __builtin_amdgcn_global_load_lds((const unsigned*)((const char*)(gbase) + (voff)[_i]), (PG8_LAS unsigned*)(lds + (bufoff) + ldsw + _i * 8192), 16, 0, 0); } while (0)
#define PG8_LDA(dst, b, h) do { _Pragma("unroll") for (int m = 0; m < 4; ++m) _Pragma("unroll") for (int k = 0; k < 2; ++k) dst[m][k] = *(const PG8_LAS bf16x8*)(lds + PG8_SA(b, h) + aoff + m * 2048 + k * 1024); } while (0)
#define PG8_LDB(dst, b, h) do { _Pragma("unroll") for (int n = 0; n < 2; ++n) _Pragma("unroll") for (int k = 0; k < 2; ++k) dst[n][k] = *(const PG8_LAS bf16x8*)(lds + PG8_SB(b, h) + boff + n * 2048 + k * 1024); } while (0)
#define PG8_MMA(ai, bj, At, Bt) do { __builtin_amdgcn_s_setprio(1); _Pragma("unroll") for (int m = 0; m < 4; ++m) _Pragma("unroll") for (int n = 0; n < 2; ++n) _Pragma("unroll") for (int k = 0; k < 2; ++k) \
        acc[ai][bj][m][n] = __builtin_amdgcn_mfma_f32_16x16x32_bf16(Bt[n][k], At[m][k], acc[ai][bj][m][n], 0, 0, 0); __builtin_amdgcn_s_setprio(0); } while (0)
#define PG8_WAIT_V(n) asm volatile("s_waitcnt vmcnt(" #n ")" ::: "memory")
#define PG8_WAIT_L(n) asm volatile("s_waitcnt lgkmcnt(" #n ")" ::: "memory")
#define PG8_BAR __builtin_amdgcn_s_barrier()
#define PG8_SCHED __builtin_amdgcn_sched_barrier(0)
    Unit cur, nxt; int ui = 0;
    if (!S.next(0, cur)) return;
    f32x4 acc[2][2][4][2];
#pragma unroll
    for (int a = 0; a < 2; ++a)
#pragma unroll
        for (int b = 0; b < 2; ++b)
#pragma unroll
            for (int m = 0; m < 4; ++m)
#pragma unroll
                for (int n = 0; n < 2; ++n) acc[a][b][m][n] = (f32x4){0.f, 0.f, 0.f, 0.f};
    bf16x8 At[4][2], B0[2][2], B1[2][2];
    const char* cA = (const char*)g.A + (size_t)cur.pm * tstep + (size_t)cur.pk * K * 2; const char* cB = (const char*)g.Bt + (size_t)cur.pn * tstep + (size_t)cur.pk * K * 2;
    S.a_ready(cur);
    PG8_STAGE(PG8_SB(0, 0), cB, voffB); PG8_STAGE(PG8_SA(0, 0), cA, voffA); PG8_STAGE(PG8_SB(0, 1), cB + hstep, voffB); PG8_STAGE(PG8_SA(0, 1), cA + hstep, voffA);
    if (wr == 1) PG8_BAR;
    PG8_WAIT_V(4); PG8_BAR;
    PG8_STAGE(PG8_SB(1, 0), cB + kstep, voffB); PG8_STAGE(PG8_SA(1, 0), cA + kstep, voffA); PG8_STAGE(PG8_SB(1, 1), cB + hstep + kstep, voffB);
    PG8_WAIT_V(6); PG8_BAR;
    for (;;) {
        const bool has_next = S.next(ui + 1, nxt);
        const char* nA = has_next ? (const char*)g.A + (size_t)nxt.pm * tstep + (size_t)nxt.pk * K * 2 : cA; const char* nB = has_next ? (const char*)g.Bt + (size_t)nxt.pn * tstep + (size_t)nxt.pk * K * 2 : cB;
        for (int t = 0; t < nt; t += 2) {
            const bool last = (t == nt - 2);
            const char* a1 = cA + (size_t)(t + 1) * kstep;
            const char* a2 = last ? nA : cA + (size_t)(t + 2) * kstep; const char* b2 = last ? nB : cB + (size_t)(t + 2) * kstep;
            const char* a3 = a2 + kstep; const char* b3 = b2 + kstep;
            if (last && has_next) S.a_ready(nxt);
            PG8_LDB(B0, 0, 0); PG8_SCHED; PG8_LDA(At, 0, 0); PG8_STAGE(PG8_SA(1, 1), a1 + hstep, voffA);
            PG8_WAIT_L(8); PG8_BAR; PG8_WAIT_L(0); PG8_MMA(0, 0, At, B0); PG8_BAR; PG8_SCHED;
            PG8_LDB(B1, 0, 1); PG8_STAGE(PG8_SB(0, 0), b2, voffB);
            PG8_BAR; PG8_WAIT_L(0); PG8_MMA(0, 1, At, B1); PG8_BAR;
            PG8_LDA(At, 0, 1); PG8_STAGE(PG8_SA(0, 0), a2, voffA);
            PG8_BAR; PG8_WAIT_L(0); PG8_MMA(1, 0, At, B0); PG8_BAR; PG8_SCHED;
            PG8_STAGE(PG8_SB(0, 1), b2 + hstep, voffB);
            PG8_WAIT_V(6); PG8_BAR; PG8_MMA(1, 1, At, B1); PG8_BAR;
            PG8_LDB(B0, 1, 0); PG8_SCHED; PG8_LDA(At, 1, 0); PG8_STAGE(PG8_SA(0, 1), a2 + hstep, voffA);
            PG8_WAIT_L(8); PG8_BAR; PG8_WAIT_L(0); PG8_MMA(0, 0, At, B0); PG8_BAR; PG8_SCHED;
            PG8_LDB(B1, 1, 1); PG8_STAGE(PG8_SB(1, 0), b3, voffB);
            PG8_BAR; PG8_WAIT_L(0); PG8_MMA(0, 1, At, B1); PG8_BAR;
            PG8_LDA(At, 1, 1); PG8_STAGE(PG8_SA(1, 0), a3, voffA);
            PG8_BAR; PG8_WAIT_L(0); PG8_MMA(1, 0, At, B0); PG8_BAR; PG8_SCHED;
            PG8_STAGE(PG8_SB(1, 1), b3 + hstep, voffB);
            PG8_WAIT_V(6); PG8_BAR; PG8_MMA(1, 1, At, B1); PG8_BAR;
        }
        if constexpr (!Epi::AFTER_DRAIN) { E(acc, cur, wr, wc, fr, fq); S.done(cur); }
        if (!has_next) break;
#pragma unroll
        for (int a = 0; a < 2; ++a)
#pragma unroll
            for (int b = 0; b < 2; ++b)
#pragma unroll
                for (int m = 0; m < 4; ++m)
#pragma unroll
                    for (int n = 0; n < 2; ++n) acc[a][b][m][n] = (f32x4){0.f, 0.f, 0.f, 0.f};
        cur = nxt; cA = nA; cB = nB; ++ui;
    }
    PG8_WAIT_V(0);
    if (wr == 0) PG8_BAR;
    PG8_BAR;
    if constexpr (Epi::AFTER_DRAIN) { E.fused(acc, cur, wr, wc, fr, fq, lds, wid, lane); S.done(cur); }
#undef PG8_SA
#undef PG8_SB
#undef PG8_STAGE
#undef PG8_LDA
#undef PG8_LDB
#undef PG8_MMA
#undef PG8_WAIT_V
#undef PG8_WAIT_L
#undef PG8_BAR
#undef PG8_SCHED
}
}

#define XB_TMO      128
#define XB_XCNT(j)  (256  + 64 * (j))
#define XB_XSUB(j)  (1280 + 64 * (j))
#define XB_XGEN(j)  (2304 + 64 * (j))
#define XB_TOP      3328
#define XB_TOPGEN   3392
#define XCD_BAR_WORDS 3456
#define XB_SPIN_CAP (1u << 18)
#define XLAS __attribute__((address_space(3)))

__device__ __forceinline__ unsigned xb_ld(unsigned* p)              { return __hip_atomic_load(p, __ATOMIC_RELAXED, __HIP_MEMORY_SCOPE_AGENT); }
__device__ __forceinline__ unsigned xb_add(unsigned* p, unsigned v) { return __hip_atomic_fetch_add(p, v, __ATOMIC_RELAXED, __HIP_MEMORY_SCOPE_AGENT); }
__device__ __forceinline__ unsigned xb_xcc_id() { return (unsigned)__builtin_amdgcn_s_getreg((3 << 11) | 20) & 0xFu; }
#define XB_SPIN(cond, bar) do { unsigned _sp = 0; while (cond) { __builtin_amdgcn_s_sleep(1); \
    if ((++_sp & 255u) == 0u) { if (xb_ld(&(bar)[XB_TMO])) break; if (_sp > XB_SPIN_CAP) { atomicAdd(&(bar)[XB_TMO], 1u); break; } } } } while (0)

struct XcdBarrier {
    unsigned* bar; unsigned x;
    volatile XLAS unsigned* st;
};

__device__ __forceinline__ XcdBarrier xcd_barrier_post(unsigned* bar, volatile XLAS unsigned* st) {
    XcdBarrier b; b.bar = bar; b.x = xb_xcc_id(); b.st = st;
    if (threadIdx.x == 0) (void)xb_add(&bar[XB_XCNT(b.x)], 1u);
    return b;
}
__device__ __forceinline__ void xcd_barrier_complete(unsigned* bar, unsigned x, unsigned& nloc, unsigned& nx) {
    const unsigned G = gridDim.x * gridDim.y * gridDim.z;
    unsigned sum, cnt, mine, sp = 0u;
    for (;;) {
        sum = 0u; cnt = 0u; mine = 0u;
#pragma unroll
        for (unsigned j = 0; j < 16; ++j) { const unsigned c = xb_ld(&bar[XB_XCNT(j)]); sum += c; cnt += (c > 0u) ? 1u : 0u; mine = (j == x) ? c : mine; }
        if (sum == G) break;
        __builtin_amdgcn_s_sleep(1);
        if ((++sp & 255u) == 0u) { if (xb_ld(&bar[XB_TMO])) break; if (sp > XB_SPIN_CAP) { atomicAdd(&bar[XB_TMO], 1u); break; } }
    }
    nloc = mine > 0u ? mine : 1u; nx = cnt > 0u ? cnt : 1u;
}

__device__ __forceinline__ void xcd_barrier(const XcdBarrier& b) {
    asm volatile("s_waitcnt vmcnt(0)" ::: "memory");
    __syncthreads();
    if (threadIdx.x == 0) {
        unsigned* bar = b.bar;
        __builtin_amdgcn_s_waitcnt(0);
        unsigned nloc = b.st[0], nx = b.st[1];
        if (nloc == 0u) { xcd_barrier_complete(bar, b.x, nloc, nx); b.st[0] = nloc; b.st[1] = nx; }
        const unsigned old = xb_add(&bar[XB_XSUB(b.x)], 1u);
        const unsigned gen = old / nloc;
        if (old + 1u == (gen + 1u) * nloc) {
            __builtin_amdgcn_fence(__ATOMIC_RELEASE, "agent");
            asm volatile("s_waitcnt vmcnt(0)" ::: "memory");
            const unsigned og = xb_add(&bar[XB_TOP], 1u);
            const unsigned tg = og / nx;
            if (og + 1u == (tg + 1u) * nx) xb_add(&bar[XB_TOPGEN], 1u);
            else XB_SPIN(xb_ld(&bar[XB_TOPGEN]) == tg, bar);
            __builtin_amdgcn_fence(__ATOMIC_ACQUIRE, "agent");
            xb_add(&bar[XB_XGEN(b.x)], 1u);
            asm volatile("s_waitcnt vmcnt(0)" ::: "memory");
        } else {
            XB_SPIN(xb_ld(&bar[XB_XGEN(b.x)]) == gen, bar);
            __builtin_amdgcn_fence(__ATOMIC_ACQUIRE, "agent");
            asm volatile("s_waitcnt vmcnt(0)" ::: "memory");
        }
    }
    __syncthreads();
}

using pg8::bf16_t; using pg8::f32x4; using pg8::bf16x8;
typedef unsigned u32x4_t __attribute__((ext_vector_type(4)));
typedef unsigned u32x2_t __attribute__((ext_vector_type(2)));

constexpr int DM = 1024, NBP = 8, SEQ = 2048, NBS = 128, SSEQ = 4, NH = 4, HD = 128, MW = 512;
constexpr int MP = NBP * SEQ, MS = NBS * SSEQ, MT = MP + MS;
constexpr int NIN = 9232, N1 = 9216, DFF = 2816, NUP = 5632;
constexpr float EPS = 1e-6f;
constexpr float QSCALE = 0.08838834764831845f;

constexpr size_t O_Y = 0;
constexpr size_t O_P_GS = (size_t)MT * DM;
constexpr size_t O_P_GC = O_P_GS + (size_t)2 * 8 * 4 * 128 * 128;
constexpr size_t O_P_MC = O_P_GC + (size_t)2 * 8 * 3 * 1536;
constexpr size_t O_P_MN = O_P_MC + (size_t)2 * 8 * 4 * 128 * 128;
constexpr size_t O_P_MM = O_P_MN + (size_t)2 * 8 * 4 * 128;
constexpr size_t O_P_HS = O_P_MM + (size_t)2 * 8 * 4;
constexpr size_t O_P_FC = O_P_HS + (size_t)2 * 8 * 4 * 128 * 128;
constexpr size_t O_S_GS = O_P_FC + (size_t)2 * 8 * 2 * 5632;
constexpr size_t O_S_GC = O_S_GS + (size_t)2 * 128 * 4 * 128 * 128;
constexpr size_t O_S_MC = O_S_GC + (size_t)2 * 128 * 3 * 1536;
constexpr size_t O_S_MN = O_S_MC + (size_t)2 * 128 * 4 * 128 * 128;
constexpr size_t O_S_MM = O_S_MN + (size_t)2 * 128 * 4 * 128;
constexpr size_t O_S_HS = O_S_MM + (size_t)2 * 128 * 4;
constexpr size_t O_S_FC = O_S_HS + (size_t)2 * 128 * 4 * 128 * 128;
constexpr size_t O_END  = O_S_FC + (size_t)2 * 128 * 2 * 5632;

constexpr size_t W_WIN = 0;
constexpr size_t W_WBR = W_WIN + (size_t)N1 * 1024 * 2;
constexpr size_t W_WOUT = W_WBR + (size_t)3 * 1024 * 512 * 2;
constexpr size_t W_WUP = W_WOUT + (size_t)1024 * 1024 * 2;
constexpr size_t W_WDN = W_WUP + (size_t)NUP * 1024 * 2;
constexpr size_t W_HBF = W_WDN + (size_t)1024 * DFF * 2;
constexpr size_t W_PROJ = W_HBF + (size_t)MT * 1024 * 2;
constexpr size_t W_ACT = W_PROJ + (size_t)MT * NUP * 2;
constexpr size_t W_OUTS = W_PROJ + (size_t)MT * N1 * 2;
constexpr size_t W_GATES = W_OUTS + (size_t)3 * MT * 512 * 2;
constexpr size_t W_DEN = W_GATES + (size_t)MT * 16 * 4;
constexpr size_t W_MT = W_DEN + (size_t)MT * 4 * 4;
constexpr size_t W_BAR = W_MT + (size_t)MT * 4 * 4;
constexpr size_t W_END = W_BAR + 16384;

constexpr int LDS_MAIN = 143360;
constexpr int LDS_BYTES = LDS_MAIN + 64 + 512;

struct Params { const float* in[28]; float* out; unsigned char* ws; };
enum { I_XP = 0, I_XS, I_SGS, I_SGC, I_SMC, I_SMN, I_SMM, I_SHS, I_SFC, I_LNMIX, I_WIN, I_GCW, I_ALOG, I_DTB, I_GNORM, I_MIB, I_MFB, I_MNORM, I_HLB, I_HNORM,
       I_WBR, I_WOUT, I_LNFFN, I_WUP, I_FCW, I_FCB, I_WDN, I_LNF };

typedef const float* const __attribute__((address_space(4))) * kargp_t;
__device__ __forceinline__ const float* argp(int i) { kargp_t kp = (kargp_t)__builtin_amdgcn_kernarg_segment_ptr(); asm volatile("" : "+s"(i)); return kp[i]; }
__device__ __forceinline__ int bidx() { int b = (int)blockIdx.x; asm volatile("" : "+s"(b)); return b; }
__device__ __forceinline__ int gdim() { int g = (int)gridDim.x; asm volatile("" : "+s"(g)); return g; }
#define PIN(i) argp(i)
#define POUT ((float*)argp(28))
#define PWS ((unsigned char*)argp(29))
__device__ __forceinline__ float bf2f(bf16_t b) { return __uint_as_float(((unsigned)b) << 16); }
__device__ __forceinline__ float bflo(unsigned u) { return __uint_as_float(u << 16); }
__device__ __forceinline__ float bfhi(unsigned u) { return __uint_as_float(u & 0xffff0000u); }
__device__ __forceinline__ bf16_t f2bf(float f) { return (bf16_t)(pg8::cvt_pk_bf16(f, 0.f) & 0xffffu); }
__device__ __forceinline__ float sigm(float x) { return __builtin_amdgcn_rcpf(1.f + __expf(-x)); }
__device__ __forceinline__ float silu(float x) { return x * sigm(x); }
__device__ __forceinline__ float rdlane(float x, int l) { return __builtin_bit_cast(float, __builtin_amdgcn_readlane(__builtin_bit_cast(int, x), l)); }
template <int CTRL> __device__ __forceinline__ float dppf(float x) { return __builtin_bit_cast(float, __builtin_amdgcn_update_dpp(0, __builtin_bit_cast(int, x), CTRL, 0xf, 0xf, true)); }
__device__ __forceinline__ float grp_sum8(float x) { x += dppf<0xB1>(x); x += dppf<0x4E>(x); x += dppf<0x141>(x); return x; }
__device__ __forceinline__ float grp_sum16(float x) { x = grp_sum8(x); x += dppf<0x140>(x); return x; }
__device__ __forceinline__ float wave_sum(float x) { x = grp_sum16(x);
    x += __builtin_bit_cast(float, __builtin_amdgcn_update_dpp(0, __builtin_bit_cast(int, x), 0x142, 0xa, 0xf, false));
    x += __builtin_bit_cast(float, __builtin_amdgcn_update_dpp(0, __builtin_bit_cast(int, x), 0x143, 0xc, 0xf, false));
    return rdlane(x, 63); }
template <int CTRL> __device__ __forceinline__ float dppm(float x) { return __builtin_bit_cast(float, __builtin_amdgcn_update_dpp(__builtin_bit_cast(int, -INFINITY), __builtin_bit_cast(int, x), CTRL, 0xf, 0xf, false)); }
template <int T> __device__ __forceinline__ float grp_sum(float x) { if constexpr (T == 16) return grp_sum16(x); else return grp_sum8(x); }

__device__ __forceinline__ int win_srccol(int n0) { const int blk = n0 >> 9, r = n0 & 511; int base;
    if (blk < 4) base = blk * 512; else if (blk < 8) base = 2056 + (blk - 4) * 512; else if (blk < 12) base = 4112 + (blk - 8) * 512; else base = 6160 + (blk - 12) * 512;
    return base + r; }
__device__ __forceinline__ void conv_T(const float* __restrict__ src, int ld, bf16_t* __restrict__ dst, int K, int N, bool winmap, float* tile, int& tcount) {
    int tid_ = threadIdx.x; asm volatile("" : "+v"(tid_)); const int tid = tid_, ntn = N / 64, ntiles = ntn * (K / 64);
    for (int t = bidx() - (tcount % gdim()); t < ntiles; t += gdim()) {
        if (t < 0) continue;
        const int tn = t % ntn, tk = t / ntn, n0 = tn * 64, k0 = tk * 64, sc0 = winmap ? win_srccol(n0) : n0;
        __syncthreads();
        { const int kk = tid >> 4, n4 = (tid & 15) * 4;
#pragma unroll
          for (int pp = 0; pp < 2; ++pp) { const float4 v = *(const float4*)(src + (size_t)(k0 + kk + 32 * pp) * ld + sc0 + n4); float* tp = tile + (kk + 32 * pp) * 65 + n4; tp[0] = v.x; tp[1] = v.y; tp[2] = v.z; tp[3] = v.w; } }
        __syncthreads();
        { const int n = tid >> 3, k8 = (tid & 7) * 8; float f[8];
#pragma unroll
          for (int i = 0; i < 8; ++i) f[i] = tile[(k8 + i) * 65 + n];
          u32x4_t o; o[0] = pg8::cvt_pk_bf16(f[0], f[1]); o[1] = pg8::cvt_pk_bf16(f[2], f[3]); o[2] = pg8::cvt_pk_bf16(f[4], f[5]); o[3] = pg8::cvt_pk_bf16(f[6], f[7]);
          *(u32x4_t*)(dst + (size_t)(n0 + n) * K + k0 + k8) = o; }
    }
    tcount += ntiles;
}

__device__ __forceinline__ void phase_rmsnorm(const Params& p, int l, const float* xa, const float* xb, const float* __restrict__ gw, bf16_t* __restrict__ hout, bool do_gates, float* sm) {
    int tid_ = threadIdx.x; asm volatile("" : "+v"(tid_)); const int tid = tid_, lane = tid & 63, w = tid >> 6;
    float* wgT = sm;
    if (do_gates) {
        const float* win = PIN(I_WIN) + (size_t)l * 1024 * NIN;
        __syncthreads();
        for (int i = tid; i < 16 * 1024; i += 512) { const int k = i >> 4, j = i & 15; const int gc = j < 8 ? 2048 + j : 4104 + (j - 8); wgT[j * 1024 + k] = win[(size_t)k * NIN + gc]; }
        __syncthreads();
    }
    float4 g4[4];
#pragma unroll
    for (int i = 0; i < 4; ++i) g4[i] = *(const float4*)(gw + lane * 4 + 256 * i);
    for (int row = bidx() * 8 + w; row < MT; row += gdim() * 8) {
        const float* xr = row < MP ? xa + (size_t)row * DM : xb + (size_t)(row - MP) * DM;
        float4 v[4]; float ss = 0.f;
#pragma unroll
        for (int i = 0; i < 4; ++i) { v[i] = *(const float4*)(xr + lane * 4 + 256 * i); ss += v[i].x * v[i].x + v[i].y * v[i].y + v[i].z * v[i].z + v[i].w * v[i].w; }
        ss = wave_sum(ss);
        const float rstd = rsqrtf(ss * (1.f / 1024.f) + EPS);
#pragma unroll
        for (int i = 0; i < 4; ++i) { v[i].x *= rstd * g4[i].x; v[i].y *= rstd * g4[i].y; v[i].z *= rstd * g4[i].z; v[i].w *= rstd * g4[i].w;
            u32x2_t o; o[0] = pg8::cvt_pk_bf16(v[i].x, v[i].y); o[1] = pg8::cvt_pk_bf16(v[i].z, v[i].w);
            *(u32x2_t*)(hout + (size_t)row * DM + lane * 4 + 256 * i) = o; }
        if (do_gates) {
            float mine = 0.f;
#pragma unroll
            for (int j = 0; j < 16; ++j) { float a = 0.f;
#pragma unroll
                for (int i = 0; i < 4; ++i) { const float4 wv = *(const float4*)(wgT + j * 1024 + lane * 4 + 256 * i); a += v[i].x * wv.x + v[i].y * wv.y + v[i].z * wv.z + v[i].w * wv.w; }
                a = wave_sum(a); if (lane == j) mine = a; }
            if (lane < 16) { const int h = lane & 3, kind = lane >> 2; float r;
                if (kind == 0) r = sigm(mine);
                else if (kind == 1) { const float xx = mine + PIN(I_DTB)[l * 4 + h]; const float sp = xx > 20.f ? xx : __logf(1.f + __expf(xx)); r = __expf(-__expf(PIN(I_ALOG)[l * 4 + h]) * sp); }
                else if (kind == 2) r = mine + PIN(I_MIB)[l * 4 + h];
                else { const float xx = -(mine + PIN(I_MFB)[l * 4 + h]); r = -(xx > 20.f ? xx : __logf(1.f + __expf(xx))); }
                ((float*)(PWS + W_GATES))[(size_t)row * 16 + lane] = r; }
        }
    }
}

struct EpiProj {
    static constexpr bool PERM = true, AFTER_DRAIN = false;
    bf16_t* O; int ldc; int actmode;
    __device__ __forceinline__ void operator()(const f32x4 (&acc)[2][2][4][2], const pg8::Unit& u, int wr, int wc, int fr, int fq) const {
        const int row0 = u.pm * 256 + wr * 64 + fr, col0 = u.pn * 256 + wc * 32 + 8 * fq;
        int act = 0;
        if (actmode) { const int pn = u.pn; act = (pn >= 24 || pn == 14 || pn == 15) ? 2 : ((pn == 6 || pn == 7 || pn == 16 || pn == 17 || pn == 22 || pn == 23) ? 1 : 0); }
#pragma unroll
        for (int ai = 0; ai < 2; ++ai)
#pragma unroll
            for (int m = 0; m < 4; ++m) { bf16_t* rowp = O + (size_t)(row0 + ai * 128 + m * 16) * ldc + col0;
#pragma unroll
                for (int bj = 0; bj < 2; ++bj) { float v[8];
#pragma unroll
                    for (int i = 0; i < 4; ++i) { v[i] = acc[ai][bj][m][0][i]; v[4 + i] = acc[ai][bj][m][1][i]; }
                    if (act == 1) {
#pragma unroll
                        for (int i = 0; i < 8; ++i) v[i] = silu(v[i]); }
                    else if (act == 2) {
#pragma unroll
                        for (int i = 0; i < 8; ++i) v[i] = sigm(v[i]); }
                    u32x4_t o; o[0] = pg8::cvt_pk_bf16(v[0], v[1]); o[1] = pg8::cvt_pk_bf16(v[2], v[3]); o[2] = pg8::cvt_pk_bf16(v[4], v[5]); o[3] = pg8::cvt_pk_bf16(v[6], v[7]);
                    *(u32x4_t*)(rowp + bj * 128) = o; } }
    }
};
struct EpiMerge {
    static constexpr bool PERM = true, AFTER_DRAIN = false;
    const bf16_t* G; bf16_t* Mx;
    __device__ __forceinline__ void operator()(const f32x4 (&acc)[2][2][4][2], const pg8::Unit& u, int wr, int wc, int fr, int fq) const {
        const int n = u.pn >> 2, first = (n == 0);
        const int row0 = (u.pm - n * (MT / 256)) * 256 + wr * 64 + fr, col0 = (u.pn & 3) * 256 + wc * 32 + 8 * fq;
        const bf16_t* Gn = G + n * 1024 + col0; bf16_t* Mc = Mx + col0;
        u32x4_t gc[2], oc[2], gn[2], on[2];
#pragma unroll
        for (int bj = 0; bj < 2; ++bj) { gc[bj] = *(const u32x4_t*)(Gn + (size_t)row0 * N1 + bj * 128); oc[bj] = first ? (u32x4_t){0u, 0u, 0u, 0u} : *(const u32x4_t*)(Mc + (size_t)row0 * DM + bj * 128); }
#pragma unroll
        for (int gI = 0; gI < 8; ++gI) { const int ai = gI >> 2, m = gI & 3; const size_t row = (size_t)(row0 + ai * 128 + m * 16);
            if (gI < 7) { const size_t row2 = (size_t)(row0 + ((gI + 1) >> 2) * 128 + ((gI + 1) & 3) * 16);
#pragma unroll
                for (int bj = 0; bj < 2; ++bj) { gn[bj] = *(const u32x4_t*)(Gn + row2 * N1 + bj * 128); on[bj] = first ? (u32x4_t){0u, 0u, 0u, 0u} : *(const u32x4_t*)(Mc + row2 * DM + bj * 128); } }
#pragma unroll
            for (int bj = 0; bj < 2; ++bj) { float v[8];
#pragma unroll
                for (int i = 0; i < 4; ++i) { v[i] = acc[ai][bj][m][0][i]; v[4 + i] = acc[ai][bj][m][1][i]; }
#pragma unroll
                for (int i = 0; i < 4; ++i) { v[2 * i] = v[2 * i] * bflo(gc[bj][i]) + bflo(oc[bj][i]); v[2 * i + 1] = v[2 * i + 1] * bfhi(gc[bj][i]) + bfhi(oc[bj][i]); }
                u32x4_t o; o[0] = pg8::cvt_pk_bf16(v[0], v[1]); o[1] = pg8::cvt_pk_bf16(v[2], v[3]); o[2] = pg8::cvt_pk_bf16(v[4], v[5]); o[3] = pg8::cvt_pk_bf16(v[6], v[7]);
                *(u32x4_t*)(Mc + row * DM + bj * 128) = o; }
#pragma unroll
            for (int bj = 0; bj < 2; ++bj) { gc[bj] = gn[bj]; oc[bj] = on[bj]; } }
    }
};
struct EpiResid {
    static constexpr bool PERM = false, AFTER_DRAIN = false;
    float* X; const float* Sa; const float* Sb;
    __device__ __forceinline__ void operator()(const f32x4 (&acc)[2][2][4][2], const pg8::Unit& u, int wr, int wc, int fr, int fq) const {
        const int row0 = u.pm * 256 + wr * 64 + fr, col0 = u.pn * 256 + wc * 32 + 4 * fq;
        const float* S = u.pm * 256 < MP ? Sa : Sb - (size_t)MP * DM;
        f32x4 cur[4], nxt[4];
#pragma unroll
        for (int q = 0; q < 4; ++q) cur[q] = *(const f32x4*)(S + (size_t)row0 * DM + col0 + (q >> 1) * 128 + (q & 1) * 16);
#pragma unroll
        for (int gI = 0; gI < 8; ++gI) { const int ai = gI >> 2, m = gI & 3; const size_t ro = (size_t)(row0 + ai * 128 + m * 16) * DM + col0;
            if (gI < 7) { const int ai2 = (gI + 1) >> 2, m2 = (gI + 1) & 3; const size_t ro2 = (size_t)(row0 + ai2 * 128 + m2 * 16) * DM + col0;
#pragma unroll
                for (int q = 0; q < 4; ++q) nxt[q] = *(const f32x4*)(S + ro2 + (q >> 1) * 128 + (q & 1) * 16); }
#pragma unroll
            for (int q = 0; q < 4; ++q) *(f32x4*)(X + ro + (q >> 1) * 128 + (q & 1) * 16) = cur[q] + acc[ai][q >> 1][m][q & 1];
#pragma unroll
            for (int q = 0; q < 4; ++q) cur[q] = nxt[q]; }
    }
};

struct EpiAtomic {
    static constexpr bool PERM = false, AFTER_DRAIN = false;
    float* X;
    __device__ __forceinline__ void operator()(const f32x4 (&acc)[2][2][4][2], const pg8::Unit& u, int wr, int wc, int fr, int fq) const {
        const int row0 = u.pm * 256 + wr * 64 + fr, col0 = u.pn * 256 + wc * 32 + 4 * fq;
#pragma unroll
        for (int ai = 0; ai < 2; ++ai)
#pragma unroll
            for (int m = 0; m < 4; ++m) { float* rowp = X + (size_t)(row0 + ai * 128 + m * 16) * DM + col0;
#pragma unroll
                for (int bj = 0; bj < 2; ++bj)
#pragma unroll
                    for (int n = 0; n < 2; ++n)
#pragma unroll
                        for (int e = 0; e < 4; ++e) unsafeAtomicAdd(rowp + bj * 128 + n * 16 + e, acc[ai][bj][m][n][e]); }
    }
};
struct MergeOrder {
    pg8::StaticOrder base;
    __device__ void init(int G_, int c_) { base.init(MT, 1024, G_, c_); }
    __device__ bool next(int i, pg8::Unit& u) const { const int t = i / 3, n = i - 3 * t; pg8::Unit b; if (!base.next(t, b)) return false; u.pm = n * (MT / 256) + b.pm; u.pn = n * 4 + b.pn; u.pk = 0; return true; }
    __device__ __forceinline__ void a_ready(const pg8::Unit&) const {}
    __device__ __forceinline__ void done(const pg8::Unit&) const {}
};
struct PieceOrder {
    int G, c, KP;
    __device__ bool next(int i, pg8::Unit& u) const { const int L = i * G + c; if (L >= 8 * KP) return false; const int tile = L / KP; u.pk = L - tile * KP; u.pm = MP / 256 + (tile >> 2); u.pn = tile & 3; return true; }
    __device__ __forceinline__ void a_ready(const pg8::Unit&) const {}
    __device__ __forceinline__ void done(const pg8::Unit&) const {}
};
__device__ __forceinline__ void phase_gdnprep(const Params& p, int l) {
    int tid_ = threadIdx.x; asm volatile("" : "+v"(tid_)); const int tid = tid_, j = tid & 15;
    const bf16_t* proj = (const bf16_t*)(PWS + W_PROJ);
    bf16_t* qkd = (bf16_t*)(PWS + W_HBF); bf16_t* vd = (bf16_t*)(PWS + W_OUTS);
    const float* cw = PIN(I_GCW) + (size_t)l * 4 * 1536; const float* cst = PIN(I_SGC) + (size_t)l * NBS * 3 * 1536;
    const int ngroups = MT * 12;
    for (int gid = bidx() * 32 + (tid >> 4); gid < ngroups; gid += gdim() * 32) {
        const int r = gid / 12, part = gid - r * 12, col = part * 128 + 8 * j;
        const bool samp = r >= MP; const int t = samp ? ((r - MP) & 3) : (r & (SEQ - 1)), b2 = samp ? ((r - MP) >> 2) : 0;
        float y[8];
#pragma unroll
        for (int i = 0; i < 8; ++i) y[i] = 0.f;
#pragma unroll
        for (int jj = 0; jj < 4; ++jj) { const int tt = t - 3 + jj; float x[8];
            if (tt >= 0) { const u32x4_t raw = *(const u32x4_t*)(proj + (size_t)(r - 3 + jj) * N1 + col);
#pragma unroll
                for (int i = 0; i < 4; ++i) { x[2 * i] = bflo(raw[i]); x[2 * i + 1] = bfhi(raw[i]); } }
            else if (samp) { const float* cp = cst + (size_t)(b2 * 3 + 3 + tt) * 1536 + col; const float4 a0 = *(const float4*)cp, a1 = *(const float4*)(cp + 4);
                x[0] = a0.x; x[1] = a0.y; x[2] = a0.z; x[3] = a0.w; x[4] = a1.x; x[5] = a1.y; x[6] = a1.z; x[7] = a1.w; }
            else {
#pragma unroll
                for (int i = 0; i < 8; ++i) x[i] = 0.f; }
            const float4 w0 = *(const float4*)(cw + jj * 1536 + col), w1 = *(const float4*)(cw + jj * 1536 + col + 4);
            y[0] += w0.x * x[0]; y[1] += w0.y * x[1]; y[2] += w0.z * x[2]; y[3] += w0.w * x[3]; y[4] += w1.x * x[4]; y[5] += w1.y * x[5]; y[6] += w1.z * x[6]; y[7] += w1.w * x[7]; }
        float ss = 0.f;
#pragma unroll
        for (int i = 0; i < 8; ++i) { y[i] = silu(y[i]); ss += y[i] * y[i]; }
        ss = grp_sum16(ss);
        const float scl = part < 4 ? rsqrtf(ss + EPS) * QSCALE : (part < 8 ? rsqrtf(ss + EPS) : 1.f);
        u32x4_t o; o[0] = pg8::cvt_pk_bf16(y[0] * scl, y[1] * scl); o[1] = pg8::cvt_pk_bf16(y[2] * scl, y[3] * scl); o[2] = pg8::cvt_pk_bf16(y[4] * scl, y[5] * scl); o[3] = pg8::cvt_pk_bf16(y[6] * scl, y[7] * scl);
        if (part < 8) *(u32x4_t*)(qkd + (size_t)r * 1024 + col) = o; else *(u32x4_t*)(vd + (size_t)r * 512 + (col - 1024)) = o;
    }
}

__device__ __forceinline__ void lds_barrier() { asm volatile("s_waitcnt lgkmcnt(0)" ::: "memory"); __builtin_amdgcn_s_barrier(); asm volatile("" ::: "memory"); }
typedef float f2 __attribute__((ext_vector_type(2)));
typedef float f4 __attribute__((ext_vector_type(4)));
template <int MIX>
__device__ __forceinline__ void scan_prompt_item(const Params& p, int l, int b, int h, int cgp, float* sm) {
    constexpr int T = 16, CPL = (MIX == 0) ? 1 : 2, NG = 128 / (4 * T), NP = 2 * NG, CPW = (64 / T) * CPL, CPG = 8 * CPW, TB = 32, BUFSZ = 16512, NBLK = SEQ / TB;
    int tid_ = threadIdx.x; asm volatile("" : "+v"(tid_)); const int tid = tid_, lane = tid & 63, w = tid >> 6, c = lane / T, j = lane % T;
    const int col = w * CPW + c, ecol = cgp * CPG + col;
    float* misc = sm + 2 * BUFSZ; float* gsc = misc; float* mcar = misc + 64;
    const float* gates = (const float*)(PWS + W_GATES);
    bf16_t* outp = (bf16_t*)(PWS + W_OUTS) + (size_t)MIX * MT * 512;
    const size_t rb = (size_t)b * SEQ;
    const int c8 = (tid & 31) * 8, srow = tid >> 5;
    const bf16_t* qsrc; size_t qld; const bf16_t* vsrc; size_t vld;
    if (MIX == 0) { qsrc = (const bf16_t*)(PWS + W_HBF) + rb * 1024 + (c8 < 128 ? h * 128 + c8 : 512 + h * 128 + (c8 - 128)); qld = 1024;
        vsrc = (const bf16_t*)(PWS + W_OUTS) + rb * 512 + h * 128 + cgp * 32; vld = 512; }
    else { const int base = MIX == 1 ? 2048 : 4096; qsrc = (const bf16_t*)(PWS + W_PROJ) + rb * N1 + base + (c8 < 128 ? h * 128 + c8 : 512 + h * 128 + (c8 - 128)); qld = N1;
        vsrc = (const bf16_t*)(PWS + W_PROJ) + rb * N1 + base + 1024 + h * 128 + cgp * 64; vld = N1; }
    constexpr int VPC = CPG / 8;
    const int vs = tid / VPC, vc8 = (tid % VPC) * 8; const bool vact = tid < TB * VPC;
    float lb8[8];
#pragma unroll
    for (int i = 0; i < 8; ++i) lb8[i] = 0.f;
    if (MIX == 2 && l > 0 && c8 >= 128) { const float* hl = PIN(I_HLB);
#pragma unroll
        for (int i = 0; i < 8; ++i) { const int cc = h * 128 + (c8 - 128) + i; lb8[i] = sigm(hl[512 + cc] - hl[cc]); } }
    f2 S2[CPL][NP];
#pragma unroll
    for (int cc = 0; cc < CPL; ++cc)
#pragma unroll
        for (int i = 0; i < NP; ++i) S2[cc][i] = (f2){0.f, 0.f};
    float nn = 0.f, okeep[CPL], oprev[CPL];
#pragma unroll
    for (int cc = 0; cc < CPL; ++cc) { okeep[cc] = 0.f; oprev[cc] = 0.f; }
    u32x4_t rq[2][2], rv[2]; float rg0[2] = {0.f, 0.f}, rg1[2] = {0.f, 0.f};
    rv[0] = (u32x4_t){0u, 0u, 0u, 0u}; rv[1] = rv[0];
#define SCAN_ISSUE(t0_, st_) do { \
        _Pragma("unroll") for (int i_ = 0; i_ < 2; ++i_) rq[st_][i_] = *(const u32x4_t*)(qsrc + (size_t)((t0_) + srow + 16 * i_) * qld); \
        if (vact) rv[st_] = *(const u32x4_t*)(vsrc + (size_t)((t0_) + vs) * vld + vc8); \
        if (MIX != 2 && tid < TB) { const size_t r_ = rb + (t0_) + tid; rg0[st_] = gates[r_ * 16 + (MIX == 0 ? 0 : 8) + h]; rg1[st_] = gates[r_ * 16 + (MIX == 0 ? 4 : 12) + h]; } } while (0)
#define SCAN_FINISH(B_, st_) do { float* qk_ = (B_); float* vv_ = (B_) + 8192; float* sc_ = (B_) + 10240; \
        _Pragma("unroll") for (int i_ = 0; i_ < 2; ++i_) { float x_[8]; \
            _Pragma("unroll") for (int e_ = 0; e_ < 4; ++e_) { x_[2 * e_] = bflo(rq[st_][i_][e_]); x_[2 * e_ + 1] = bfhi(rq[st_][i_][e_]); } \
            if (MIX == 2 && c8 >= 128) { _Pragma("unroll") for (int e_ = 0; e_ < 8; ++e_) x_[e_] = lb8[e_] + (1.f - lb8[e_]) * sigm(x_[e_]); } \
            float* d_ = qk_ + (srow + 16 * i_) * 256 + c8; *(f4*)d_ = (f4){x_[0], x_[1], x_[2], x_[3]}; *(f4*)(d_ + 4) = (f4){x_[4], x_[5], x_[6], x_[7]}; } \
        if (vact) { float* d_ = vv_ + vs * 64 + vc8; *(f4*)d_ = (f4){bflo(rv[st_][0]), bfhi(rv[st_][0]), bflo(rv[st_][1]), bfhi(rv[st_][1])}; *(f4*)(d_ + 4) = (f4){bflo(rv[st_][2]), bfhi(rv[st_][2]), bflo(rv[st_][3]), bfhi(rv[st_][3])}; } \
        if (MIX == 0 && tid < TB) { sc_[tid * 4] = rg0[st_]; sc_[tid * 4 + 1] = rg1[st_]; } \
        if (MIX == 1 && tid < TB) { gsc[tid * 2] = rg0[st_]; gsc[tid * 2 + 1] = rg1[st_]; } } while (0)
#define SCAN_CHAIN(B_) do { if (w == 1) { float* sc_ = (B_) + 10240; const int ls_ = lane & 31; const float m0_ = mcar[0]; \
            const float ig_ = gsc[2 * ls_], lf_ = gsc[2 * ls_ + 1]; \
            float F_ = lf_; F_ += dppf<0x111>(F_); F_ += dppf<0x112>(F_); F_ += dppf<0x114>(F_); F_ += dppf<0x118>(F_);              \
            { const float t0_ = rdlane(F_, 15); if (lane & 16) F_ += t0_; } \
            float P_ = ig_ - F_; P_ = fmaxf(P_, dppm<0x111>(P_)); P_ = fmaxf(P_, dppm<0x112>(P_)); P_ = fmaxf(P_, dppm<0x114>(P_)); P_ = fmaxf(P_, dppm<0x118>(P_)); \
            { const float t1_ = rdlane(P_, 15); if (lane & 16) P_ = fmaxf(P_, t1_); } \
            const float m_ = F_ + fmaxf(m0_, P_); \
            float mp_ = dppf<0x111>(m_); { const float t2_ = rdlane(m_, 15); if ((lane & 15) == 0) mp_ = (lane & 16) ? t2_ : m0_; } \
            const float mlast_ = rdlane(m_, 31); \
            if (lane < 32) { sc_[lane * 4] = __expf(lf_ + mp_ - m_); sc_[lane * 4 + 1] = __expf(ig_ - m_) * QSCALE; sc_[lane * 4 + 2] = m_; } \
            if (lane == 0) mcar[0] = mlast_; } } while (0)
    if (MIX == 1 && tid == 64) mcar[0] = 0.f;
    __syncthreads();
    SCAN_ISSUE(0, 0);
    SCAN_FINISH(sm, 0);
    SCAN_ISSUE(TB, 1);
    __syncthreads();
    if (MIX == 1) { SCAN_CHAIN(sm); __syncthreads(); }
#pragma unroll 1
    for (int blk2 = 0; blk2 < NBLK; blk2 += 2) {
#pragma unroll
      for (int par = 0; par < 2; ++par) {
        const int blk = blk2 + par;
        const int t0 = blk * TB;
        float* B = sm + (blk & 1) * BUFSZ; float* Bn = sm + ((blk & 1) ^ 1) * BUFSZ;
        const float* qk = B; const float* vv = B + 8192; const float* sc = B + 10240; float* denp = B + 10368; float* ost = B + 14464;
        if (blk + 2 < NBLK) SCAN_ISSUE(t0 + 2 * TB, par);
        f4 qa[2][NG], ka[2][NG]; float va[2][CPL], sa[2], sb[2], kda[2], qda[2];
#define SCAN_LOADOPS(slot_, s_) do { const float* qs_ = qk + (s_) * 256; \
            _Pragma("unroll") for (int g_ = 0; g_ < NG; ++g_) { qa[slot_][g_] = *(const f4*)(qs_ + g_ * 4 * T + 4 * j); ka[slot_][g_] = *(const f4*)(qs_ + 128 + g_ * 4 * T + 4 * j); } \
            _Pragma("unroll") for (int cc_ = 0; cc_ < CPL; ++cc_) va[slot_][cc_] = vv[(s_) * 64 + col + 4 * cc_]; \
            if (MIX != 2) { sa[slot_] = sc[(s_) * 4]; sb[slot_] = sc[(s_) * 4 + 1]; } \
            if (MIX == 1) { const int dn_ = 16 * w + (lane & 15); kda[slot_] = qs_[128 + dn_]; qda[slot_] = qs_[dn_]; } } while (0)
        SCAN_LOADOPS(0, 0);
#pragma unroll 1
        for (int sg = 0; sg < TB; sg += T) {
#pragma unroll
            for (int ss = 0; ss < T; ++ss) {
                const int s = sg + ss; constexpr int dummy = 0; (void)dummy;
                const int cur = ss & 1, nxt = cur ^ 1;
                SCAN_LOADOPS(nxt, (s + 1) & (TB - 1));
                __builtin_amdgcn_sched_barrier(0);
                f2 qq[NP], kk[NP];
#pragma unroll
                for (int g = 0; g < NG; ++g) { qq[2 * g] = qa[cur][g].xy; qq[2 * g + 1] = qa[cur][g].zw; kk[2 * g] = ka[cur][g].xy; kk[2 * g + 1] = ka[cur][g].zw; }
                float onew[CPL];
#pragma unroll
                for (int cc = 0; cc < CPL; ++cc) {
                    const float v = va[cur][cc];
                    f2 oa = (f2){0.f, 0.f}, ob = (f2){0.f, 0.f};
                    if (MIX == 0) {
                        const float beta = sa[cur], a = sb[cur];
                        f2 ka2 = kk[0] * S2[cc][0], kb2 = kk[1] * S2[cc][1];
#pragma unroll
                        for (int i = 2; i < NP; i += 2) { ka2 = kk[i] * S2[cc][i] + ka2; kb2 = kk[i + 1] * S2[cc][i + 1] + kb2; }
                        ka2 = ka2 + kb2;
                        const float ks = grp_sum<T>(ka2.x + ka2.y);
                        const float u = beta * (v - a * ks);
                        const f2 a2 = (f2){a, a}, u2 = (f2){u, u};
#pragma unroll
                        for (int i = 0; i < NP; i += 2) { S2[cc][i] = S2[cc][i] * a2 + kk[i] * u2; S2[cc][i + 1] = S2[cc][i + 1] * a2 + kk[i + 1] * u2; oa = qq[i] * S2[cc][i] + oa; ob = qq[i + 1] * S2[cc][i + 1] + ob; }
                    } else if (MIX == 1) {
                        const float fp = sa[cur], ip = sb[cur], iv = ip * v;
                        const f2 f2v = (f2){fp, fp}, iv2 = (f2){iv, iv};
#pragma unroll
                        for (int i = 0; i < NP; i += 2) { S2[cc][i] = S2[cc][i] * f2v + kk[i] * iv2; S2[cc][i + 1] = S2[cc][i + 1] * f2v + kk[i + 1] * iv2; oa = qq[i] * S2[cc][i] + oa; ob = qq[i + 1] * S2[cc][i + 1] + ob; }
                    } else {
                        const f2 v2 = (f2){v, v};
#pragma unroll
                        for (int i = 0; i < NP; i += 2) { S2[cc][i] = kk[i] * (S2[cc][i] - v2) + v2; S2[cc][i + 1] = kk[i + 1] * (S2[cc][i + 1] - v2) + v2; oa = qq[i] * S2[cc][i] + oa; ob = qq[i + 1] * S2[cc][i + 1] + ob; }
                    }
                    oa = oa + ob; onew[cc] = oa.x + oa.y;
                }
                if (MIX == 1) { const float fp = sa[cur], ip = sb[cur];
                    nn = fp * nn + ip * kda[cur];
                    denp[s * 128 + 16 * w + (lane & 15)] = qda[cur] * nn; }
#pragma unroll
                for (int cc = 0; cc < CPL; ++cc) {
                    if (ss > 0) { const float o = grp_sum<T>(oprev[cc]); okeep[cc] = (ss - 1 == j) ? o : okeep[cc]; }
                    oprev[cc] = onew[cc]; }
            }
#pragma unroll
            for (int cc = 0; cc < CPL; ++cc) { const float o = grp_sum<T>(oprev[cc]); okeep[cc] = (T - 1 == j) ? o : okeep[cc];
                ost[(sg + j) * CPG + col + 4 * cc] = okeep[cc]; }
        }
#undef SCAN_LOADOPS
        if (blk + 1 < NBLK) SCAN_FINISH(Bn, par ^ 1);
        __syncthreads();
        if (tid < TB * (CPG / 8)) { const int orow = tid / (CPG / 8), oc8 = (tid % (CPG / 8)) * 8; const f4 o0 = *(const f4*)(ost + orow * CPG + oc8), o1 = *(const f4*)(ost + orow * CPG + oc8 + 4);
            u32x4_t ov; ov[0] = pg8::cvt_pk_bf16(o0.x, o0.y); ov[1] = pg8::cvt_pk_bf16(o0.z, o0.w); ov[2] = pg8::cvt_pk_bf16(o1.x, o1.y); ov[3] = pg8::cvt_pk_bf16(o1.z, o1.w);
            *(u32x4_t*)(outp + (rb + t0 + orow) * 512 + h * 128 + cgp * CPG + oc8) = ov; }
        if (MIX == 1) {
            if (cgp == 0) { const int sr = tid >> 4, jl = tid & 15; const f4 a0 = *(const f4*)(denp + sr * 128 + 8 * jl), a1 = *(const f4*)(denp + sr * 128 + 8 * jl + 4);
                const float d = grp_sum16((a0.x + a0.y) + (a0.z + a0.w) + (a1.x + a1.y) + (a1.z + a1.w));
                if (jl == 0) { const size_t r = rb + t0 + sr; ((float*)(PWS + W_DEN))[r * 4 + h] = d; ((float*)(PWS + W_MT))[r * 4 + h] = sc[sr * 4 + 2]; } }
            if (blk + 1 < NBLK) SCAN_CHAIN(Bn);
            __syncthreads();
        }
      }
    }
#undef SCAN_ISSUE
#undef SCAN_FINISH
#undef SCAN_CHAIN
    const size_t sidx = ((size_t)(l * NBP + b) * NH + h);
    float* So = POUT + (MIX == 0 ? O_P_GS : (MIX == 1 ? O_P_MC : O_P_HS)) + sidx * 16384;
#pragma unroll
    for (int cc = 0; cc < CPL; ++cc)
#pragma unroll
        for (int g = 0; g < NG; ++g) { const int d0 = g * 4 * T + 4 * j, ec = ecol + 4 * cc;
            So[(size_t)(d0 + 0) * 128 + ec] = S2[cc][2 * g].x; So[(size_t)(d0 + 1) * 128 + ec] = S2[cc][2 * g].y; So[(size_t)(d0 + 2) * 128 + ec] = S2[cc][2 * g + 1].x; So[(size_t)(d0 + 3) * 128 + ec] = S2[cc][2 * g + 1].y; }
    if (MIX == 1 && cgp == 0) {
        if (lane < 16) POUT[O_P_MN + sidx * 128 + 16 * w + lane] = nn;
        if (tid == 64) POUT[O_P_MM + sidx] = mcar[0];
    }
    __syncthreads();
}

template <int MIX>
__device__ __forceinline__ void scan_prompt_lin(const Params& p, int l, int b, int h, int cgp, float* sm) {
    constexpr int TB = 32, NBLK = SEQ / TB;
    int tid_ = threadIdx.x; asm volatile("" : "+v"(tid_)); const int tid = tid_, lane = tid & 63, w = tid >> 6;
    float* qk = sm; float* vv = sm + 8192; float* denp = sm + 10240; float* opart = sm + 14336; float* scall = sm + 30720;
    const float* gates = (const float*)(PWS + W_GATES);
    bf16_t* outp = (bf16_t*)(PWS + W_OUTS) + (size_t)MIX * MT * 512;
    const size_t rb = (size_t)b * SEQ;
    const int c8 = (tid & 31) * 8, srow = tid >> 5;
    const int base = MIX == 1 ? 2048 : 4096;
    const bf16_t* qsrc = (const bf16_t*)(PWS + W_PROJ) + rb * N1 + base + (c8 < 128 ? h * 128 + c8 : 512 + h * 128 + (c8 - 128));
    const bf16_t* vsrc = (const bf16_t*)(PWS + W_PROJ) + rb * N1 + base + 1024 + h * 128 + cgp * 64;
    const int vs = tid >> 3, vc8 = (tid & 7) * 8; const bool vact = tid < TB * 8;
    float lb8[8];
#pragma unroll
    for (int i = 0; i < 8; ++i) lb8[i] = 0.f;
    if (MIX == 2 && l > 0 && c8 >= 128) { const float* hl = PIN(I_HLB);
#pragma unroll
        for (int i = 0; i < 8; ++i) { const int cc = h * 128 + (c8 - 128) + i; lb8[i] = sigm(hl[512 + cc] - hl[cc]); } }
    __syncthreads();
    float mfinal = 0.f;
    if (MIX == 1) {
        float* graw = opart;
        for (int i = tid; i < SEQ; i += 512) { const size_t r = rb + i; graw[2 * i] = gates[r * 16 + 8 + h]; graw[2 * i + 1] = gates[r * 16 + 12 + h]; }
        __syncthreads();
        if (w == 1) { float m0 = 0.f; const int ls = lane & 31;
            for (int t0 = 0; t0 < SEQ; t0 += 32) {
                const float ig = graw[2 * (t0 + ls)], lf = graw[2 * (t0 + ls) + 1];
                float F = lf; F += dppf<0x111>(F); F += dppf<0x112>(F); F += dppf<0x114>(F); F += dppf<0x118>(F);
                { const float t0v = rdlane(F, 15); if (lane & 16) F += t0v; }
                float P = ig - F; P = fmaxf(P, dppm<0x111>(P)); P = fmaxf(P, dppm<0x112>(P)); P = fmaxf(P, dppm<0x114>(P)); P = fmaxf(P, dppm<0x118>(P));
                { const float t1v = rdlane(P, 15); if (lane & 16) P = fmaxf(P, t1v); }
                const float m = F + fmaxf(m0, P);
                float mp = dppf<0x111>(m); { const float t2v = rdlane(m, 15); if ((lane & 15) == 0) mp = (lane & 16) ? t2v : m0; }
                if (lane < 32) { scall[2 * (t0 + lane)] = __expf(lf + mp - m); scall[2 * (t0 + lane) + 1] = __expf(ig - m) * QSCALE;
                    if (cgp == 0) ((float*)(PWS + W_MT))[(rb + t0 + lane) * 4 + h] = m; }
                m0 = rdlane(m, 31); }
            mfinal = m0; }
        __syncthreads();
    }
    f2 S2[8];
#pragma unroll
    for (int i = 0; i < 8; ++i) S2[i] = (f2){0.f, 0.f};
    float nn = 0.f;
    u32x4_t rq[2][2], rv[2]; rv[0] = (u32x4_t){0u, 0u, 0u, 0u}; rv[1] = rv[0];
#define LIN_ISSUE(t0_, st_) do { \
        _Pragma("unroll") for (int i_ = 0; i_ < 2; ++i_) rq[st_][i_] = *(const u32x4_t*)(qsrc + (size_t)((t0_) + srow + 16 * i_) * N1); \
        if (vact) rv[st_] = *(const u32x4_t*)(vsrc + (size_t)((t0_) + vs) * N1 + vc8); } while (0)
#define LIN_FINISH(st_) do { \
        _Pragma("unroll") for (int i_ = 0; i_ < 2; ++i_) { float x_[8]; \
            _Pragma("unroll") for (int e_ = 0; e_ < 4; ++e_) { x_[2 * e_] = bflo(rq[st_][i_][e_]); x_[2 * e_ + 1] = bfhi(rq[st_][i_][e_]); } \
            if (MIX == 2 && c8 >= 128) { _Pragma("unroll") for (int e_ = 0; e_ < 8; ++e_) x_[e_] = lb8[e_] + (1.f - lb8[e_]) * sigm(x_[e_]); } \
            float* d_ = qk + (srow + 16 * i_) * 256 + c8; *(f4*)d_ = (f4){x_[0], x_[1], x_[2], x_[3]}; *(f4*)(d_ + 4) = (f4){x_[4], x_[5], x_[6], x_[7]}; } \
        if (vact) { float* d_ = vv + vs * 64 + vc8; *(f4*)d_ = (f4){bflo(rv[st_][0]), bfhi(rv[st_][0]), bflo(rv[st_][1]), bfhi(rv[st_][1])}; *(f4*)(d_ + 4) = (f4){bflo(rv[st_][2]), bfhi(rv[st_][2]), bflo(rv[st_][3]), bfhi(rv[st_][3])}; } } while (0)
    LIN_ISSUE(0, 0);
    LIN_FINISH(0);
    LIN_ISSUE(TB, 1);
    __syncthreads();
#pragma unroll 1
    for (int blk2 = 0; blk2 < NBLK; blk2 += 2) {
#pragma unroll
      for (int par = 0; par < 2; ++par) {
        const int blk = blk2 + par;
        const int t0 = blk * TB;
        if (blk + 2 < NBLK) LIN_ISSUE(t0 + 2 * TB, par);
        f4 qa[2][4], ka[2][4]; float va[2], kda[2], qda[2]; f2 sca[2];
#define LIN_LOADOPS(slot_, s_) do { const float* qs_ = qk + (s_) * 256 + 16 * w; \
            _Pragma("unroll") for (int g_ = 0; g_ < 4; ++g_) { qa[slot_][g_] = *(const f4*)(qs_ + 4 * g_); ka[slot_][g_] = *(const f4*)(qs_ + 128 + 4 * g_); } \
            va[slot_] = vv[(s_) * 64 + lane]; \
            if (MIX == 1) { sca[slot_] = *(const f2*)(scall + 2 * (t0 + (s_))); kda[slot_] = qs_[128 + (lane & 15)]; qda[slot_] = qs_[lane & 15]; } } while (0)
        LIN_LOADOPS(0, 0);
#pragma unroll 1
        for (int sg = 0; sg < TB; sg += 4) {
#pragma unroll
            for (int ss = 0; ss < 4; ++ss) {
                const int s = sg + ss, cur = ss & 1, nxt = cur ^ 1;
                LIN_LOADOPS(nxt, (s + 1) & (TB - 1));
                __builtin_amdgcn_sched_barrier(0);
                f2 qq[8], kk[8];
#pragma unroll
                for (int g = 0; g < 4; ++g) { qq[2 * g] = qa[cur][g].xy; qq[2 * g + 1] = qa[cur][g].zw; kk[2 * g] = ka[cur][g].xy; kk[2 * g + 1] = ka[cur][g].zw; }
                const float v = va[cur];
                f2 oa = (f2){0.f, 0.f}, ob = (f2){0.f, 0.f};
                if (MIX == 1) {
                    const float fp = sca[cur].x, ip = sca[cur].y, iv = ip * v;
                    const f2 f2v = (f2){fp, fp}, iv2 = (f2){iv, iv};
#pragma unroll
                    for (int i = 0; i < 8; i += 2) { S2[i] = S2[i] * f2v + kk[i] * iv2; S2[i + 1] = S2[i + 1] * f2v + kk[i + 1] * iv2; oa = qq[i] * S2[i] + oa; ob = qq[i + 1] * S2[i + 1] + ob; }
                    nn = fp * nn + ip * kda[cur];
                    denp[s * 128 + 16 * w + (lane & 15)] = qda[cur] * nn;
                } else {
                    const f2 v2 = (f2){v, v};
#pragma unroll
                    for (int i = 0; i < 8; i += 2) { S2[i] = kk[i] * (S2[i] - v2) + v2; S2[i + 1] = kk[i + 1] * (S2[i + 1] - v2) + v2; oa = qq[i] * S2[i] + oa; ob = qq[i + 1] * S2[i + 1] + ob; }
                }
                oa = oa + ob;
                opart[(s * 8 + w) * 64 + lane] = oa.x + oa.y;
            }
        }
#undef LIN_LOADOPS
        __syncthreads();
        { const int s = tid >> 5, e2 = (tid & 31) * 2; f2 acc2 = (f2){0.f, 0.f};
#pragma unroll
            for (int ww = 0; ww < 8; ++ww) acc2 = acc2 + *(const f2*)(opart + (s * 8 + ww) * 64 + e2);
            const int s2 = s + 16; f2 acc3 = (f2){0.f, 0.f};
#pragma unroll
            for (int ww = 0; ww < 8; ++ww) acc3 = acc3 + *(const f2*)(opart + (s2 * 8 + ww) * 64 + e2);
            *(unsigned*)(outp + (rb + t0 + s) * 512 + h * 128 + cgp * 64 + e2) = pg8::cvt_pk_bf16(acc2.x, acc2.y);
            *(unsigned*)(outp + (rb + t0 + s2) * 512 + h * 128 + cgp * 64 + e2) = pg8::cvt_pk_bf16(acc3.x, acc3.y); }
        if (MIX == 1 && cgp == 0) { const int sr = tid >> 4, jl = tid & 15; const f4 a0 = *(const f4*)(denp + sr * 128 + 8 * jl), a1 = *(const f4*)(denp + sr * 128 + 8 * jl + 4);
            const float d = grp_sum16((a0.x + a0.y) + (a0.z + a0.w) + (a1.x + a1.y) + (a1.z + a1.w));
            if (jl == 0) ((float*)(PWS + W_DEN))[(rb + t0 + sr) * 4 + h] = d; }
        if (blk + 1 < NBLK) LIN_FINISH(par ^ 1);
        __syncthreads();
      }
    }
#undef LIN_ISSUE
#undef LIN_FINISH
    const size_t sidx = ((size_t)(l * NBP + b) * NH + h);
    float* So = POUT + (MIX == 1 ? O_P_MC : O_P_HS) + sidx * 16384;
#pragma unroll
    for (int i = 0; i < 8; ++i) { So[(size_t)(16 * w + 2 * i) * 128 + cgp * 64 + lane] = S2[i].x; So[(size_t)(16 * w + 2 * i + 1) * 128 + cgp * 64 + lane] = S2[i].y; }
    if (MIX == 1 && cgp == 0) {
        if (lane < 16) POUT[O_P_MN + sidx * 128 + 16 * w + lane] = nn;
        if (tid == 64) POUT[O_P_MM + sidx] = mfinal;
    }
    __syncthreads();
}

__device__ __forceinline__ void scan_sample_item(const Params& p, int l, int mix, int b, int h, float* sm) {
    int tid_ = threadIdx.x; asm volatile("" : "+v"(tid_)); const int tid = tid_, lane = tid & 63, w = tid >> 6, e = tid & 127, dg = tid >> 7;
    float* qk = sm; float* vv = sm + 1024; float* gs = sm + 1536; float* red = sm + 1600; float* dpart = sm + 1600 + 4096;
    const bf16_t* proj = (const bf16_t*)(PWS + W_PROJ);
    const float* gates = (const float*)(PWS + W_GATES);
    bf16_t* outp = (bf16_t*)(PWS + W_OUTS) + (size_t)mix * MT * 512;
    const size_t rs = (size_t)MP + (size_t)b * SSEQ;
    const size_t sidx = ((size_t)(l * NBS + b) * NH + h);
    const float* Sin = (mix == 0 ? PIN(I_SGS) : (mix == 1 ? PIN(I_SMC) : PIN(I_SHS))) + sidx * 16384;
    float S[32];
#pragma unroll
    for (int i = 0; i < 32; ++i) S[i] = Sin[(size_t)(32 * dg + i) * 128 + e];
    __syncthreads();
    for (int idx = tid; idx < 4 * 384; idx += 512) { const int s = idx / 384, ch = idx - s * 384; float val;
        if (mix == 0) { val = ch < 256 ? bf2f(((const bf16_t*)(PWS + W_HBF))[(rs + s) * 1024 + (ch >> 7) * 512 + h * 128 + (ch & 127)]) : bf2f(outp[(rs + s) * 512 + h * 128 + (ch - 256)]);
        } else if (mix == 1) { const int colx = 2048 + (ch >> 7) * 512 + h * 128 + (ch & 127); val = bf2f(proj[(rs + s) * N1 + colx]); }
        else { const int colx = 4096 + (ch >> 7) * 512 + h * 128 + (ch & 127); val = bf2f(proj[(rs + s) * N1 + colx]);
            if (ch >= 128 && ch < 256) { float lbv = 0.f; if (l > 0) { const float* hl = PIN(I_HLB); const int cc = h * 128 + (ch & 127); lbv = sigm(hl[512 + cc] - hl[cc]); } val = lbv + (1.f - lbv) * sigm(val); } }
        if (ch < 256) qk[s * 256 + ch] = val; else vv[s * 128 + ch - 256] = val; }
    if (tid < 4) { const size_t r = rs + tid;
        if (mix == 0) { gs[tid * 4] = gates[r * 16 + h]; gs[tid * 4 + 1] = gates[r * 16 + 4 + h]; }
        else if (mix == 1) { gs[tid * 4] = gates[r * 16 + 8 + h]; gs[tid * 4 + 1] = gates[r * 16 + 12 + h]; } }
    __syncthreads();
    float m = 0.f, nn = 0.f, mts[4] = {0.f, 0.f, 0.f, 0.f};
    if (mix == 1) { m = PIN(I_SMM)[sidx]; if (dg == 0) nn = PIN(I_SMN)[sidx * 128 + e]; }
#pragma unroll
    for (int s = 0; s < 4; ++s) {
        const float* qs = qk + s * 256 + 32 * dg; const float* ksp = qs + 128;
        const float v = vv[s * 128 + e];
        float po = 0.f;
        if (mix == 0) {
            const float beta = gs[s * 4], a = gs[s * 4 + 1];
            float pk = 0.f;
#pragma unroll
            for (int i = 0; i < 32; ++i) pk += ksp[i] * S[i];
            red[((s * 2) * 4 + dg) * 128 + e] = pk;
            __syncthreads();
            const float ks = red[((s * 2) * 4 + 0) * 128 + e] + red[((s * 2) * 4 + 1) * 128 + e] + red[((s * 2) * 4 + 2) * 128 + e] + red[((s * 2) * 4 + 3) * 128 + e];
            const float u = beta * (v - a * ks);
#pragma unroll
            for (int i = 0; i < 32; ++i) { S[i] = a * S[i] + ksp[i] * u; po += qs[i] * S[i]; }
        } else if (mix == 1) {
            const float ig = gs[s * 4], lf = gs[s * 4 + 1]; const float mn = fmaxf(lf + m, ig); const float fp = __expf(lf + m - mn), ip = __expf(ig - mn) * QSCALE; m = mn; mts[s] = mn;
            const float iv = ip * v;
#pragma unroll
            for (int i = 0; i < 32; ++i) { S[i] = fp * S[i] + ksp[i] * iv; po += qs[i] * S[i]; }
            if (dg == 0) { nn = fp * nn + ip * qk[s * 256 + 128 + e]; const float dp = wave_sum(qk[s * 256 + e] * nn); if (lane == 0) dpart[s * 2 + w] = dp; }
        } else {
#pragma unroll
            for (int i = 0; i < 32; ++i) { S[i] = ksp[i] * (S[i] - v) + v; po += qs[i] * S[i]; }
        }
        red[((s * 2 + 1) * 4 + dg) * 128 + e] = po;
    }
    __syncthreads();
    if (tid < 128) {
#pragma unroll
        for (int s = 0; s < 4; ++s) { const float o = red[((s * 2 + 1) * 4 + 0) * 128 + e] + red[((s * 2 + 1) * 4 + 1) * 128 + e] + red[((s * 2 + 1) * 4 + 2) * 128 + e] + red[((s * 2 + 1) * 4 + 3) * 128 + e];
            outp[(rs + s) * 512 + h * 128 + e] = f2bf(o); } }
    if (mix == 1 && tid == 0) {
#pragma unroll
        for (int s = 0; s < 4; ++s) { ((float*)(PWS + W_DEN))[(rs + s) * 4 + h] = dpart[s * 2] + dpart[s * 2 + 1]; ((float*)(PWS + W_MT))[(rs + s) * 4 + h] = mts[s]; }
        POUT[O_S_MM + sidx] = m; }
    float* So = POUT + (mix == 0 ? O_S_GS : (mix == 1 ? O_S_MC : O_S_HS)) + sidx * 16384;
#pragma unroll
    for (int i = 0; i < 32; ++i) So[(size_t)(32 * dg + i) * 128 + e] = S[i];
    if (mix == 1 && dg == 0) POUT[O_S_MN + sidx * 128 + e] = nn;
}

__device__ __forceinline__ void scan_sample_all(const Params& p, int l, float* sm) {
    int tid_ = threadIdx.x; asm volatile("" : "+v"(tid_)); const int tid = tid_, lane = tid & 63, w = tid >> 6, e = tid & 127, dg = tid >> 7;
    float* qk = sm; float* vv = sm + 1024; float* gs = sm + 1536; float* red = sm + 1600; float* dpart = sm + 1600 + 4096; volatile int* qslot = (volatile int*)(sm + 5760);
    float* simg = sm + 6144;
    PG8_LAS unsigned char* simg_l = (PG8_LAS unsigned char*)simg;
    const bf16_t* proj = (const bf16_t*)(PWS + W_PROJ); const bf16_t* hbf = (const bf16_t*)(PWS + W_HBF);
    const float* gates = (const float*)(PWS + W_GATES);
    bf16_t* outs = (bf16_t*)(PWS + W_OUTS);
    unsigned* qctr = (unsigned*)(PWS + W_BAR) + 64 * l;
    constexpr int NIT = 3 * NBS * NH;
    const float* hl = PIN(I_HLB);
    __syncthreads();
    if (tid == 0) { qslot[0] = (int)__hip_atomic_fetch_add(qctr, 1u, __ATOMIC_RELAXED, __HIP_MEMORY_SCOPE_AGENT); qslot[1] = (int)__hip_atomic_fetch_add(qctr, 1u, __ATOMIC_RELAXED, __HIP_MEMORY_SCOPE_AGENT); }
    __syncthreads();
    int it0 = qslot[0], it1 = qslot[1];
    float stg[3], gn0 = 0.f, gn1 = 0.f, mn_in = 0.f, nn_in = 0.f;
    stg[0] = stg[1] = stg[2] = 0.f;
#define SMP_ISSUE(it_) do { const int mix_ = (it_) / (NBS * NH), r_ = (it_) - mix_ * (NBS * NH), b_ = r_ >> 2, h_ = r_ & 3; \
        const size_t sidx_ = ((size_t)(l * NBS + b_) * NH + h_), rs_ = (size_t)MP + (size_t)b_ * SSEQ; \
        const float* Sin_ = (mix_ == 0 ? PIN(I_SGS) : (mix_ == 1 ? PIN(I_SMC) : PIN(I_SHS))) + sidx_ * 16384; \
        _Pragma("unroll") for (int k_ = 0; k_ < 8; ++k_) __builtin_amdgcn_global_load_lds((const unsigned*)((const char*)Sin_ + (size_t)((w * 8 + k_) * 1024 + lane * 16)), (PG8_LAS unsigned*)(simg_l + (w * 8 + k_) * 1024), 16, 0, 0); \
        int tq_ = tid; asm volatile("" : "+v"(tq_)); \
        _Pragma("unroll") for (int k_ = 0; k_ < 3; ++k_) { const int idx_ = tq_ + 512 * k_, s_ = idx_ / 384, ch_ = idx_ - s_ * 384; unsigned short raw_; \
            if (mix_ == 0) raw_ = ch_ < 256 ? hbf[(rs_ + s_) * 1024 + (ch_ >> 7) * 512 + h_ * 128 + (ch_ & 127)] : outs[(rs_ + s_) * 512 + h_ * 128 + (ch_ - 256)]; \
            else raw_ = proj[(rs_ + s_) * N1 + (mix_ == 1 ? 2048 : 4096) + (ch_ >> 7) * 512 + h_ * 128 + (ch_ & 127)]; \
            stg[k_] = bf2f(raw_); } \
        if (tid < 4 && mix_ != 2) { const size_t rr_ = rs_ + tid; gn0 = gates[rr_ * 16 + (mix_ == 0 ? 0 : 8) + h_]; gn1 = gates[rr_ * 16 + (mix_ == 0 ? 4 : 12) + h_]; } \
        if (mix_ == 1) { mn_in = PIN(I_SMM)[sidx_]; if (dg == 0) nn_in = PIN(I_SMN)[sidx_ * 128 + e]; } } while (0)
    if (it0 < NIT) SMP_ISSUE(it0);
    while (it0 < NIT) {
#ifdef TPROBE_ITEM
        const unsigned long long tst_ = __builtin_amdgcn_s_memrealtime();
#endif
        const int mix = it0 / (NBS * NH), r = it0 - mix * (NBS * NH), b = r >> 2, h = r & 3;
        const size_t sidx = ((size_t)(l * NBS + b) * NH + h), rs = (size_t)MP + (size_t)b * SSEQ;
        bf16_t* outp = outs + (size_t)mix * MT * 512;
        asm volatile("s_waitcnt vmcnt(0)" ::: "memory");
        lds_barrier();
        float S[32];
#pragma unroll
        for (int i = 0; i < 32; ++i) S[i] = simg[(32 * dg + i) * 128 + e];
        float m = mn_in, nn = nn_in;
#pragma unroll
        for (int k = 0; k < 3; ++k) { const int idx = tid + 512 * k, s = idx / 384, ch = idx - s * 384; float val = stg[k];
            if (mix == 2 && ch >= 128 && ch < 256) { float lbv = 0.f; if (l > 0) { const int cc = h * 128 + (ch & 127); lbv = sigm(hl[512 + cc] - hl[cc]); } val = lbv + (1.f - lbv) * sigm(val); }
            if (ch < 256) qk[s * 256 + ch] = val; else vv[s * 128 + ch - 256] = val; }
        if (tid < 4 && mix != 2) { gs[tid * 4] = gn0; gs[tid * 4 + 1] = gn1; }
        int it2 = NIT;
        if (tid == 0) it2 = (int)__hip_atomic_fetch_add(qctr, 1u, __ATOMIC_RELAXED, __HIP_MEMORY_SCOPE_AGENT);
        lds_barrier();
        if (it1 < NIT) SMP_ISSUE(it1);
#pragma unroll 1
        for (int s = 0; s < 4; ++s) {
            const float* qs = qk + s * 256 + 32 * dg; const float* ksp = qs + 128;
            const float v = vv[s * 128 + e];
            float po = 0.f;
            if (mix == 0) {
                const float beta = gs[s * 4], a = gs[s * 4 + 1];
                float pk = 0.f;
#pragma unroll
                for (int c4 = 0; c4 < 4; ++c4) {
#pragma unroll
                    for (int i = 8 * c4; i < 8 * c4 + 8; ++i) pk += ksp[i] * S[i];
                    __builtin_amdgcn_sched_barrier(0); }
                red[((s * 2) * 4 + dg) * 128 + e] = pk;
                lds_barrier();
                const float ks = red[((s * 2) * 4 + 0) * 128 + e] + red[((s * 2) * 4 + 1) * 128 + e] + red[((s * 2) * 4 + 2) * 128 + e] + red[((s * 2) * 4 + 3) * 128 + e];
                const float u = beta * (v - a * ks);
#pragma unroll
                for (int c4 = 0; c4 < 4; ++c4) {
#pragma unroll
                    for (int i = 8 * c4; i < 8 * c4 + 8; ++i) { S[i] = a * S[i] + ksp[i] * u; po += qs[i] * S[i]; }
                    __builtin_amdgcn_sched_barrier(0); }
            } else if (mix == 1) {
                const float ig = gs[s * 4], lf = gs[s * 4 + 1]; const float mn = fmaxf(lf + m, ig); const float fp = __expf(lf + m - mn), ip = __expf(ig - mn) * QSCALE; m = mn; if (tid == 0) ((float*)(PWS + W_MT))[(rs + s) * 4 + h] = mn;
                const float iv = ip * v;
#pragma unroll
                for (int c4 = 0; c4 < 4; ++c4) {
#pragma unroll
                    for (int i = 8 * c4; i < 8 * c4 + 8; ++i) { S[i] = fp * S[i] + ksp[i] * iv; po += qs[i] * S[i]; }
                    __builtin_amdgcn_sched_barrier(0); }
                if (dg == 0) { nn = fp * nn + ip * qk[s * 256 + 128 + e]; const float dp = wave_sum(qk[s * 256 + e] * nn); if (lane == 0) dpart[s * 2 + w] = dp; }
            } else {
#pragma unroll
                for (int c4 = 0; c4 < 4; ++c4) {
#pragma unroll
                    for (int i = 8 * c4; i < 8 * c4 + 8; ++i) { S[i] = ksp[i] * (S[i] - v) + v; po += qs[i] * S[i]; }
                    __builtin_amdgcn_sched_barrier(0); }
            }
            red[((s * 2 + 1) * 4 + dg) * 128 + e] = po;
        }
        if (tid == 0) qslot[0] = it2;
        lds_barrier();
        if (tid < 128) {
#pragma unroll
            for (int s = 0; s < 4; ++s) { const float o = red[((s * 2 + 1) * 4 + 0) * 128 + e] + red[((s * 2 + 1) * 4 + 1) * 128 + e] + red[((s * 2 + 1) * 4 + 2) * 128 + e] + red[((s * 2 + 1) * 4 + 3) * 128 + e];
                outp[(rs + s) * 512 + h * 128 + e] = f2bf(o); } }
        if (mix == 1 && tid == 0) {
#pragma unroll
            for (int s = 0; s < 4; ++s) { ((float*)(PWS + W_DEN))[(rs + s) * 4 + h] = dpart[s * 2] + dpart[s * 2 + 1]; }
            POUT[O_S_MM + sidx] = m; }
        float* So = POUT + (mix == 0 ? O_S_GS : (mix == 1 ? O_S_MC : O_S_HS)) + sidx * 16384;
#ifndef DUPST
#define DUPST 1
#endif
        for (int rst = 0; rst < DUPST; ++rst) {
#pragma unroll
        for (int i = 0; i < 32; ++i) So[(size_t)(32 * dg + i) * 128 + e] = S[i];
        if (DUPST > 1) { asm volatile("s_waitcnt vmcnt(0)" ::: "memory"); } }
        if (mix == 1 && dg == 0) POUT[O_S_MN + sidx * 128 + e] = nn;
        it0 = it1; it1 = qslot[0];
        lds_barrier();
#ifdef TPROBE_ITEM
        if (blockIdx.x == TPROBE_WG && threadIdx.x == 0) { volatile unsigned long long* sp_ = (volatile unsigned long long*)((unsigned char*)sm + LDS_MAIN + 64); sp_[40] += __builtin_amdgcn_s_memrealtime() - tst_; sp_[41] += 1; }
#endif
    }
#undef SMP_ISSUE
}
__device__ __forceinline__ void phase_postnorm(const Params& p, int l) {
    int tid_ = threadIdx.x; asm volatile("" : "+v"(tid_)); const int tid = tid_, j = tid & 15;
    bf16_t* outs = (bf16_t*)(PWS + W_OUTS);
    const bf16_t* proj = (const bf16_t*)(PWS + W_PROJ);
    const float* den = (const float*)(PWS + W_DEN); const float* mt = (const float*)(PWS + W_MT);
    const int ngroups = MT * 12;
    for (int gid = bidx() * 32 + (tid >> 4); gid < ngroups; gid += gdim() * 32) {
        const int r = gid / 12, mh = gid - r * 12, mix = mh >> 2, h = mh & 3;
        bf16_t* op = outs + (size_t)mix * MT * 512 + (size_t)r * 512 + h * 128 + 8 * j;
        const u32x4_t raw = *(const u32x4_t*)op;
        float v[8];
#pragma unroll
        for (int i = 0; i < 4; ++i) { v[2 * i] = bflo(raw[i]); v[2 * i + 1] = bfhi(raw[i]); }
        if (mix == 1) { const float dn = fmaxf(fabsf(den[(size_t)r * 4 + h]), __expf(-mt[(size_t)r * 4 + h])); const float inv = 1.f / dn;
#pragma unroll
            for (int i = 0; i < 8; ++i) v[i] *= inv; }
        float ss = 0.f;
#pragma unroll
        for (int i = 0; i < 8; ++i) ss += v[i] * v[i];
        ss = grp_sum16(ss);
        const float rstd = rsqrtf(ss * (1.f / 128.f) + EPS);
        const int gcol = (mix == 0 ? 1536 : (mix == 1 ? 3584 : 5632)) + h * 128 + 8 * j;
        const u32x4_t gr = *(const u32x4_t*)(proj + (size_t)r * N1 + gcol);
        const float* nw = (mix == 0 ? PIN(I_GNORM) : (mix == 1 ? PIN(I_MNORM) : PIN(I_HNORM))) + l * 512 + h * 128 + 8 * j;
        const float4 n0 = *(const float4*)nw, n1 = *(const float4*)(nw + 4);
        const float nwv[8] = {n0.x, n0.y, n0.z, n0.w, n1.x, n1.y, n1.z, n1.w};
#pragma unroll
        for (int i = 0; i < 4; ++i) { v[2 * i] *= rstd * nwv[2 * i] * bflo(gr[i]); v[2 * i + 1] *= rstd * nwv[2 * i + 1] * bfhi(gr[i]); }
        u32x4_t o; o[0] = pg8::cvt_pk_bf16(v[0], v[1]); o[1] = pg8::cvt_pk_bf16(v[2], v[3]); o[2] = pg8::cvt_pk_bf16(v[4], v[5]); o[3] = pg8::cvt_pk_bf16(v[6], v[7]);
        *(u32x4_t*)op = o;
    }
    const int ncs = (NBP + NBS) * 3 * 1536;
    for (int i = bidx() * 512 + tid; i < ncs; i += gdim() * 512) {
        const int cc = i % 1536, ri = (i / 1536) % 3, bb = i / (3 * 1536);
        if (bb < NBP) POUT[O_P_GC + ((size_t)(l * NBP + bb) * 3 + ri) * 1536 + cc] = bf2f(proj[((size_t)bb * SEQ + SEQ - 3 + ri) * N1 + cc]);
        else { const int b2 = bb - NBP; POUT[O_S_GC + ((size_t)(l * NBS + b2) * 3 + ri) * 1536 + cc] = bf2f(proj[((size_t)MP + (size_t)b2 * SSEQ + 1 + ri) * N1 + cc]); }
    }
}

__device__ __forceinline__ void phase_convffn(const Params& p, int l) {
    int tid_ = threadIdx.x; asm volatile("" : "+v"(tid_)); const int tid = tid_;
    const bf16_t* u = (const bf16_t*)(PWS + W_PROJ);
    bf16_t* act = (bf16_t*)(PWS + W_ACT);
    const float* cw = PIN(I_FCW) + (size_t)l * 3 * NUP; const float* cb = PIN(I_FCB) + (size_t)l * NUP;
    const int nitems = (MT / 4) * (DFF / 8);
    for (int it = bidx() * 512 + tid; it < nitems; it += gdim() * 512) {
        const int jg = it % (DFF / 8), rbk = it / (DFF / 8), r0 = rbk * 4, jc = jg * 8;
        const bool samp = r0 >= MP; const int tf = samp ? 0 : (r0 & (SEQ - 1));
        float wa[3][8], wb[3][8], ba[8], bb[8];
#pragma unroll
        for (int i = 0; i < 3; ++i) { const float4 a0 = *(const float4*)(cw + i * NUP + jc), a1 = *(const float4*)(cw + i * NUP + jc + 4), b0 = *(const float4*)(cw + i * NUP + DFF + jc), b1 = *(const float4*)(cw + i * NUP + DFF + jc + 4);
            wa[i][0] = a0.x; wa[i][1] = a0.y; wa[i][2] = a0.z; wa[i][3] = a0.w; wa[i][4] = a1.x; wa[i][5] = a1.y; wa[i][6] = a1.z; wa[i][7] = a1.w;
            wb[i][0] = b0.x; wb[i][1] = b0.y; wb[i][2] = b0.z; wb[i][3] = b0.w; wb[i][4] = b1.x; wb[i][5] = b1.y; wb[i][6] = b1.z; wb[i][7] = b1.w; }
        { const float4 a0 = *(const float4*)(cb + jc), a1 = *(const float4*)(cb + jc + 4), b0 = *(const float4*)(cb + DFF + jc), b1 = *(const float4*)(cb + DFF + jc + 4);
            ba[0] = a0.x; ba[1] = a0.y; ba[2] = a0.z; ba[3] = a0.w; ba[4] = a1.x; ba[5] = a1.y; ba[6] = a1.z; ba[7] = a1.w;
            bb[0] = b0.x; bb[1] = b0.y; bb[2] = b0.z; bb[3] = b0.w; bb[4] = b1.x; bb[5] = b1.y; bb[6] = b1.z; bb[7] = b1.w; }
        float xa[6][8], xb[6][8];
#pragma unroll
        for (int rr = 0; rr < 6; ++rr) {
            if (rr < 2 && tf == 0) {
                if (samp) { const float* st = PIN(I_SFC) + ((size_t)(l * NBS + (r0 - MP) / 4) * 2 + rr) * NUP;
#pragma unroll
                    for (int i = 0; i < 8; ++i) { xa[rr][i] = st[jc + i]; xb[rr][i] = st[DFF + jc + i]; } }
                else {
#pragma unroll
                    for (int i = 0; i < 8; ++i) { xa[rr][i] = 0.f; xb[rr][i] = 0.f; } }
            } else { const bf16_t* ur = u + (size_t)(r0 - 2 + rr) * NUP; const u32x4_t ra = *(const u32x4_t*)(ur + jc), rbv = *(const u32x4_t*)(ur + DFF + jc);
#pragma unroll
                for (int i = 0; i < 4; ++i) { xa[rr][2 * i] = bflo(ra[i]); xa[rr][2 * i + 1] = bfhi(ra[i]); xb[rr][2 * i] = bflo(rbv[i]); xb[rr][2 * i + 1] = bfhi(rbv[i]); } }
        }
#pragma unroll
        for (int t = 0; t < 4; ++t) { float o[8];
#pragma unroll
            for (int i = 0; i < 8; ++i) { const float ya = wa[0][i] * xa[t][i] + wa[1][i] * xa[t + 1][i] + wa[2][i] * xa[t + 2][i] + ba[i]; const float yb = wb[0][i] * xb[t][i] + wb[1][i] * xb[t + 1][i] + wb[2][i] * xb[t + 2][i] + bb[i]; o[i] = silu(ya) * yb; }
            u32x4_t ov; ov[0] = pg8::cvt_pk_bf16(o[0], o[1]); ov[1] = pg8::cvt_pk_bf16(o[2], o[3]); ov[2] = pg8::cvt_pk_bf16(o[4], o[5]); ov[3] = pg8::cvt_pk_bf16(o[6], o[7]);
            *(u32x4_t*)(act + (size_t)(r0 + t) * DFF + jc) = ov; }
        if (samp || tf == SEQ - 4) {
            float* dst = samp ? POUT + O_S_FC + (size_t)(l * NBS + (r0 - MP) / 4) * 2 * NUP : POUT + O_P_FC + (size_t)(l * NBP + r0 / SEQ) * 2 * NUP;
#pragma unroll
            for (int rr = 0; rr < 2; ++rr)
#pragma unroll
                for (int i = 0; i < 8; ++i) { dst[(size_t)rr * NUP + jc + i] = xa[4 + rr][i]; dst[(size_t)rr * NUP + DFF + jc + i] = xb[4 + rr][i]; }
        }
    }
}

__device__ __forceinline__ void phase_final_norm(const Params& p) {
    int tid_ = threadIdx.x; asm volatile("" : "+v"(tid_)); const int tid = tid_, lane = tid & 63, w = tid >> 6;
    const float* gw = PIN(I_LNF);
    float4 g4[4];
#pragma unroll
    for (int i = 0; i < 4; ++i) g4[i] = *(const float4*)(gw + lane * 4 + 256 * i);
    for (int row = bidx() * 8 + w; row < MT; row += gdim() * 8) {
        float* xr = POUT + (size_t)row * DM; float4 v[4]; float ss = 0.f;
#pragma unroll
        for (int i = 0; i < 4; ++i) { v[i] = *(const float4*)(xr + lane * 4 + 256 * i); ss += v[i].x * v[i].x + v[i].y * v[i].y + v[i].z * v[i].z + v[i].w * v[i].w; }
        ss = wave_sum(ss); const float rstd = rsqrtf(ss * (1.f / 1024.f) + EPS);
#pragma unroll
        for (int i = 0; i < 4; ++i) { v[i].x *= rstd * g4[i].x; v[i].y *= rstd * g4[i].y; v[i].z *= rstd * g4[i].z; v[i].w *= rstd * g4[i].w; *(float4*)(xr + lane * 4 + 256 * i) = v[i]; }
    }
}

#ifndef PHM
#define PHM 0xFFFF
#endif
#ifndef DUPB
#define DUPB 1
#endif
#ifndef DUPC
#define DUPC 1
#endif
#ifndef DUPS
#define DUPS 1
#endif
#ifndef DUPH
#define DUPH 1
#endif
#ifndef DUPY
#define DUPY 1
#endif
#ifndef DUPA
#define DUPA 1
#endif
#ifndef DUPI
#define DUPI 1
#endif
#define GSYNC() do { for (int y_ = 0; y_ < DUPY; ++y_) xcd_barrier(xb); } while (0)
__global__ void __launch_bounds__(512, 2) fwd_megakernel(Params p) {
    extern __shared__ __attribute__((aligned(16))) unsigned char shm[];
    cg::grid_group grid = cg::this_grid();
    float* smf = (float*)shm;
    PG8_LAS unsigned char* lds = (PG8_LAS unsigned char*)shm;
    int tid_ = threadIdx.x; asm volatile("" : "+v"(tid_)); const int tid = tid_;
    float* X = POUT;
    volatile XLAS unsigned* xst = (volatile XLAS unsigned*)(lds + LDS_MAIN);
    if (tid == 0) { xst[0] = 0u; xst[1] = 0u; xst[2] = 0u; xst[3] = 0u; }
    __syncthreads();
    XcdBarrier xb = xcd_barrier_post((unsigned*)(PWS + W_BAR), xst);
    bool first_sync = true;
#ifdef TPROBE1
    volatile XLAS unsigned long long* stp = (volatile XLAS unsigned long long*)(lds + LDS_MAIN + 64);
    int nst = 0;
#define STAMP() do { if (blockIdx.x == TPROBE_WG && threadIdx.x == 0) stp[nst] = __builtin_amdgcn_s_memrealtime(); ++nst; } while (0)
#else
#define STAMP() do {} while (0)
#endif
    STAMP();
#ifdef TPROBE_ITEM
    if (blockIdx.x == TPROBE_WG && threadIdx.x == 0) { stp[40] = 0; stp[41] = 0; }
#endif
    bf16_t* hbf = (bf16_t*)(PWS + W_HBF);
    bf16_t* proj = (bf16_t*)(PWS + W_PROJ);

    for (int l = 0; l < 2; ++l) {
        const int G = gdim(), bid = bidx();
        for (int repa = 0; repa < DUPA; ++repa) { if (PHM & 1) { int tc = 0;
          conv_T(PIN(I_WIN) + (size_t)l * 1024 * NIN, NIN, (bf16_t*)(PWS + W_WIN), 1024, N1, true, smf, tc);
          for (int n = 0; n < 3; ++n) conv_T(PIN(I_WBR) + ((size_t)l * 3 + n) * 512 * 1024, 1024, (bf16_t*)(PWS + W_WBR) + (size_t)n * 1024 * 512, 512, 1024, false, smf, tc);
          conv_T(PIN(I_WOUT) + (size_t)l * 1024 * 1024, 1024, (bf16_t*)(PWS + W_WOUT), 1024, 1024, false, smf, tc);
          conv_T(PIN(I_WUP) + (size_t)l * 1024 * NUP, NUP, (bf16_t*)(PWS + W_WUP), 1024, NUP, false, smf, tc);
          conv_T(PIN(I_WDN) + (size_t)l * DFF * 1024, 1024, (bf16_t*)(PWS + W_WDN), DFF, 1024, false, smf, tc);
          __syncthreads(); }
        if (PHM & 2) {
        if (l == 0) { int tq_ = threadIdx.x; asm volatile("" : "+v"(tq_)); const float4* s1 = (const float4*)PIN(I_XS); float4* d1 = (float4*)(X + (size_t)MP * DM);
            for (int i = bid * 512 + tq_; i < MS * DM / 4; i += G * 512) d1[i] = s1[i]; }
        phase_rmsnorm(p, l, l == 0 ? PIN(I_XP) : X, l == 0 ? PIN(I_XS) : X + (size_t)MP * DM, PIN(I_LNMIX) + l * DM, hbf, true, smf); } }
        if (first_sync) { grid.sync(); first_sync = false; }
        else GSYNC();
        STAMP();
        for (int rep = 0; rep < DUPB; ++rep) { pg8::Gemm g{hbf, (const bf16_t*)(PWS + W_WIN), MT, N1, 1024, 1024}; pg8::StaticOrder S; S.init(MT, N1, G, bid); EpiProj E{proj, N1, 1}; pg8::gemm_phase(lds, g, S, E); }
        GSYNC(); STAMP();
        phase_gdnprep(p, l);
        GSYNC(); STAMP();
#ifdef TPROBE_MAX
        const unsigned long long tb_ = __builtin_amdgcn_s_memrealtime();
#endif
        for (int rep = 0; rep < DUPC; ++rep) for (int it = bid; it < 256; it += G) {
            if (it < 128) scan_prompt_item<0>(p, l, (it >> 2) >> 2, (it >> 2) & 3, it & 3, smf);
            else if (it < 192) { const int q = it - 128; scan_prompt_lin<1>(p, l, (q >> 1) >> 2, (q >> 1) & 3, q & 1, smf); }
            else { const int q = it - 192; scan_prompt_lin<2>(p, l, (q >> 1) >> 2, (q >> 1) & 3, q & 1, smf); }
        }
#ifdef TPROBE_MAX
        if (l == TPROBE_MAX - 1 && threadIdx.x == 0) { const unsigned dt_ = (unsigned)(__builtin_amdgcn_s_memrealtime() - tb_); atomicMax((unsigned*)(PWS + W_BAR) + 32, (dt_ << 8) | (unsigned)blockIdx.x); if (dt_ > 40000u) atomicAdd((unsigned*)(PWS + W_BAR) + 33, 1u); if (dt_ > 30000u) atomicAdd((unsigned*)(PWS + W_BAR) + 34, 1u); if (dt_ > 20000u) atomicAdd((unsigned*)(PWS + W_BAR) + 35, 1u); }
#endif
        STAMP();
#ifdef SEQ_SAMPLE
        GSYNC();
#endif
        scan_sample_all(p, l, smf);
        GSYNC(); STAMP();
        if (PHM & 32) phase_postnorm(p, l);
        GSYNC(); STAMP();
        if (PHM & 64) { pg8::Gemm g{(const bf16_t*)(PWS + W_OUTS), (const bf16_t*)(PWS + W_WBR), 3 * MT, 3 * 1024, 512, 512};
            MergeOrder S; S.init(G, bid); EpiMerge E{proj + 6144, hbf}; pg8::gemm_phase(lds, g, S, E); }
        GSYNC(); STAMP();
        if (PHM & 128) { pg8::Gemm g{hbf, (const bf16_t*)(PWS + W_WOUT), MT, 1024, 1024, 1024}; pg8::StaticOrder S; S.init(MT, 1024, G, bid); EpiResid E{X, l == 0 ? PIN(I_XP) : X, l == 0 ? PIN(I_XS) : X + (size_t)MP * DM}; pg8::gemm_phase(lds, g, S, E); }
        GSYNC(); STAMP();
        if (PHM & 256) phase_rmsnorm(p, l, X, X + (size_t)MP * DM, PIN(I_LNFFN) + l * DM, hbf, false, smf);
        GSYNC(); STAMP();
        for (int rep = 0; rep < DUPH; ++rep) { pg8::Gemm g{hbf, (const bf16_t*)(PWS + W_WUP), MT, NUP, 1024, 1024}; pg8::StaticOrder S; S.init(MT, NUP, G, bid); EpiProj E{proj, NUP, 0}; pg8::gemm_phase(lds, g, S, E); }
        GSYNC(); STAMP();
        for (int repi = 0; repi < DUPI; ++repi) phase_convffn(p, l);
        GSYNC(); STAMP();
        if (PHM & 2048) { { pg8::Gemm g{(const bf16_t*)(PWS + W_ACT), (const bf16_t*)(PWS + W_WDN), MP, 1024, DFF, DFF}; pg8::StaticOrder S; S.init(MP, 1024, G, bid); EpiResid E{X, X, X + (size_t)MP * DM}; pg8::gemm_phase(lds, g, S, E); }
            { pg8::Gemm g{(const bf16_t*)(PWS + W_ACT), (const bf16_t*)(PWS + W_WDN), MT, 1024, DFF / 2, DFF}; PieceOrder S{G, (bid + G / 2) % G, 2}; EpiAtomic E{X}; pg8::gemm_phase(lds, g, S, E); } }
        GSYNC(); STAMP();
    }
    if (PHM & 4096) phase_final_norm(p);
#ifdef TPROBE1
    if (blockIdx.x == TPROBE_WG && threadIdx.x == 0) {
        const int per = (nst - 1) / 2;
        unsigned long long d1 = 0, d2 = 0;
        for (int l2 = 0; l2 < 2; ++l2) { d1 += stp[l2 * per + TPROBE1E] - stp[l2 * per + TPROBE1]; d2 += stp[l2 * per + TPROBE2E] - stp[l2 * per + TPROBE2]; }
        unsigned long long cntcode_ = 0;
        unsigned long long q1 = (d1 + 1000) / 2000, q2 = (d2 + 500) / 1000;
#ifdef TPROBE_MAX
        { const unsigned mx_ = __hip_atomic_load((unsigned*)(PWS + W_BAR) + 32, __ATOMIC_RELAXED, __HIP_MEMORY_SCOPE_AGENT); q1 = ((mx_ >> 8) + 1000) / 2000 * 10 + (mx_ & 255) / 100; q2 = (mx_ & 255) % 100;
#ifdef TPROBE_CNT
          const unsigned c4_ = __hip_atomic_load((unsigned*)(PWS + W_BAR) + 33, __ATOMIC_RELAXED, __HIP_MEMORY_SCOPE_AGENT), c3_ = __hip_atomic_load((unsigned*)(PWS + W_BAR) + 34, __ATOMIC_RELAXED, __HIP_MEMORY_SCOPE_AGENT), c2_ = __hip_atomic_load((unsigned*)(PWS + W_BAR) + 35, __ATOMIC_RELAXED, __HIP_MEMORY_SCOPE_AGENT);
          q1 = 0; q2 = 0; cntcode_ = c4_ * 300 + c3_; (void)c2_;
#endif
 }
#endif
#ifdef TPROBE_ITEM
        q1 = stp[41] ? (stp[40] / stp[41] + 50) / 100 : 0; q2 = stp[41];
#endif if (q2 > 99) q2 = 99;
#ifndef TPROBE_MAX
        if (q1 > 99) q1 = 99;
#endif
        const unsigned long long wait = (q1 * 100 + q2) * 2000ull + cntcode_ * 200ull, t0 = __builtin_amdgcn_s_memrealtime();
        while (__builtin_amdgcn_s_memrealtime() - t0 < wait) __builtin_amdgcn_s_sleep(32);
    }
#endif
}

extern "C" void kernel_launch(void* const* d_in, const int* in_sizes, int n_in, void* d_out, int out_size, void* d_ws, size_t ws_size, hipStream_t stream) {
    static int grid_blocks = 0;
    if (grid_blocks == 0) {
        if (n_in != 28 || (size_t)out_size != O_END || ws_size < W_END) { fprintf(stderr, "kernel_launch: unexpected shapes: n_in %d out %d (want %zu) ws %zu (need %zu)\n", n_in, out_size, (size_t)O_END, ws_size, (size_t)W_END); grid_blocks = -1; return; }
        int dev = 0, cus = 0, per_cu = 0;
        hipGetDevice(&dev); hipDeviceGetAttribute(&cus, hipDeviceAttributeMultiprocessorCount, dev);
        if (hipFuncSetAttribute((const void*)fwd_megakernel, hipFuncAttributeMaxDynamicSharedMemorySize, LDS_BYTES) != hipSuccess) { fprintf(stderr, "kernel_launch: hipFuncSetAttribute failed\n"); grid_blocks = -1; return; }
        if (hipOccupancyMaxActiveBlocksPerMultiprocessor(&per_cu, (const void*)fwd_megakernel, 512, LDS_BYTES) != hipSuccess || per_cu < 1) { fprintf(stderr, "kernel_launch: occupancy query gave %d\n", per_cu); per_cu = 1; (void)hipGetLastError(); }
        grid_blocks = cus * per_cu;
    }
    if (grid_blocks < 0) return;
    if (hipMemsetAsync((unsigned char*)d_ws + W_BAR, 0, XCD_BAR_WORDS * 4, stream) != hipSuccess) { fprintf(stderr, "kernel_launch: memset of barrier words failed\n"); return; }
    Params p{};
    for (int i = 0; i < 28; ++i) p.in[i] = (const float*)d_in[i];
    p.out = (float*)d_out; p.ws = (unsigned char*)d_ws;
    void* args[] = {&p};
    hipError_t e = hipLaunchCooperativeKernel((const void*)fwd_megakernel, dim3(grid_blocks), dim3(512), args, LDS_BYTES, stream);
    if (e != hipSuccess) fprintf(stderr, "kernel_launch: cooperative launch failed: %s (grid %d)\n", hipGetErrorString(e), grid_blocks);
}
```

```cpp
#include <hip/hip_runtime.h>
#include <hip/hip_cooperative_groups.h>
#include <cstdio>
namespace cg = cooperative_groups;
namespace pg8 {
#define PG8_LAS __attribute__((address_space(3)))
typedef unsigned short bf16_t;
typedef short bf16x8 __attribute__((ext_vector_type(8)));
typedef float f32x4 __attribute__((ext_vector_type(4)));
typedef unsigned u32x4 __attribute__((ext_vector_type(4)));
constexpr int BM = 256, BK = 64, HALF = 128, HTB = HALF * BK * 2  , STAGE_BYTES = 8 * HTB, NXCD = 8, WGM = 8;

__host__ __device__ __forceinline__ int lds_byte(int r, int c) { const int st = (r >> 4) * 2 + (c >> 5), rr = r & 15, cc = c & 31, ob = rr * 64 + cc * 2; return st * 1024 + (ob ^ (((ob >> 9) & 1) << 5)); }
__host__ __device__ __forceinline__ void stage_rc(int b, int& R, int& C) { const int st = b / 1024, sb = b % 1024, swz = sb ^ (((sb >> 9) & 1) << 5); R = (st >> 1) * 16 + swz / 64; C = (st & 1) * 32 + (swz % 64) / 2; }
__host__ __device__ __forceinline__ int perm32(int rho) { const int n = rho >> 4, i = rho & 15; return 8 * (i >> 2) + 4 * n + (i & 3); }

struct Unit { int pm, pn, pk; };
struct Gemm { const bf16_t* A; const bf16_t* Bt; int M, N, K, ld; };

struct StaticOrder {
    int nM, nN, nwg, G, c;
    __host__ __device__ void init(int M, int N, int G_, int c_) { nM = M / BM; nN = N / BM; nwg = nM * nN; G = G_; c = c_; }
    __host__ __device__ bool next(int i, Unit& u) const {
        const long L = (long)i * G + c; if (L >= nwg) return false;
        int wgid = (int)L; { const int q = nwg / NXCD, r = nwg % NXCD, xcd = wgid % NXCD, off = wgid / NXCD; wgid = (xcd < r ? xcd * (q + 1) : r * (q + 1) + (xcd - r) * q) + off; }
        const int nig = WGM * nN, gid = wgid / nig, fm = gid * WGM, gsz = (nM - fm) < WGM ? (nM - fm) : WGM;
        u.pm = fm + ((wgid % nig) % gsz); u.pn = (wgid % nig) / gsz; u.pk = 0; return true;
    }
    __device__ __forceinline__ void a_ready(const Unit&) const {}
    __device__ __forceinline__ void done(const Unit&) const {}
};
__device__ __forceinline__ unsigned cvt_pk_bf16(float lo, float hi) { unsigned r; asm volatile("v_cvt_pk_bf16_f32 %0, %1, %2" : "=v"(r) : "v"(lo), "v"(hi)); return r; }
template <class Epi, class Sched>
__device__ __forceinline__ void gemm_phase(PG8_LAS unsigned char* lds, const Gemm g, const Sched& S, const Epi& E) {
    int tid_ = threadIdx.x; asm volatile("" : "+v"(tid_));
    const int tid = tid_, wid = __builtin_amdgcn_readfirstlane(tid >> 6), lane = tid & 63, wr = wid >> 2, wc = wid & 3, fr = lane & 15, fq = lane >> 4;
    const int K = g.K, nt = K / BK, ld = g.ld;
    unsigned voffA[2], voffB[2];
#pragma unroll
    for (int i = 0; i < 2; ++i) { int R, C; stage_rc(tid * 16 + i * 8192, R, C); const int Rb = Epi::PERM ? ((R & ~31) + perm32(R & 31)) : R;
        voffA[i] = (unsigned)(R * ld + C) * 2u; voffB[i] = (unsigned)(Rb * ld + C) * 2u; }
    const size_t kstep = (size_t)(BK * 2);
    const size_t hstep = (size_t)HALF * ld * 2;
    const size_t tstep = 2 * hstep;
    const unsigned ldsw = (unsigned)wid * 1024u;
    const int aoff = lds_byte(wr * 64 + fr, fq * 8), boff = lds_byte(wc * 32 + fr, fq * 8);
#define PG8_SA(b, h) (((b) * 2 + (h)) * HTB)
#define PG8_SB(b, h) ((4 + (b) * 2 + (h)) * HTB)
#define PG8_STAGE(bufoff, gbase, voff) do { _Pragma("unroll") for (int _i = 0; _i < 2; ++_i) \
        __builtin_amdgcn_global_load_lds((const unsigned*)((const char*)(gbase) + (voff)[_i]), (PG8_LAS unsigned*)(lds + (bufoff) + ldsw + _i * 8192), 16, 0, 0); } while (0)
#define PG8_LDA(dst, b, h) do { _Pragma("unroll") for (int m = 0; m < 4; ++m) _Pragma("unroll") for (int k = 0; k < 2; ++k) dst[m][k] = *(const PG8_LAS bf16x8*)(lds + PG8_SA(b, h) + aoff + m * 2048 + k * 1024); } while (0)
#define PG8_LDB(dst, b, h) do { _Pragma("unroll") for (int n = 0; n < 2; ++n) _Pragma("unroll") for (int k = 0; k < 2; ++k) dst[n][k] = *(const PG8_LAS bf16x8*)(lds + PG8_SB(b, h) + boff + n * 2048 + k * 1024); } while (0)
#define PG8_MMA(ai, bj, At, Bt) do { __builtin_amdgcn_s_setprio(1); _Pragma("unroll") for (int m = 0; m < 4; ++m) _Pragma("unroll") for (int n = 0; n < 2; ++n) _Pragma("unroll") for (int k = 0; k < 2; ++k) \
        acc[ai][bj][m][n] = __builtin_amdgcn_mfma_f32_16x16x32_bf16(Bt[n][k], At[m][k], acc[ai][bj][m][n], 0, 0, 0); __builtin_amdgcn_s_setprio(0); } while (0)
#define PG8_WAIT_V(n) asm volatile("s_waitcnt vmcnt(" #n ")" ::: "memory")
#define PG8_WAIT_L(n) asm volatile("s_waitcnt lgkmcnt(" #n ")" ::: "memory")
#define PG8_BAR __builtin_amdgcn_s_barrier()
#define PG8_SCHED __builtin_amdgcn_sched_barrier(0)
    Unit cur, nxt; int ui = 0;
    if (!S.next(0, cur)) return;
    f32x4 acc[2][2][4][2];
#pragma unroll
    for (int a = 0; a < 2; ++a)
#pragma unroll
        for (int b = 0; b < 2; ++b)
#pragma unroll
            for (int m = 0; m < 4; ++m)
#pragma unroll
                for (int n = 0; n < 2; ++n) acc[a][b][m][n] = (f32x4){0.f, 0.f, 0.f, 0.f};
    bf16x8 At[4][2], B0[2][2], B1[2][2];
    const char* cA = (const char*)g.A + (size_t)cur.pm * tstep + (size_t)cur.pk * K * 2; const char* cB = (const char*)g.Bt + (size_t)cur.pn * tstep + (size_t)cur.pk * K * 2;
    S.a_ready(cur);
    PG8_STAGE(PG8_SB(0, 0), cB, voffB); PG8_STAGE(PG8_SA(0, 0), cA, voffA); PG8_STAGE(PG8_SB(0, 1), cB + hstep, voffB); PG8_STAGE(PG8_SA(0, 1), cA + hstep, voffA);
    if (wr == 1) PG8_BAR;
    PG8_WAIT_V(4); PG8_BAR;
    PG8_STAGE(PG8_SB(1, 0), cB + kstep, voffB); PG8_STAGE(PG8_SA(1, 0), cA + kstep, voffA); PG8_STAGE(PG8_SB(1, 1), cB + hstep + kstep, voffB);
    PG8_WAIT_V(6); PG8_BAR;
    for (;;) {
        const bool has_next = S.next(ui + 1, nxt);
        const char* nA = has_next ? (const char*)g.A + (size_t)nxt.pm * tstep + (size_t)nxt.pk * K * 2 : cA; const char* nB = has_next ? (const char*)g.Bt + (size_t)nxt.pn * tstep + (size_t)nxt.pk * K * 2 : cB;
        for (int t = 0; t < nt; t += 2) {
            const bool last = (t == nt - 2);
            const char* a1 = cA + (size_t)(t + 1) * kstep;
            const char* a2 = last ? nA : cA + (size_t)(t + 2) * kstep; const char* b2 = last ? nB : cB + (size_t)(t + 2) * kstep;
            const char* a3 = a2 + kstep; const char* b3 = b2 + kstep;
            if (last && has_next) S.a_ready(nxt);
            PG8_LDB(B0, 0, 0); PG8_SCHED; PG8_LDA(At, 0, 0); PG8_STAGE(PG8_SA(1, 1), a1 + hstep, voffA);
            PG8_WAIT_L(8); PG8_BAR; PG8_WAIT_L(0); PG8_MMA(0, 0, At, B0); PG8_BAR; PG8_SCHED;
            PG8_LDB(B1, 0, 1); PG8_STAGE(PG8_SB(0, 0), b2, voffB);
            PG8_BAR; PG8_WAIT_L(0); PG8_MMA(0, 1, At, B1); PG8_BAR;
            PG8_LDA(At, 0, 1); PG8_STAGE(PG8_SA(0, 0), a2, voffA);
            PG8_BAR; PG8_WAIT_L(0); PG8_MMA(1, 0, At, B0); PG8_BAR; PG8_SCHED;
            PG8_STAGE(PG8_SB(0, 1), b2 + hstep, voffB);
            PG8_WAIT_V(6); PG8_BAR; PG8_MMA(1, 1, At, B1); PG8_BAR;
            PG8_LDB(B0, 1, 0); PG8_SCHED; PG8_LDA(At, 1, 0); PG8_STAGE(PG8_SA(0, 1), a2 + hstep, voffA);
            PG8_WAIT_L(8); PG8_BAR; PG8_WAIT_L(0); PG8_MMA(0, 0, At, B0); PG8_BAR; PG8_SCHED;
            PG8_LDB(B1, 1, 1); PG8_STAGE(PG8_SB(1, 0), b3, voffB);
            PG8_BAR; PG8_WAIT_L(0); PG8_MMA(0, 1, At, B1); PG8_BAR;
            PG8_LDA(At, 1, 1); PG8_STAGE(PG8_SA(1, 0), a3, voffA);
            PG8_BAR; PG8_WAIT_L(0); PG8_MMA(1, 0, At, B0); PG8_BAR; PG8_SCHED;
            PG8_STAGE(PG8_SB(1, 1), b3 + hstep, voffB);
            PG8_WAIT_V(6); PG8_BAR; PG8_MMA(1, 1, At, B1); PG8_BAR;
        }
        if constexpr (!Epi::AFTER_DRAIN) { E(acc, cur, wr, wc, fr, fq); S.done(cur); }
        if (!has_next) break;
#pragma unroll
        for (int a = 0; a < 2; ++a)
#pragma unroll
            for (int b = 0; b < 2; ++b)
#pragma unroll
                for (int m = 0; m < 4; ++m)
#pragma unroll
                    for (int n = 0; n < 2; ++n) acc[a][b][m][n] = (f32x4){0.f, 0.f, 0.f, 0.f};
        cur = nxt; cA = nA; cB = nB; ++ui;
    }
    PG8_WAIT_V(0);
    if (wr == 0) PG8_BAR;
    PG8_BAR;
    if constexpr (Epi::AFTER_DRAIN) { E.fused(acc, cur, wr, wc, fr, fq, lds, wid, lane); S.done(cur); }
#undef PG8_SA
#undef PG8_SB
#undef PG8_STAGE
#undef PG8_LDA
#undef PG8_LDB
#undef PG8_MMA
#undef PG8_WAIT_V
#undef PG8_WAIT_L
#undef PG8_BAR
#undef PG8_SCHED
}
}

#define XB_TMO      128
#define XB_XCNT(j)  (256  + 64 * (j))
#define XB_XSUB(j)  (1280 + 64 * (j))
#define XB_XGEN(j)  (2304 + 64 * (j))
#define XB_TOP      3328
#define XB_TOPGEN   3392
#define XCD_BAR_WORDS 3456
#define XB_SPIN_CAP (1u << 18)
#define XLAS __attribute__((address_space(3)))

__device__ __forceinline__ unsigned xb_ld(unsigned* p)              { return __hip_atomic_load(p, __ATOMIC_RELAXED, __HIP_MEMORY_SCOPE_AGENT); }
__device__ __forceinline__ unsigned xb_add(unsigned* p, unsigned v) { return __hip_atomic_fetch_add(p, v, __ATOMIC_RELAXED, __HIP_MEMORY_SCOPE_AGENT); }
__device__ __forceinline__ unsigned xb_xcc_id() { return (unsigned)__builtin_amdgcn_s_getreg((3 << 11) | 20) & 0xFu; }
#define XB_SPIN(cond, bar) do { unsigned _sp = 0; while (cond) { __builtin_amdgcn_s_sleep(1); \
    if ((++_sp & 255u) == 0u) { if (xb_ld(&(bar)[XB_TMO])) break; if (_sp > XB_SPIN_CAP) { atomicAdd(&(bar)[XB_TMO], 1u); break; } } } } while (0)

struct XcdBarrier {
    unsigned* bar; unsigned x;
    volatile XLAS unsigned* st;
};

__device__ __forceinline__ XcdBarrier xcd_barrier_post(unsigned* bar, volatile XLAS unsigned* st) {
    XcdBarrier b; b.bar = bar; b.x = xb_xcc_id(); b.st = st;
    if (threadIdx.x == 0) (void)xb_add(&bar[XB_XCNT(b.x)], 1u);
    return b;
}
__device__ __forceinline__ void xcd_barrier_complete(unsigned* bar, unsigned x, unsigned& nloc, unsigned& nx) {
    const unsigned G = gridDim.x * gridDim.y * gridDim.z;
    unsigned sum, cnt, mine, sp = 0u;
    for (;;) {
        sum = 0u; cnt = 0u; mine = 0u;
#pragma unroll
        for (unsigned j = 0; j < 16; ++j) { const unsigned c = xb_ld(&bar[XB_XCNT(j)]); sum += c; cnt += (c > 0u) ? 1u : 0u; mine = (j == x) ? c : mine; }
        if (sum == G) break;
        __builtin_amdgcn_s_sleep(1);
        if ((++sp & 255u) == 0u) { if (xb_ld(&bar[XB_TMO])) break; if (sp > XB_SPIN_CAP) { atomicAdd(&bar[XB_TMO], 1u); break; } }
    }
    nloc = mine > 0u ? mine : 1u; nx = cnt > 0u ? cnt : 1u;
}

__device__ __forceinline__ void xcd_barrier(const XcdBarrier& b) {
    asm volatile("s_waitcnt vmcnt(0)" ::: "memory");
    __syncthreads();
    if (threadIdx.x == 0) {
        unsigned* bar = b.bar;
        __builtin_amdgcn_s_waitcnt(0);
        unsigned nloc = b.st[0], nx = b.st[1];
        if (nloc == 0u) { xcd_barrier_complete(bar, b.x, nloc, nx); b.st[0] = nloc; b.st[1] = nx; }
        const unsigned old = xb_add(&bar[XB_XSUB(b.x)], 1u);
        const unsigned gen = old / nloc;
        if (old + 1u == (gen + 1u) * nloc) {
            __builtin_amdgcn_fence(__ATOMIC_RELEASE, "agent");
            asm volatile("s_waitcnt vmcnt(0)" ::: "memory");
            const unsigned og = xb_add(&bar[XB_TOP], 1u);
            const unsigned tg = og / nx;
            if (og + 1u == (tg + 1u) * nx) xb_add(&bar[XB_TOPGEN], 1u);
            else XB_SPIN(xb_ld(&bar[XB_TOPGEN]) == tg, bar);
            __builtin_amdgcn_fence(__ATOMIC_ACQUIRE, "agent");
            xb_add(&bar[XB_XGEN(b.x)], 1u);
            asm volatile("s_waitcnt vmcnt(0)" ::: "memory");
        } else {
            XB_SPIN(xb_ld(&bar[XB_XGEN(b.x)]) == gen, bar);
            __builtin_amdgcn_fence(__ATOMIC_ACQUIRE, "agent");
            asm volatile("s_waitcnt vmcnt(0)" ::: "memory");
        }
    }
    __syncthreads();
}

using pg8::bf16_t; using pg8::f32x4; using pg8::bf16x8;
typedef unsigned u32x4_t __attribute__((ext_vector_type(4)));
typedef unsigned u32x2_t __attribute__((ext_vector_type(2)));

constexpr int DM = 1024, NBP = 8, SEQ = 2048, NBS = 128, SSEQ = 4, NH = 4, HD = 128, MW = 512;
constexpr int MP = NBP * SEQ, MS = NBS * SSEQ, MT = MP + MS;
constexpr int NIN = 9232, N1 = 9216, DFF = 2816, NUP = 5632;
constexpr float EPS = 1e-6f;
constexpr float QSCALE = 0.08838834764831845f;

constexpr size_t O_Y = 0;
constexpr size_t O_P_GS = (size_t)MT * DM;
constexpr size_t O_P_GC = O_P_GS + (size_t)2 * 8 * 4 * 128 * 128;
constexpr size_t O_P_MC = O_P_GC + (size_t)2 * 8 * 3 * 1536;
constexpr size_t O_P_MN = O_P_MC + (size_t)2 * 8 * 4 * 128 * 128;
constexpr size_t O_P_MM = O_P_MN + (size_t)2 * 8 * 4 * 128;
constexpr size_t O_P_HS = O_P_MM + (size_t)2 * 8 * 4;
constexpr size_t O_P_FC = O_P_HS + (size_t)2 * 8 * 4 * 128 * 128;
constexpr size_t O_S_GS = O_P_FC + (size_t)2 * 8 * 2 * 5632;
constexpr size_t O_S_GC = O_S_GS + (size_t)2 * 128 * 4 * 128 * 128;
constexpr size_t O_S_MC = O_S_GC + (size_t)2 * 128 * 3 * 1536;
constexpr size_t O_S_MN = O_S_MC + (size_t)2 * 128 * 4 * 128 * 128;
constexpr size_t O_S_MM = O_S_MN + (size_t)2 * 128 * 4 * 128;
constexpr size_t O_S_HS = O_S_MM + (size_t)2 * 128 * 4;
constexpr size_t O_S_FC = O_S_HS + (size_t)2 * 128 * 4 * 128 * 128;
constexpr size_t O_END  = O_S_FC + (size_t)2 * 128 * 2 * 5632;

constexpr size_t W_WIN = 0;
constexpr size_t W_WBR = W_WIN + (size_t)N1 * 1024 * 2;
constexpr size_t W_WOUT = W_WBR + (size_t)3 * 1024 * 512 * 2;
constexpr size_t W_WUP = W_WOUT + (size_t)1024 * 1024 * 2;
constexpr size_t W_WDN = W_WUP + (size_t)NUP * 1024 * 2;
constexpr size_t W_HBF = W_WDN + (size_t)1024 * DFF * 2;
constexpr size_t W_PROJ = W_HBF + (size_t)MT * 1024 * 2;
constexpr size_t W_ACT = W_PROJ + (size_t)MT * NUP * 2;
constexpr size_t W_OUTS = W_PROJ + (size_t)MT * N1 * 2;
constexpr size_t W_GATES = W_OUTS + (size_t)3 * MT * 512 * 2;
constexpr size_t W_DEN = W_GATES + (size_t)MT * 16 * 4;
constexpr size_t W_MT = W_DEN + (size_t)MT * 4 * 4;
constexpr size_t W_BAR = W_MT + (size_t)MT * 4 * 4;
constexpr size_t W_END = W_BAR + 16384;

constexpr int LDS_MAIN = 143360;
constexpr int LDS_BYTES = LDS_MAIN + 64 + 512;

struct Params { const float* in[28]; float* out; unsigned char* ws; };
enum { I_XP = 0, I_XS, I_SGS, I_SGC, I_SMC, I_SMN, I_SMM, I_SHS, I_SFC, I_LNMIX, I_WIN, I_GCW, I_ALOG, I_DTB, I_GNORM, I_MIB, I_MFB, I_MNORM, I_HLB, I_HNORM,
       I_WBR, I_WOUT, I_LNFFN, I_WUP, I_FCW, I_FCB, I_WDN, I_LNF };

typedef const float* const __attribute__((address_space(4))) * kargp_t;
__device__ __forceinline__ const float* argp(int i) { kargp_t kp = (kargp_t)__builtin_amdgcn_kernarg_segment_ptr(); asm volatile("" : "+s"(i)); return kp[i]; }
__device__ __forceinline__ int bidx() { int b = (int)blockIdx.x; asm volatile("" : "+s"(b)); return b; }
__device__ __forceinline__ int gdim() { int g = (int)gridDim.x; asm volatile("" : "+s"(g)); return g; }
#define PIN(i) argp(i)
#define POUT ((float*)argp(28))
#define PWS ((unsigned char*)argp(29))
__device__ __forceinline__ float bf2f(bf16_t b) { return __uint_as_float(((unsigned)b) << 16); }
__device__ __forceinline__ float bflo(unsigned u) { return __uint_as_float(u << 16); }
__device__ __forceinline__ float bfhi(unsigned u) { return __uint_as_float(u & 0xffff0000u); }
__device__ __forceinline__ bf16_t f2bf(float f) { return (bf16_t)(pg8::cvt_pk_bf16(f, 0.f) & 0xffffu); }
__device__ __forceinline__ float sigm(float x) { return __builtin_amdgcn_rcpf(1.f + __expf(-x)); }
__device__ __forceinline__ float silu(float x) { return x * sigm(x); }
__device__ __forceinline__ float rdlane(float x, int l) { return __builtin_bit_cast(float, __builtin_amdgcn_readlane(__builtin_bit_cast(int, x), l)); }
template <int CTRL> __device__ __forceinline__ float dppf(float x) { return __builtin_bit_cast(float, __builtin_amdgcn_update_dpp(0, __builtin_bit_cast(int, x), CTRL, 0xf, 0xf, true)); }
__device__ __forceinline__ float grp_sum8(float x) { x += dppf<0xB1>(x); x += dppf<0x4E>(x); x += dppf<0x141>(x); return x; }
__device__ __forceinline__ float grp_sum16(float x) { x = grp_sum8(x); x += dppf<0x140>(x); return x; }
__device__ __forceinline__ float wave_sum(float x) { x = grp_sum16(x);
    x += __builtin_bit_cast(float, __builtin_amdgcn_update_dpp(0, __builtin_bit_cast(int, x), 0x142, 0xa, 0xf, false));
    x += __builtin_bit_cast(float, __builtin_amdgcn_update_dpp(0, __builtin_bit_cast(int, x), 0x143, 0xc, 0xf, false));
    return rdlane(x, 63); }
template <int CTRL> __device__ __forceinline__ float dppm(float x) { return __builtin_bit_cast(float, __builtin_amdgcn_update_dpp(__builtin_bit_cast(int, -INFINITY), __builtin_bit_cast(int, x), CTRL, 0xf, 0xf, false)); }
template <int T> __device__ __forceinline__ float grp_sum(float x) { if constexpr (T == 16) return grp_sum16(x); else return grp_sum8(x); }

__device__ __forceinline__ int win_srccol(int n0) { const int blk = n0 >> 9, r = n0 & 511; int base;
    if (blk < 4) base = blk * 512; else if (blk < 8) base = 2056 + (blk - 4) * 512; else if (blk < 12) base = 4112 + (blk - 8) * 512; else base = 6160 + (blk - 12) * 512;
    return base + r; }
__device__ __forceinline__ void conv_T(const float* __restrict__ src, int ld, bf16_t* __restrict__ dst, int K, int N, bool winmap, float* tile, int& tcount) {
    int tid_ = threadIdx.x; asm volatile("" : "+v"(tid_)); const int tid = tid_, ntn = N / 64, ntiles = ntn * (K / 64);
    for (int t = bidx() - (tcount % gdim()); t < ntiles; t += gdim()) {
        if (t < 0) continue;
        const int tn = t % ntn, tk = t / ntn, n0 = tn * 64, k0 = tk * 64, sc0 = winmap ? win_srccol(n0) : n0;
        __syncthreads();
        { const int kk = tid >> 4, n4 = (tid & 15) * 4;
#pragma unroll
          for (int pp = 0; pp < 2; ++pp) { const float4 v = *(const float4*)(src + (size_t)(k0 + kk + 32 * pp) * ld + sc0 + n4); float* tp = tile + (kk + 32 * pp) * 65 + n4; tp[0] = v.x; tp[1] = v.y; tp[2] = v.z; tp[3] = v.w; } }
        __syncthreads();
        { const int n = tid >> 3, k8 = (tid & 7) * 8; float f[8];
#pragma unroll
          for (int i = 0; i < 8; ++i) f[i] = tile[(k8 + i) * 65 + n];
          u32x4_t o; o[0] = pg8::cvt_pk_bf16(f[0], f[1]); o[1] = pg8::cvt_pk_bf16(f[2], f[3]); o[2] = pg8::cvt_pk_bf16(f[4], f[5]); o[3] = pg8::cvt_pk_bf16(f[6], f[7]);
          *(u32x4_t*)(dst + (size_t)(n0 + n) * K + k0 + k8) = o; }
    }
    tcount += ntiles;
}

__device__ __forceinline__ void phase_rmsnorm(const Params& p, int l, const float* xa, const float* xb, const float* __restrict__ gw, bf16_t* __restrict__ hout, bool do_gates, float* sm) {
    int tid_ = threadIdx.x; asm volatile("" : "+v"(tid_)); const int tid = tid_, lane = tid & 63, w = tid >> 6;
    float* wgT = sm;
    if (do_gates) {
        const float* win = PIN(I_WIN) + (size_t)l * 1024 * NIN;
        __syncthreads();
        for (int i = tid; i < 16 * 1024; i += 512) { const int k = i >> 4, j = i & 15; const int gc = j < 8 ? 2048 + j : 4104 + (j - 8); wgT[j * 1024 + k] = win[(size_t)k * NIN + gc]; }
        __syncthreads();
    }
    float4 g4[4];
#pragma unroll
    for (int i = 0; i < 4; ++i) g4[i] = *(const float4*)(gw + lane * 4 + 256 * i);
    for (int row = bidx() * 8 + w; row < MT; row += gdim() * 8) {
        const float* xr = row < MP ? xa + (size_t)row * DM : xb + (size_t)(row - MP) * DM;
        float4 v[4]; float ss = 0.f;
#pragma unroll
        for (int i = 0; i < 4; ++i) { v[i] = *(const float4*)(xr + lane * 4 + 256 * i); ss += v[i].x * v[i].x + v[i].y * v[i].y + v[i].z * v[i].z + v[i].w * v[i].w; }
        ss = wave_sum(ss);
        const float rstd = rsqrtf(ss * (1.f / 1024.f) + EPS);
#pragma unroll
        for (int i = 0; i < 4; ++i) { v[i].x *= rstd * g4[i].x; v[i].y *= rstd * g4[i].y; v[i].z *= rstd * g4[i].z; v[i].w *= rstd * g4[i].w;
            u32x2_t o; o[0] = pg8::cvt_pk_bf16(v[i].x, v[i].y); o[1] = pg8::cvt_pk_bf16(v[i].z, v[i].w);
            *(u32x2_t*)(hout + (size_t)row * DM + lane * 4 + 256 * i) = o; }
        if (do_gates) {
            float mine = 0.f;
#pragma unroll
            for (int j = 0; j < 16; ++j) { float a = 0.f;
#pragma unroll
                for (int i = 0; i < 4; ++i) { const float4 wv = *(const float4*)(wgT + j * 1024 + lane * 4 + 256 * i); a += v[i].x * wv.x + v[i].y * wv.y + v[i].z * wv.z + v[i].w * wv.w; }
                a = wave_sum(a); if (lane == j) mine = a; }
            if (lane < 16) { const int h = lane & 3, kind = lane >> 2; float r;
                if (kind == 0) r = sigm(mine);
                else if (kind == 1) { const float xx = mine + PIN(I_DTB)[l * 4 + h]; const float sp = xx > 20.f ? xx : __logf(1.f + __expf(xx)); r = __expf(-__expf(PIN(I_ALOG)[l * 4 + h]) * sp); }
                else if (kind == 2) r = mine + PIN(I_MIB)[l * 4 + h];
                else { const float xx = -(mine + PIN(I_MFB)[l * 4 + h]); r = -(xx > 20.f ? xx : __logf(1.f + __expf(xx))); }
                ((float*)(PWS + W_GATES))[(size_t)row * 16 + lane] = r; }
        }
    }
}

struct EpiProj {
    static constexpr bool PERM = true, AFTER_DRAIN = false;
    bf16_t* O; int ldc; int actmode;
    __device__ __forceinline__ void operator()(const f32x4 (&acc)[2][2][4][2], const pg8::Unit& u, int wr, int wc, int fr, int fq) const {
        const int row0 = u.pm * 256 + wr * 64 + fr, col0 = u.pn * 256 + wc * 32 + 8 * fq;
        int act = 0;
        if (actmode) { const int pn = u.pn; act = (pn >= 24 || pn == 14 || pn == 15) ? 2 : ((pn == 6 || pn == 7 || pn == 16 || pn == 17 || pn == 22 || pn == 23) ? 1 : 0); }
#pragma unroll
        for (int ai = 0; ai < 2; ++ai)
#pragma unroll
            for (int m = 0; m < 4; ++m) { bf16_t* rowp = O + (size_t)(row0 + ai * 128 + m * 16) * ldc + col0;
#pragma unroll
                for (int bj = 0; bj < 2; ++bj) { float v[8];
#pragma unroll
                    for (int i = 0; i < 4; ++i) { v[i] = acc[ai][bj][m][0][i]; v[4 + i] = acc[ai][bj][m][1][i]; }
                    if (act == 1) {
#pragma unroll
                        for (int i = 0; i < 8; ++i) v[i] = silu(v[i]); }
                    else if (act == 2) {
#pragma unroll
                        for (int i = 0; i < 8; ++i) v[i] = sigm(v[i]); }
                    u32x4_t o; o[0] = pg8::cvt_pk_bf16(v[0], v[1]); o[1] = pg8::cvt_pk_bf16(v[2], v[3]); o[2] = pg8::cvt_pk_bf16(v[4], v[5]); o[3] = pg8::cvt_pk_bf16(v[6], v[7]);
                    *(u32x4_t*)(rowp + bj * 128) = o; } }
    }
};
struct EpiMerge {
    static constexpr bool PERM = true, AFTER_DRAIN = false;
    const bf16_t* G; bf16_t* Mx;
    __device__ __forceinline__ void operator()(const f32x4 (&acc)[2][2][4][2], const pg8::Unit& u, int wr, int wc, int fr, int fq) const {
        const int n = u.pn >> 2, first = (n == 0);
        const int row0 = (u.pm - n * (MT / 256)) * 256 + wr * 64 + fr, col0 = (u.pn & 3) * 256 + wc * 32 + 8 * fq;
        const bf16_t* Gn = G + n * 1024 + col0; bf16_t* Mc = Mx + col0;
        u32x4_t gc[2], oc[2], gn[2], on[2];
#pragma unroll
        for (int bj = 0; bj < 2; ++bj) { gc[bj] = *(const u32x4_t*)(Gn + (size_t)row0 * N1 + bj * 128); oc[bj] = first ? (u32x4_t){0u, 0u, 0u, 0u} : *(const u32x4_t*)(Mc + (size_t)row0 * DM + bj * 128); }
#pragma unroll
        for (int gI = 0; gI < 8; ++gI) { const int ai = gI >> 2, m = gI & 3; const size_t row = (size_t)(row0 + ai * 128 + m * 16);
            if (gI < 7) { const size_t row2 = (size_t)(row0 + ((gI + 1) >> 2) * 128 + ((gI + 1) & 3) * 16);
#pragma unroll
                for (int bj = 0; bj < 2; ++bj) { gn[bj] = *(const u32x4_t*)(Gn + row2 * N1 + bj * 128); on[bj] = first ? (u32x4_t){0u, 0u, 0u, 0u} : *(const u32x4_t*)(Mc + row2 * DM + bj * 128); } }
#pragma unroll
            for (int bj = 0; bj < 2; ++bj) { float v[8];
#pragma unroll
                for (int i = 0; i < 4; ++i) { v[i] = acc[ai][bj][m][0][i]; v[4 + i] = acc[ai][bj][m][1][i]; }
#pragma unroll
                for (int i = 0; i < 4; ++i) { v[2 * i] = v[2 * i] * bflo(gc[bj][i]) + bflo(oc[bj][i]); v[2 * i + 1] = v[2 * i + 1] * bfhi(gc[bj][i]) + bfhi(oc[bj][i]); }
                u32x4_t o; o[0] = pg8::cvt_pk_bf16(v[0], v[1]); o[1] = pg8::cvt_pk_bf16(v[2], v[3]); o[2] = pg8::cvt_pk_bf16(v[4], v[5]); o[3] = pg8::cvt_pk_bf16(v[6], v[7]);
                *(u32x4_t*)(Mc + row * DM + bj * 128) = o; }
#pragma unroll
            for (int bj = 0; bj < 2; ++bj) { gc[bj] = gn[bj]; oc[bj] = on[bj]; } }
    }
};
struct EpiResid {
    static constexpr bool PERM = false, AFTER_DRAIN = false;
    float* X; const float* Sa; const float* Sb;
    __device__ __forceinline__ void operator()(const f32x4 (&acc)[2][2][4][2], const pg8::Unit& u, int wr, int wc, int fr, int fq) const {
        const int row0 = u.pm * 256 + wr * 64 + fr, col0 = u.pn * 256 + wc * 32 + 4 * fq;
        const float* S = u.pm * 256 < MP ? Sa : Sb - (size_t)MP * DM;
        f32x4 cur[4], nxt[4];
#pragma unroll
        for (int q = 0; q < 4; ++q) cur[q] = *(const f32x4*)(S + (size_t)row0 * DM + col0 + (q >> 1) * 128 + (q & 1) * 16);
#pragma unroll
        for (int gI = 0; gI < 8; ++gI) { const int ai = gI >> 2, m = gI & 3; const size_t ro = (size_t)(row0 + ai * 128 + m * 16) * DM + col0;
            if (gI < 7) { const int ai2 = (gI + 1) >> 2, m2 = (gI + 1) & 3; const size_t ro2 = (size_t)(row0 + ai2 * 128 + m2 * 16) * DM + col0;
#pragma unroll
                for (int q = 0; q < 4; ++q) nxt[q] = *(const f32x4*)(S + ro2 + (q >> 1) * 128 + (q & 1) * 16); }
#pragma unroll
            for (int q = 0; q < 4; ++q) *(f32x4*)(X + ro + (q >> 1) * 128 + (q & 1) * 16) = cur[q] + acc[ai][q >> 1][m][q & 1];
#pragma unroll
            for (int q = 0; q < 4; ++q) cur[q] = nxt[q]; }
    }
};

struct EpiAtomic {
    static constexpr bool PERM = false, AFTER_DRAIN = false;
    float* X;
    __device__ __forceinline__ void operator()(const f32x4 (&acc)[2][2][4][2], const pg8::Unit& u, int wr, int wc, int fr, int fq) const {
        const int row0 = u.pm * 256 + wr * 64 + fr, col0 = u.pn * 256 + wc * 32 + 4 * fq;
#pragma unroll
        for (int ai = 0; ai < 2; ++ai)
#pragma unroll
            for (int m = 0; m < 4; ++m) { float* rowp = X + (size_t)(row0 + ai * 128 + m * 16) * DM + col0;
#pragma unroll
                for (int bj = 0; bj < 2; ++bj)
#pragma unroll
                    for (int n = 0; n < 2; ++n)
#pragma unroll
                        for (int e = 0; e < 4; ++e) unsafeAtomicAdd(rowp + bj * 128 + n * 16 + e, acc[ai][bj][m][n][e]); }
    }
};
struct MergeOrder {
    pg8::StaticOrder base;
    __device__ void init(int G_, int c_) { base.init(MT, 1024, G_, c_); }
    __device__ bool next(int i, pg8::Unit& u) const { const int t = i / 3, n = i - 3 * t; pg8::Unit b; if (!base.next(t, b)) return false; u.pm = n * (MT / 256) + b.pm; u.pn = n * 4 + b.pn; u.pk = 0; return true; }
    __device__ __forceinline__ void a_ready(const pg8::Unit&) const {}
    __device__ __forceinline__ void done(const pg8::Unit&) const {}
};
struct PieceOrder {
    int G, c, KP;
    __device__ bool next(int i, pg8::Unit& u) const { const int L = i * G + c; if (L >= 8 * KP) return false; const int tile = L / KP; u.pk = L - tile * KP; u.pm = MP / 256 + (tile >> 2); u.pn = tile & 3; return true; }
    __device__ __forceinline__ void a_ready(const pg8::Unit&) const {}
    __device__ __forceinline__ void done(const pg8::Unit&) const {}
};
__device__ __forceinline__ void phase_gdnprep(const Params& p, int l) {
    int tid_ = threadIdx.x; asm volatile("" : "+v"(tid_)); const int tid = tid_, j = tid & 15;
    const bf16_t* proj = (const bf16_t*)(PWS + W_PROJ);
    bf16_t* qkd = (bf16_t*)(PWS + W_HBF); bf16_t* vd = (bf16_t*)(PWS + W_OUTS);
    const float* cw = PIN(I_GCW) + (size_t)l * 4 * 1536; const float* cst = PIN(I_SGC) + (size_t)l * NBS * 3 * 1536;
    const int ngroups = MT * 12;
    for (int gid = bidx() * 32 + (tid >> 4); gid < ngroups; gid += gdim() * 32) {
        const int r = gid / 12, part = gid - r * 12, col = part * 128 + 8 * j;
        const bool samp = r >= MP; const int t = samp ? ((r - MP) & 3) : (r & (SEQ - 1)), b2 = samp ? ((r - MP) >> 2) : 0;
        float y[8];
#pragma unroll
        for (int i = 0; i < 8; ++i) y[i] = 0.f;
#pragma unroll
        for (int jj = 0; jj < 4; ++jj) { const int tt = t - 3 + jj; float x[8];
            if (tt >= 0) { const u32x4_t raw = *(const u32x4_t*)(proj + (size_t)(r - 3 + jj) * N1 + col);
#pragma unroll
                for (int i = 0; i < 4; ++i) { x[2 * i] = bflo(raw[i]); x[2 * i + 1] = bfhi(raw[i]); } }
            else if (samp) { const float* cp = cst + (size_t)(b2 * 3 + 3 + tt) * 1536 + col; const float4 a0 = *(const float4*)cp, a1 = *(const float4*)(cp + 4);
                x[0] = a0.x; x[1] = a0.y; x[2] = a0.z; x[3] = a0.w; x[4] = a1.x; x[5] = a1.y; x[6] = a1.z; x[7] = a1.w; }
            else {
#pragma unroll
                for (int i = 0; i < 8; ++i) x[i] = 0.f; }
            const float4 w0 = *(const float4*)(cw + jj * 1536 + col), w1 = *(const float4*)(cw + jj * 1536 + col + 4);
            y[0] += w0.x * x[0]; y[1] += w0.y * x[1]; y[2] += w0.z * x[2]; y[3] += w0.w * x[3]; y[4] += w1.x * x[4]; y[5] += w1.y * x[5]; y[6] += w1.z * x[6]; y[7] += w1.w * x[7]; }
        float ss = 0.f;
#pragma unroll
        for (int i = 0; i < 8; ++i) { y[i] = silu(y[i]); ss += y[i] * y[i]; }
        ss = grp_sum16(ss);
        const float scl = part < 4 ? rsqrtf(ss + EPS) * QSCALE : (part < 8 ? rsqrtf(ss + EPS) : 1.f);
        u32x4_t o; o[0] = pg8::cvt_pk_bf16(y[0] * scl, y[1] * scl); o[1] = pg8::cvt_pk_bf16(y[2] * scl, y[3] * scl); o[2] = pg8::cvt_pk_bf16(y[4] * scl, y[5] * scl); o[3] = pg8::cvt_pk_bf16(y[6] * scl, y[7] * scl);
        if (part < 8) *(u32x4_t*)(qkd + (size_t)r * 1024 + col) = o; else *(u32x4_t*)(vd + (size_t)r * 512 + (col - 1024)) = o;
    }
}

__device__ __forceinline__ void lds_barrier() { asm volatile("s_waitcnt lgkmcnt(0)" ::: "memory"); __builtin_amdgcn_s_barrier(); asm volatile("" ::: "memory"); }
typedef float f2 __attribute__((ext_vector_type(2)));
typedef float f4 __attribute__((ext_vector_type(4)));
template <int MIX>
__device__ __forceinline__ void scan_prompt_item(const Params& p, int l, int b, int h, int cgp, float* sm) {
    constexpr int T = 16, CPL = (MIX == 0) ? 1 : 2, NG = 128 / (4 * T), NP = 2 * NG, CPW = (64 / T) * CPL, CPG = 8 * CPW, TB = 32, BUFSZ = 16512, NBLK = SEQ / TB;
    int tid_ = threadIdx.x; asm volatile("" : "+v"(tid_)); const int tid = tid_, lane = tid & 63, w = tid >> 6, c = lane / T, j = lane % T;
    const int col = w * CPW + c, ecol = cgp * CPG + col;
    float* misc = sm + 2 * BUFSZ; float* gsc = misc; float* mcar = misc + 64;
    const float* gates = (const float*)(PWS + W_GATES);
    bf16_t* outp = (bf16_t*)(PWS + W_OUTS) + (size_t)MIX * MT * 512;
    const size_t rb = (size_t)b * SEQ;
    const int c8 = (tid & 31) * 8, srow = tid >> 5;
    const bf16_t* qsrc; size_t qld; const bf16_t* vsrc; size_t vld;
    if (MIX == 0) { qsrc = (const bf16_t*)(PWS + W_HBF) + rb * 1024 + (c8 < 128 ? h * 128 + c8 : 512 + h * 128 + (c8 - 128)); qld = 1024;
        vsrc = (const bf16_t*)(PWS + W_OUTS) + rb * 512 + h * 128 + cgp * 32; vld = 512; }
    else { const int base = MIX == 1 ? 2048 : 4096; qsrc = (const bf16_t*)(PWS + W_PROJ) + rb * N1 + base + (c8 < 128 ? h * 128 + c8 : 512 + h * 128 + (c8 - 128)); qld = N1;
        vsrc = (const bf16_t*)(PWS + W_PROJ) + rb * N1 + base + 1024 + h * 128 + cgp * 64; vld = N1; }
    constexpr int VPC = CPG / 8;
    const int vs = tid / VPC, vc8 = (tid % VPC) * 8; const bool vact = tid < TB * VPC;
    float lb8[8];
#pragma unroll
    for (int i = 0; i < 8; ++i) lb8[i] = 0.f;
    if (MIX == 2 && l > 0 && c8 >= 128) { const float* hl = PIN(I_HLB);
#pragma unroll
        for (int i = 0; i < 8; ++i) { const int cc = h * 128 + (c8 - 128) + i; lb8[i] = sigm(hl[512 + cc] - hl[cc]); } }
    f2 S2[CPL][NP];
#pragma unroll
    for (int cc = 0; cc < CPL; ++cc)
#pragma unroll
        for (int i = 0; i < NP; ++i) S2[cc][i] = (f2){0.f, 0.f};
    float nn = 0.f, okeep[CPL], oprev[CPL];
#pragma unroll
    for (int cc = 0; cc < CPL; ++cc) { okeep[cc] = 0.f; oprev[cc] = 0.f; }
    u32x4_t rq[2][2], rv[2]; float rg0[2] = {0.f, 0.f}, rg1[2] = {0.f, 0.f};
    rv[0] = (u32x4_t){0u, 0u, 0u, 0u}; rv[1] = rv[0];
#define SCAN_ISSUE(t0_, st_) do { \
        _Pragma("unroll") for (int i_ = 0; i_ < 2; ++i_) rq[st_][i_] = *(const u32x4_t*)(qsrc + (size_t)((t0_) + srow + 16 * i_) * qld); \
        if (vact) rv[st_] = *(const u32x4_t*)(vsrc + (size_t)((t0_) + vs) * vld + vc8); \
        if (MIX != 2 && tid < TB) { const size_t r_ = rb + (t0_) + tid; rg0[st_] = gates[r_ * 16 + (MIX == 0 ? 0 : 8) + h]; rg1[st_] = gates[r_ * 16 + (MIX == 0 ? 4 : 12) + h]; } } while (0)
#define SCAN_FINISH(B_, st_) do { float* qk_ = (B_); float* vv_ = (B_) + 8192; float* sc_ = (B_) + 10240; \
        _Pragma("unroll") for (int i_ = 0; i_ < 2; ++i_) { float x_[8]; \
            _Pragma("unroll") for (int e_ = 0; e_ < 4; ++e_) { x_[2 * e_] = bflo(rq[st_][i_][e_]); x_[2 * e_ + 1] = bfhi(rq[st_][i_][e_]); } \
            if (MIX == 2 && c8 >= 128) { _Pragma("unroll") for (int e_ = 0; e_ < 8; ++e_) x_[e_] = lb8[e_] + (1.f - lb8[e_]) * sigm(x_[e_]); } \
            float* d_ = qk_ + (srow + 16 * i_) * 256 + c8; *(f4*)d_ = (f4){x_[0], x_[1], x_[2], x_[3]}; *(f4*)(d_ + 4) = (f4){x_[4], x_[5], x_[6], x_[7]}; } \
        if (vact) { float* d_ = vv_ + vs * 64 + vc8; *(f4*)d_ = (f4){bflo(rv[st_][0]), bfhi(rv[st_][0]), bflo(rv[st_][1]), bfhi(rv[st_][1])}; *(f4*)(d_ + 4) = (f4){bflo(rv[st_][2]), bfhi(rv[st_][2]), bflo(rv[st_][3]), bfhi(rv[st_][3])}; } \
        if (MIX == 0 && tid < TB) { sc_[tid * 4] = rg0[st_]; sc_[tid * 4 + 1] = rg1[st_]; } \
        if (MIX == 1 && tid < TB) { gsc[tid * 2] = rg0[st_]; gsc[tid * 2 + 1] = rg1[st_]; } } while (0)
#define SCAN_CHAIN(B_) do { if (w == 1) { float* sc_ = (B_) + 10240; const int ls_ = lane & 31; const float m0_ = mcar[0]; \
            const float ig_ = gsc[2 * ls_], lf_ = gsc[2 * ls_ + 1]; \
            float F_ = lf_; F_ += dppf<0x111>(F_); F_ += dppf<0x112>(F_); F_ += dppf<0x114>(F_); F_ += dppf<0x118>(F_);              \
            { const float t0_ = rdlane(F_, 15); if (lane & 16) F_ += t0_; } \
            float P_ = ig_ - F_; P_ = fmaxf(P_, dppm<0x111>(P_)); P_ = fmaxf(P_, dppm<0x112>(P_)); P_ = fmaxf(P_, dppm<0x114>(P_)); P_ = fmaxf(P_, dppm<0x118>(P_)); \
            { const float t1_ = rdlane(P_, 15); if (lane & 16) P_ = fmaxf(P_, t1_); } \
            const float m_ = F_ + fmaxf(m0_, P_); \
            float mp_ = dppf<0x111>(m_); { const float t2_ = rdlane(m_, 15); if ((lane & 15) == 0) mp_ = (lane & 16) ? t2_ : m0_; } \
            const float mlast_ = rdlane(m_, 31); \
            if (lane < 32) { sc_[lane * 4] = __expf(lf_ + mp_ - m_); sc_[lane * 4 + 1] = __expf(ig_ - m_) * QSCALE; sc_[lane * 4 + 2] = m_; } \
            if (lane == 0) mcar[0] = mlast_; } } while (0)
    if (MIX == 1 && tid == 64) mcar[0] = 0.f;
    __syncthreads();
    SCAN_ISSUE(0, 0);
    SCAN_FINISH(sm, 0);
    SCAN_ISSUE(TB, 1);
    __syncthreads();
    if (MIX == 1) { SCAN_CHAIN(sm); __syncthreads(); }
#pragma unroll 1
    for (int blk2 = 0; blk2 < NBLK; blk2 += 2) {
#pragma unroll
      for (int par = 0; par < 2; ++par) {
        const int blk = blk2 + par;
        const int t0 = blk * TB;
        float* B = sm + (blk & 1) * BUFSZ; float* Bn = sm + ((blk & 1) ^ 1) * BUFSZ;
        const float* qk = B; const float* vv = B + 8192; const float* sc = B + 10240; float* denp = B + 10368; float* ost = B + 14464;
        if (blk + 2 < NBLK) SCAN_ISSUE(t0 + 2 * TB, par);
        f4 qa[2][NG], ka[2][NG]; float va[2][CPL], sa[2], sb[2], kda[2], qda[2];
#define SCAN_LOADOPS(slot_, s_) do { const float* qs_ = qk + (s_) * 256; \
            _Pragma("unroll") for (int g_ = 0; g_ < NG; ++g_) { qa[slot_][g_] = *(const f4*)(qs_ + g_ * 4 * T + 4 * j); ka[slot_][g_] = *(const f4*)(qs_ + 128 + g_ * 4 * T + 4 * j); } \
            _Pragma("unroll") for (int cc_ = 0; cc_ < CPL; ++cc_) va[slot_][cc_] = vv[(s_) * 64 + col + 4 * cc_]; \
            if (MIX != 2) { sa[slot_] = sc[(s_) * 4]; sb[slot_] = sc[(s_) * 4 + 1]; } \
            if (MIX == 1) { const int dn_ = 16 * w + (lane & 15); kda[slot_] = qs_[128 + dn_]; qda[slot_] = qs_[dn_]; } } while (0)
        SCAN_LOADOPS(0, 0);
#pragma unroll 1
        for (int sg = 0; sg < TB; sg += T) {
#pragma unroll
            for (int ss = 0; ss < T; ++ss) {
                const int s = sg + ss; constexpr int dummy = 0; (void)dummy;
                const int cur = ss & 1, nxt = cur ^ 1;
                SCAN_LOADOPS(nxt, (s + 1) & (TB - 1));
                __builtin_amdgcn_sched_barrier(0);
                f2 qq[NP], kk[NP];
#pragma unroll
                for (int g = 0; g < NG; ++g) { qq[2 * g] = qa[cur][g].xy; qq[2 * g + 1] = qa[cur][g].zw; kk[2 * g] = ka[cur][g].xy; kk[2 * g + 1] = ka[cur][g].zw; }
                float onew[CPL];
#pragma unroll
                for (int cc = 0; cc < CPL; ++cc) {
                    const float v = va[cur][cc];
                    f2 oa = (f2){0.f, 0.f}, ob = (f2){0.f, 0.f};
                    if (MIX == 0) {
                        const float beta = sa[cur], a = sb[cur];
                        f2 ka2 = kk[0] * S2[cc][0], kb2 = kk[1] * S2[cc][1];
#pragma unroll
                        for (int i = 2; i < NP; i += 2) { ka2 = kk[i] * S2[cc][i] + ka2; kb2 = kk[i + 1] * S2[cc][i + 1] + kb2; }
                        ka2 = ka2 + kb2;
                        const float ks = grp_sum<T>(ka2.x + ka2.y);
                        const float u = beta * (v - a * ks);
                        const f2 a2 = (f2){a, a}, u2 = (f2){u, u};
#pragma unroll
                        for (int i = 0; i < NP; i += 2) { S2[cc][i] = S2[cc][i] * a2 + kk[i] * u2; S2[cc][i + 1] = S2[cc][i + 1] * a2 + kk[i + 1] * u2; oa = qq[i] * S2[cc][i] + oa; ob = qq[i + 1] * S2[cc][i + 1] + ob; }
                    } else if (MIX == 1) {
                        const float fp = sa[cur], ip = sb[cur], iv = ip * v;
                        const f2 f2v = (f2){fp, fp}, iv2 = (f2){iv, iv};
#pragma unroll
                        for (int i = 0; i < NP; i += 2) { S2[cc][i] = S2[cc][i] * f2v + kk[i] * iv2; S2[cc][i + 1] = S2[cc][i + 1] * f2v + kk[i + 1] * iv2; oa = qq[i] * S2[cc][i] + oa; ob = qq[i + 1] * S2[cc][i + 1] + ob; }
                    } else {
                        const f2 v2 = (f2){v, v};
#pragma unroll
                        for (int i = 0; i < NP; i += 2) { S2[cc][i] = kk[i] * (S2[cc][i] - v2) + v2; S2[cc][i + 1] = kk[i + 1] * (S2[cc][i + 1] - v2) + v2; oa = qq[i] * S2[cc][i] + oa; ob = qq[i + 1] * S2[cc][i + 1] + ob; }
                    }
                    oa = oa + ob; onew[cc] = oa.x + oa.y;
                }
                if (MIX == 1) { const float fp = sa[cur], ip = sb[cur];
                    nn = fp * nn + ip * kda[cur];
                    denp[s * 128 + 16 * w + (lane & 15)] = qda[cur] * nn; }
#pragma unroll
                for (int cc = 0; cc < CPL; ++cc) {
                    if (ss > 0) { const float o = grp_sum<T>(oprev[cc]); okeep[cc] = (ss - 1 == j) ? o : okeep[cc]; }
                    oprev[cc] = onew[cc]; }
            }
#pragma unroll
            for (int cc = 0; cc < CPL; ++cc) { const float o = grp_sum<T>(oprev[cc]); okeep[cc] = (T - 1 == j) ? o : okeep[cc];
                ost[(sg + j) * CPG + col + 4 * cc] = okeep[cc]; }
        }
#undef SCAN_LOADOPS
        if (blk + 1 < NBLK) SCAN_FINISH(Bn, par ^ 1);
        __syncthreads();
        if (tid < TB * (CPG / 8)) { const int orow = tid / (CPG / 8), oc8 = (tid % (CPG / 8)) * 8; const f4 o0 = *(const f4*)(ost + orow * CPG + oc8), o1 = *(const f4*)(ost + orow * CPG + oc8 + 4);
            u32x4_t ov; ov[0] = pg8::cvt_pk_bf16(o0.x, o0.y); ov[1] = pg8::cvt_pk_bf16(o0.z, o0.w); ov[2] = pg8::cvt_pk_bf16(o1.x, o1.y); ov[3] = pg8::cvt_pk_bf16(o1.z, o1.w);
            *(u32x4_t*)(outp + (rb + t0 + orow) * 512 + h * 128 + cgp * CPG + oc8) = ov; }
        if (MIX == 1) {
            if (cgp == 0) { const int sr = tid >> 4, jl = tid & 15; const f4 a0 = *(const f4*)(denp + sr * 128 + 8 * jl), a1 = *(const f4*)(denp + sr * 128 + 8 * jl + 4);
                const float d = grp_sum16((a0.x + a0.y) + (a0.z + a0.w) + (a1.x + a1.y) + (a1.z + a1.w));
                if (jl == 0) { const size_t r = rb + t0 + sr; ((float*)(PWS + W_DEN))[r * 4 + h] = d; ((float*)(PWS + W_MT))[r * 4 + h] = sc[sr * 4 + 2]; } }
            if (blk + 1 < NBLK) SCAN_CHAIN(Bn);
            __syncthreads();
        }
      }
    }
#undef SCAN_ISSUE
#undef SCAN_FINISH
#undef SCAN_CHAIN
    const size_t sidx = ((size_t)(l * NBP + b) * NH + h);
    float* So = POUT + (MIX == 0 ? O_P_GS : (MIX == 1 ? O_P_MC : O_P_HS)) + sidx * 16384;
#pragma unroll
    for (int cc = 0; cc < CPL; ++cc)
#pragma unroll
        for (int g = 0; g < NG; ++g) { const int d0 = g * 4 * T + 4 * j, ec = ecol + 4 * cc;
            So[(size_t)(d0 + 0) * 128 + ec] = S2[cc][2 * g].x; So[(size_t)(d0 + 1) * 128 + ec] = S2[cc][2 * g].y; So[(size_t)(d0 + 2) * 128 + ec] = S2[cc][2 * g + 1].x; So[(size_t)(d0 + 3) * 128 + ec] = S2[cc][2 * g + 1].y; }
    if (MIX == 1 && cgp == 0) {
        if (lane < 16) POUT[O_P_MN + sidx * 128 + 16 * w + lane] = nn;
        if (tid == 64) POUT[O_P_MM + sidx] = mcar[0];
    }
    __syncthreads();
}

template <int MIX>
__device__ __forceinline__ void scan_prompt_lin(const Params& p, int l, int b, int h, int cgp, float* sm) {
    constexpr int TB = 32, NBLK = SEQ / TB;
    int tid_ = threadIdx.x; asm volatile("" : "+v"(tid_)); const int tid = tid_, lane = tid & 63, w = tid >> 6;
    float* qk = sm; float* vv = sm + 8192; float* denp = sm + 10240; float* opart = sm + 14336; float* scall = sm + 30720;
    const float* gates = (const float*)(PWS + W_GATES);
    bf16_t* outp = (bf16_t*)(PWS + W_OUTS) + (size_t)MIX * MT * 512;
    const size_t rb = (size_t)b * SEQ;
    const int c8 = (tid & 31) * 8, srow = tid >> 5;
    const int base = MIX == 1 ? 2048 : 4096;
    const bf16_t* qsrc = (const bf16_t*)(PWS + W_PROJ) + rb * N1 + base + (c8 < 128 ? h * 128 + c8 : 512 + h * 128 + (c8 - 128));
    const bf16_t* vsrc = (const bf16_t*)(PWS + W_PROJ) + rb * N1 + base + 1024 + h * 128 + cgp * 64;
    const int vs = tid >> 3, vc8 = (tid & 7) * 8; const bool vact = tid < TB * 8;
    float lb8[8];
#pragma unroll
    for (int i = 0; i < 8; ++i) lb8[i] = 0.f;
    if (MIX == 2 && l > 0 && c8 >= 128) { const float* hl = PIN(I_HLB);
#pragma unroll
        for (int i = 0; i < 8; ++i) { const int cc = h * 128 + (c8 - 128) + i; lb8[i] = sigm(hl[512 + cc] - hl[cc]); } }
    __syncthreads();
    float mfinal = 0.f;
    if (MIX == 1) {
        float* graw = opart;
        for (int i = tid; i < SEQ; i += 512) { const size_t r = rb + i; graw[2 * i] = gates[r * 16 + 8 + h]; graw[2 * i + 1] = gates[r * 16 + 12 + h]; }
        __syncthreads();
        if (w == 1) { float m0 = 0.f; const int ls = lane & 31;
            for (int t0 = 0; t0 < SEQ; t0 += 32) {
                const float ig = graw[2 * (t0 + ls)], lf = graw[2 * (t0 + ls) + 1];
                float F = lf; F += dppf<0x111>(F); F += dppf<0x112>(F); F += dppf<0x114>(F); F += dppf<0x118>(F);
                { const float t0v = rdlane(F, 15); if (lane & 16) F += t0v; }
                float P = ig - F; P = fmaxf(P, dppm<0x111>(P)); P = fmaxf(P, dppm<0x112>(P)); P = fmaxf(P, dppm<0x114>(P)); P = fmaxf(P, dppm<0x118>(P));
                { const float t1v = rdlane(P, 15); if (lane & 16) P = fmaxf(P, t1v); }
                const float m = F + fmaxf(m0, P);
                float mp = dppf<0x111>(m); { const float t2v = rdlane(m, 15); if ((lane & 15) == 0) mp = (lane & 16) ? t2v : m0; }
                if (lane < 32) { scall[2 * (t0 + lane)] = __expf(lf + mp - m); scall[2 * (t0 + lane) + 1] = __expf(ig - m) * QSCALE;
                    if (cgp == 0) ((float*)(PWS + W_MT))[(rb + t0 + lane) * 4 + h] = m; }
                m0 = rdlane(m, 31); }
            mfinal = m0; }
        __syncthreads();
    }
    f2 S2[8];
#pragma unroll
    for (int i = 0; i < 8; ++i) S2[i] = (f2){0.f, 0.f};
    float nn = 0.f;
    u32x4_t rq[2][2], rv[2]; rv[0] = (u32x4_t){0u, 0u, 0u, 0u}; rv[1] = rv[0];
#define LIN_ISSUE(t0_, st_) do { \
        _Pragma("unroll") for (int i_ = 0; i_ < 2; ++i_) rq[st_][i_] = *(const u32x4_t*)(qsrc + (size_t)((t0_) + srow + 16 * i_) * N1); \
        if (vact) rv[st_] = *(const u32x4_t*)(vsrc + (size_t)((t0_) + vs) * N1 + vc8); } while (0)
#define LIN_FINISH(st_) do { \
        _Pragma("unroll") for (int i_ = 0; i_ < 2; ++i_) { float x_[8]; \
            _Pragma("unroll") for (int e_ = 0; e_ < 4; ++e_) { x_[2 * e_] = bflo(rq[st_][i_][e_]); x_[2 * e_ + 1] = bfhi(rq[st_][i_][e_]); } \
            if (MIX == 2 && c8 >= 128) { _Pragma("unroll") for (int e_ = 0; e_ < 8; ++e_) x_[e_] = lb8[e_] + (1.f - lb8[e_]) * sigm(x_[e_]); } \
            float* d_ = qk + (srow + 16 * i_) * 256 + c8; *(f4*)d_ = (f4){x_[0], x_[1], x_[2], x_[3]}; *(f4*)(d_ + 4) = (f4){x_[4], x_[5], x_[6], x_[7]}; } \
        if (vact) { float* d_ = vv + vs * 64 + vc8; *(f4*)d_ = (f4){bflo(rv[st_][0]), bfhi(rv[st_][0]), bflo(rv[st_][1]), bfhi(rv[st_][1])}; *(f4*)(d_ + 4) = (f4){bflo(rv[st_][2]), bfhi(rv[st_][2]), bflo(rv[st_][3]), bfhi(rv[st_][3])}; } } while (0)
    LIN_ISSUE(0, 0);
    LIN_FINISH(0);
    LIN_ISSUE(TB, 1);
    __syncthreads();
#pragma unroll 1
    for (int blk2 = 0; blk2 < NBLK; blk2 += 2) {
#pragma unroll
      for (int par = 0; par < 2; ++par) {
        const int blk = blk2 + par;
        const int t0 = blk * TB;
        if (blk + 2 < NBLK) LIN_ISSUE(t0 + 2 * TB, par);
        f4 qa[2][4], ka[2][4]; float va[2], kda[2], qda[2]; f2 sca[2];
#define LIN_LOADOPS(slot_, s_) do { const float* qs_ = qk + (s_) * 256 + 16 * w; \
            _Pragma("unroll") for (int g_ = 0; g_ < 4; ++g_) { qa[slot_][g_] = *(const f4*)(qs_ + 4 * g_); ka[slot_][g_] = *(const f4*)(qs_ + 128 + 4 * g_); } \
            va[slot_] = vv[(s_) * 64 + lane]; \
            if (MIX == 1) { sca[slot_] = *(const f2*)(scall + 2 * (t0 + (s_))); kda[slot_] = qs_[128 + (lane & 15)]; qda[slot_] = qs_[lane & 15]; } } while (0)
        LIN_LOADOPS(0, 0);
#pragma unroll 1
        for (int sg = 0; sg < TB; sg += 4) {
#pragma unroll
            for (int ss = 0; ss < 4; ++ss) {
                const int s = sg + ss, cur = ss & 1, nxt = cur ^ 1;
                LIN_LOADOPS(nxt, (s + 1) & (TB - 1));
                __builtin_amdgcn_sched_barrier(0);
                f2 qq[8], kk[8];
#pragma unroll
                for (int g = 0; g < 4; ++g) { qq[2 * g] = qa[cur][g].xy; qq[2 * g + 1] = qa[cur][g].zw; kk[2 * g] = ka[cur][g].xy; kk[2 * g + 1] = ka[cur][g].zw; }
                const float v = va[cur];
                f2 oa = (f2){0.f, 0.f}, ob = (f2){0.f, 0.f};
                if (MIX == 1) {
                    const float fp = sca[cur].x, ip = sca[cur].y, iv = ip * v;
                    const f2 f2v = (f2){fp, fp}, iv2 = (f2){iv, iv};
#pragma unroll
                    for (int i = 0; i < 8; i += 2) { S2[i] = S2[i] * f2v + kk[i] * iv2; S2[i + 1] = S2[i + 1] * f2v + kk[i + 1] * iv2; oa = qq[i] * S2[i] + oa; ob = qq[i + 1] * S2[i + 1] + ob; }
                    nn = fp * nn + ip * kda[cur];
                    denp[s * 128 + 16 * w + (lane & 15)] = qda[cur] * nn;
                } else {
                    const f2 v2 = (f2){v, v};
#pragma unroll
                    for (int i = 0; i < 8; i += 2) { S2[i] = kk[i] * (S2[i] - v2) + v2; S2[i + 1] = kk[i + 1] * (S2[i + 1] - v2) + v2; oa = qq[i] * S2[i] + oa; ob = qq[i + 1] * S2[i + 1] + ob; }
                }
                oa = oa + ob;
                opart[(s * 8 + w) * 64 + lane] = oa.x + oa.y;
            }
        }
#undef LIN_LOADOPS
        __syncthreads();
        { const int s = tid >> 5, e2 = (tid & 31) * 2; f2 acc2 = (f2){0.f, 0.f};
#pragma unroll
            for (int ww = 0; ww < 8; ++ww) acc2 = acc2 + *(const f2*)(opart + (s * 8 + ww) * 64 + e2);
            const int s2 = s + 16; f2 acc3 = (f2){0.f, 0.f};
#pragma unroll
            for (int ww = 0; ww < 8; ++ww) acc3 = acc3 + *(const f2*)(opart + (s2 * 8 + ww) * 64 + e2);
            *(unsigned*)(outp + (rb + t0 + s) * 512 + h * 128 + cgp * 64 + e2) = pg8::cvt_pk_bf16(acc2.x, acc2.y);
            *(unsigned*)(outp + (rb + t0 + s2) * 512 + h * 128 + cgp * 64 + e2) = pg8::cvt_pk_bf16(acc3.x, acc3.y); }
        if (MIX == 1 && cgp == 0) { const int sr = tid >> 4, jl = tid & 15; const f4 a0 = *(const f4*)(denp + sr * 128 + 8 * jl), a1 = *(const f4*)(denp + sr * 128 + 8 * jl + 4);
            const float d = grp_sum16((a0.x + a0.y) + (a0.z + a0.w) + (a1.x + a1.y) + (a1.z + a1.w));
            if (jl == 0) ((float*)(PWS + W_DEN))[(rb + t0 + sr) * 4 + h] = d; }
        if (blk + 1 < NBLK) LIN_FINISH(par ^ 1);
        __syncthreads();
      }
    }
#undef LIN_ISSUE
#undef LIN_FINISH
    const size_t sidx = ((size_t)(l * NBP + b) * NH + h);
    float* So = POUT + (MIX == 1 ? O_P_MC : O_P_HS) + sidx * 16384;
#pragma unroll
    for (int i = 0; i < 8; ++i) { So[(size_t)(16 * w + 2 * i) * 128 + cgp * 64 + lane] = S2[i].x; So[(size_t)(16 * w + 2 * i + 1) * 128 + cgp * 64 + lane] = S2[i].y; }
    if (MIX == 1 && cgp == 0) {
        if (lane < 16) POUT[O_P_MN + sidx * 128 + 16 * w + lane] = nn;
        if (tid == 64) POUT[O_P_MM + sidx] = mfinal;
    }
    __syncthreads();
}

__device__ __forceinline__ void scan_sample_item(const Params& p, int l, int mix, int b, int h, float* sm) {
    int tid_ = threadIdx.x; asm volatile("" : "+v"(tid_)); const int tid = tid_, lane = tid & 63, w = tid >> 6, e = tid & 127, dg = tid >> 7;
    float* qk = sm; float* vv = sm + 1024; float* gs = sm + 1536; float* red = sm + 1600; float* dpart = sm + 1600 + 4096;
    const bf16_t* proj = (const bf16_t*)(PWS + W_PROJ);
    const float* gates = (const float*)(PWS + W_GATES);
    bf16_t* outp = (bf16_t*)(PWS + W_OUTS) + (size_t)mix * MT * 512;
    const size_t rs = (size_t)MP + (size_t)b * SSEQ;
    const size_t sidx = ((size_t)(l * NBS + b) * NH + h);
    const float* Sin = (mix == 0 ? PIN(I_SGS) : (mix == 1 ? PIN(I_SMC) : PIN(I_SHS))) + sidx * 16384;
    float S[32];
#pragma unroll
    for (int i = 0; i < 32; ++i) S[i] = Sin[(size_t)(32 * dg + i) * 128 + e];
    __syncthreads();
    for (int idx = tid; idx < 4 * 384; idx += 512) { const int s = idx / 384, ch = idx - s * 384; float val;
        if (mix == 0) { val = ch < 256 ? bf2f(((const bf16_t*)(PWS + W_HBF))[(rs + s) * 1024 + (ch >> 7) * 512 + h * 128 + (ch & 127)]) : bf2f(outp[(rs + s) * 512 + h * 128 + (ch - 256)]);
        } else if (mix == 1) { const int colx = 2048 + (ch >> 7) * 512 + h * 128 + (ch & 127); val = bf2f(proj[(rs + s) * N1 + colx]); }
        else { const int colx = 4096 + (ch >> 7) * 512 + h * 128 + (ch & 127); val = bf2f(proj[(rs + s) * N1 + colx]);
            if (ch >= 128 && ch < 256) { float lbv = 0.f; if (l > 0) { const float* hl = PIN(I_HLB); const int cc = h * 128 + (ch & 127); lbv = sigm(hl[512 + cc] - hl[cc]); } val = lbv + (1.f - lbv) * sigm(val); } }
        if (ch < 256) qk[s * 256 + ch] = val; else vv[s * 128 + ch - 256] = val; }
    if (tid < 4) { const size_t r = rs + tid;
        if (mix == 0) { gs[tid * 4] = gates[r * 16 + h]; gs[tid * 4 + 1] = gates[r * 16 + 4 + h]; }
        else if (mix == 1) { gs[tid * 4] = gates[r * 16 + 8 + h]; gs[tid * 4 + 1] = gates[r * 16 + 12 + h]; } }
    __syncthreads();
    float m = 0.f, nn = 0.f, mts[4] = {0.f, 0.f, 0.f, 0.f};
    if (mix == 1) { m = PIN(I_SMM)[sidx]; if (dg == 0) nn = PIN(I_SMN)[sidx * 128 + e]; }
#pragma unroll
    for (int s = 0; s < 4; ++s) {
        const float* qs = qk + s * 256 + 32 * dg; const float* ksp = qs + 128;
        const float v = vv[s * 128 + e];
        float po = 0.f;
        if (mix == 0) {
            const float beta = gs[s * 4], a = gs[s * 4 + 1];
            float pk = 0.f;
#pragma unroll
            for (int i = 0; i < 32; ++i) pk += ksp[i] * S[i];
            red[((s * 2) * 4 + dg) * 128 + e] = pk;
            __syncthreads();
            const float ks = red[((s * 2) * 4 + 0) * 128 + e] + red[((s * 2) * 4 + 1) * 128 + e] + red[((s * 2) * 4 + 2) * 128 + e] + red[((s * 2) * 4 + 3) * 128 + e];
            const float u = beta * (v - a * ks);
#pragma unroll
            for (int i = 0; i < 32; ++i) { S[i] = a * S[i] + ksp[i] * u; po += qs[i] * S[i]; }
        } else if (mix == 1) {
            const float ig = gs[s * 4], lf = gs[s * 4 + 1]; const float mn = fmaxf(lf + m, ig); const float fp = __expf(lf + m - mn), ip = __expf(ig - mn) * QSCALE; m = mn; mts[s] = mn;
            const float iv = ip * v;
#pragma unroll
            for (int i = 0; i < 32; ++i) { S[i] = fp * S[i] + ksp[i] * iv; po += qs[i] * S[i]; }
            if (dg == 0) { nn = fp * nn + ip * qk[s * 256 + 128 + e]; const float dp = wave_sum(qk[s * 256 + e] * nn); if (lane == 0) dpart[s * 2 + w] = dp; }
        } else {
#pragma unroll
            for (int i = 0; i < 32; ++i) { S[i] = ksp[i] * (S[i] - v) + v; po += qs[i] * S[i]; }
        }
        red[((s * 2 + 1) * 4 + dg) * 128 + e] = po;
    }
    __syncthreads();
    if (tid < 128) {
#pragma unroll
        for (int s = 0; s < 4; ++s) { const float o = red[((s * 2 + 1) * 4 + 0) * 128 + e] + red[((s * 2 + 1) * 4 + 1) * 128 + e] + red[((s * 2 + 1) * 4 + 2) * 128 + e] + red[((s * 2 + 1) * 4 + 3) * 128 + e];
            outp[(rs + s) * 512 + h * 128 + e] = f2bf(o); } }
    if (mix == 1 && tid == 0) {
#pragma unroll
        for (int s = 0; s < 4; ++s) { ((float*)(PWS + W_DEN))[(rs + s) * 4 + h] = dpart[s * 2] + dpart[s * 2 + 1]; ((float*)(PWS + W_MT))[(rs + s) * 4 + h] = mts[s]; }
        POUT[O_S_MM + sidx] = m; }
    float* So = POUT + (mix == 0 ? O_S_GS : (mix == 1 ? O_S_MC : O_S_HS)) + sidx * 16384;
#pragma unroll
    for (int i = 0; i < 32; ++i) So[(size_t)(32 * dg + i) * 128 + e] = S[i];
    if (mix == 1 && dg == 0) POUT[O_S_MN + sidx * 128 + e] = nn;
}

__device__ __forceinline__ void scan_sample_all(const Params& p, int l, float* sm) {
    int tid_ = threadIdx.x; asm volatile("" : "+v"(tid_)); const int tid = tid_, lane = tid & 63, w = tid >> 6, e = tid & 127, dg = tid >> 7;
    float* qk = sm; float* vv = sm + 1024; float* gs = sm + 1536; float* red = sm + 1600; float* dpart = sm + 1600 + 4096; volatile int* qslot = (volatile int*)(sm + 5760);
    float* simg = sm + 6144;
    PG8_LAS unsigned char* simg_l = (PG8_LAS unsigned char*)simg;
    const bf16_t* proj = (const bf16_t*)(PWS + W_PROJ); const bf16_t* hbf = (const bf16_t*)(PWS + W_HBF);
    const float* gates = (const float*)(PWS + W_GATES);
    bf16_t* outs = (bf16_t*)(PWS + W_OUTS);
    unsigned* qctr = (unsigned*)(PWS + W_BAR) + 64 * l;
    constexpr int NIT = 3 * NBS * NH;
    const float* hl = PIN(I_HLB);
    __syncthreads();
    if (tid == 0) { qslot[0] = (int)__hip_atomic_fetch_add(qctr, 1u, __ATOMIC_RELAXED, __HIP_MEMORY_SCOPE_AGENT); qslot[1] = (int)__hip_atomic_fetch_add(qctr, 1u, __ATOMIC_RELAXED, __HIP_MEMORY_SCOPE_AGENT); }
    __syncthreads();
    int it0 = qslot[0], it1 = qslot[1];
    float stg[3], gn0 = 0.f, gn1 = 0.f, mn_in = 0.f, nn_in = 0.f;
    stg[0] = stg[1] = stg[2] = 0.f;
#define SMP_ISSUE(it_) do { const int mix_ = (it_) / (NBS * NH), r_ = (it_) - mix_ * (NBS * NH), b_ = r_ >> 2, h_ = r_ & 3; \
        const size_t sidx_ = ((size_t)(l * NBS + b_) * NH + h_), rs_ = (size_t)MP + (size_t)b_ * SSEQ; \
        const float* Sin_ = (mix_ == 0 ? PIN(I_SGS) : (mix_ == 1 ? PIN(I_SMC) : PIN(I_SHS))) + sidx_ * 16384; \
        _Pragma("unroll") for (int k_ = 0; k_ < 8; ++k_) __builtin_amdgcn_global_load_lds((const unsigned*)((const char*)Sin_ + (size_t)((w * 8 + k_) * 1024 + lane * 16)), (PG8_LAS unsigned*)(simg_l + (w * 8 + k_) * 1024), 16, 0, 0); \
        int tq_ = tid; asm volatile("" : "+v"(tq_)); \
        _Pragma("unroll") for (int k_ = 0; k_ < 3; ++k_) { const int idx_ = tq_ + 512 * k_, s_ = idx_ / 384, ch_ = idx_ - s_ * 384; unsigned short raw_; \
            if (mix_ == 0) raw_ = ch_ < 256 ? hbf[(rs_ + s_) * 1024 + (ch_ >> 7) * 512 + h_ * 128 + (ch_ & 127)] : outs[(rs_ + s_) * 512 + h_ * 128 + (ch_ - 256)]; \
            else raw_ = proj[(rs_ + s_) * N1 + (mix_ == 1 ? 2048 : 4096) + (ch_ >> 7) * 512 + h_ * 128 + (ch_ & 127)]; \
            stg[k_] = bf2f(raw_); } \
        if (tid < 4 && mix_ != 2) { const size_t rr_ = rs_ + tid; gn0 = gates[rr_ * 16 + (mix_ == 0 ? 0 : 8) + h_]; gn1 = gates[rr_ * 16 + (mix_ == 0 ? 4 : 12) + h_]; } \
        if (mix_ == 1) { mn_in = PIN(I_SMM)[sidx_]; if (dg == 0) nn_in = PIN(I_SMN)[sidx_ * 128 + e]; } } while (0)
    if (it0 < NIT) SMP_ISSUE(it0);
    while (it0 < NIT) {
#ifdef TPROBE_ITEM
        const unsigned long long tst_ = __builtin_amdgcn_s_memrealtime();
#endif
        const int mix = it0 / (NBS * NH), r = it0 - mix * (NBS * NH), b = r >> 2, h = r & 3;
        const size_t sidx = ((size_t)(l * NBS + b) * NH + h), rs = (size_t)MP + (size_t)b * SSEQ;
        bf16_t* outp = outs + (size_t)mix * MT * 512;
        asm volatile("s_waitcnt vmcnt(0)" ::: "memory");
        lds_barrier();
        float S[32];
#pragma unroll
        for (int i = 0; i < 32; ++i) S[i] = simg[(32 * dg + i) * 128 + e];
        float m = mn_in, nn = nn_in;
#pragma unroll
        for (int k = 0; k < 3; ++k) { const int idx = tid + 512 * k, s = idx / 384, ch = idx - s * 384; float val = stg[k];
            if (mix == 2 && ch >= 128 && ch < 256) { float lbv = 0.f; if (l > 0) { const int cc = h * 128 + (ch & 127); lbv = sigm(hl[512 + cc] - hl[cc]); } val = lbv + (1.f - lbv) * sigm(val); }
            if (ch < 256) qk[s * 256 + ch] = val; else vv[s * 128 + ch - 256] = val; }
        if (tid < 4 && mix != 2) { gs[tid * 4] = gn0; gs[tid * 4 + 1] = gn1; }
        int it2 = NIT;
        if (tid == 0) it2 = (int)__hip_atomic_fetch_add(qctr, 1u, __ATOMIC_RELAXED, __HIP_MEMORY_SCOPE_AGENT);
        lds_barrier();
        if (it1 < NIT) SMP_ISSUE(it1);
#pragma unroll 1
        for (int s = 0; s < 4; ++s) {
            const float* qs = qk + s * 256 + 32 * dg; const float* ksp = qs + 128;
            const float v = vv[s * 128 + e];
            float po = 0.f;
            if (mix == 0) {
                const float beta = gs[s * 4], a = gs[s * 4 + 1];
                float pk = 0.f;
#pragma unroll
                for (int c4 = 0; c4 < 4; ++c4) {
#pragma unroll
                    for (int i = 8 * c4; i < 8 * c4 + 8; ++i) pk += ksp[i] * S[i];
                    __builtin_amdgcn_sched_barrier(0); }
                red[((s * 2) * 4 + dg) * 128 + e] = pk;
                lds_barrier();
                const float ks = red[((s * 2) * 4 + 0) * 128 + e] + red[((s * 2) * 4 + 1) * 128 + e] + red[((s * 2) * 4 + 2) * 128 + e] + red[((s * 2) * 4 + 3) * 128 + e];
                const float u = beta * (v - a * ks);
#pragma unroll
                for (int c4 = 0; c4 < 4; ++c4) {
#pragma unroll
                    for (int i = 8 * c4; i < 8 * c4 + 8; ++i) { S[i] = a * S[i] + ksp[i] * u; po += qs[i] * S[i]; }
                    __builtin_amdgcn_sched_barrier(0); }
            } else if (mix == 1) {
                const float ig = gs[s * 4], lf = gs[s * 4 + 1]; const float mn = fmaxf(lf + m, ig); const float fp = __expf(lf + m - mn), ip = __expf(ig - mn) * QSCALE; m = mn; if (tid == 0) ((float*)(PWS + W_MT))[(rs + s) * 4 + h] = mn;
                const float iv = ip * v;
#pragma unroll
                for (int c4 = 0; c4 < 4; ++c4) {
#pragma unroll
                    for (int i = 8 * c4; i < 8 * c4 + 8; ++i) { S[i] = fp * S[i] + ksp[i] * iv; po += qs[i] * S[i]; }
                    __builtin_amdgcn_sched_barrier(0); }
                if (dg == 0) { nn = fp * nn + ip * qk[s * 256 + 128 + e]; const float dp = wave_sum(qk[s * 256 + e] * nn); if (lane == 0) dpart[s * 2 + w] = dp; }
            } else {
#pragma unroll
                for (int c4 = 0; c4 < 4; ++c4) {
#pragma unroll
                    for (int i = 8 * c4; i < 8 * c4 + 8; ++i) { S[i] = ksp[i] * (S[i] - v) + v; po += qs[i] * S[i]; }
                    __builtin_amdgcn_sched_barrier(0); }
            }
            red[((s * 2 + 1) * 4 + dg) * 128 + e] = po;
        }
        if (tid == 0) qslot[0] = it2;
        lds_barrier();
        if (tid < 128) {
#pragma unroll
            for (int s = 0; s < 4; ++s) { const float o = red[((s * 2 + 1) * 4 + 0) * 128 + e] + red[((s * 2 + 1) * 4 + 1) * 128 + e] + red[((s * 2 + 1) * 4 + 2) * 128 + e] + red[((s * 2 + 1) * 4 + 3) * 128 + e];
                outp[(rs + s) * 512 + h * 128 + e] = f2bf(o); } }
        if (mix == 1 && tid == 0) {
#pragma unroll
            for (int s = 0; s < 4; ++s) { ((float*)(PWS + W_DEN))[(rs + s) * 4 + h] = dpart[s * 2] + dpart[s * 2 + 1]; }
            POUT[O_S_MM + sidx] = m; }
        float* So = POUT + (mix == 0 ? O_S_GS : (mix == 1 ? O_S_MC : O_S_HS)) + sidx * 16384;
#ifndef DUPST
#define DUPST 1
#endif
        for (int rst = 0; rst < DUPST; ++rst) {
#pragma unroll
        for (int i = 0; i < 32; ++i) So[(size_t)(32 * dg + i) * 128 + e] = S[i];
        if (DUPST > 1) { asm volatile("s_waitcnt vmcnt(0)" ::: "memory"); } }
        if (mix == 1 && dg == 0) POUT[O_S_MN + sidx * 128 + e] = nn;
        it0 = it1; it1 = qslot[0];
        lds_barrier();
#ifdef TPROBE_ITEM
        if (blockIdx.x == TPROBE_WG && threadIdx.x == 0) { volatile unsigned long long* sp_ = (volatile unsigned long long*)((unsigned char*)sm + LDS_MAIN + 64); sp_[40] += __builtin_amdgcn_s_memrealtime() - tst_; sp_[41] += 1; }
#endif
    }
#undef SMP_ISSUE
}
__device__ __forceinline__ void phase_postnorm(const Params& p, int l) {
    int tid_ = threadIdx.x; asm volatile("" : "+v"(tid_)); const int tid = tid_, j = tid & 15;
    bf16_t* outs = (bf16_t*)(PWS + W_OUTS);
    const bf16_t* proj = (const bf16_t*)(PWS + W_PROJ);
    const float* den = (const float*)(PWS + W_DEN); const float* mt = (const float*)(PWS + W_MT);
    const int ngroups = MT * 12;
    for (int gid = bidx() * 32 + (tid >> 4); gid < ngroups; gid += gdim() * 32) {
        const int r = gid / 12, mh = gid - r * 12, mix = mh >> 2, h = mh & 3;
        bf16_t* op = outs + (size_t)mix * MT * 512 + (size_t)r * 512 + h * 128 + 8 * j;
        const u32x4_t raw = *(const u32x4_t*)op;
        float v[8];
#pragma unroll
        for (int i = 0; i < 4; ++i) { v[2 * i] = bflo(raw[i]); v[2 * i + 1] = bfhi(raw[i]); }
        if (mix == 1) { const float dn = fmaxf(fabsf(den[(size_t)r * 4 + h]), __expf(-mt[(size_t)r * 4 + h])); const float inv = 1.f / dn;
#pragma unroll
            for (int i = 0; i < 8; ++i) v[i] *= inv; }
        float ss = 0.f;
#pragma unroll
        for (int i = 0; i < 8; ++i) ss += v[i] * v[i];
        ss = grp_sum16(ss);
        const float rstd = rsqrtf(ss * (1.f / 128.f) + EPS);
        const int gcol = (mix == 0 ? 1536 : (mix == 1 ? 3584 : 5632)) + h * 128 + 8 * j;
        const u32x4_t gr = *(const u32x4_t*)(proj + (size_t)r * N1 + gcol);
        const float* nw = (mix == 0 ? PIN(I_GNORM) : (mix == 1 ? PIN(I_MNORM) : PIN(I_HNORM))) + l * 512 + h * 128 + 8 * j;
        const float4 n0 = *(const float4*)nw, n1 = *(const float4*)(nw + 4);
        const float nwv[8] = {n0.x, n0.y, n0.z, n0.w, n1.x, n1.y, n1.z, n1.w};
#pragma unroll
        for (int i = 0; i < 4; ++i) { v[2 * i] *= rstd * nwv[2 * i] * bflo(gr[i]); v[2 * i + 1] *= rstd * nwv[2 * i + 1] * bfhi(gr[i]); }
        u32x4_t o; o[0] = pg8::cvt_pk_bf16(v[0], v[1]); o[1] = pg8::cvt_pk_bf16(v[2], v[3]); o[2] = pg8::cvt_pk_bf16(v[4], v[5]); o[3] = pg8::cvt_pk_bf16(v[6], v[7]);
        *(u32x4_t*)op = o;
    }
    const int ncs = (NBP + NBS) * 3 * 1536;
    for (int i = bidx() * 512 + tid; i < ncs; i += gdim() * 512) {
        const int cc = i % 1536, ri = (i / 1536) % 3, bb = i / (3 * 1536);
        if (bb < NBP) POUT[O_P_GC + ((size_t)(l * NBP + bb) * 3 + ri) * 1536 + cc] = bf2f(proj[((size_t)bb * SEQ + SEQ - 3 + ri) * N1 + cc]);
        else { const int b2 = bb - NBP; POUT[O_S_GC + ((size_t)(l * NBS + b2) * 3 + ri) * 1536 + cc] = bf2f(proj[((size_t)MP + (size_t)b2 * SSEQ + 1 + ri) * N1 + cc]); }
    }
}

__device__ __forceinline__ void phase_convffn(const Params& p, int l) {
    int tid_ = threadIdx.x; asm volatile("" : "+v"(tid_)); const int tid = tid_;
    const bf16_t* u = (const bf16_t*)(PWS + W_PROJ);
    bf16_t* act = (bf16_t*)(PWS + W_ACT);
    const float* cw = PIN(I_FCW) + (size_t)l * 3 * NUP; const float* cb = PIN(I_FCB) + (size_t)l * NUP;
    const int nitems = (MT / 4) * (DFF / 8);
    for (int it = bidx() * 512 + tid; it < nitems; it += gdim() * 512) {
        const int jg = it % (DFF / 8), rbk = it / (DFF / 8), r0 = rbk * 4, jc = jg * 8;
        const bool samp = r0 >= MP; const int tf = samp ? 0 : (r0 & (SEQ - 1));
        float wa[3][8], wb[3][8], ba[8], bb[8];
#pragma unroll
        for (int i = 0; i < 3; ++i) { const float4 a0 = *(const float4*)(cw + i * NUP + jc), a1 = *(const float4*)(cw + i * NUP + jc + 4), b0 = *(const float4*)(cw + i * NUP + DFF + jc), b1 = *(const float4*)(cw + i * NUP + DFF + jc + 4);
            wa[i][0] = a0.x; wa[i][1] = a0.y; wa[i][2] = a0.z; wa[i][3] = a0.w; wa[i][4] = a1.x; wa[i][5] = a1.y; wa[i][6] = a1.z; wa[i][7] = a1.w;
            wb[i][0] = b0.x; wb[i][1] = b0.y; wb[i][2] = b0.z; wb[i][3] = b0.w; wb[i][4] = b1.x; wb[i][5] = b1.y; wb[i][6] = b1.z; wb[i][7] = b1.w; }
        { const float4 a0 = *(const float4*)(cb + jc), a1 = *(const float4*)(cb + jc + 4), b0 = *(const float4*)(cb + DFF + jc), b1 = *(const float4*)(cb + DFF + jc + 4);
            ba[0] = a0.x; ba[1] = a0.y; ba[2] = a0.z; ba[3] = a0.w; ba[4] = a1.x; ba[5] = a1.y; ba[6] = a1.z; ba[7] = a1.w;
            bb[0] = b0.x; bb[1] = b0.y; bb[2] = b0.z; bb[3] = b0.w; bb[4] = b1.x; bb[5] = b1.y; bb[6] = b1.z; bb[7] = b1.w; }
        float xa[6][8], xb[6][8];
#pragma unroll
        for (int rr = 0; rr < 6; ++rr) {
            if (rr < 2 && tf == 0) {
                if (samp) { const float* st = PIN(I_SFC) + ((size_t)(l * NBS + (r0 - MP) / 4) * 2 + rr) * NUP;
#pragma unroll
                    for (int i = 0; i < 8; ++i) { xa[rr][i] = st[jc + i]; xb[rr][i] = st[DFF + jc + i]; } }
                else {
#pragma unroll
                    for (int i = 0; i < 8; ++i) { xa[rr][i] = 0.f; xb[rr][i] = 0.f; } }
            } else { const bf16_t* ur = u + (size_t)(r0 - 2 + rr) * NUP; const u32x4_t ra = *(const u32x4_t*)(ur + jc), rbv = *(const u32x4_t*)(ur + DFF + jc);
#pragma unroll
                for (int i = 0; i < 4; ++i) { xa[rr][2 * i] = bflo(ra[i]); xa[rr][2 * i + 1] = bfhi(ra[i]); xb[rr][2 * i] = bflo(rbv[i]); xb[rr][2 * i + 1] = bfhi(rbv[i]); } }
        }
#pragma unroll
        for (int t = 0; t < 4; ++t) { float o[8];
#pragma unroll
            for (int i = 0; i < 8; ++i) { const float ya = wa[0][i] * xa[t][i] + wa[1][i] * xa[t + 1][i] + wa[2][i] * xa[t + 2][i] + ba[i]; const float yb = wb[0][i] * xb[t][i] + wb[1][i] * xb[t + 1][i] + wb[2][i] * xb[t + 2][i] + bb[i]; o[i] = silu(ya) * yb; }
            u32x4_t ov; ov[0] = pg8::cvt_pk_bf16(o[0], o[1]); ov[1] = pg8::cvt_pk_bf16(o[2], o[3]); ov[2] = pg8::cvt_pk_bf16(o[4], o[5]); ov[3] = pg8::cvt_pk_bf16(o[6], o[7]);
            *(u32x4_t*)(act + (size_t)(r0 + t) * DFF + jc) = ov; }
        if (samp || tf == SEQ - 4) {
            float* dst = samp ? POUT + O_S_FC + (size_t)(l * NBS + (r0 - MP) / 4) * 2 * NUP : POUT + O_P_FC + (size_t)(l * NBP + r0 / SEQ) * 2 * NUP;
#pragma unroll
            for (int rr = 0; rr < 2; ++rr)
#pragma unroll
                for (int i = 0; i < 8; ++i) { dst[(size_t)rr * NUP + jc + i] = xa[4 + rr][i]; dst[(size_t)rr * NUP + DFF + jc + i] = xb[4 + rr][i]; }
        }
    }
}

__device__ __forceinline__ void phase_final_norm(const Params& p) {
    int tid_ = threadIdx.x; asm volatile("" : "+v"(tid_)); const int tid = tid_, lane = tid & 63, w = tid >> 6;
    const float* gw = PIN(I_LNF);
    float4 g4[4];
#pragma unroll
    for (int i = 0; i < 4; ++i) g4[i] = *(const float4*)(gw + lane * 4 + 256 * i);
    for (int row = bidx() * 8 + w; row < MT; row += gdim() * 8) {
        float* xr = POUT + (size_t)row * DM; float4 v[4]; float ss = 0.f;
#pragma unroll
        for (int i = 0; i < 4; ++i) { v[i] = *(const float4*)(xr + lane * 4 + 256 * i); ss += v[i].x * v[i].x + v[i].y * v[i].y + v[i].z * v[i].z + v[i].w * v[i].w; }
        ss = wave_sum(ss); const float rstd = rsqrtf(ss * (1.f / 1024.f) + EPS);
#pragma unroll
        for (int i = 0; i < 4; ++i) { v[i].x *= rstd * g4[i].x; v[i].y *= rstd * g4[i].y; v[i].z *= rstd * g4[i].z; v[i].w *= rstd * g4[i].w; *(float4*)(xr + lane * 4 + 256 * i) = v[i]; }
    }
}

#ifndef PHM
#define PHM 0xFFFF
#endif
#ifndef DUPB
#define DUPB 1
#endif
#ifndef DUPC
#define DUPC 1
#endif
#ifndef DUPS
#define DUPS 1
#endif
#ifndef DUPH
#define DUPH 1
#endif
#ifndef DUPY
#define DUPY 1
#endif
#ifndef DUPA
#define DUPA 1
#endif
#ifndef DUPI
#define DUPI 1
#endif
#define GSYNC() do { for (int y_ = 0; y_ < DUPY; ++y_) xcd_barrier(xb); } while (0)
__global__ void __launch_bounds__(512, 2) fwd_megakernel(Params p) {
    extern __shared__ __attribute__((aligned(16))) unsigned char shm[];
    cg::grid_group grid = cg::this_grid();
    float* smf = (float*)shm;
    PG8_LAS unsigned char* lds = (PG8_LAS unsigned char*)shm;
    int tid_ = threadIdx.x; asm volatile("" : "+v"(tid_)); const int tid = tid_;
    float* X = POUT;
    volatile XLAS unsigned* xst = (volatile XLAS unsigned*)(lds + LDS_MAIN);
    if (tid == 0) { xst[0] = 0u; xst[1] = 0u; xst[2] = 0u; xst[3] = 0u; }
    __syncthreads();
    XcdBarrier xb = xcd_barrier_post((unsigned*)(PWS + W_BAR), xst);
#ifdef TPROBE1
    volatile XLAS unsigned long long* stp = (volatile XLAS unsigned long long*)(lds + LDS_MAIN + 64);
    int nst = 0;
#define STAMP() do { if (blockIdx.x == TPROBE_WG && threadIdx.x == 0) stp[nst] = __builtin_amdgcn_s_memrealtime(); ++nst; } while (0)
#else
#define STAMP() do {} while (0)
#endif
    STAMP();
#ifdef TPROBE_ITEM
    if (blockIdx.x == TPROBE_WG && threadIdx.x == 0) { stp[40] = 0; stp[41] = 0; }
#endif
    bf16_t* hbf = (bf16_t*)(PWS + W_HBF);
    bf16_t* proj = (bf16_t*)(PWS + W_PROJ);

    for (int l = 0; l < 2; ++l) {
        const int G = gdim(), bid = bidx();
        for (int repa = 0; repa < DUPA; ++repa) { if (PHM & 1) { int tc = 0;
          conv_T(PIN(I_WIN) + (size_t)l * 1024 * NIN, NIN, (bf16_t*)(PWS + W_WIN), 1024, N1, true, smf, tc);
          for (int n = 0; n < 3; ++n) conv_T(PIN(I_WBR) + ((size_t)l * 3 + n) * 512 * 1024, 1024, (bf16_t*)(PWS + W_WBR) + (size_t)n * 1024 * 512, 512, 1024, false, smf, tc);
          conv_T(PIN(I_WOUT) + (size_t)l * 1024 * 1024, 1024, (bf16_t*)(PWS + W_WOUT), 1024, 1024, false, smf, tc);
          conv_T(PIN(I_WUP) + (size_t)l * 1024 * NUP, NUP, (bf16_t*)(PWS + W_WUP), 1024, NUP, false, smf, tc);
          conv_T(PIN(I_WDN) + (size_t)l * DFF * 1024, 1024, (bf16_t*)(PWS + W_WDN), DFF, 1024, false, smf, tc);
          __syncthreads(); }
        if (PHM & 2) {
        if (l == 0) { int tq_ = threadIdx.x; asm volatile("" : "+v"(tq_)); const float4* s1 = (const float4*)PIN(I_XS); float4* d1 = (float4*)(X + (size_t)MP * DM);
            for (int i = bid * 512 + tq_; i < MS * DM / 4; i += G * 512) d1[i] = s1[i]; }
        phase_rmsnorm(p, l, l == 0 ? PIN(I_XP) : X, l == 0 ? PIN(I_XS) : X + (size_t)MP * DM, PIN(I_LNMIX) + l * DM, hbf, true, smf); } }
        if (PWS == nullptr) grid.sync();
        GSYNC();
        STAMP();
        for (int rep = 0; rep < DUPB; ++rep) { pg8::Gemm g{hbf, (const bf16_t*)(PWS + W_WIN), MT, N1, 1024, 1024}; pg8::StaticOrder S; S.init(MT, N1, G, bid); EpiProj E{proj, N1, 1}; pg8::gemm_phase(lds, g, S, E); }
        GSYNC(); STAMP();
        phase_gdnprep(p, l);
        GSYNC(); STAMP();
#ifdef TPROBE_MAX
        const unsigned long long tb_ = __builtin_amdgcn_s_memrealtime();
#endif
        for (int rep = 0; rep < DUPC; ++rep) for (int it = bid; it < 256; it += G) {
            if (it < 128) scan_prompt_item<0>(p, l, (it >> 2) >> 2, (it >> 2) & 3, it & 3, smf);
            else if (it < 192) { const int q = it - 128; scan_prompt_lin<1>(p, l, (q >> 1) >> 2, (q >> 1) & 3, q & 1, smf); }
            else { const int q = it - 192; scan_prompt_lin<2>(p, l, (q >> 1) >> 2, (q >> 1) & 3, q & 1, smf); }
        }
#ifdef TPROBE_MAX
        if (l == TPROBE_MAX - 1 && threadIdx.x == 0) { const unsigned dt_ = (unsigned)(__builtin_amdgcn_s_memrealtime() - tb_); atomicMax((unsigned*)(PWS + W_BAR) + 32, (dt_ << 8) | (unsigned)blockIdx.x); if (dt_ > 40000u) atomicAdd((unsigned*)(PWS + W_BAR) + 33, 1u); if (dt_ > 30000u) atomicAdd((unsigned*)(PWS + W_BAR) + 34, 1u); if (dt_ > 20000u) atomicAdd((unsigned*)(PWS + W_BAR) + 35, 1u); }
#endif
        STAMP();
#ifdef SEQ_SAMPLE
        GSYNC();
#endif
        scan_sample_all(p, l, smf);
        GSYNC(); STAMP();
        if (PHM & 32) phase_postnorm(p, l);
        GSYNC(); STAMP();
        if (PHM & 64) { pg8::Gemm g{(const bf16_t*)(PWS + W_OUTS), (const bf16_t*)(PWS + W_WBR), 3 * MT, 3 * 1024, 512, 512};
            MergeOrder S; S.init(G, bid); EpiMerge E{proj + 6144, hbf}; pg8::gemm_phase(lds, g, S, E); }
        GSYNC(); STAMP();
        if (PHM & 128) { pg8::Gemm g{hbf, (const bf16_t*)(PWS + W_WOUT), MT, 1024, 1024, 1024}; pg8::StaticOrder S; S.init(MT, 1024, G, bid); EpiResid E{X, l == 0 ? PIN(I_XP) : X, l == 0 ? PIN(I_XS) : X + (size_t)MP * DM}; pg8::gemm_phase(lds, g, S, E); }
        GSYNC(); STAMP();
        if (PHM & 256) phase_rmsnorm(p, l, X, X + (size_t)MP * DM, PIN(I_LNFFN) + l * DM, hbf, false, smf);
        GSYNC(); STAMP();
        for (int rep = 0; rep < DUPH; ++rep) { pg8::Gemm g{hbf, (const bf16_t*)(PWS + W_WUP), MT, NUP, 1024, 1024}; pg8::StaticOrder S; S.init(MT, NUP, G, bid); EpiProj E{proj, NUP, 0}; pg8::gemm_phase(lds, g, S, E); }
        GSYNC(); STAMP();
        for (int repi = 0; repi < DUPI; ++repi) phase_convffn(p, l);
        GSYNC(); STAMP();
        if (PHM & 2048) { { pg8::Gemm g{(const bf16_t*)(PWS + W_ACT), (const bf16_t*)(PWS + W_WDN), MP, 1024, DFF, DFF}; pg8::StaticOrder S; S.init(MP, 1024, G, bid); EpiResid E{X, X, X + (size_t)MP * DM}; pg8::gemm_phase(lds, g, S, E); }
            { pg8::Gemm g{(const bf16_t*)(PWS + W_ACT), (const bf16_t*)(PWS + W_WDN), MT, 1024, DFF / 2, DFF}; PieceOrder S{G, (bid + G / 2) % G, 2}; EpiAtomic E{X}; pg8::gemm_phase(lds, g, S, E); } }
        GSYNC(); STAMP();
    }
    if (PHM & 4096) phase_final_norm(p);
#ifdef TPROBE1
    if (blockIdx.x == TPROBE_WG && threadIdx.x == 0) {
        const int per = (nst - 1) / 2;
        unsigned long long d1 = 0, d2 = 0;
        for (int l2 = 0; l2 < 2; ++l2) { d1 += stp[l2 * per + TPROBE1E] - stp[l2 * per + TPROBE1]; d2 += stp[l2 * per + TPROBE2E] - stp[l2 * per + TPROBE2]; }
        unsigned long long cntcode_ = 0;
        unsigned long long q1 = (d1 + 1000) / 2000, q2 = (d2 + 500) / 1000;
#ifdef TPROBE_MAX
        { const unsigned mx_ = __hip_atomic_load((unsigned*)(PWS + W_BAR) + 32, __ATOMIC_RELAXED, __HIP_MEMORY_SCOPE_AGENT); q1 = ((mx_ >> 8) + 1000) / 2000 * 10 + (mx_ & 255) / 100; q2 = (mx_ & 255) % 100;
#ifdef TPROBE_CNT
          const unsigned c4_ = __hip_atomic_load((unsigned*)(PWS + W_BAR) + 33, __ATOMIC_RELAXED, __HIP_MEMORY_SCOPE_AGENT), c3_ = __hip_atomic_load((unsigned*)(PWS + W_BAR) + 34, __ATOMIC_RELAXED, __HIP_MEMORY_SCOPE_AGENT), c2_ = __hip_atomic_load((unsigned*)(PWS + W_BAR) + 35, __ATOMIC_RELAXED, __HIP_MEMORY_SCOPE_AGENT);
          q1 = 0; q2 = 0; cntcode_ = c4_ * 300 + c3_; (void)c2_;
#endif
 }
#endif
#ifdef TPROBE_ITEM
        q1 = stp[41] ? (stp[40] / stp[41] + 50) / 100 : 0; q2 = stp[41];
#endif if (q2 > 99) q2 = 99;
#ifndef TPROBE_MAX
        if (q1 > 99) q1 = 99;
#endif
        const unsigned long long wait = (q1 * 100 + q2) * 2000ull + cntcode_ * 200ull, t0 = __builtin_amdgcn_s_memrealtime();
        while (__builtin_amdgcn_s_memrealtime() - t0 < wait) __builtin_amdgcn_s_sleep(32);
    }
#endif
}

extern "C" void kernel_launch(void* const* d_in, const int* in_sizes, int n_in, void* d_out, int out_size, void* d_ws, size_t ws_size, hipStream_t stream) {
    static int grid_blocks = 0;
    if (grid_blocks == 0) {
        if (n_in != 28 || (size_t)out_size != O_END || ws_size < W_END) { fprintf(stderr, "kernel_launch: unexpected shapes: n_in %d out %d (want %zu) ws %zu (need %zu)\n", n_in, out_size, (size_t)O_END, ws_size, (size_t)W_END); grid_blocks = -1; return; }
        int dev = 0, cus = 0, per_cu = 0;
        hipGetDevice(&dev); hipDeviceGetAttribute(&cus, hipDeviceAttributeMultiprocessorCount, dev);
        if (hipFuncSetAttribute((const void*)fwd_megakernel, hipFuncAttributeMaxDynamicSharedMemorySize, LDS_BYTES) != hipSuccess) { fprintf(stderr, "kernel_launch: hipFuncSetAttribute failed\n"); grid_blocks = -1; return; }
        if (hipOccupancyMaxActiveBlocksPerMultiprocessor(&per_cu, (const void*)fwd_megakernel, 512, LDS_BYTES) != hipSuccess || per_cu < 1) { fprintf(stderr, "kernel_launch: occupancy query gave %d\n", per_cu); per_cu = 1; (void)hipGetLastError(); }
        grid_blocks = cus * per_cu;
    }
    if (grid_blocks < 0) return;
    if (hipMemsetAsync((unsigned char*)d_ws + W_BAR, 0, XCD_BAR_WORDS * 4, stream) != hipSuccess) { fprintf(stderr, "kernel_launch: memset of barrier words failed\n"); return; }
    Params p{};
    for (int i = 0; i < 28; ++i) p.in[i] = (const float*)d_in[i];
    p.out = (float*)d_out; p.ws = (unsigned char*)d_ws;
    void* args[] = {&p};
    hipError_t e = hipLaunchCooperativeKernel((const void*)fwd_megakernel, dim3(grid_blocks), dim3(512), args, LDS_BYTES, stream);
    if (e != hipSuccess) fprintf(stderr, "kernel_launch: cooperative launch failed: %s (grid %d)\n", hipGetErrorString(e), grid_blocks);
}
```

```cpp
#include <hip/hip_runtime.h>
#include <hip/hip_cooperative_groups.h>
#include <cstdio>
namespace cg = cooperative_groups;
namespace pg8 {
#define PG8_LAS __attribute__((address_space(3)))
typedef unsigned short bf16_t;
typedef short bf16x8 __attribute__((ext_vector_type(8)));
typedef float f32x4 __attribute__((ext_vector_type(4)));
typedef unsigned u32x4 __attribute__((ext_vector_type(4)));
constexpr int BM = 256, BK = 64, HALF = 128, HTB = HALF * BK * 2  , STAGE_BYTES = 8 * HTB, NXCD = 8, WGM = 8;

__host__ __device__ __forceinline__ int lds_byte(int r, int c) { const int st = (r >> 4) * 2 + (c >> 5), rr = r & 15, cc = c & 31, ob = rr * 64 + cc * 2; return st * 1024 + (ob ^ (((ob >> 9) & 1) << 5)); }
__host__ __device__ __forceinline__ void stage_rc(int b, int& R, int& C) { const int st = b / 1024, sb = b % 1024, swz = sb ^ (((sb >> 9) & 1) << 5); R = (st >> 1) * 16 + swz / 64; C = (st & 1) * 32 + (swz % 64) / 2; }
__host__ __device__ __forceinline__ int perm32(int rho) { const int n = rho >> 4, i = rho & 15; return 8 * (i >> 2) + 4 * n + (i & 3); }

struct Unit { int pm, pn, pk; };
struct Gemm { const bf16_t* A; const bf16_t* Bt; int M, N, K, ld; };

struct StaticOrder {
    int nM, nN, nwg, G, c;
    __host__ __device__ void init(int M, int N, int G_, int c_) { nM = M / BM; nN = N / BM; nwg = nM * nN; G = G_; c = c_; }
    __host__ __device__ bool next(int i, Unit& u) const {
        const long L = (long)i * G + c; if (L >= nwg) return false;
        int wgid = (int)L; { const int q = nwg / NXCD, r = nwg % NXCD, xcd = wgid % NXCD, off = wgid / NXCD; wgid = (xcd < r ? xcd * (q + 1) : r * (q + 1) + (xcd - r) * q) + off; }
        const int nig = WGM * nN, gid = wgid / nig, fm = gid * WGM, gsz = (nM - fm) < WGM ? (nM - fm) : WGM;
        u.pm = fm + ((wgid % nig) % gsz); u.pn = (wgid % nig) / gsz; u.pk = 0; return true;
    }
    __device__ __forceinline__ void a_ready(const Unit&) const {}
    __device__ __forceinline__ void done(const Unit&) const {}
};
__device__ __forceinline__ unsigned cvt_pk_bf16(float lo, float hi) { unsigned r; asm volatile("v_cvt_pk_bf16_f32 %0, %1, %2" : "=v"(r) : "v"(lo), "v"(hi)); return r; }
template <class Epi, class Sched>
__device__ __forceinline__ void gemm_phase(PG8_LAS unsigned char* lds, const Gemm g, const Sched& S, const Epi& E) {
    int tid_ = threadIdx.x; asm volatile("" : "+v"(tid_));
    const int tid = tid_, wid = __builtin_amdgcn_readfirstlane(tid >> 6), lane = tid & 63, wr = wid >> 2, wc = wid & 3, fr = lane & 15, fq = lane >> 4;
    const int K = g.K, nt = K / BK, ld = g.ld;
    unsigned voffA[2], voffB[2];
#pragma unroll
    for (int i = 0; i < 2; ++i) { int R, C; stage_rc(tid * 16 + i * 8192, R, C); const int Rb = Epi::PERM ? ((R & ~31) + perm32(R & 31)) : R;
        voffA[i] = (unsigned)(R * ld + C) * 2u; voffB[i] = (unsigned)(Rb * ld + C) * 2u; }
    const size_t kstep = (size_t)(BK * 2);
    const size_t hstep = (size_t)HALF * ld * 2;
    const size_t tstep = 2 * hstep;
    const unsigned ldsw = (unsigned)wid * 1024u;
    const int aoff = lds_byte(wr * 64 + fr, fq * 8), boff = lds_byte(wc * 32 + fr, fq * 8);
#define PG8_SA(b, h) (((b) * 2 + (h)) * HTB)
#define PG8_SB(b, h) ((4 + (b) * 2 + (h)) * HTB)
#define PG8_STAGE(bufoff, gbase, voff) do { _Pragma("unroll") for (int _i = 0; _i < 2; ++_i) \
        __builtin_amdgcn_global_load_lds((const unsigned*)((const char*)(gbase) + (voff)[_i]), (PG8_LAS unsigned*)(lds + (bufoff) + ldsw + _i * 8192), 16, 0, 0); } while (0)
#define PG8_LDA(dst, b, h) do { _Pragma("unroll") for (int m = 0; m < 4; ++m) _Pragma("unroll") for (int k = 0; k < 2; ++k) dst[m][k] = *(const PG8_LAS bf16x8*)(lds + PG8_SA(b, h) + aoff + m * 2048 + k * 1024); } while (0)
#define PG8_LDB(dst, b, h) do { _Pragma("unroll") for (int n = 0; n < 2; ++n) _Pragma("unroll") for (int k = 0; k < 2; ++k) dst[n][k] = *(const PG8_LAS bf16x8*)(lds + PG8_SB(b, h) + boff + n * 2048 + k * 1024); } while (0)
#define PG8_MMA(ai, bj, At, Bt) do { __builtin_amdgcn_s_setprio(1); _Pragma("unroll") for (int m = 0; m < 4; ++m) _Pragma("unroll") for (int n = 0; n < 2; ++n) _Pragma("unroll") for (int k = 0; k < 2; ++k) \
        acc[ai][bj][m][n] = __builtin_amdgcn_mfma_f32_16x16x32_bf16(Bt[n][k], At[m][k], acc[ai][bj][m][n], 0, 0, 0); __builtin_amdgcn_s_setprio(0); } while (0)
#define PG8_WAIT_V(n) asm volatile("s_waitcnt vmcnt(" #n ")" ::: "memory")
#define PG8_WAIT_L(n) asm volatile("s_waitcnt lgkmcnt(" #n ")" ::: "memory")
#define PG8_BAR __builtin_amdgcn_s_barrier()
#define PG8_SCHED __builtin_amdgcn_sched_barrier(0)
    Unit cur, nxt; int ui = 0;
    if (!S.next(0, cur)) return;
    f32x4 acc[2][2][4][2];
#pragma unroll
    for (int a = 0; a < 2; ++a)
#pragma unroll
        for (int b = 0; b < 2; ++b)
#pragma unroll
            for (int m = 0; m < 4; ++m)
#pragma unroll
                for (int n = 0; n < 2; ++n) acc[a][b][m][n] = (f32x4){0.f, 0.f, 0.f, 0.f};
    bf16x8 At[4][2], B0[2][2], B1[2][2];
    const char* cA = (const char*)g.A + (size_t)cur.pm * tstep + (size_t)cur.pk * K * 2; const char* cB = (const char*)g.Bt + (size_t)cur.pn * tstep + (size_t)cur.pk * K * 2;
    S.a_ready(cur);
    PG8_STAGE(PG8_SB(0, 0), cB, voffB); PG8_STAGE(PG8_SA(0, 0), cA, voffA); PG8_STAGE(PG8_SB(0, 1), cB + hstep, voffB); PG8_STAGE(PG8_SA(0, 1), cA + hstep, voffA);
    if (wr == 1) PG8_BAR;
    PG8_WAIT_V(4); PG8_BAR;
    PG8_STAGE(PG8_SB(1, 0), cB + kstep, voffB); PG8_STAGE(PG8_SA(1, 0), cA + kstep, voffA); PG8_STAGE(PG8_SB(1, 1), cB + hstep + kstep, voffB);
    PG8_WAIT_V(6); PG8_BAR;
    for (;;) {
        const bool has_next = S.next(ui + 1, nxt);
        const char* nA = has_next ? (const char*)g.A + (size_t)nxt.pm * tstep + (size_t)nxt.pk * K * 2 : cA; const char* nB = has_next ? (const char*)g.Bt + (size_t)nxt.pn * tstep + (size_t)nxt.pk * K * 2 : cB;
        for (int t = 0; t < nt; t += 2) {
            const bool last = (t == nt - 2);
            const char* a1 = cA + (size_t)(t + 1) * kstep;
            const char* a2 = last ? nA : cA + (size_t)(t + 2) * kstep; const char* b2 = last ? nB : cB + (size_t)(t + 2) * kstep;
            const char* a3 = a2 + kstep; const char* b3 = b2 + kstep;
            if (last && has_next) S.a_ready(nxt);
            PG8_LDB(B0, 0, 0); PG8_SCHED; PG8_LDA(At, 0, 0); PG8_STAGE(PG8_SA(1, 1), a1 + hstep, voffA);
            PG8_WAIT_L(8); PG8_BAR; PG8_WAIT_L(0); PG8_MMA(0, 0, At, B0); PG8_BAR; PG8_SCHED;
            PG8_LDB(B1, 0, 1); PG8_STAGE(PG8_SB(0, 0), b2, voffB);
            PG8_BAR; PG8_WAIT_L(0); PG8_MMA(0, 1, At, B1); PG8_BAR;
            PG8_LDA(At, 0, 1); PG8_STAGE(PG8_SA(0, 0), a2, voffA);
            PG8_BAR; PG8_WAIT_L(0); PG8_MMA(1, 0, At, B0); PG8_BAR; PG8_SCHED;
            PG8_STAGE(PG8_SB(0, 1), b2 + hstep, voffB);
            PG8_WAIT_V(6); PG8_BAR; PG8_MMA(1, 1, At, B1); PG8_BAR;
            PG8_LDB(B0, 1, 0); PG8_SCHED; PG8_LDA(At, 1, 0); PG8_STAGE(PG8_SA(0, 1), a2 + hstep, voffA);
            PG8_WAIT_L(8); PG8_BAR; PG8_WAIT_L(0); PG8_MMA(0, 0, At, B0); PG8_BAR; PG8_SCHED;
            PG8_LDB(B1, 1, 1); PG8_STAGE(PG8_SB(1, 0), b3, voffB);
            PG8_BAR; PG8_WAIT_L(0); PG8_MMA(0, 1, At, B1); PG8_BAR;
            PG8_LDA(At, 1, 1); PG8_STAGE(PG8_SA(1, 0), a3, voffA);
            PG8_BAR; PG8_WAIT_L(0); PG8_MMA(1, 0, At, B0); PG8_BAR; PG8_SCHED;
            PG8_STAGE(PG8_SB(1, 1), b3 + hstep, voffB);
            PG8_WAIT_V(6); PG8_BAR; PG8_MMA(1, 1, At, B1); PG8_BAR;
        }
        if constexpr (!Epi::AFTER_DRAIN) { E(acc, cur, wr, wc, fr, fq); S.done(cur); }
        if (!has_next) break;
#pragma unroll
        for (int a = 0; a < 2; ++a)
#pragma unroll
            for (int b = 0; b < 2; ++b)
#pragma unroll
                for (int m = 0; m < 4; ++m)
#pragma unroll
                    for (int n = 0; n < 2; ++n) acc[a][b][m][n] = (f32x4){0.f, 0.f, 0.f, 0.f};
        cur = nxt; cA = nA; cB = nB; ++ui;
    }
    PG8_WAIT_V(0);
    if (wr == 0) PG8_BAR;
    PG8_BAR;
    if constexpr (Epi::AFTER_DRAIN) { E.fused(acc, cur, wr, wc, fr, fq, lds, wid, lane); S.done(cur); }
#undef PG8_SA
#undef PG8_SB
#undef PG8_STAGE
#undef PG8_LDA
#undef PG8_LDB
#undef PG8_MMA
#undef PG8_WAIT_V
#undef PG8_WAIT_L
#undef PG8_BAR
#undef PG8_SCHED
}
}

#define XB_TMO      128
#define XB_XCNT(j)  (256  + 64 * (j))
#define XB_XSUB(j)  (1280 + 64 * (j))
#define XB_XGEN(j)  (2304 + 64 * (j))
#define XB_TOP      3328
#define XB_TOPGEN   3392
#define XCD_BAR_WORDS 3456
#define XB_SPIN_CAP (1u << 18)
#define XLAS __attribute__((address_space(3)))

__device__ __forceinline__ unsigned xb_ld(unsigned* p)              { return __hip_atomic_load(p, __ATOMIC_RELAXED, __HIP_MEMORY_SCOPE_AGENT); }
__device__ __forceinline__ unsigned xb_add(unsigned* p, unsigned v) { return __hip_atomic_fetch_add(p, v, __ATOMIC_RELAXED, __HIP_MEMORY_SCOPE_AGENT); }
__device__ __forceinline__ unsigned xb_xcc_id() { return (unsigned)__builtin_amdgcn_s_getreg((3 << 11) | 20) & 0xFu; }
#define XB_SPIN(cond, bar) do { unsigned _sp = 0; while (cond) { __builtin_amdgcn_s_sleep(1); \
    if ((++_sp & 255u) == 0u) { if (xb_ld(&(bar)[XB_TMO])) break; if (_sp > XB_SPIN_CAP) { atomicAdd(&(bar)[XB_TMO], 1u); break; } } } } while (0)

struct XcdBarrier {
    unsigned* bar; unsigned x;
    volatile XLAS unsigned* st;
};

__device__ __forceinline__ XcdBarrier xcd_barrier_post(unsigned* bar, volatile XLAS unsigned* st) {
    XcdBarrier b; b.bar = bar; b.x = xb_xcc_id(); b.st = st;
    if (threadIdx.x == 0) (void)xb_add(&bar[XB_XCNT(b.x)], 1u);
    return b;
}
__device__ __forceinline__ void xcd_barrier_complete(unsigned* bar, unsigned x, unsigned& nloc, unsigned& nx) {
    const unsigned G = gridDim.x * gridDim.y * gridDim.z;
    unsigned sum, cnt, mine, sp = 0u;
    for (;;) {
        sum = 0u; cnt = 0u; mine = 0u;
#pragma unroll
        for (unsigned j = 0; j < 16; ++j) { const unsigned c = xb_ld(&bar[XB_XCNT(j)]); sum += c; cnt += (c > 0u) ? 1u : 0u; mine = (j == x) ? c : mine; }
        if (sum == G) break;
        __builtin_amdgcn_s_sleep(1);
        if ((++sp & 255u) == 0u) { if (xb_ld(&bar[XB_TMO])) break; if (sp > XB_SPIN_CAP) { atomicAdd(&bar[XB_TMO], 1u); break; } }
    }
    nloc = mine > 0u ? mine : 1u; nx = cnt > 0u ? cnt : 1u;
}

__device__ __forceinline__ void xcd_barrier(const XcdBarrier& b) {
    asm volatile("s_waitcnt vmcnt(0)" ::: "memory");
    __syncthreads();
    if (threadIdx.x == 0) {
        unsigned* bar = b.bar;
        __builtin_amdgcn_s_waitcnt(0);
        unsigned nloc = b.st[0], nx = b.st[1];
        if (nloc == 0u) { xcd_barrier_complete(bar, b.x, nloc, nx); b.st[0] = nloc; b.st[1] = nx; }
        const unsigned old = xb_add(&bar[XB_XSUB(b.x)], 1u);
        const unsigned gen = old / nloc;
        if (old + 1u == (gen + 1u) * nloc) {
            __builtin_amdgcn_fence(__ATOMIC_RELEASE, "agent");
            asm volatile("s_waitcnt vmcnt(0)" ::: "memory");
            const unsigned og = xb_add(&bar[XB_TOP], 1u);
            const unsigned tg = og / nx;
            if (og + 1u == (tg + 1u) * nx) xb_add(&bar[XB_TOPGEN], 1u);
            else XB_SPIN(xb_ld(&bar[XB_TOPGEN]) == tg, bar);
            __builtin_amdgcn_fence(__ATOMIC_ACQUIRE, "agent");
            xb_add(&bar[XB_XGEN(b.x)], 1u);
            asm volatile("s_waitcnt vmcnt(0)" ::: "memory");
        } else {
            XB_SPIN(xb_ld(&bar[XB_XGEN(b.x)]) == gen, bar);
            __builtin_amdgcn_fence(__ATOMIC_ACQUIRE, "agent");
            asm volatile("s_waitcnt vmcnt(0)" ::: "memory");
        }
    }
    __syncthreads();
}

using pg8::bf16_t; using pg8::f32x4; using pg8::bf16x8;
typedef unsigned u32x4_t __attribute__((ext_vector_type(4)));
typedef unsigned u32x2_t __attribute__((ext_vector_type(2)));

constexpr int DM = 1024, NBP = 8, SEQ = 2048, NBS = 128, SSEQ = 4, NH = 4, HD = 128, MW = 512;
constexpr int MP = NBP * SEQ, MS = NBS * SSEQ, MT = MP + MS;
constexpr int NIN = 9232, N1 = 9216, DFF = 2816, NUP = 5632;
constexpr float EPS = 1e-6f;
constexpr float QSCALE = 0.08838834764831845f;

constexpr size_t O_Y = 0;
constexpr size_t O_P_GS = (size_t)MT * DM;
constexpr size_t O_P_GC = O_P_GS + (size_t)2 * 8 * 4 * 128 * 128;
constexpr size_t O_P_MC = O_P_GC + (size_t)2 * 8 * 3 * 1536;
constexpr size_t O_P_MN = O_P_MC + (size_t)2 * 8 * 4 * 128 * 128;
constexpr size_t O_P_MM = O_P_MN + (size_t)2 * 8 * 4 * 128;
constexpr size_t O_P_HS = O_P_MM + (size_t)2 * 8 * 4;
constexpr size_t O_P_FC = O_P_HS + (size_t)2 * 8 * 4 * 128 * 128;
constexpr size_t O_S_GS = O_P_FC + (size_t)2 * 8 * 2 * 5632;
constexpr size_t O_S_GC = O_S_GS + (size_t)2 * 128 * 4 * 128 * 128;
constexpr size_t O_S_MC = O_S_GC + (size_t)2 * 128 * 3 * 1536;
constexpr size_t O_S_MN = O_S_MC + (size_t)2 * 128 * 4 * 128 * 128;
constexpr size_t O_S_MM = O_S_MN + (size_t)2 * 128 * 4 * 128;
constexpr size_t O_S_HS = O_S_MM + (size_t)2 * 128 * 4;
constexpr size_t O_S_FC = O_S_HS + (size_t)2 * 128 * 4 * 128 * 128;
constexpr size_t O_END  = O_S_FC + (size_t)2 * 128 * 2 * 5632;

constexpr size_t W_WIN = 0;
constexpr size_t W_WBR = W_WIN + (size_t)N1 * 1024 * 2;
constexpr size_t W_WOUT = W_WBR + (size_t)3 * 1024 * 512 * 2;
constexpr size_t W_WUP = W_WOUT + (size_t)1024 * 1024 * 2;
constexpr size_t W_WDN = W_WUP + (size_t)NUP * 1024 * 2;
constexpr size_t W_HBF = W_WDN + (size_t)1024 * DFF * 2;
constexpr size_t W_PROJ = W_HBF + (size_t)MT * 1024 * 2;
constexpr size_t W_ACT = W_PROJ + (size_t)MT * NUP * 2;
constexpr size_t W_OUTS = W_PROJ + (size_t)MT * N1 * 2;
constexpr size_t W_GATES = W_OUTS + (size_t)3 * MT * 512 * 2;
constexpr size_t W_DEN = W_GATES + (size_t)MT * 16 * 4;
constexpr size_t W_MT = W_DEN + (size_t)MT * 4 * 4;
constexpr size_t W_BAR = W_MT + (size_t)MT * 4 * 4;
constexpr size_t W_END = W_BAR + 16384;

constexpr int LDS_MAIN = 143360;
constexpr int LDS_BYTES = LDS_MAIN + 64 + 512;

struct Params { const float* in[28]; float* out; unsigned char* ws; };
enum { I_XP = 0, I_XS, I_SGS, I_SGC, I_SMC, I_SMN, I_SMM, I_SHS, I_SFC, I_LNMIX, I_WIN, I_GCW, I_ALOG, I_DTB, I_GNORM, I_MIB, I_MFB, I_MNORM, I_HLB, I_HNORM,
       I_WBR, I_WOUT, I_LNFFN, I_WUP, I_FCW, I_FCB, I_WDN, I_LNF };

typedef const float* const __attribute__((address_space(4))) * kargp_t;
__device__ __forceinline__ const float* argp(int i) { kargp_t kp = (kargp_t)__builtin_amdgcn_kernarg_segment_ptr(); asm volatile("" : "+s"(i)); return kp[i]; }
__device__ __forceinline__ int bidx() { int b = (int)blockIdx.x; asm volatile("" : "+s"(b)); return b; }
__device__ __forceinline__ int gdim() { int g = (int)gridDim.x; asm volatile("" : "+s"(g)); return g; }
#define PIN(i) argp(i)
#define POUT ((float*)argp(28))
#define PWS ((unsigned char*)argp(29))
__device__ __forceinline__ float bf2f(bf16_t b) { return __uint_as_float(((unsigned)b) << 16); }
__device__ __forceinline__ float bflo(unsigned u) { return __uint_as_float(u << 16); }
__device__ __forceinline__ float bfhi(unsigned u) { return __uint_as_float(u & 0xffff0000u); }
__device__ __forceinline__ bf16_t f2bf(float f) { return (bf16_t)(pg8::cvt_pk_bf16(f, 0.f) & 0xffffu); }
__device__ __forceinline__ float sigm(float x) { return __builtin_amdgcn_rcpf(1.f + __expf(-x)); }
__device__ __forceinline__ float silu(float x) { return x * sigm(x); }
__device__ __forceinline__ float rdlane(float x, int l) { return __builtin_bit_cast(float, __builtin_amdgcn_readlane(__builtin_bit_cast(int, x), l)); }
template <int CTRL> __device__ __forceinline__ float dppf(float x) { return __builtin_bit_cast(float, __builtin_amdgcn_update_dpp(0, __builtin_bit_cast(int, x), CTRL, 0xf, 0xf, true)); }
__device__ __forceinline__ float grp_sum8(float x) { x += dppf<0xB1>(x); x += dppf<0x4E>(x); x += dppf<0x141>(x); return x; }
__device__ __forceinline__ float grp_sum16(float x) { x = grp_sum8(x); x += dppf<0x140>(x); return x; }
__device__ __forceinline__ float wave_sum(float x) { x = grp_sum16(x);
    x += __builtin_bit_cast(float, __builtin_amdgcn_update_dpp(0, __builtin_bit_cast(int, x), 0x142, 0xa, 0xf, false));
    x += __builtin_bit_cast(float, __builtin_amdgcn_update_dpp(0, __builtin_bit_cast(int, x), 0x143, 0xc, 0xf, false));
    return rdlane(x, 63); }
template <int CTRL> __device__ __forceinline__ float dppm(float x) { return __builtin_bit_cast(float, __builtin_amdgcn_update_dpp(__builtin_bit_cast(int, -INFINITY), __builtin_bit_cast(int, x), CTRL, 0xf, 0xf, false)); }
template <int T> __device__ __forceinline__ float grp_sum(float x) { if constexpr (T == 16) return grp_sum16(x); else return grp_sum8(x); }

__device__ __forceinline__ int win_srccol(int n0) { const int blk = n0 >> 9, r = n0 & 511; int base;
    if (blk < 4) base = blk * 512; else if (blk < 8) base = 2056 + (blk - 4) * 512; else if (blk < 12) base = 4112 + (blk - 8) * 512; else base = 6160 + (blk - 12) * 512;
    return base + r; }
__device__ __forceinline__ void conv_T(const float* __restrict__ src, int ld, bf16_t* __restrict__ dst, int K, int N, bool winmap, float* tile, int& tcount) {
    int tid_ = threadIdx.x; asm volatile("" : "+v"(tid_)); const int tid = tid_, ntn = N / 64, ntiles = ntn * (K / 64);
    int t = bidx() - (tcount % gdim()); if (t < 0) t += gdim();
    const int kk = tid >> 4, n4 = (tid & 15) * 4;
    float4 va[2], vb[2];
#define CT_LOAD(dst_, t_) do { const int tn_ = (t_) % ntn, tk_ = (t_) / ntn, n0_ = tn_ * 64, k0_ = tk_ * 64, sc0_ = winmap ? win_srccol(n0_) : n0_; \
        _Pragma("unroll") for (int pp_ = 0; pp_ < 2; ++pp_) dst_[pp_] = *(const float4*)(src + (size_t)(k0_ + kk + 32 * pp_) * ld + sc0_ + n4); } while (0)
    if (t < ntiles) CT_LOAD(va, t);
    for (; t < ntiles; t += gdim()) {
        const int tn = t % ntn, tk = t / ntn, n0 = tn * 64, k0 = tk * 64;
        const int tnext = t + gdim();
        if (tnext < ntiles) CT_LOAD(vb, tnext);
        __syncthreads();
#pragma unroll
        for (int pp = 0; pp < 2; ++pp) { float* tp = tile + (kk + 32 * pp) * 65 + n4; tp[0] = va[pp].x; tp[1] = va[pp].y; tp[2] = va[pp].z; tp[3] = va[pp].w; }
        __syncthreads();
        { const int n = tid >> 3, k8 = (tid & 7) * 8; float f[8];
#pragma unroll
          for (int i = 0; i < 8; ++i) f[i] = tile[(k8 + i) * 65 + n];
          u32x4_t o; o[0] = pg8::cvt_pk_bf16(f[0], f[1]); o[1] = pg8::cvt_pk_bf16(f[2], f[3]); o[2] = pg8::cvt_pk_bf16(f[4], f[5]); o[3] = pg8::cvt_pk_bf16(f[6], f[7]);
          *(u32x4_t*)(dst + (size_t)(n0 + n) * K + k0 + k8) = o; }
        va[0] = vb[0]; va[1] = vb[1];
    }
#undef CT_LOAD
    tcount += ntiles;
}

__device__ __forceinline__ void phase_rmsnorm(const Params& p, int l, const float* xa, const float* xb, const float* __restrict__ gw, bf16_t* __restrict__ hout, bool do_gates, float* sm) {
    int tid_ = threadIdx.x; asm volatile("" : "+v"(tid_)); const int tid = tid_, lane = tid & 63, w = tid >> 6;
    float* wgT = sm;
    if (do_gates) {
        const float* win = PIN(I_WIN) + (size_t)l * 1024 * NIN;
        __syncthreads();
        for (int i = tid; i < 16 * 1024; i += 512) { const int k = i >> 4, j = i & 15; const int gc = j < 8 ? 2048 + j : 4104 + (j - 8); wgT[j * 1024 + k] = win[(size_t)k * NIN + gc]; }
        __syncthreads();
    }
    float4 g4[4];
#pragma unroll
    for (int i = 0; i < 4; ++i) g4[i] = *(const float4*)(gw + lane * 4 + 256 * i);
    for (int row = bidx() * 8 + w; row < MT; row += gdim() * 8) {
        const float* xr = row < MP ? xa + (size_t)row * DM : xb + (size_t)(row - MP) * DM;
        float4 v[4]; float ss = 0.f;
#pragma unroll
        for (int i = 0; i < 4; ++i) { v[i] = *(const float4*)(xr + lane * 4 + 256 * i); ss += v[i].x * v[i].x + v[i].y * v[i].y + v[i].z * v[i].z + v[i].w * v[i].w; }
        ss = wave_sum(ss);
        const float rstd = rsqrtf(ss * (1.f / 1024.f) + EPS);
#pragma unroll
        for (int i = 0; i < 4; ++i) { v[i].x *= rstd * g4[i].x; v[i].y *= rstd * g4[i].y; v[i].z *= rstd * g4[i].z; v[i].w *= rstd * g4[i].w;
            u32x2_t o; o[0] = pg8::cvt_pk_bf16(v[i].x, v[i].y); o[1] = pg8::cvt_pk_bf16(v[i].z, v[i].w);
            *(u32x2_t*)(hout + (size_t)row * DM + lane * 4 + 256 * i) = o; }
        if (do_gates) {
            float mine = 0.f;
#pragma unroll
            for (int j = 0; j < 16; ++j) { float a = 0.f;
#pragma unroll
                for (int i = 0; i < 4; ++i) { const float4 wv = *(const float4*)(wgT + j * 1024 + lane * 4 + 256 * i); a += v[i].x * wv.x + v[i].y * wv.y + v[i].z * wv.z + v[i].w * wv.w; }
                a = wave_sum(a); if (lane == j) mine = a; }
            if (lane < 16) { const int h = lane & 3, kind = lane >> 2; float r;
                if (kind == 0) r = sigm(mine);
                else if (kind == 1) { const float xx = mine + PIN(I_DTB)[l * 4 + h]; const float sp = xx > 20.f ? xx : __logf(1.f + __expf(xx)); r = __expf(-__expf(PIN(I_ALOG)[l * 4 + h]) * sp); }
                else if (kind == 2) r = mine + PIN(I_MIB)[l * 4 + h];
                else { const float xx = -(mine + PIN(I_MFB)[l * 4 + h]); r = -(xx > 20.f ? xx : __logf(1.f + __expf(xx))); }
                ((float*)(PWS + W_GATES))[(size_t)row * 16 + lane] = r; }
        }
    }
}

struct EpiProj {
    static constexpr bool PERM = true, AFTER_DRAIN = false;
    bf16_t* O; int ldc; int actmode;
    __device__ __forceinline__ void operator()(const f32x4 (&acc)[2][2][4][2], const pg8::Unit& u, int wr, int wc, int fr, int fq) const {
        const int row0 = u.pm * 256 + wr * 64 + fr, col0 = u.pn * 256 + wc * 32 + 8 * fq;
        int act = 0;
        if (actmode) { const int pn = u.pn; act = (pn >= 24 || pn == 14 || pn == 15) ? 2 : ((pn == 6 || pn == 7 || pn == 16 || pn == 17 || pn == 22 || pn == 23) ? 1 : 0); }
#pragma unroll
        for (int ai = 0; ai < 2; ++ai)
#pragma unroll
            for (int m = 0; m < 4; ++m) { bf16_t* rowp = O + (size_t)(row0 + ai * 128 + m * 16) * ldc + col0;
#pragma unroll
                for (int bj = 0; bj < 2; ++bj) { float v[8];
#pragma unroll
                    for (int i = 0; i < 4; ++i) { v[i] = acc[ai][bj][m][0][i]; v[4 + i] = acc[ai][bj][m][1][i]; }
                    if (act == 1) {
#pragma unroll
                        for (int i = 0; i < 8; ++i) v[i] = silu(v[i]); }
                    else if (act == 2) {
#pragma unroll
                        for (int i = 0; i < 8; ++i) v[i] = sigm(v[i]); }
                    u32x4_t o; o[0] = pg8::cvt_pk_bf16(v[0], v[1]); o[1] = pg8::cvt_pk_bf16(v[2], v[3]); o[2] = pg8::cvt_pk_bf16(v[4], v[5]); o[3] = pg8::cvt_pk_bf16(v[6], v[7]);
                    *(u32x4_t*)(rowp + bj * 128) = o; } }
    }
};
struct EpiMerge {
    static constexpr bool PERM = true, AFTER_DRAIN = false;
    const bf16_t* G; bf16_t* Mx;
    __device__ __forceinline__ void operator()(const f32x4 (&acc)[2][2][4][2], const pg8::Unit& u, int wr, int wc, int fr, int fq) const {
        const int n = u.pn >> 2, first = (n == 0);
        const int row0 = (u.pm - n * (MT / 256)) * 256 + wr * 64 + fr, col0 = (u.pn & 3) * 256 + wc * 32 + 8 * fq;
        const bf16_t* Gn = G + n * 1024 + col0; bf16_t* Mc = Mx + col0;
        u32x4_t gc[2], oc[2], gn[2], on[2];
#pragma unroll
        for (int bj = 0; bj < 2; ++bj) { gc[bj] = *(const u32x4_t*)(Gn + (size_t)row0 * N1 + bj * 128); oc[bj] = first ? (u32x4_t){0u, 0u, 0u, 0u} : *(const u32x4_t*)(Mc + (size_t)row0 * DM + bj * 128); }
#pragma unroll
        for (int gI = 0; gI < 8; ++gI) { const int ai = gI >> 2, m = gI & 3; const size_t row = (size_t)(row0 + ai * 128 + m * 16);
            if (gI < 7) { const size_t row2 = (size_t)(row0 + ((gI + 1) >> 2) * 128 + ((gI + 1) & 3) * 16);
#pragma unroll
                for (int bj = 0; bj < 2; ++bj) { gn[bj] = *(const u32x4_t*)(Gn + row2 * N1 + bj * 128); on[bj] = first ? (u32x4_t){0u, 0u, 0u, 0u} : *(const u32x4_t*)(Mc + row2 * DM + bj * 128); } }
#pragma unroll
            for (int bj = 0; bj < 2; ++bj) { float v[8];
#pragma unroll
                for (int i = 0; i < 4; ++i) { v[i] = acc[ai][bj][m][0][i]; v[4 + i] = acc[ai][bj][m][1][i]; }
#pragma unroll
                for (int i = 0; i < 4; ++i) { v[2 * i] = v[2 * i] * bflo(gc[bj][i]) + bflo(oc[bj][i]); v[2 * i + 1] = v[2 * i + 1] * bfhi(gc[bj][i]) + bfhi(oc[bj][i]); }
                u32x4_t o; o[0] = pg8::cvt_pk_bf16(v[0], v[1]); o[1] = pg8::cvt_pk_bf16(v[2], v[3]); o[2] = pg8::cvt_pk_bf16(v[4], v[5]); o[3] = pg8::cvt_pk_bf16(v[6], v[7]);
                *(u32x4_t*)(Mc + row * DM + bj * 128) = o; }
#pragma unroll
            for (int bj = 0; bj < 2; ++bj) { gc[bj] = gn[bj]; oc[bj] = on[bj]; } }
    }
};
struct EpiResid {
    static constexpr bool PERM = false, AFTER_DRAIN = false;
    float* X; const float* Sa; const float* Sb;
    __device__ __forceinline__ void operator()(const f32x4 (&acc)[2][2][4][2], const pg8::Unit& u, int wr, int wc, int fr, int fq) const {
        const int row0 = u.pm * 256 + wr * 64 + fr, col0 = u.pn * 256 + wc * 32 + 4 * fq;
        const float* S = u.pm * 256 < MP ? Sa : Sb - (size_t)MP * DM;
        f32x4 cur[4], nxt[4];
#pragma unroll
        for (int q = 0; q < 4; ++q) cur[q] = *(const f32x4*)(S + (size_t)row0 * DM + col0 + (q >> 1) * 128 + (q & 1) * 16);
#pragma unroll
        for (int gI = 0; gI < 8; ++gI) { const int ai = gI >> 2, m = gI & 3; const size_t ro = (size_t)(row0 + ai * 128 + m * 16) * DM + col0;
            if (gI < 7) { const int ai2 = (gI + 1) >> 2, m2 = (gI + 1) & 3; const size_t ro2 = (size_t)(row0 + ai2 * 128 + m2 * 16) * DM + col0;
#pragma unroll
                for (int q = 0; q < 4; ++q) nxt[q] = *(const f32x4*)(S + ro2 + (q >> 1) * 128 + (q & 1) * 16); }
#pragma unroll
            for (int q = 0; q < 4; ++q) *(f32x4*)(X + ro + (q >> 1) * 128 + (q & 1) * 16) = cur[q] + acc[ai][q >> 1][m][q & 1];
#pragma unroll
            for (int q = 0; q < 4; ++q) cur[q] = nxt[q]; }
    }
};

struct EpiAtomic {
    static constexpr bool PERM = false, AFTER_DRAIN = false;
    float* X;
    __device__ __forceinline__ void operator()(const f32x4 (&acc)[2][2][4][2], const pg8::Unit& u, int wr, int wc, int fr, int fq) const {
        const int row0 = u.pm * 256 + wr * 64 + fr, col0 = u.pn * 256 + wc * 32 + 4 * fq;
#pragma unroll
        for (int ai = 0; ai < 2; ++ai)
#pragma unroll
            for (int m = 0; m < 4; ++m) { float* rowp = X + (size_t)(row0 + ai * 128 + m * 16) * DM + col0;
#pragma unroll
                for (int bj = 0; bj < 2; ++bj)
#pragma unroll
                    for (int n = 0; n < 2; ++n)
#pragma unroll
                        for (int e = 0; e < 4; ++e) unsafeAtomicAdd(rowp + bj * 128 + n * 16 + e, acc[ai][bj][m][n][e]); }
    }
};
struct MergeOrder {
    pg8::StaticOrder base;
    __device__ void init(int G_, int c_) { base.init(MT, 1024, G_, c_); }
    __device__ bool next(int i, pg8::Unit& u) const { const int t = i / 3, n = i - 3 * t; pg8::Unit b; if (!base.next(t, b)) return false; u.pm = n * (MT / 256) + b.pm; u.pn = n * 4 + b.pn; u.pk = 0; return true; }
    __device__ __forceinline__ void a_ready(const pg8::Unit&) const {}
    __device__ __forceinline__ void done(const pg8::Unit&) const {}
};
struct PieceOrder {
    int G, c, KP;
    __device__ bool next(int i, pg8::Unit& u) const { const int L = i * G + c; if (L >= 8 * KP) return false; const int tile = L / KP; u.pk = L - tile * KP; u.pm = MP / 256 + (tile >> 2); u.pn = tile & 3; return true; }
    __device__ __forceinline__ void a_ready(const pg8::Unit&) const {}
    __device__ __forceinline__ void done(const pg8::Unit&) const {}
};
__device__ __forceinline__ void phase_gdnprep(const Params& p, int l) {
    int tid_ = threadIdx.x; asm volatile("" : "+v"(tid_)); const int tid = tid_, j = tid & 15;
    const bf16_t* proj = (const bf16_t*)(PWS + W_PROJ);
    bf16_t* qkd = (bf16_t*)(PWS + W_HBF); bf16_t* vd = (bf16_t*)(PWS + W_OUTS);
    const float* cw = PIN(I_GCW) + (size_t)l * 4 * 1536; const float* cst = PIN(I_SGC) + (size_t)l * NBS * 3 * 1536;
    const int ngroups = MT * 12, half = ngroups / 2;
    for (int gid0 = bidx() * 32 + (tid >> 4); gid0 < half; gid0 += gdim() * 32) {
        const int part = gid0 % 12, col = part * 128 + 8 * j;
        float4 w0[4], w1[4];
#pragma unroll
        for (int jj = 0; jj < 4; ++jj) { w0[jj] = *(const float4*)(cw + jj * 1536 + col); w1[jj] = *(const float4*)(cw + jj * 1536 + col + 4); }
        float x[2][4][8]; int rr[2];
#pragma unroll
        for (int k = 0; k < 2; ++k) { const int gid = gid0 + k * half, r = gid / 12; rr[k] = r;
            const bool samp = r >= MP; const int t = samp ? ((r - MP) & 3) : (r & (SEQ - 1)), b2 = samp ? ((r - MP) >> 2) : 0;
#pragma unroll
            for (int jj = 0; jj < 4; ++jj) { const int tt = t - 3 + jj;
                if (tt >= 0) { const u32x4_t raw = *(const u32x4_t*)(proj + (size_t)(r - 3 + jj) * N1 + col);
#pragma unroll
                    for (int i = 0; i < 4; ++i) { x[k][jj][2 * i] = bflo(raw[i]); x[k][jj][2 * i + 1] = bfhi(raw[i]); } }
                else if (samp) { const float* cp = cst + (size_t)(b2 * 3 + 3 + tt) * 1536 + col; const float4 a0 = *(const float4*)cp, a1 = *(const float4*)(cp + 4);
                    x[k][jj][0] = a0.x; x[k][jj][1] = a0.y; x[k][jj][2] = a0.z; x[k][jj][3] = a0.w; x[k][jj][4] = a1.x; x[k][jj][5] = a1.y; x[k][jj][6] = a1.z; x[k][jj][7] = a1.w; }
                else {
#pragma unroll
                    for (int i = 0; i < 8; ++i) x[k][jj][i] = 0.f; } } }
#pragma unroll
        for (int k = 0; k < 2; ++k) { const int r = rr[k]; float y[8];
#pragma unroll
            for (int i = 0; i < 8; ++i) y[i] = 0.f;
#pragma unroll
            for (int jj = 0; jj < 4; ++jj) { y[0] += w0[jj].x * x[k][jj][0]; y[1] += w0[jj].y * x[k][jj][1]; y[2] += w0[jj].z * x[k][jj][2]; y[3] += w0[jj].w * x[k][jj][3];
                y[4] += w1[jj].x * x[k][jj][4]; y[5] += w1[jj].y * x[k][jj][5]; y[6] += w1[jj].z * x[k][jj][6]; y[7] += w1[jj].w * x[k][jj][7]; }
            float ss = 0.f;
#pragma unroll
            for (int i = 0; i < 8; ++i) { y[i] = silu(y[i]); ss += y[i] * y[i]; }
            ss = grp_sum16(ss);
            const float scl = part < 4 ? rsqrtf(ss + EPS) * QSCALE : (part < 8 ? rsqrtf(ss + EPS) : 1.f);
            u32x4_t o; o[0] = pg8::cvt_pk_bf16(y[0] * scl, y[1] * scl); o[1] = pg8::cvt_pk_bf16(y[2] * scl, y[3] * scl); o[2] = pg8::cvt_pk_bf16(y[4] * scl, y[5] * scl); o[3] = pg8::cvt_pk_bf16(y[6] * scl, y[7] * scl);
            if (part < 8) *(u32x4_t*)(qkd + (size_t)r * 1024 + col) = o; else *(u32x4_t*)(vd + (size_t)r * 512 + (col - 1024)) = o; }
    }
}

__device__ __forceinline__ void lds_barrier() { asm volatile("s_waitcnt lgkmcnt(0)" ::: "memory"); __builtin_amdgcn_s_barrier(); asm volatile("" ::: "memory"); }
typedef float f2 __attribute__((ext_vector_type(2)));
typedef float f4 __attribute__((ext_vector_type(4)));
template <int MIX>
__device__ __forceinline__ void scan_prompt_item(const Params& p, int l, int b, int h, int cgp, float* sm) {
    constexpr int T = 16, CPL = (MIX == 0) ? 1 : 2, NG = 128 / (4 * T), NP = 2 * NG, CPW = (64 / T) * CPL, CPG = 8 * CPW, TB = 32, BUFSZ = 16512, NBLK = SEQ / TB;
    int tid_ = threadIdx.x; asm volatile("" : "+v"(tid_)); const int tid = tid_, lane = tid & 63, w = tid >> 6, c = lane / T, j = lane % T;
    const int col = w * CPW + c, ecol = cgp * CPG + col;
    float* misc = sm + 2 * BUFSZ; float* gsc = misc; float* mcar = misc + 64;
    const float* gates = (const float*)(PWS + W_GATES);
    bf16_t* outp = (bf16_t*)(PWS + W_OUTS) + (size_t)MIX * MT * 512;
    const size_t rb = (size_t)b * SEQ;
    const int c8 = (tid & 31) * 8, srow = tid >> 5;
    const bf16_t* qsrc; size_t qld; const bf16_t* vsrc; size_t vld;
    if (MIX == 0) { qsrc = (const bf16_t*)(PWS + W_HBF) + rb * 1024 + (c8 < 128 ? h * 128 + c8 : 512 + h * 128 + (c8 - 128)); qld = 1024;
        vsrc = (const bf16_t*)(PWS + W_OUTS) + rb * 512 + h * 128 + cgp * 32; vld = 512; }
    else { const int base = MIX == 1 ? 2048 : 4096; qsrc = (const bf16_t*)(PWS + W_PROJ) + rb * N1 + base + (c8 < 128 ? h * 128 + c8 : 512 + h * 128 + (c8 - 128)); qld = N1;
        vsrc = (const bf16_t*)(PWS + W_PROJ) + rb * N1 + base + 1024 + h * 128 + cgp * 64; vld = N1; }
    constexpr int VPC = CPG / 8;
    const int vs = tid / VPC, vc8 = (tid % VPC) * 8; const bool vact = tid < TB * VPC;
    float lb8[8];
#pragma unroll
    for (int i = 0; i < 8; ++i) lb8[i] = 0.f;
    if (MIX == 2 && l > 0 && c8 >= 128) { const float* hl = PIN(I_HLB);
#pragma unroll
        for (int i = 0; i < 8; ++i) { const int cc = h * 128 + (c8 - 128) + i; lb8[i] = sigm(hl[512 + cc] - hl[cc]); } }
    f2 S2[CPL][NP];
#pragma unroll
    for (int cc = 0; cc < CPL; ++cc)
#pragma unroll
        for (int i = 0; i < NP; ++i) S2[cc][i] = (f2){0.f, 0.f};
    float nn = 0.f, okeep[CPL], oprev[CPL];
#pragma unroll
    for (int cc = 0; cc < CPL; ++cc) { okeep[cc] = 0.f; oprev[cc] = 0.f; }
    u32x4_t rq[2][2], rv[2]; float rg0[2] = {0.f, 0.f}, rg1[2] = {0.f, 0.f};
    rv[0] = (u32x4_t){0u, 0u, 0u, 0u}; rv[1] = rv[0];
#define SCAN_ISSUE(t0_, st_) do { \
        _Pragma("unroll") for (int i_ = 0; i_ < 2; ++i_) rq[st_][i_] = *(const u32x4_t*)(qsrc + (size_t)((t0_) + srow + 16 * i_) * qld); \
        if (vact) rv[st_] = *(const u32x4_t*)(vsrc + (size_t)((t0_) + vs) * vld + vc8); \
        if (MIX != 2 && tid < TB) { const size_t r_ = rb + (t0_) + tid; rg0[st_] = gates[r_ * 16 + (MIX == 0 ? 0 : 8) + h]; rg1[st_] = gates[r_ * 16 + (MIX == 0 ? 4 : 12) + h]; } } while (0)
#define SCAN_FINISH(B_, st_) do { float* qk_ = (B_); float* vv_ = (B_) + 8192; float* sc_ = (B_) + 10240; \
        _Pragma("unroll") for (int i_ = 0; i_ < 2; ++i_) { float x_[8]; \
            _Pragma("unroll") for (int e_ = 0; e_ < 4; ++e_) { x_[2 * e_] = bflo(rq[st_][i_][e_]); x_[2 * e_ + 1] = bfhi(rq[st_][i_][e_]); } \
            if (MIX == 2 && c8 >= 128) { _Pragma("unroll") for (int e_ = 0; e_ < 8; ++e_) x_[e_] = lb8[e_] + (1.f - lb8[e_]) * sigm(x_[e_]); } \
            float* d_ = qk_ + (srow + 16 * i_) * 256 + c8; *(f4*)d_ = (f4){x_[0], x_[1], x_[2], x_[3]}; *(f4*)(d_ + 4) = (f4){x_[4], x_[5], x_[6], x_[7]}; } \
        if (vact) { float* d_ = vv_ + vs * 64 + vc8; *(f4*)d_ = (f4){bflo(rv[st_][0]), bfhi(rv[st_][0]), bflo(rv[st_][1]), bfhi(rv[st_][1])}; *(f4*)(d_ + 4) = (f4){bflo(rv[st_][2]), bfhi(rv[st_][2]), bflo(rv[st_][3]), bfhi(rv[st_][3])}; } \
        if (MIX == 0 && tid < TB) { sc_[tid * 4] = rg0[st_]; sc_[tid * 4 + 1] = rg1[st_]; } \
        if (MIX == 1 && tid < TB) { gsc[tid * 2] = rg0[st_]; gsc[tid * 2 + 1] = rg1[st_]; } } while (0)
#define SCAN_CHAIN(B_) do { if (w == 1) { float* sc_ = (B_) + 10240; const int ls_ = lane & 31; const float m0_ = mcar[0]; \
            const float ig_ = gsc[2 * ls_], lf_ = gsc[2 * ls_ + 1]; \
            float F_ = lf_; F_ += dppf<0x111>(F_); F_ += dppf<0x112>(F_); F_ += dppf<0x114>(F_); F_ += dppf<0x118>(F_);              \
            { const float t0_ = rdlane(F_, 15); if (lane & 16) F_ += t0_; } \
            float P_ = ig_ - F_; P_ = fmaxf(P_, dppm<0x111>(P_)); P_ = fmaxf(P_, dppm<0x112>(P_)); P_ = fmaxf(P_, dppm<0x114>(P_)); P_ = fmaxf(P_, dppm<0x118>(P_)); \
            { const float t1_ = rdlane(P_, 15); if (lane & 16) P_ = fmaxf(P_, t1_); } \
            const float m_ = F_ + fmaxf(m0_, P_); \
            float mp_ = dppf<0x111>(m_); { const float t2_ = rdlane(m_, 15); if ((lane & 15) == 0) mp_ = (lane & 16) ? t2_ : m0_; } \
            const float mlast_ = rdlane(m_, 31); \
            if (lane < 32) { sc_[lane * 4] = __expf(lf_ + mp_ - m_); sc_[lane * 4 + 1] = __expf(ig_ - m_) * QSCALE; sc_[lane * 4 + 2] = m_; } \
            if (lane == 0) mcar[0] = mlast_; } } while (0)
    if (MIX == 1 && tid == 64) mcar[0] = 0.f;
    __syncthreads();
    SCAN_ISSUE(0, 0);
    SCAN_FINISH(sm, 0);
    SCAN_ISSUE(TB, 1);
    __syncthreads();
    if (MIX == 1) { SCAN_CHAIN(sm); __syncthreads(); }
#pragma unroll 1
    for (int blk2 = 0; blk2 < NBLK; blk2 += 2) {
#pragma unroll
      for (int par = 0; par < 2; ++par) {
        const int blk = blk2 + par;
        const int t0 = blk * TB;
        float* B = sm + (blk & 1) * BUFSZ; float* Bn = sm + ((blk & 1) ^ 1) * BUFSZ;
        const float* qk = B; const float* vv = B + 8192; const float* sc = B + 10240; float* denp = B + 10368; float* ost = B + 14464;
        if (blk + 2 < NBLK) SCAN_ISSUE(t0 + 2 * TB, par);
        f4 qa[2][NG], ka[2][NG]; float va[2][CPL], sa[2], sb[2], kda[2], qda[2];
#define SCAN_LOADOPS(slot_, s_) do { const float* qs_ = qk + (s_) * 256; \
            _Pragma("unroll") for (int g_ = 0; g_ < NG; ++g_) { qa[slot_][g_] = *(const f4*)(qs_ + g_ * 4 * T + 4 * j); ka[slot_][g_] = *(const f4*)(qs_ + 128 + g_ * 4 * T + 4 * j); } \
            _Pragma("unroll") for (int cc_ = 0; cc_ < CPL; ++cc_) va[slot_][cc_] = vv[(s_) * 64 + col + 4 * cc_]; \
            if (MIX != 2) { sa[slot_] = sc[(s_) * 4]; sb[slot_] = sc[(s_) * 4 + 1]; } \
            if (MIX == 1) { const int dn_ = 16 * w + (lane & 15); kda[slot_] = qs_[128 + dn_]; qda[slot_] = qs_[dn_]; } } while (0)
        SCAN_LOADOPS(0, 0);
#pragma unroll 1
        for (int sg = 0; sg < TB; sg += T) {
#pragma unroll
            for (int ss = 0; ss < T; ++ss) {
                const int s = sg + ss; constexpr int dummy = 0; (void)dummy;
                const int cur = ss & 1, nxt = cur ^ 1;
                SCAN_LOADOPS(nxt, (s + 1) & (TB - 1));
                __builtin_amdgcn_sched_barrier(0);
                f2 qq[NP], kk[NP];
#pragma unroll
                for (int g = 0; g < NG; ++g) { qq[2 * g] = qa[cur][g].xy; qq[2 * g + 1] = qa[cur][g].zw; kk[2 * g] = ka[cur][g].xy; kk[2 * g + 1] = ka[cur][g].zw; }
                float onew[CPL];
#pragma unroll
                for (int cc = 0; cc < CPL; ++cc) {
                    const float v = va[cur][cc];
                    f2 oa = (f2){0.f, 0.f}, ob = (f2){0.f, 0.f};
                    if (MIX == 0) {
                        const float beta = sa[cur], a = sb[cur];
                        f2 ka2 = kk[0] * S2[cc][0], kb2 = kk[1] * S2[cc][1];
#pragma unroll
                        for (int i = 2; i < NP; i += 2) { ka2 = kk[i] * S2[cc][i] + ka2; kb2 = kk[i + 1] * S2[cc][i + 1] + kb2; }
                        ka2 = ka2 + kb2;
                        const float ks = grp_sum<T>(ka2.x + ka2.y);
                        const float u = beta * (v - a * ks);
                        const f2 a2 = (f2){a, a}, u2 = (f2){u, u};
#pragma unroll
                        for (int i = 0; i < NP; i += 2) { S2[cc][i] = S2[cc][i] * a2 + kk[i] * u2; S2[cc][i + 1] = S2[cc][i + 1] * a2 + kk[i + 1] * u2; oa = qq[i] * S2[cc][i] + oa; ob = qq[i + 1] * S2[cc][i + 1] + ob; }
                    } else if (MIX == 1) {
                        const float fp = sa[cur], ip = sb[cur], iv = ip * v;
                        const f2 f2v = (f2){fp, fp}, iv2 = (f2){iv, iv};
#pragma unroll
                        for (int i = 0; i < NP; i += 2) { S2[cc][i] = S2[cc][i] * f2v + kk[i] * iv2; S2[cc][i + 1] = S2[cc][i + 1] * f2v + kk[i + 1] * iv2; oa = qq[i] * S2[cc][i] + oa; ob = qq[i + 1] * S2[cc][i + 1] + ob; }
                    } else {
                        const f2 v2 = (f2){v, v};
#pragma unroll
                        for (int i = 0; i < NP; i += 2) { S2[cc][i] = kk[i] * (S2[cc][i] - v2) + v2; S2[cc][i + 1] = kk[i + 1] * (S2[cc][i + 1] - v2) + v2; oa = qq[i] * S2[cc][i] + oa; ob = qq[i + 1] * S2[cc][i + 1] + ob; }
                    }
                    oa = oa + ob; onew[cc] = oa.x + oa.y;
                }
                if (MIX == 1) { const float fp = sa[cur], ip = sb[cur];
                    nn = fp * nn + ip * kda[cur];
                    denp[s * 128 + 16 * w + (lane & 15)] = qda[cur] * nn; }
#pragma unroll
                for (int cc = 0; cc < CPL; ++cc) {
                    if (ss > 0) { const float o = grp_sum<T>(oprev[cc]); okeep[cc] = (ss - 1 == j) ? o : okeep[cc]; }
                    oprev[cc] = onew[cc]; }
            }
#pragma unroll
            for (int cc = 0; cc < CPL; ++cc) { const float o = grp_sum<T>(oprev[cc]); okeep[cc] = (T - 1 == j) ? o : okeep[cc];
                ost[(sg + j) * CPG + col + 4 * cc] = okeep[cc]; }
        }
#undef SCAN_LOADOPS
        if (blk + 1 < NBLK) SCAN_FINISH(Bn, par ^ 1);
        __syncthreads();
        if (tid < TB * (CPG / 8)) { const int orow = tid / (CPG / 8), oc8 = (tid % (CPG / 8)) * 8; const f4 o0 = *(const f4*)(ost + orow * CPG + oc8), o1 = *(const f4*)(ost + orow * CPG + oc8 + 4);
            u32x4_t ov; ov[0] = pg8::cvt_pk_bf16(o0.x, o0.y); ov[1] = pg8::cvt_pk_bf16(o0.z, o0.w); ov[2] = pg8::cvt_pk_bf16(o1.x, o1.y); ov[3] = pg8::cvt_pk_bf16(o1.z, o1.w);
            *(u32x4_t*)(outp + (rb + t0 + orow) * 512 + h * 128 + cgp * CPG + oc8) = ov; }
        if (MIX == 1) {
            if (cgp == 0) { const int sr = tid >> 4, jl = tid & 15; const f4 a0 = *(const f4*)(denp + sr * 128 + 8 * jl), a1 = *(const f4*)(denp + sr * 128 + 8 * jl + 4);
                const float d = grp_sum16((a0.x + a0.y) + (a0.z + a0.w) + (a1.x + a1.y) + (a1.z + a1.w));
                if (jl == 0) { const size_t r = rb + t0 + sr; ((float*)(PWS + W_DEN))[r * 4 + h] = d; ((float*)(PWS + W_MT))[r * 4 + h] = sc[sr * 4 + 2]; } }
            if (blk + 1 < NBLK) SCAN_CHAIN(Bn);
            __syncthreads();
        }
      }
    }
#undef SCAN_ISSUE
#undef SCAN_FINISH
#undef SCAN_CHAIN
    const size_t sidx = ((size_t)(l * NBP + b) * NH + h);
    float* So = POUT + (MIX == 0 ? O_P_GS : (MIX == 1 ? O_P_MC : O_P_HS)) + sidx * 16384;
#pragma unroll
    for (int cc = 0; cc < CPL; ++cc)
#pragma unroll
        for (int g = 0; g < NG; ++g) { const int d0 = g * 4 * T + 4 * j, ec = ecol + 4 * cc;
            So[(size_t)(d0 + 0) * 128 + ec] = S2[cc][2 * g].x; So[(size_t)(d0 + 1) * 128 + ec] = S2[cc][2 * g].y; So[(size_t)(d0 + 2) * 128 + ec] = S2[cc][2 * g + 1].x; So[(size_t)(d0 + 3) * 128 + ec] = S2[cc][2 * g + 1].y; }
    if (MIX == 1 && cgp == 0) {
        if (lane < 16) POUT[O_P_MN + sidx * 128 + 16 * w + lane] = nn;
        if (tid == 64) POUT[O_P_MM + sidx] = mcar[0];
    }
    __syncthreads();
}

template <int MIX>
__device__ __forceinline__ void scan_prompt_lin(const Params& p, int l, int b, int h, int cgp, float* sm) {
    constexpr int TB = 32, NBLK = SEQ / TB;
    int tid_ = threadIdx.x; asm volatile("" : "+v"(tid_)); const int tid = tid_, lane = tid & 63, w = tid >> 6;
    float* qk = sm; float* vv = sm + 8192; float* denp = sm + 10240; float* opart = sm + 14336; float* scall = sm + 30720;
    const float* gates = (const float*)(PWS + W_GATES);
    bf16_t* outp = (bf16_t*)(PWS + W_OUTS) + (size_t)MIX * MT * 512;
    const size_t rb = (size_t)b * SEQ;
    const int c8 = (tid & 31) * 8, srow = tid >> 5;
    const int base = MIX == 1 ? 2048 : 4096;
    const bf16_t* qsrc = (const bf16_t*)(PWS + W_PROJ) + rb * N1 + base + (c8 < 128 ? h * 128 + c8 : 512 + h * 128 + (c8 - 128));
    const bf16_t* vsrc = (const bf16_t*)(PWS + W_PROJ) + rb * N1 + base + 1024 + h * 128 + cgp * 64;
    const int vs = tid >> 3, vc8 = (tid & 7) * 8; const bool vact = tid < TB * 8;
    float lb8[8];
#pragma unroll
    for (int i = 0; i < 8; ++i) lb8[i] = 0.f;
    if (MIX == 2 && l > 0 && c8 >= 128) { const float* hl = PIN(I_HLB);
#pragma unroll
        for (int i = 0; i < 8; ++i) { const int cc = h * 128 + (c8 - 128) + i; lb8[i] = sigm(hl[512 + cc] - hl[cc]); } }
    __syncthreads();
    float mfinal = 0.f;
    if (MIX == 1) {
        float* graw = opart;
        for (int i = tid; i < SEQ; i += 512) { const size_t r = rb + i; graw[2 * i] = gates[r * 16 + 8 + h]; graw[2 * i + 1] = gates[r * 16 + 12 + h]; }
        __syncthreads();
        if (w == 1) { float m0 = 0.f; const int ls = lane & 31;
            for (int t0 = 0; t0 < SEQ; t0 += 32) {
                const float ig = graw[2 * (t0 + ls)], lf = graw[2 * (t0 + ls) + 1];
                float F = lf; F += dppf<0x111>(F); F += dppf<0x112>(F); F += dppf<0x114>(F); F += dppf<0x118>(F);
                { const float t0v = rdlane(F, 15); if (lane & 16) F += t0v; }
                float P = ig - F; P = fmaxf(P, dppm<0x111>(P)); P = fmaxf(P, dppm<0x112>(P)); P = fmaxf(P, dppm<0x114>(P)); P = fmaxf(P, dppm<0x118>(P));
                { const float t1v = rdlane(P, 15); if (lane & 16) P = fmaxf(P, t1v); }
                const float m = F + fmaxf(m0, P);
                float mp = dppf<0x111>(m); { const float t2v = rdlane(m, 15); if ((lane & 15) == 0) mp = (lane & 16) ? t2v : m0; }
                if (lane < 32) { scall[2 * (t0 + lane)] = __expf(lf + mp - m); scall[2 * (t0 + lane) + 1] = __expf(ig - m) * QSCALE;
                    if (cgp == 0) ((float*)(PWS + W_MT))[(rb + t0 + lane) * 4 + h] = m; }
                m0 = rdlane(m, 31); }
            mfinal = m0; }
        __syncthreads();
    }
    f2 S2[8];
#pragma unroll
    for (int i = 0; i < 8; ++i) S2[i] = (f2){0.f, 0.f};
    float nn = 0.f;
    u32x4_t rq[2][2], rv[2]; rv[0] = (u32x4_t){0u, 0u, 0u, 0u}; rv[1] = rv[0];
#define LIN_ISSUE(t0_, st_) do { \
        _Pragma("unroll") for (int i_ = 0; i_ < 2; ++i_) rq[st_][i_] = *(const u32x4_t*)(qsrc + (size_t)((t0_) + srow + 16 * i_) * N1); \
        if (vact) rv[st_] = *(const u32x4_t*)(vsrc + (size_t)((t0_) + vs) * N1 + vc8); } while (0)
#define LIN_FINISH(st_) do { \
        _Pragma("unroll") for (int i_ = 0; i_ < 2; ++i_) { float x_[8]; \
            _Pragma("unroll") for (int e_ = 0; e_ < 4; ++e_) { x_[2 * e_] = bflo(rq[st_][i_][e_]); x_[2 * e_ + 1] = bfhi(rq[st_][i_][e_]); } \
            if (MIX == 2 && c8 >= 128) { _Pragma("unroll") for (int e_ = 0; e_ < 8; ++e_) x_[e_] = lb8[e_] + (1.f - lb8[e_]) * sigm(x_[e_]); } \
            float* d_ = qk + (srow + 16 * i_) * 256 + c8; *(f4*)d_ = (f4){x_[0], x_[1], x_[2], x_[3]}; *(f4*)(d_ + 4) = (f4){x_[4], x_[5], x_[6], x_[7]}; } \
        if (vact) { float* d_ = vv + vs * 64 + vc8; *(f4*)d_ = (f4){bflo(rv[st_][0]), bfhi(rv[st_][0]), bflo(rv[st_][1]), bfhi(rv[st_][1])}; *(f4*)(d_ + 4) = (f4){bflo(rv[st_][2]), bfhi(rv[st_][2]), bflo(rv[st_][3]), bfhi(rv[st_][3])}; } } while (0)
    LIN_ISSUE(0, 0);
    LIN_FINISH(0);
    LIN_ISSUE(TB, 1);
    __syncthreads();
#pragma unroll 1
    for (int blk2 = 0; blk2 < NBLK; blk2 += 2) {
#pragma unroll
      for (int par = 0; par < 2; ++par) {
        const int blk = blk2 + par;
        const int t0 = blk * TB;
        if (blk + 2 < NBLK) LIN_ISSUE(t0 + 2 * TB, par);
        f4 qa[2][4], ka[2][4]; float va[2], kda[2], qda[2]; f2 sca[2];
#define LIN_LOADOPS(slot_, s_) do { const float* qs_ = qk + (s_) * 256 + 16 * w; \
            _Pragma("unroll") for (int g_ = 0; g_ < 4; ++g_) { qa[slot_][g_] = *(const f4*)(qs_ + 4 * g_); ka[slot_][g_] = *(const f4*)(qs_ + 128 + 4 * g_); } \
            va[slot_] = vv[(s_) * 64 + lane]; \
            if (MIX == 1) { sca[slot_] = *(const f2*)(scall + 2 * (t0 + (s_))); kda[slot_] = qs_[128 + (lane & 15)]; qda[slot_] = qs_[lane & 15]; } } while (0)
        LIN_LOADOPS(0, 0);
#pragma unroll 1
        for (int sg = 0; sg < TB; sg += 4) {
#pragma unroll
            for (int ss = 0; ss < 4; ++ss) {
                const int s = sg + ss, cur = ss & 1, nxt = cur ^ 1;
                LIN_LOADOPS(nxt, (s + 1) & (TB - 1));
                __builtin_amdgcn_sched_barrier(0);
                f2 qq[8], kk[8];
#pragma unroll
                for (int g = 0; g < 4; ++g) { qq[2 * g] = qa[cur][g].xy; qq[2 * g + 1] = qa[cur][g].zw; kk[2 * g] = ka[cur][g].xy; kk[2 * g + 1] = ka[cur][g].zw; }
                const float v = va[cur];
                f2 oa = (f2){0.f, 0.f}, ob = (f2){0.f, 0.f};
                if (MIX == 1) {
                    const float fp = sca[cur].x, ip = sca[cur].y, iv = ip * v;
                    const f2 f2v = (f2){fp, fp}, iv2 = (f2){iv, iv};
#pragma unroll
                    for (int i = 0; i < 8; i += 2) { S2[i] = S2[i] * f2v + kk[i] * iv2; S2[i + 1] = S2[i + 1] * f2v + kk[i + 1] * iv2; oa = qq[i] * S2[i] + oa; ob = qq[i + 1] * S2[i + 1] + ob; }
                    nn = fp * nn + ip * kda[cur];
                    denp[s * 128 + 16 * w + (lane & 15)] = qda[cur] * nn;
                } else {
                    const f2 v2 = (f2){v, v};
#pragma unroll
                    for (int i = 0; i < 8; i += 2) { S2[i] = kk[i] * (S2[i] - v2) + v2; S2[i + 1] = kk[i + 1] * (S2[i + 1] - v2) + v2; oa = qq[i] * S2[i] + oa; ob = qq[i + 1] * S2[i + 1] + ob; }
                }
                oa = oa + ob;
                opart[(s * 8 + w) * 64 + lane] = oa.x + oa.y;
            }
        }
#undef LIN_LOADOPS
        __syncthreads();
        { const int s = tid >> 5, e2 = (tid & 31) * 2; f2 acc2 = (f2){0.f, 0.f};
#pragma unroll
            for (int ww = 0; ww < 8; ++ww) acc2 = acc2 + *(const f2*)(opart + (s * 8 + ww) * 64 + e2);
            const int s2 = s + 16; f2 acc3 = (f2){0.f, 0.f};
#pragma unroll
            for (int ww = 0; ww < 8; ++ww) acc3 = acc3 + *(const f2*)(opart + (s2 * 8 + ww) * 64 + e2);
            *(unsigned*)(outp + (rb + t0 + s) * 512 + h * 128 + cgp * 64 + e2) = pg8::cvt_pk_bf16(acc2.x, acc2.y);
            *(unsigned*)(outp + (rb + t0 + s2) * 512 + h * 128 + cgp * 64 + e2) = pg8::cvt_pk_bf16(acc3.x, acc3.y); }
        if (MIX == 1 && cgp == 0) { const int sr = tid >> 4, jl = tid & 15; const f4 a0 = *(const f4*)(denp + sr * 128 + 8 * jl), a1 = *(const f4*)(denp + sr * 128 + 8 * jl + 4);
            const float d = grp_sum16((a0.x + a0.y) + (a0.z + a0.w) + (a1.x + a1.y) + (a1.z + a1.w));
            if (jl == 0) ((float*)(PWS + W_DEN))[(rb + t0 + sr) * 4 + h] = d; }
        if (blk + 1 < NBLK) LIN_FINISH(par ^ 1);
        __syncthreads();
      }
    }
#undef LIN_ISSUE
#undef LIN_FINISH
    const size_t sidx = ((size_t)(l * NBP + b) * NH + h);
    float* So = POUT + (MIX == 1 ? O_P_MC : O_P_HS) + sidx * 16384;
#pragma unroll
    for (int i = 0; i < 8; ++i) { So[(size_t)(16 * w + 2 * i) * 128 + cgp * 64 + lane] = S2[i].x; So[(size_t)(16 * w + 2 * i + 1) * 128 + cgp * 64 + lane] = S2[i].y; }
    if (MIX == 1 && cgp == 0) {
        if (lane < 16) POUT[O_P_MN + sidx * 128 + 16 * w + lane] = nn;
        if (tid == 64) POUT[O_P_MM + sidx] = mfinal;
    }
    __syncthreads();
}

__device__ __forceinline__ void scan_sample_item(const Params& p, int l, int mix, int b, int h, float* sm) {
    int tid_ = threadIdx.x; asm volatile("" : "+v"(tid_)); const int tid = tid_, lane = tid & 63, w = tid >> 6, e = tid & 127, dg = tid >> 7;
    float* qk = sm; float* vv = sm + 1024; float* gs = sm + 1536; float* red = sm + 1600; float* dpart = sm + 1600 + 4096;
    const bf16_t* proj = (const bf16_t*)(PWS + W_PROJ);
    const float* gates = (const float*)(PWS + W_GATES);
    bf16_t* outp = (bf16_t*)(PWS + W_OUTS) + (size_t)mix * MT * 512;
    const size_t rs = (size_t)MP + (size_t)b * SSEQ;
    const size_t sidx = ((size_t)(l * NBS + b) * NH + h);
    const float* Sin = (mix == 0 ? PIN(I_SGS) : (mix == 1 ? PIN(I_SMC) : PIN(I_SHS))) + sidx * 16384;
    float S[32];
#pragma unroll
    for (int i = 0; i < 32; ++i) S[i] = Sin[(size_t)(32 * dg + i) * 128 + e];
    __syncthreads();
    for (int idx = tid; idx < 4 * 384; idx += 512) { const int s = idx / 384, ch = idx - s * 384; float val;
        if (mix == 0) { val = ch < 256 ? bf2f(((const bf16_t*)(PWS + W_HBF))[(rs + s) * 1024 + (ch >> 7) * 512 + h * 128 + (ch & 127)]) : bf2f(outp[(rs + s) * 512 + h * 128 + (ch - 256)]);
        } else if (mix == 1) { const int colx = 2048 + (ch >> 7) * 512 + h * 128 + (ch & 127); val = bf2f(proj[(rs + s) * N1 + colx]); }
        else { const int colx = 4096 + (ch >> 7) * 512 + h * 128 + (ch & 127); val = bf2f(proj[(rs + s) * N1 + colx]);
            if (ch >= 128 && ch < 256) { float lbv = 0.f; if (l > 0) { const float* hl = PIN(I_HLB); const int cc = h * 128 + (ch & 127); lbv = sigm(hl[512 + cc] - hl[cc]); } val = lbv + (1.f - lbv) * sigm(val); } }
        if (ch < 256) qk[s * 256 + ch] = val; else vv[s * 128 + ch - 256] = val; }
    if (tid < 4) { const size_t r = rs + tid;
        if (mix == 0) { gs[tid * 4] = gates[r * 16 + h]; gs[tid * 4 + 1] = gates[r * 16 + 4 + h]; }
        else if (mix == 1) { gs[tid * 4] = gates[r * 16 + 8 + h]; gs[tid * 4 + 1] = gates[r * 16 + 12 + h]; } }
    __syncthreads();
    float m = 0.f, nn = 0.f, mts[4] = {0.f, 0.f, 0.f, 0.f};
    if (mix == 1) { m = PIN(I_SMM)[sidx]; if (dg == 0) nn = PIN(I_SMN)[sidx * 128 + e]; }
#pragma unroll
    for (int s = 0; s < 4; ++s) {
        const float* qs = qk + s * 256 + 32 * dg; const float* ksp = qs + 128;
        const float v = vv[s * 128 + e];
        float po = 0.f;
        if (mix == 0) {
            const float beta = gs[s * 4], a = gs[s * 4 + 1];
            float pk = 0.f;
#pragma unroll
            for (int i = 0; i < 32; ++i) pk += ksp[i] * S[i];
            red[((s * 2) * 4 + dg) * 128 + e] = pk;
            __syncthreads();
            const float ks = red[((s * 2) * 4 + 0) * 128 + e] + red[((s * 2) * 4 + 1) * 128 + e] + red[((s * 2) * 4 + 2) * 128 + e] + red[((s * 2) * 4 + 3) * 128 + e];
            const float u = beta * (v - a * ks);
#pragma unroll
            for (int i = 0; i < 32; ++i) { S[i] = a * S[i] + ksp[i] * u; po += qs[i] * S[i]; }
        } else if (mix == 1) {
            const float ig = gs[s * 4], lf = gs[s * 4 + 1]; const float mn = fmaxf(lf + m, ig); const float fp = __expf(lf + m - mn), ip = __expf(ig - mn) * QSCALE; m = mn; mts[s] = mn;
            const float iv = ip * v;
#pragma unroll
            for (int i = 0; i < 32; ++i) { S[i] = fp * S[i] + ksp[i] * iv; po += qs[i] * S[i]; }
            if (dg == 0) { nn = fp * nn + ip * qk[s * 256 + 128 + e]; const float dp = wave_sum(qk[s * 256 + e] * nn); if (lane == 0) dpart[s * 2 + w] = dp; }
        } else {
#pragma unroll
            for (int i = 0; i < 32; ++i) { S[i] = ksp[i] * (S[i] - v) + v; po += qs[i] * S[i]; }
        }
        red[((s * 2 + 1) * 4 + dg) * 128 + e] = po;
    }
    __syncthreads();
    if (tid < 128) {
#pragma unroll
        for (int s = 0; s < 4; ++s) { const float o = red[((s * 2 + 1) * 4 + 0) * 128 + e] + red[((s * 2 + 1) * 4 + 1) * 128 + e] + red[((s * 2 + 1) * 4 + 2) * 128 + e] + red[((s * 2 + 1) * 4 + 3) * 128 + e];
            outp[(rs + s) * 512 + h * 128 + e] = f2bf(o); } }
    if (mix == 1 && tid == 0) {
#pragma unroll
        for (int s = 0; s < 4; ++s) { ((float*)(PWS + W_DEN))[(rs + s) * 4 + h] = dpart[s * 2] + dpart[s * 2 + 1]; ((float*)(PWS + W_MT))[(rs + s) * 4 + h] = mts[s]; }
        POUT[O_S_MM + sidx] = m; }
    float* So = POUT + (mix == 0 ? O_S_GS : (mix == 1 ? O_S_MC : O_S_HS)) + sidx * 16384;
#pragma unroll
    for (int i = 0; i < 32; ++i) So[(size_t)(32 * dg + i) * 128 + e] = S[i];
    if (mix == 1 && dg == 0) POUT[O_S_MN + sidx * 128 + e] = nn;
}

__device__ __forceinline__ void scan_sample_all(const Params& p, int l, float* sm) {
    int tid_ = threadIdx.x; asm volatile("" : "+v"(tid_)); const int tid = tid_, lane = tid & 63, w = tid >> 6, e = tid & 127, dg = tid >> 7;
    float* qk = sm; float* vv = sm + 1024; float* gs = sm + 1536; float* red = sm + 1600; float* dpart = sm + 1600 + 4096; volatile int* qslot = (volatile int*)(sm + 5760);
    float* simg = sm + 6144;
    PG8_LAS unsigned char* simg_l = (PG8_LAS unsigned char*)simg;
    const bf16_t* proj = (const bf16_t*)(PWS + W_PROJ); const bf16_t* hbf = (const bf16_t*)(PWS + W_HBF);
    const float* gates = (const float*)(PWS + W_GATES);
    bf16_t* outs = (bf16_t*)(PWS + W_OUTS);
    unsigned* qctr = (unsigned*)(PWS + W_BAR) + 64 * l;
    constexpr int NIT = 3 * NBS * NH;
    const float* hl = PIN(I_HLB);
    __syncthreads();
    if (tid == 0) { qslot[0] = (int)__hip_atomic_fetch_add(qctr, 1u, __ATOMIC_RELAXED, __HIP_MEMORY_SCOPE_AGENT); qslot[1] = (int)__hip_atomic_fetch_add(qctr, 1u, __ATOMIC_RELAXED, __HIP_MEMORY_SCOPE_AGENT); }
    __syncthreads();
    int it0 = qslot[0], it1 = qslot[1];
    float stg[3], gn0 = 0.f, gn1 = 0.f, mn_in = 0.f, nn_in = 0.f;
    stg[0] = stg[1] = stg[2] = 0.f;
#define SMP_ISSUE(it_) do { const int mix_ = (it_) / (NBS * NH), r_ = (it_) - mix_ * (NBS * NH), b_ = r_ >> 2, h_ = r_ & 3; \
        const size_t sidx_ = ((size_t)(l * NBS + b_) * NH + h_), rs_ = (size_t)MP + (size_t)b_ * SSEQ; \
        const float* Sin_ = (mix_ == 0 ? PIN(I_SGS) : (mix_ == 1 ? PIN(I_SMC) : PIN(I_SHS))) + sidx_ * 16384; \
        _Pragma("unroll") for (int k_ = 0; k_ < 8; ++k_) __builtin_amdgcn_global_load_lds((const unsigned*)((const char*)Sin_ + (size_t)((w * 8 + k_) * 1024 + lane * 16)), (PG8_LAS unsigned*)(simg_l + (w * 8 + k_) * 1024), 16, 0, 0); \
        int tq_ = tid; asm volatile("" : "+v"(tq_)); \
        _Pragma("unroll") for (int k_ = 0; k_ < 3; ++k_) { const int idx_ = tq_ + 512 * k_, s_ = idx_ / 384, ch_ = idx_ - s_ * 384; unsigned short raw_; \
            if (mix_ == 0) raw_ = ch_ < 256 ? hbf[(rs_ + s_) * 1024 + (ch_ >> 7) * 512 + h_ * 128 + (ch_ & 127)] : outs[(rs_ + s_) * 512 + h_ * 128 + (ch_ - 256)]; \
            else raw_ = proj[(rs_ + s_) * N1 + (mix_ == 1 ? 2048 : 4096) + (ch_ >> 7) * 512 + h_ * 128 + (ch_ & 127)]; \
            stg[k_] = bf2f(raw_); } \
        if (tid < 4 && mix_ != 2) { const size_t rr_ = rs_ + tid; gn0 = gates[rr_ * 16 + (mix_ == 0 ? 0 : 8) + h_]; gn1 = gates[rr_ * 16 + (mix_ == 0 ? 4 : 12) + h_]; } \
        if (mix_ == 1) { mn_in = PIN(I_SMM)[sidx_]; if (dg == 0) nn_in = PIN(I_SMN)[sidx_ * 128 + e]; } } while (0)
    if (it0 < NIT) SMP_ISSUE(it0);
    while (it0 < NIT) {
#ifdef TPROBE_ITEM
        const unsigned long long tst_ = __builtin_amdgcn_s_memrealtime();
#endif
        const int mix = it0 / (NBS * NH), r = it0 - mix * (NBS * NH), b = r >> 2, h = r & 3;
        const size_t sidx = ((size_t)(l * NBS + b) * NH + h), rs = (size_t)MP + (size_t)b * SSEQ;
        bf16_t* outp = outs + (size_t)mix * MT * 512;
        asm volatile("s_waitcnt vmcnt(0)" ::: "memory");
        lds_barrier();
        float S[32];
#pragma unroll
        for (int i = 0; i < 32; ++i) S[i] = simg[(32 * dg + i) * 128 + e];
        float m = mn_in, nn = nn_in;
#pragma unroll
        for (int k = 0; k < 3; ++k) { const int idx = tid + 512 * k, s = idx / 384, ch = idx - s * 384; float val = stg[k];
            if (mix == 2 && ch >= 128 && ch < 256) { float lbv = 0.f; if (l > 0) { const int cc = h * 128 + (ch & 127); lbv = sigm(hl[512 + cc] - hl[cc]); } val = lbv + (1.f - lbv) * sigm(val); }
            if (ch < 256) qk[s * 256 + ch] = val; else vv[s * 128 + ch - 256] = val; }
        if (tid < 4 && mix != 2) { gs[tid * 4] = gn0; gs[tid * 4 + 1] = gn1; }
        int it2 = NIT;
        if (tid == 0) it2 = (int)__hip_atomic_fetch_add(qctr, 1u, __ATOMIC_RELAXED, __HIP_MEMORY_SCOPE_AGENT);
        lds_barrier();
        if (it1 < NIT) SMP_ISSUE(it1);
#pragma unroll 1
        for (int s = 0; s < 4; ++s) {
            const float* qs = qk + s * 256 + 32 * dg; const float* ksp = qs + 128;
            const float v = vv[s * 128 + e];
            float po = 0.f;
            if (mix == 0) {
                const float beta = gs[s * 4], a = gs[s * 4 + 1];
                float pk = 0.f;
#pragma unroll
                for (int c4 = 0; c4 < 4; ++c4) {
#pragma unroll
                    for (int i = 8 * c4; i < 8 * c4 + 8; ++i) pk += ksp[i] * S[i];
                    __builtin_amdgcn_sched_barrier(0); }
                red[((s * 2) * 4 + dg) * 128 + e] = pk;
                lds_barrier();
                const float ks = red[((s * 2) * 4 + 0) * 128 + e] + red[((s * 2) * 4 + 1) * 128 + e] + red[((s * 2) * 4 + 2) * 128 + e] + red[((s * 2) * 4 + 3) * 128 + e];
                const float u = beta * (v - a * ks);
#pragma unroll
                for (int c4 = 0; c4 < 4; ++c4) {
#pragma unroll
                    for (int i = 8 * c4; i < 8 * c4 + 8; ++i) { S[i] = a * S[i] + ksp[i] * u; po += qs[i] * S[i]; }
                    __builtin_amdgcn_sched_barrier(0); }
            } else if (mix == 1) {
                const float ig = gs[s * 4], lf = gs[s * 4 + 1]; const float mn = fmaxf(lf + m, ig); const float fp = __expf(lf + m - mn), ip = __expf(ig - mn) * QSCALE; m = mn; if (tid == 0) ((float*)(PWS + W_MT))[(rs + s) * 4 + h] = mn;
                const float iv = ip * v;
#pragma unroll
                for (int c4 = 0; c4 < 4; ++c4) {
#pragma unroll
                    for (int i = 8 * c4; i < 8 * c4 + 8; ++i) { S[i] = fp * S[i] + ksp[i] * iv; po += qs[i] * S[i]; }
                    __builtin_amdgcn_sched_barrier(0); }
                if (dg == 0) { nn = fp * nn + ip * qk[s * 256 + 128 + e]; const float dp = wave_sum(qk[s * 256 + e] * nn); if (lane == 0) dpart[s * 2 + w] = dp; }
            } else {
#pragma unroll
                for (int c4 = 0; c4 < 4; ++c4) {
#pragma unroll
                    for (int i = 8 * c4; i < 8 * c4 + 8; ++i) { S[i] = ksp[i] * (S[i] - v) + v; po += qs[i] * S[i]; }
                    __builtin_amdgcn_sched_barrier(0); }
            }
            red[((s * 2 + 1) * 4 + dg) * 128 + e] = po;
        }
        if (tid == 0) qslot[0] = it2;
        lds_barrier();
        if (tid < 128) {
#pragma unroll
            for (int s = 0; s < 4; ++s) { const float o = red[((s * 2 + 1) * 4 + 0) * 128 + e] + red[((s * 2 + 1) * 4 + 1) * 128 + e] + red[((s * 2 + 1) * 4 + 2) * 128 + e] + red[((s * 2 + 1) * 4 + 3) * 128 + e];
                outp[(rs + s) * 512 + h * 128 + e] = f2bf(o); } }
        if (mix == 1 && tid == 0) {
#pragma unroll
            for (int s = 0; s < 4; ++s) { ((float*)(PWS + W_DEN))[(rs + s) * 4 + h] = dpart[s * 2] + dpart[s * 2 + 1]; }
            POUT[O_S_MM + sidx] = m; }
        float* So = POUT + (mix == 0 ? O_S_GS : (mix == 1 ? O_S_MC : O_S_HS)) + sidx * 16384;
#ifndef DUPST
#define DUPST 1
#endif
        for (int rst = 0; rst < DUPST; ++rst) {
#pragma unroll
        for (int i = 0; i < 32; ++i) So[(size_t)(32 * dg + i) * 128 + e] = S[i];
        if (DUPST > 1) { asm volatile("s_waitcnt vmcnt(0)" ::: "memory"); } }
        if (mix == 1 && dg == 0) POUT[O_S_MN + sidx * 128 + e] = nn;
        it0 = it1; it1 = qslot[0];
        lds_barrier();
#ifdef TPROBE_ITEM
        if (blockIdx.x == TPROBE_WG && threadIdx.x == 0) { volatile unsigned long long* sp_ = (volatile unsigned long long*)((unsigned char*)sm + LDS_MAIN + 64); sp_[40] += __builtin_amdgcn_s_memrealtime() - tst_; sp_[41] += 1; }
#endif
    }
#undef SMP_ISSUE
}
__device__ __forceinline__ void phase_postnorm(const Params& p, int l) {
    int tid_ = threadIdx.x; asm volatile("" : "+v"(tid_)); const int tid = tid_, j = tid & 15;
    bf16_t* outs = (bf16_t*)(PWS + W_OUTS);
    const bf16_t* proj = (const bf16_t*)(PWS + W_PROJ);
    const float* den = (const float*)(PWS + W_DEN); const float* mt = (const float*)(PWS + W_MT);
    const int ngroups = MT * 12, half = ngroups / 2;
    for (int gid0 = bidx() * 32 + (tid >> 4); gid0 < half; gid0 += gdim() * 32) {
        u32x4_t raw[2], gr[2]; float dnv[2], mtv[2]; float4 n0[2], n1[2]; bf16_t* opp[2]; int mixk[2];
#pragma unroll
        for (int k = 0; k < 2; ++k) { const int gid = gid0 + k * half;
            const int r = gid / 12, mh = gid - r * 12, mix = mh >> 2, h = mh & 3; mixk[k] = mix;
            opp[k] = outs + (size_t)mix * MT * 512 + (size_t)r * 512 + h * 128 + 8 * j;
            raw[k] = *(const u32x4_t*)opp[k];
            const int gcol = (mix == 0 ? 1536 : (mix == 1 ? 3584 : 5632)) + h * 128 + 8 * j;
            gr[k] = *(const u32x4_t*)(proj + (size_t)r * N1 + gcol);
            dnv[k] = den[(size_t)r * 4 + h]; mtv[k] = mt[(size_t)r * 4 + h];
            const float* nw = (mix == 0 ? PIN(I_GNORM) : (mix == 1 ? PIN(I_MNORM) : PIN(I_HNORM))) + l * 512 + h * 128 + 8 * j;
            n0[k] = *(const float4*)nw; n1[k] = *(const float4*)(nw + 4); }
#pragma unroll
        for (int k = 0; k < 2; ++k) {
            float v[8];
#pragma unroll
            for (int i = 0; i < 4; ++i) { v[2 * i] = bflo(raw[k][i]); v[2 * i + 1] = bfhi(raw[k][i]); }
            if (mixk[k] == 1) { const float dn = fmaxf(fabsf(dnv[k]), __expf(-mtv[k])); const float inv = 1.f / dn;
#pragma unroll
                for (int i = 0; i < 8; ++i) v[i] *= inv; }
            float ss = 0.f;
#pragma unroll
            for (int i = 0; i < 8; ++i) ss += v[i] * v[i];
            ss = grp_sum16(ss);
            const float rstd = rsqrtf(ss * (1.f / 128.f) + EPS);
            const float nwv[8] = {n0[k].x, n0[k].y, n0[k].z, n0[k].w, n1[k].x, n1[k].y, n1[k].z, n1[k].w};
#pragma unroll
            for (int i = 0; i < 4; ++i) { v[2 * i] *= rstd * nwv[2 * i] * bflo(gr[k][i]); v[2 * i + 1] *= rstd * nwv[2 * i + 1] * bfhi(gr[k][i]); }
            u32x4_t o; o[0] = pg8::cvt_pk_bf16(v[0], v[1]); o[1] = pg8::cvt_pk_bf16(v[2], v[3]); o[2] = pg8::cvt_pk_bf16(v[4], v[5]); o[3] = pg8::cvt_pk_bf16(v[6], v[7]);
            *(u32x4_t*)opp[k] = o; }
    }
    const int ncs = (NBP + NBS) * 3 * 1536;
    for (int i = bidx() * 512 + tid; i < ncs; i += gdim() * 512) {
        const int cc = i % 1536, ri = (i / 1536) % 3, bb = i / (3 * 1536);
        if (bb < NBP) POUT[O_P_GC + ((size_t)(l * NBP + bb) * 3 + ri) * 1536 + cc] = bf2f(proj[((size_t)bb * SEQ + SEQ - 3 + ri) * N1 + cc]);
        else { const int b2 = bb - NBP; POUT[O_S_GC + ((size_t)(l * NBS + b2) * 3 + ri) * 1536 + cc] = bf2f(proj[((size_t)MP + (size_t)b2 * SSEQ + 1 + ri) * N1 + cc]); }
    }
}

__device__ __forceinline__ void phase_convffn(const Params& p, int l) {
    int tid_ = threadIdx.x; asm volatile("" : "+v"(tid_)); const int tid = tid_;
    const bf16_t* u = (const bf16_t*)(PWS + W_PROJ);
    bf16_t* act = (bf16_t*)(PWS + W_ACT);
    const float* cw = PIN(I_FCW) + (size_t)l * 3 * NUP; const float* cb = PIN(I_FCB) + (size_t)l * NUP;
    const int nitems = (MT / 4) * (DFF / 8);
    for (int it = bidx() * 512 + tid; it < nitems; it += gdim() * 512) {
        const int jg = it % (DFF / 8), rbk = it / (DFF / 8), r0 = rbk * 4, jc = jg * 8;
        const bool samp = r0 >= MP; const int tf = samp ? 0 : (r0 & (SEQ - 1));
        float wa[3][8], wb[3][8], ba[8], bb[8];
#pragma unroll
        for (int i = 0; i < 3; ++i) { const float4 a0 = *(const float4*)(cw + i * NUP + jc), a1 = *(const float4*)(cw + i * NUP + jc + 4), b0 = *(const float4*)(cw + i * NUP + DFF + jc), b1 = *(const float4*)(cw + i * NUP + DFF + jc + 4);
            wa[i][0] = a0.x; wa[i][1] = a0.y; wa[i][2] = a0.z; wa[i][3] = a0.w; wa[i][4] = a1.x; wa[i][5] = a1.y; wa[i][6] = a1.z; wa[i][7] = a1.w;
            wb[i][0] = b0.x; wb[i][1] = b0.y; wb[i][2] = b0.z; wb[i][3] = b0.w; wb[i][4] = b1.x; wb[i][5] = b1.y; wb[i][6] = b1.z; wb[i][7] = b1.w; }
        { const float4 a0 = *(const float4*)(cb + jc), a1 = *(const float4*)(cb + jc + 4), b0 = *(const float4*)(cb + DFF + jc), b1 = *(const float4*)(cb + DFF + jc + 4);
            ba[0] = a0.x; ba[1] = a0.y; ba[2] = a0.z; ba[3] = a0.w; ba[4] = a1.x; ba[5] = a1.y; ba[6] = a1.z; ba[7] = a1.w;
            bb[0] = b0.x; bb[1] = b0.y; bb[2] = b0.z; bb[3] = b0.w; bb[4] = b1.x; bb[5] = b1.y; bb[6] = b1.z; bb[7] = b1.w; }
        float xa[6][8], xb[6][8];
#pragma unroll
        for (int rr = 0; rr < 6; ++rr) {
            if (rr < 2 && tf == 0) {
                if (samp) { const float* st = PIN(I_SFC) + ((size_t)(l * NBS + (r0 - MP) / 4) * 2 + rr) * NUP;
#pragma unroll
                    for (int i = 0; i < 8; ++i) { xa[rr][i] = st[jc + i]; xb[rr][i] = st[DFF + jc + i]; } }
                else {
#pragma unroll
                    for (int i = 0; i < 8; ++i) { xa[rr][i] = 0.f; xb[rr][i] = 0.f; } }
            } else { const bf16_t* ur = u + (size_t)(r0 - 2 + rr) * NUP; const u32x4_t ra = *(const u32x4_t*)(ur + jc), rbv = *(const u32x4_t*)(ur + DFF + jc);
#pragma unroll
                for (int i = 0; i < 4; ++i) { xa[rr][2 * i] = bflo(ra[i]); xa[rr][2 * i + 1] = bfhi(ra[i]); xb[rr][2 * i] = bflo(rbv[i]); xb[rr][2 * i + 1] = bfhi(rbv[i]); } }
        }
#pragma unroll
        for (int t = 0; t < 4; ++t) { float o[8];
#pragma unroll
            for (int i = 0; i < 8; ++i) { const float ya = wa[0][i] * xa[t][i] + wa[1][i] * xa[t + 1][i] + wa[2][i] * xa[t + 2][i] + ba[i]; const float yb = wb[0][i] * xb[t][i] + wb[1][i] * xb[t + 1][i] + wb[2][i] * xb[t + 2][i] + bb[i]; o[i] = silu(ya) * yb; }
            u32x4_t ov; ov[0] = pg8::cvt_pk_bf16(o[0], o[1]); ov[1] = pg8::cvt_pk_bf16(o[2], o[3]); ov[2] = pg8::cvt_pk_bf16(o[4], o[5]); ov[3] = pg8::cvt_pk_bf16(o[6], o[7]);
            *(u32x4_t*)(act + (size_t)(r0 + t) * DFF + jc) = ov; }
        if (samp || tf == SEQ - 4) {
            float* dst = samp ? POUT + O_S_FC + (size_t)(l * NBS + (r0 - MP) / 4) * 2 * NUP : POUT + O_P_FC + (size_t)(l * NBP + r0 / SEQ) * 2 * NUP;
#pragma unroll
            for (int rr = 0; rr < 2; ++rr)
#pragma unroll
                for (int i = 0; i < 8; ++i) { dst[(size_t)rr * NUP + jc + i] = xa[4 + rr][i]; dst[(size_t)rr * NUP + DFF + jc + i] = xb[4 + rr][i]; }
        }
    }
}

__device__ __forceinline__ void phase_final_norm(const Params& p) {
    int tid_ = threadIdx.x; asm volatile("" : "+v"(tid_)); const int tid = tid_, lane = tid & 63, w = tid >> 6;
    const float* gw = PIN(I_LNF);
    float4 g4[4];
#pragma unroll
    for (int i = 0; i < 4; ++i) g4[i] = *(const float4*)(gw + lane * 4 + 256 * i);
    for (int row = bidx() * 8 + w; row < MT; row += gdim() * 8) {
        float* xr = POUT + (size_t)row * DM; float4 v[4]; float ss = 0.f;
#pragma unroll
        for (int i = 0; i < 4; ++i) { v[i] = *(const float4*)(xr + lane * 4 + 256 * i); ss += v[i].x * v[i].x + v[i].y * v[i].y + v[i].z * v[i].z + v[i].w * v[i].w; }
        ss = wave_sum(ss); const float rstd = rsqrtf(ss * (1.f / 1024.f) + EPS);
#pragma unroll
        for (int i = 0; i < 4; ++i) { v[i].x *= rstd * g4[i].x; v[i].y *= rstd * g4[i].y; v[i].z *= rstd * g4[i].z; v[i].w *= rstd * g4[i].w; *(float4*)(xr + lane * 4 + 256 * i) = v[i]; }
    }
}

#ifndef PHM
#define PHM 0xFFFF
#endif
#ifndef DUPB
#define DUPB 1
#endif
#ifndef DUPC
#define DUPC 1
#endif
#ifndef DUPS
#define DUPS 1
#endif
#ifndef DUPH
#define DUPH 1
#endif
#ifndef DUPY
#define DUPY 1
#endif
#ifndef DUPA
#define DUPA 1
#endif
#ifndef DUPI
#define DUPI 1
#endif
#define GSYNC() do { for (int y_ = 0; y_ < DUPY; ++y_) xcd_barrier(xb); } while (0)
__global__ void __launch_bounds__(512, 2) fwd_megakernel(Params p) {
    extern __shared__ __attribute__((aligned(16))) unsigned char shm[];
    cg::grid_group grid = cg::this_grid();
    float* smf = (float*)shm;
    PG8_LAS unsigned char* lds = (PG8_LAS unsigned char*)shm;
    int tid_ = threadIdx.x; asm volatile("" : "+v"(tid_)); const int tid = tid_;
    float* X = POUT;
    volatile XLAS unsigned* xst = (volatile XLAS unsigned*)(lds + LDS_MAIN);
    if (tid == 0) { xst[0] = 0u; xst[1] = 0u; xst[2] = 0u; xst[3] = 0u; }
    __syncthreads();
    XcdBarrier xb = xcd_barrier_post((unsigned*)(PWS + W_BAR), xst);
#ifdef TPROBE1
    volatile XLAS unsigned long long* stp = (volatile XLAS unsigned long long*)(lds + LDS_MAIN + 64);
    int nst = 0;
#define STAMP() do { if (blockIdx.x == TPROBE_WG && threadIdx.x == 0) stp[nst] = __builtin_amdgcn_s_memrealtime(); ++nst; } while (0)
#else
#define STAMP() do {} while (0)
#endif
    STAMP();
#ifdef TPROBE_ITEM
    if (blockIdx.x == TPROBE_WG && threadIdx.x == 0) { stp[40] = 0; stp[41] = 0; }
#endif
    bf16_t* hbf = (bf16_t*)(PWS + W_HBF);
    bf16_t* proj = (bf16_t*)(PWS + W_PROJ);

    for (int l = 0; l < 2; ++l) {
        const int G = gdim(), bid = bidx();
        for (int repa = 0; repa < DUPA; ++repa) { if (PHM & 1) { int tc = 0;
          conv_T(PIN(I_WIN) + (size_t)l * 1024 * NIN, NIN, (bf16_t*)(PWS + W_WIN), 1024, N1, true, smf, tc);
          for (int n = 0; n < 3; ++n) conv_T(PIN(I_WBR) + ((size_t)l * 3 + n) * 512 * 1024, 1024, (bf16_t*)(PWS + W_WBR) + (size_t)n * 1024 * 512, 512, 1024, false, smf, tc);
          conv_T(PIN(I_WOUT) + (size_t)l * 1024 * 1024, 1024, (bf16_t*)(PWS + W_WOUT), 1024, 1024, false, smf, tc);
          conv_T(PIN(I_WUP) + (size_t)l * 1024 * NUP, NUP, (bf16_t*)(PWS + W_WUP), 1024, NUP, false, smf, tc);
          conv_T(PIN(I_WDN) + (size_t)l * DFF * 1024, 1024, (bf16_t*)(PWS + W_WDN), DFF, 1024, false, smf, tc);
          __syncthreads(); }
        if (PHM & 2) {
        if (l == 0) { int tq_ = threadIdx.x; asm volatile("" : "+v"(tq_)); const float4* s1 = (const float4*)PIN(I_XS); float4* d1 = (float4*)(X + (size_t)MP * DM);
            for (int i = bid * 512 + tq_; i < MS * DM / 4; i += G * 512) d1[i] = s1[i]; }
        phase_rmsnorm(p, l, l == 0 ? PIN(I_XP) : X, l == 0 ? PIN(I_XS) : X + (size_t)MP * DM, PIN(I_LNMIX) + l * DM, hbf, true, smf); } }
        if (PWS == nullptr) grid.sync();
        GSYNC();
        STAMP();
        for (int rep = 0; rep < DUPB; ++rep) { pg8::Gemm g{hbf, (const bf16_t*)(PWS + W_WIN), MT, N1, 1024, 1024}; pg8::StaticOrder S; S.init(MT, N1, G, bid); EpiProj E{proj, N1, 1}; pg8::gemm_phase(lds, g, S, E); }
        GSYNC(); STAMP();
        phase_gdnprep(p, l);
        GSYNC(); STAMP();
#ifdef TPROBE_MAX
        const unsigned long long tb_ = __builtin_amdgcn_s_memrealtime();
#endif
        for (int rep = 0; rep < DUPC; ++rep) for (int it = bid; it < 256; it += G) {
            if (it < 128) scan_prompt_item<0>(p, l, (it >> 2) >> 2, (it >> 2) & 3, it & 3, smf);
            else if (it < 192) { const int q = it - 128; scan_prompt_lin<1>(p, l, (q >> 1) >> 2, (q >> 1) & 3, q & 1, smf); }
            else { const int q = it - 192; scan_prompt_lin<2>(p, l, (q >> 1) >> 2, (q >> 1) & 3, q & 1, smf); }
        }
#ifdef TPROBE_MAX
        if (l == TPROBE_MAX - 1 && threadIdx.x == 0) { const unsigned dt_ = (unsigned)(__builtin_amdgcn_s_memrealtime() - tb_); atomicMax((unsigned*)(PWS + W_BAR) + 32, (dt_ << 8) | (unsigned)blockIdx.x); if (dt_ > 40000u) atomicAdd((unsigned*)(PWS + W_BAR) + 33, 1u); if (dt_ > 30000u) atomicAdd((unsigned*)(PWS + W_BAR) + 34, 1u); if (dt_ > 20000u) atomicAdd((unsigned*)(PWS + W_BAR) + 35, 1u); }
#endif
        STAMP();
#ifdef SEQ_SAMPLE
        GSYNC();
#endif
        scan_sample_all(p, l, smf);
        GSYNC(); STAMP();
        if (PHM & 32) phase_postnorm(p, l);
        GSYNC(); STAMP();
        if (PHM & 64) { pg8::Gemm g{(const bf16_t*)(PWS + W_OUTS), (const bf16_t*)(PWS + W_WBR), 3 * MT, 3 * 1024, 512, 512};
            MergeOrder S; S.init(G, bid); EpiMerge E{proj + 6144, hbf}; pg8::gemm_phase(lds, g, S, E); }
        GSYNC(); STAMP();
        if (PHM & 128) { pg8::Gemm g{hbf, (const bf16_t*)(PWS + W_WOUT), MT, 1024, 1024, 1024}; pg8::StaticOrder S; S.init(MT, 1024, G, bid); EpiResid E{X, l == 0 ? PIN(I_XP) : X, l == 0 ? PIN(I_XS) : X + (size_t)MP * DM}; pg8::gemm_phase(lds, g, S, E); }
        GSYNC(); STAMP();
        if (PHM & 256) phase_rmsnorm(p, l, X, X + (size_t)MP * DM, PIN(I_LNFFN) + l * DM, hbf, false, smf);
        GSYNC(); STAMP();
        for (int rep = 0; rep < DUPH; ++rep) { pg8::Gemm g{hbf, (const bf16_t*)(PWS + W_WUP), MT, NUP, 1024, 1024}; pg8::StaticOrder S; S.init(MT, NUP, G, bid); EpiProj E{proj, NUP, 0}; pg8::gemm_phase(lds, g, S, E); }
        GSYNC(); STAMP();
        for (int repi = 0; repi < DUPI; ++repi) phase_convffn(p, l);
        GSYNC(); STAMP();
        if (PHM & 2048) { { pg8::Gemm g{(const bf16_t*)(PWS + W_ACT), (const bf16_t*)(PWS + W_WDN), MP, 1024, DFF, DFF}; pg8::StaticOrder S; S.init(MP, 1024, G, bid); EpiResid E{X, X, X + (size_t)MP * DM}; pg8::gemm_phase(lds, g, S, E); }
            { pg8::Gemm g{(const bf16_t*)(PWS + W_ACT), (const bf16_t*)(PWS + W_WDN), MT, 1024, DFF / 2, DFF}; PieceOrder S{G, (bid + G / 2) % G, 2}; EpiAtomic E{X}; pg8::gemm_phase(lds, g, S, E); } }
        GSYNC(); STAMP();
    }
    if (PHM & 4096) phase_final_norm(p);
#ifdef TPROBE1
    if (blockIdx.x == TPROBE_WG && threadIdx.x == 0) {
        const int per = (nst - 1) / 2;
        unsigned long long d1 = 0, d2 = 0;
        for (int l2 = 0; l2 < 2; ++l2) { d1 += stp[l2 * per + TPROBE1E] - stp[l2 * per + TPROBE1]; d2 += stp[l2 * per + TPROBE2E] - stp[l2 * per + TPROBE2]; }
        unsigned long long cntcode_ = 0;
        unsigned long long q1 = (d1 + 1000) / 2000, q2 = (d2 + 500) / 1000;
#ifdef TPROBE_MAX
        { const unsigned mx_ = __hip_atomic_load((unsigned*)(PWS + W_BAR) + 32, __ATOMIC_RELAXED, __HIP_MEMORY_SCOPE_AGENT); q1 = ((mx_ >> 8) + 1000) / 2000 * 10 + (mx_ & 255) / 100; q2 = (mx_ & 255) % 100;
#ifdef TPROBE_CNT
          const unsigned c4_ = __hip_atomic_load((unsigned*)(PWS + W_BAR) + 33, __ATOMIC_RELAXED, __HIP_MEMORY_SCOPE_AGENT), c3_ = __hip_atomic_load((unsigned*)(PWS + W_BAR) + 34, __ATOMIC_RELAXED, __HIP_MEMORY_SCOPE_AGENT), c2_ = __hip_atomic_load((unsigned*)(PWS + W_BAR) + 35, __ATOMIC_RELAXED, __HIP_MEMORY_SCOPE_AGENT);
          q1 = 0; q2 = 0; cntcode_ = c4_ * 300 + c3_; (void)c2_;
#endif
 }
#endif
#ifdef TPROBE_ITEM
        q1 = stp[41] ? (stp[40] / stp[41] + 50) / 100 : 0; q2 = stp[41];
#endif if (q2 > 99) q2 = 99;
#ifndef TPROBE_MAX
        if (q1 > 99) q1 = 99;
#endif
        const unsigned long long wait = (q1 * 100 + q2) * 2000ull + cntcode_ * 200ull, t0 = __builtin_amdgcn_s_memrealtime();
        while (__builtin_amdgcn_s_memrealtime() - t0 < wait) __builtin_amdgcn_s_sleep(32);
    }
#endif
}

extern "C" void kernel_launch(void* const* d_in, const int* in_sizes, int n_in, void* d_out, int out_size, void* d_ws, size_t ws_size, hipStream_t stream) {
    static int grid_blocks = 0;
    if (grid_blocks == 0) {
        if (n_in != 28 || (size_t)out_size != O_END || ws_size < W_END) { fprintf(stderr, "kernel_launch: unexpected shapes: n_in %d out %d (want %zu) ws %zu (need %zu)\n", n_in, out_size, (size_t)O_END, ws_size, (size_t)W_END); grid_blocks = -1; return; }
        int dev = 0, cus = 0, per_cu = 0;
        hipGetDevice(&dev); hipDeviceGetAttribute(&cus, hipDeviceAttributeMultiprocessorCount, dev);
        if (hipFuncSetAttribute((const void*)fwd_megakernel, hipFuncAttributeMaxDynamicSharedMemorySize, LDS_BYTES) != hipSuccess) { fprintf(stderr, "kernel_launch: hipFuncSetAttribute failed\n"); grid_blocks = -1; return; }
        if (hipOccupancyMaxActiveBlocksPerMultiprocessor(&per_cu, (const void*)fwd_megakernel, 512, LDS_BYTES) != hipSuccess || per_cu < 1) { fprintf(stderr, "kernel_launch: occupancy query gave %d\n", per_cu); per_cu = 1; (void)hipGetLastError(); }
        grid_blocks = cus * per_cu;
    }
    if (grid_blocks < 0) return;
    if (hipMemsetAsync((unsigned char*)d_ws + W_BAR, 0, XCD_BAR_WORDS * 4, stream) != hipSuccess) { fprintf(stderr, "kernel_launch: memset of barrier words failed\n"); return; }
    Params p{};
    for (int i = 0; i < 28; ++i) p.in[i] = (const float*)d_in[i];
    p.out = (float*)d_out; p.ws = (unsigned char*)d_ws;
    void* args[] = {&p};
    hipError_t e = hipLaunchCooperativeKernel((const void*)fwd_megakernel, dim3(grid_blocks), dim3(512), args, LDS_BYTES, stream);
    if (e != hipSuccess) fprintf(stderr, "kernel_launch: cooperative launch failed: %s (grid %d)\n", hipGetErrorString(e), grid_blocks);
}
```

```cpp
#include <hip/hip_runtime.h>
#include <hip/hip_cooperative_groups.h>
#include <cstdio>
namespace cg = cooperative_groups;
namespace pg8 {
#define PG8_LAS __attribute__((address_space(3)))
typedef unsigned short bf16_t;
typedef short bf16x8 __attribute__((ext_vector_type(8)));
typedef float f32x4 __attribute__((ext_vector_type(4)));
typedef unsigned u32x4 __attribute__((ext_vector_type(4)));
constexpr int BM = 256, BK = 64, HALF = 128, HTB = HALF * BK * 2  , STAGE_BYTES = 8 * HTB, NXCD = 8, WGM = 8;

__host__ __device__ __forceinline__ int lds_byte(int r, int c) { const int st = (r >> 4) * 2 + (c >> 5), rr = r & 15, cc = c & 31, ob = rr * 64 + cc * 2; return st * 1024 + (ob ^ (((ob >> 9) & 1) << 5)); }
__host__ __device__ __forceinline__ void stage_rc(int b, int& R, int& C) { const int st = b / 1024, sb = b % 1024, swz = sb ^ (((sb >> 9) & 1) << 5); R = (st >> 1) * 16 + swz / 64; C = (st & 1) * 32 + (swz % 64) / 2; }
__host__ __device__ __forceinline__ int perm32(int rho) { const int n = rho >> 4, i = rho & 15; return 8 * (i >> 2) + 4 * n + (i & 3); }

struct Unit { int pm, pn, pk; };
struct Gemm { const bf16_t* A; const bf16_t* Bt; int M, N, K, ld; };

struct StaticOrder {
    int nM, nN, nwg, G, c;
    __host__ __device__ void init(int M, int N, int G_, int c_) { nM = M / BM; nN = N / BM; nwg = nM * nN; G = G_; c = c_; }
    __host__ __device__ bool next(int i, Unit& u) const {
        const long L = (long)i * G + c; if (L >= nwg) return false;
        int wgid = (int)L; { const int q = nwg / NXCD, r = nwg % NXCD, xcd = wgid % NXCD, off = wgid / NXCD; wgid = (xcd < r ? xcd * (q + 1) : r * (q + 1) + (xcd - r) * q) + off; }
        const int nig = WGM * nN, gid = wgid / nig, fm = gid * WGM, gsz = (nM - fm) < WGM ? (nM - fm) : WGM;
        u.pm = fm + ((wgid % nig) % gsz); u.pn = (wgid % nig) / gsz; u.pk = 0; return true;
    }
    __device__ __forceinline__ void a_ready(const Unit&) const {}
    __device__ __forceinline__ void done(const Unit&) const {}
};
__device__ __forceinline__ unsigned cvt_pk_bf16(float lo, float hi) { unsigned r; asm volatile("v_cvt_pk_bf16_f32 %0, %1, %2" : "=v"(r) : "v"(lo), "v"(hi)); return r; }
template <class Epi, class Sched>
__device__ __forceinline__ void gemm_phase(PG8_LAS unsigned char* lds, const Gemm g, const Sched& S, const Epi& E) {
    int tid_ = threadIdx.x; asm volatile("" : "+v"(tid_));
    const int tid = tid_, wid = __builtin_amdgcn_readfirstlane(tid >> 6), lane = tid & 63, wr = wid >> 2, wc = wid & 3, fr = lane & 15, fq = lane >> 4;
    const int K = g.K, nt = K / BK, ld = g.ld;
    unsigned voffA[2], voffB[2];
#pragma unroll
    for (int i = 0; i < 2; ++i) { int R, C; stage_rc(tid * 16 + i * 8192, R, C); const int Rb = Epi::PERM ? ((R & ~31) + perm32(R & 31)) : R;
        voffA[i] = (unsigned)(R * ld + C) * 2u; voffB[i] = (unsigned)(Rb * ld + C) * 2u; }
    const size_t kstep = (size_t)(BK * 2);
    const size_t hstep = (size_t)HALF * ld * 2;
    const size_t tstep = 2 * hstep;
    const unsigned ldsw = (unsigned)wid * 1024u;
    const int aoff = lds_byte(wr * 64 + fr, fq * 8), boff = lds_byte(wc * 32 + fr, fq * 8);
#define PG8_SA(b, h) (((b) * 2 + (h)) * HTB)
#define PG8_SB(b, h) ((4 + (b) * 2 + (h)) * HTB)
#define PG8_STAGE(bufoff, gbase, voff) do { _Pragma("unroll") for (int _i = 0; _i < 2; ++_i) \
        __builtin_amdgcn_global_load_lds((const unsigned*)((const char*)(gbase) + (voff)[_i]), (PG8_LAS unsigned*)(lds + (bufoff) + ldsw + _i * 8192), 16, 0, 0); } while (0)
#define PG8_LDA(dst, b, h) do { _Pragma("unroll") for (int m = 0; m < 4; ++m) _Pragma("unroll") for (int k = 0; k < 2; ++k) dst[m][k] = *(const PG8_LAS bf16x8*)(lds + PG8_SA(b, h) + aoff + m * 2048 + k * 1024); } while (0)
#define PG8_LDB(dst, b, h) do { _Pragma("unroll") for (int n = 0; n < 2; ++n) _Pragma("unroll") for (int k = 0; k < 2; ++k) dst[n][k] = *(const PG8_LAS bf16x8*)(lds + PG8_SB(b, h) + boff + n * 2048 + k * 1024); } while (0)
#define PG8_MMA(ai, bj, At, Bt) do { __builtin_amdgcn_s_setprio(1); _Pragma("unroll") for (int m = 0; m < 4; ++m) _Pragma("unroll") for (int n = 0; n < 2; ++n) _Pragma("unroll") for (int k = 0; k < 2; ++k) \
        acc[ai][bj][m][n] = __builtin_amdgcn_mfma_f32_16x16x32_bf16(Bt[n][k], At[m][k], acc[ai][bj][m][n], 0, 0, 0); __builtin_amdgcn_s_setprio(0); } while (0)
#define PG8_WAIT_V(n) asm volatile("s_waitcnt vmcnt(" #n ")" ::: "memory")
#define PG8_WAIT_L(n) asm volatile("s_waitcnt lgkmcnt(" #n ")" ::: "memory")
#define PG8_BAR __builtin_amdgcn_s_barrier()
#define PG8_SCHED __builtin_amdgcn_sched_barrier(0)
    Unit cur, nxt; int ui = 0;
    if (!S.next(0, cur)) return;
    f32x4 acc[2][2][4][2];
#pragma unroll
    for (int a = 0; a < 2; ++a)
#pragma unroll
        for (int b = 0; b < 2; ++b)
#pragma unroll
            for (int m = 0; m < 4; ++m)
#pragma unroll
                for (int n = 0; n < 2; ++n) acc[a][b][m][n] = (f32x4){0.f, 0.f, 0.f, 0.f};
    bf16x8 At[4][2], B0[2][2], B1[2][2];
    const char* cA = (const char*)g.A + (size_t)cur.pm * tstep + (size_t)cur.pk * K * 2; const char* cB = (const char*)g.Bt + (size_t)cur.pn * tstep + (size_t)cur.pk * K * 2;
    S.a_ready(cur);
    PG8_STAGE(PG8_SB(0, 0), cB, voffB); PG8_STAGE(PG8_SA(0, 0), cA, voffA); PG8_STAGE(PG8_SB(0, 1), cB + hstep, voffB); PG8_STAGE(PG8_SA(0, 1), cA + hstep, voffA);
    if (wr == 1) PG8_BAR;
    PG8_WAIT_V(4); PG8_BAR;
    PG8_STAGE(PG8_SB(1, 0), cB + kstep, voffB); PG8_STAGE(PG8_SA(1, 0), cA + kstep, voffA); PG8_STAGE(PG8_SB(1, 1), cB + hstep + kstep, voffB);
    PG8_WAIT_V(6); PG8_BAR;
    for (;;) {
        const bool has_next = S.next(ui + 1, nxt);
        const char* nA = has_next ? (const char*)g.A + (size_t)nxt.pm * tstep + (size_t)nxt.pk * K * 2 : cA; const char* nB = has_next ? (const char*)g.Bt + (size_t)nxt.pn * tstep + (size_t)nxt.pk * K * 2 : cB;
        for (int t = 0; t < nt; t += 2) {
            const bool last = (t == nt - 2);
            const char* a1 = cA + (size_t)(t + 1) * kstep;
            const char* a2 = last ? nA : cA + (size_t)(t + 2) * kstep; const char* b2 = last ? nB : cB + (size_t)(t + 2) * kstep;
            const char* a3 = a2 + kstep; const char* b3 = b2 + kstep;
            if (last && has_next) S.a_ready(nxt);
            PG8_LDB(B0, 0, 0); PG8_SCHED; PG8_LDA(At, 0, 0); PG8_STAGE(PG8_SA(1, 1), a1 + hstep, voffA);
            PG8_WAIT_L(8); PG8_BAR; PG8_WAIT_L(0); PG8_MMA(0, 0, At, B0); PG8_BAR; PG8_SCHED;
            PG8_LDB(B1, 0, 1); PG8_STAGE(PG8_SB(0, 0), b2, voffB);
            PG8_BAR; PG8_WAIT_L(0); PG8_MMA(0, 1, At, B1); PG8_BAR;
            PG8_LDA(At, 0, 1); PG8_STAGE(PG8_SA(0, 0), a2, voffA);
            PG8_BAR; PG8_WAIT_L(0); PG8_MMA(1, 0, At, B0); PG8_BAR; PG8_SCHED;
            PG8_STAGE(PG8_SB(0, 1), b2 + hstep, voffB);
            PG8_WAIT_V(6); PG8_BAR; PG8_MMA(1, 1, At, B1); PG8_BAR;
            PG8_LDB(B0, 1, 0); PG8_SCHED; PG8_LDA(At, 1, 0); PG8_STAGE(PG8_SA(0, 1), a2 + hstep, voffA);
            PG8_WAIT_L(8); PG8_BAR; PG8_WAIT_L(0); PG8_MMA(0, 0, At, B0); PG8_BAR; PG8_SCHED;
            PG8_LDB(B1, 1, 1); PG8_STAGE(PG8_SB(1, 0), b3, voffB);
            PG8_BAR; PG8_WAIT_L(0); PG8_MMA(0, 1, At, B1); PG8_BAR;
            PG8_LDA(At, 1, 1); PG8_STAGE(PG8_SA(1, 0), a3, voffA);
            PG8_BAR; PG8_WAIT_L(0); PG8_MMA(1, 0, At, B0); PG8_BAR; PG8_SCHED;
            PG8_STAGE(PG8_SB(1, 1), b3 + hstep, voffB);
            PG8_WAIT_V(6); PG8_BAR; PG8_MMA(1, 1, At, B1); PG8_BAR;
        }
        if constexpr (!Epi::AFTER_DRAIN) { E(acc, cur, wr, wc, fr, fq); S.done(cur); }
        if (!has_next) break;
#pragma unroll
        for (int a = 0; a < 2; ++a)
#pragma unroll
            for (int b = 0; b < 2; ++b)
#pragma unroll
                for (int m = 0; m < 4; ++m)
#pragma unroll
                    for (int n = 0; n < 2; ++n) acc[a][b][m][n] = (f32x4){0.f, 0.f, 0.f, 0.f};
        cur = nxt; cA = nA; cB = nB; ++ui;
    }
    PG8_WAIT_V(0);
    if (wr == 0) PG8_BAR;
    PG8_BAR;
    if constexpr (Epi::AFTER_DRAIN) { E.fused(acc, cur, wr, wc, fr, fq, lds, wid, lane); S.done(cur); }
#undef PG8_SA
#undef PG8_SB
#undef PG8_STAGE
#undef PG8_LDA
#undef PG8_LDB
#undef PG8_MMA
#undef PG8_WAIT_V
#undef PG8_WAIT_L
#undef PG8_BAR
#undef PG8_SCHED
}
}

#define XB_TMO      128
#define XB_XCNT(j)  (256  + 64 * (j))
#define XB_XSUB(j)  (1280 + 64 * (j))
#define XB_XGEN(j)  (2304 + 64 * (j))
#define XB_TOP      3328
#define XB_TOPGEN   3392
#define XCD_BAR_WORDS 3456
#define XB_SPIN_CAP (1u << 18)
#define XLAS __attribute__((address_space(3)))

__device__ __forceinline__ unsigned xb_ld(unsigned* p)              { return __hip_atomic_load(p, __ATOMIC_RELAXED, __HIP_MEMORY_SCOPE_AGENT); }
__device__ __forceinline__ unsigned xb_add(unsigned* p, unsigned v) { return __hip_atomic_fetch_add(p, v, __ATOMIC_RELAXED, __HIP_MEMORY_SCOPE_AGENT); }
__device__ __forceinline__ unsigned xb_xcc_id() { return (unsigned)__builtin_amdgcn_s_getreg((3 << 11) | 20) & 0xFu; }
#define XB_SPIN(cond, bar) do { unsigned _sp = 0; while (cond) { __builtin_amdgcn_s_sleep(1); \
    if ((++_sp & 255u) == 0u) { if (xb_ld(&(bar)[XB_TMO])) break; if (_sp > XB_SPIN_CAP) { atomicAdd(&(bar)[XB_TMO], 1u); break; } } } } while (0)

struct XcdBarrier {
    unsigned* bar; unsigned x;
    volatile XLAS unsigned* st;
};

__device__ __forceinline__ XcdBarrier xcd_barrier_post(unsigned* bar, volatile XLAS unsigned* st) {
    XcdBarrier b; b.bar = bar; b.x = xb_xcc_id(); b.st = st;
    if (threadIdx.x == 0) (void)xb_add(&bar[XB_XCNT(b.x)], 1u);
    return b;
}
__device__ __forceinline__ void xcd_barrier_complete(unsigned* bar, unsigned x, unsigned& nloc, unsigned& nx) {
    const unsigned G = gridDim.x * gridDim.y * gridDim.z;
    unsigned sum, cnt, mine, sp = 0u;
    for (;;) {
        sum = 0u; cnt = 0u; mine = 0u;
#pragma unroll
        for (unsigned j = 0; j < 16; ++j) { const unsigned c = xb_ld(&bar[XB_XCNT(j)]); sum += c; cnt += (c > 0u) ? 1u : 0u; mine = (j == x) ? c : mine; }
        if (sum == G) break;
        __builtin_amdgcn_s_sleep(1);
        if ((++sp & 255u) == 0u) { if (xb_ld(&bar[XB_TMO])) break; if (sp > XB_SPIN_CAP) { atomicAdd(&bar[XB_TMO], 1u); break; } }
    }
    nloc = mine > 0u ? mine : 1u; nx = cnt > 0u ? cnt : 1u;
}

__device__ __forceinline__ void xcd_barrier(const XcdBarrier& b) {
    asm volatile("s_waitcnt vmcnt(0)" ::: "memory");
    __syncthreads();
    if (threadIdx.x == 0) {
        unsigned* bar = b.bar;
        __builtin_amdgcn_s_waitcnt(0);
        unsigned nloc = b.st[0], nx = b.st[1];
        if (nloc == 0u) { xcd_barrier_complete(bar, b.x, nloc, nx); b.st[0] = nloc; b.st[1] = nx; }
        const unsigned old = xb_add(&bar[XB_XSUB(b.x)], 1u);
        const unsigned gen = old / nloc;
        if (old + 1u == (gen + 1u) * nloc) {
            __builtin_amdgcn_fence(__ATOMIC_RELEASE, "agent");
            asm volatile("s_waitcnt vmcnt(0)" ::: "memory");
            const unsigned og = xb_add(&bar[XB_TOP], 1u);
            const unsigned tg = og / nx;
            if (og + 1u == (tg + 1u) * nx) xb_add(&bar[XB_TOPGEN], 1u);
            else XB_SPIN(xb_ld(&bar[XB_TOPGEN]) == tg, bar);
            __builtin_amdgcn_fence(__ATOMIC_ACQUIRE, "agent");
            xb_add(&bar[XB_XGEN(b.x)], 1u);
            asm volatile("s_waitcnt vmcnt(0)" ::: "memory");
        } else {
            XB_SPIN(xb_ld(&bar[XB_XGEN(b.x)]) == gen, bar);
            __builtin_amdgcn_fence(__ATOMIC_ACQUIRE, "agent");
            asm volatile("s_waitcnt vmcnt(0)" ::: "memory");
        }
    }
    __syncthreads();
}

using pg8::bf16_t; using pg8::f32x4; using pg8::bf16x8;
typedef unsigned u32x4_t __attribute__((ext_vector_type(4)));
typedef unsigned u32x2_t __attribute__((ext_vector_type(2)));

constexpr int DM = 1024, NBP = 8, SEQ = 2048, NBS = 128, SSEQ = 4, NH = 4, HD = 128, MW = 512;
constexpr int MP = NBP * SEQ, MS = NBS * SSEQ, MT = MP + MS;
constexpr int NIN = 9232, N1 = 9216, DFF = 2816, NUP = 5632;
constexpr float EPS = 1e-6f;
constexpr float QSCALE = 0.08838834764831845f;

constexpr size_t O_Y = 0;
constexpr size_t O_P_GS = (size_t)MT * DM;
constexpr size_t O_P_GC = O_P_GS + (size_t)2 * 8 * 4 * 128 * 128;
constexpr size_t O_P_MC = O_P_GC + (size_t)2 * 8 * 3 * 1536;
constexpr size_t O_P_MN = O_P_MC + (size_t)2 * 8 * 4 * 128 * 128;
constexpr size_t O_P_MM = O_P_MN + (size_t)2 * 8 * 4 * 128;
constexpr size_t O_P_HS = O_P_MM + (size_t)2 * 8 * 4;
constexpr size_t O_P_FC = O_P_HS + (size_t)2 * 8 * 4 * 128 * 128;
constexpr size_t O_S_GS = O_P_FC + (size_t)2 * 8 * 2 * 5632;
constexpr size_t O_S_GC = O_S_GS + (size_t)2 * 128 * 4 * 128 * 128;
constexpr size_t O_S_MC = O_S_GC + (size_t)2 * 128 * 3 * 1536;
constexpr size_t O_S_MN = O_S_MC + (size_t)2 * 128 * 4 * 128 * 128;
constexpr size_t O_S_MM = O_S_MN + (size_t)2 * 128 * 4 * 128;
constexpr size_t O_S_HS = O_S_MM + (size_t)2 * 128 * 4;
constexpr size_t O_S_FC = O_S_HS + (size_t)2 * 128 * 4 * 128 * 128;
constexpr size_t O_END  = O_S_FC + (size_t)2 * 128 * 2 * 5632;

constexpr size_t W_WIN = 0;
constexpr size_t W_WBR = W_WIN + (size_t)N1 * 1024 * 2;
constexpr size_t W_WOUT = W_WBR + (size_t)3 * 1024 * 512 * 2;
constexpr size_t W_WUP = W_WOUT + (size_t)1024 * 1024 * 2;
constexpr size_t W_WDN = W_WUP + (size_t)NUP * 1024 * 2;
constexpr size_t W_HBF = W_WDN + (size_t)1024 * DFF * 2;
constexpr size_t W_PROJ = W_HBF + (size_t)MT * 1024 * 2;
constexpr size_t W_ACT = W_PROJ + (size_t)MT * NUP * 2;
constexpr size_t W_OUTS = W_PROJ + (size_t)MT * N1 * 2;
constexpr size_t W_GATES = W_OUTS + (size_t)3 * MT * 512 * 2;
constexpr size_t W_DEN = W_GATES + (size_t)MT * 16 * 4;
constexpr size_t W_MT = W_DEN + (size_t)MT * 4 * 4;
constexpr size_t W_BAR = W_MT + (size_t)MT * 4 * 4;
constexpr size_t W_END = W_BAR + 16384;

constexpr int LDS_MAIN = 143360;
constexpr int LDS_BYTES = LDS_MAIN + 64 + 512;

struct Params { const float* in[28]; float* out; unsigned char* ws; };
enum { I_XP = 0, I_XS, I_SGS, I_SGC, I_SMC, I_SMN, I_SMM, I_SHS, I_SFC, I_LNMIX, I_WIN, I_GCW, I_ALOG, I_DTB, I_GNORM, I_MIB, I_MFB, I_MNORM, I_HLB, I_HNORM,
       I_WBR, I_WOUT, I_LNFFN, I_WUP, I_FCW, I_FCB, I_WDN, I_LNF };

typedef const float* const __attribute__((address_space(4))) * kargp_t;
__device__ __forceinline__ const float* argp(int i) { kargp_t kp = (kargp_t)__builtin_amdgcn_kernarg_segment_ptr(); asm volatile("" : "+s"(i)); return kp[i]; }
__device__ __forceinline__ int bidx() { int b = (int)blockIdx.x; asm volatile("" : "+s"(b)); return b; }
__device__ __forceinline__ int gdim() { int g = (int)gridDim.x; asm volatile("" : "+s"(g)); return g; }
#define PIN(i) argp(i)
#define POUT ((float*)argp(28))
#define PWS ((unsigned char*)argp(29))
__device__ __forceinline__ float bf2f(bf16_t b) { return __uint_as_float(((unsigned)b) << 16); }
__device__ __forceinline__ float bflo(unsigned u) { return __uint_as_float(u << 16); }
__device__ __forceinline__ float bfhi(unsigned u) { return __uint_as_float(u & 0xffff0000u); }
__device__ __forceinline__ bf16_t f2bf(float f) { return (bf16_t)(pg8::cvt_pk_bf16(f, 0.f) & 0xffffu); }
__device__ __forceinline__ float sigm(float x) { return __builtin_amdgcn_rcpf(1.f + __expf(-x)); }
__device__ __forceinline__ float silu(float x) { return x * sigm(x); }
__device__ __forceinline__ float rdlane(float x, int l) { return __builtin_bit_cast(float, __builtin_amdgcn_readlane(__builtin_bit_cast(int, x), l)); }
template <int CTRL> __device__ __forceinline__ float dppf(float x) { return __builtin_bit_cast(float, __builtin_amdgcn_update_dpp(0, __builtin_bit_cast(int, x), CTRL, 0xf, 0xf, true)); }
__device__ __forceinline__ float grp_sum8(float x) { x += dppf<0xB1>(x); x += dppf<0x4E>(x); x += dppf<0x141>(x); return x; }
__device__ __forceinline__ float grp_sum16(float x) { x = grp_sum8(x); x += dppf<0x140>(x); return x; }
__device__ __forceinline__ float wave_sum(float x) { x = grp_sum16(x);
    x += __builtin_bit_cast(float, __builtin_amdgcn_update_dpp(0, __builtin_bit_cast(int, x), 0x142, 0xa, 0xf, false));
    x += __builtin_bit_cast(float, __builtin_amdgcn_update_dpp(0, __builtin_bit_cast(int, x), 0x143, 0xc, 0xf, false));
    return rdlane(x, 63); }
template <int CTRL> __device__ __forceinline__ float dppm(float x) { return __builtin_bit_cast(float, __builtin_amdgcn_update_dpp(__builtin_bit_cast(int, -INFINITY), __builtin_bit_cast(int, x), CTRL, 0xf, 0xf, false)); }
template <int T> __device__ __forceinline__ float grp_sum(float x) { if constexpr (T == 16) return grp_sum16(x); else return grp_sum8(x); }

__device__ __forceinline__ int win_srccol(int n0) { const int blk = n0 >> 9, r = n0 & 511; int base;
    if (blk < 4) base = blk * 512; else if (blk < 8) base = 2056 + (blk - 4) * 512; else if (blk < 12) base = 4112 + (blk - 8) * 512; else base = 6160 + (blk - 12) * 512;
    return base + r; }
__device__ __forceinline__ void conv_T(const float* __restrict__ src, int ld, bf16_t* __restrict__ dst, int K, int N, bool winmap, float* tile, int& tcount) {
    int tid_ = threadIdx.x; asm volatile("" : "+v"(tid_)); const int tid = tid_, ntn = N / 64, ntiles = ntn * (K / 64);
    int t = bidx() - (tcount % gdim()); if (t < 0) t += gdim();
    const int kk = tid >> 4, n4 = (tid & 15) * 4;
    float4 va[2], vb[2];
#define CT_LOAD(dst_, t_) do { const int tn_ = (t_) % ntn, tk_ = (t_) / ntn, n0_ = tn_ * 64, k0_ = tk_ * 64, sc0_ = winmap ? win_srccol(n0_) : n0_; \
        _Pragma("unroll") for (int pp_ = 0; pp_ < 2; ++pp_) dst_[pp_] = *(const float4*)(src + (size_t)(k0_ + kk + 32 * pp_) * ld + sc0_ + n4); } while (0)
    if (t < ntiles) CT_LOAD(va, t);
    for (; t < ntiles; t += gdim()) {
        const int tn = t % ntn, tk = t / ntn, n0 = tn * 64, k0 = tk * 64;
        const int tnext = t + gdim();
        if (tnext < ntiles) CT_LOAD(vb, tnext);
        __syncthreads();
#pragma unroll
        for (int pp = 0; pp < 2; ++pp) { float* tp = tile + (kk + 32 * pp) * 65 + n4; tp[0] = va[pp].x; tp[1] = va[pp].y; tp[2] = va[pp].z; tp[3] = va[pp].w; }
        __syncthreads();
        { const int n = tid >> 3, k8 = (tid & 7) * 8; float f[8];
#pragma unroll
          for (int i = 0; i < 8; ++i) f[i] = tile[(k8 + i) * 65 + n];
          u32x4_t o; o[0] = pg8::cvt_pk_bf16(f[0], f[1]); o[1] = pg8::cvt_pk_bf16(f[2], f[3]); o[2] = pg8::cvt_pk_bf16(f[4], f[5]); o[3] = pg8::cvt_pk_bf16(f[6], f[7]);
          *(u32x4_t*)(dst + (size_t)(n0 + n) * K + k0 + k8) = o; }
        va[0] = vb[0]; va[1] = vb[1];
    }
#undef CT_LOAD
    tcount += ntiles;
}

__device__ __forceinline__ void phase_rmsnorm(const Params& p, int l, const float* xa, const float* xb, const float* __restrict__ gw, bf16_t* __restrict__ hout, bool do_gates, float* sm) {
    int tid_ = threadIdx.x; asm volatile("" : "+v"(tid_)); const int tid = tid_, lane = tid & 63, w = tid >> 6;
    float* wgT = sm;
    if (do_gates) {
        const float* win = PIN(I_WIN) + (size_t)l * 1024 * NIN;
        __syncthreads();
        for (int i = tid; i < 16 * 1024; i += 512) { const int k = i >> 4, j = i & 15; const int gc = j < 8 ? 2048 + j : 4104 + (j - 8); wgT[j * 1024 + k] = win[(size_t)k * NIN + gc]; }
        __syncthreads();
    }
    float4 g4[4];
#pragma unroll
    for (int i = 0; i < 4; ++i) g4[i] = *(const float4*)(gw + lane * 4 + 256 * i);
    for (int row = bidx() * 8 + w; row < MT; row += gdim() * 8) {
        const float* xr = row < MP ? xa + (size_t)row * DM : xb + (size_t)(row - MP) * DM;
        float4 v[4]; float ss = 0.f;
#pragma unroll
        for (int i = 0; i < 4; ++i) { v[i] = *(const float4*)(xr + lane * 4 + 256 * i); ss += v[i].x * v[i].x + v[i].y * v[i].y + v[i].z * v[i].z + v[i].w * v[i].w; }
        ss = wave_sum(ss);
        const float rstd = rsqrtf(ss * (1.f / 1024.f) + EPS);
#pragma unroll
        for (int i = 0; i < 4; ++i) { v[i].x *= rstd * g4[i].x; v[i].y *= rstd * g4[i].y; v[i].z *= rstd * g4[i].z; v[i].w *= rstd * g4[i].w;
            u32x2_t o; o[0] = pg8::cvt_pk_bf16(v[i].x, v[i].y); o[1] = pg8::cvt_pk_bf16(v[i].z, v[i].w);
            *(u32x2_t*)(hout + (size_t)row * DM + lane * 4 + 256 * i) = o; }
        if (do_gates) {
            float mine = 0.f;
#pragma unroll
            for (int j = 0; j < 16; ++j) { float a = 0.f;
#pragma unroll
                for (int i = 0; i < 4; ++i) { const float4 wv = *(const float4*)(wgT + j * 1024 + lane * 4 + 256 * i); a += v[i].x * wv.x + v[i].y * wv.y + v[i].z * wv.z + v[i].w * wv.w; }
                a = wave_sum(a); if (lane == j) mine = a; }
            if (lane < 16) { const int h = lane & 3, kind = lane >> 2; float r;
                if (kind == 0) r = sigm(mine);
                else if (kind == 1) { const float xx = mine + PIN(I_DTB)[l * 4 + h]; const float sp = xx > 20.f ? xx : __logf(1.f + __expf(xx)); r = __expf(-__expf(PIN(I_ALOG)[l * 4 + h]) * sp); }
                else if (kind == 2) r = mine + PIN(I_MIB)[l * 4 + h];
                else { const float xx = -(mine + PIN(I_MFB)[l * 4 + h]); r = -(xx > 20.f ? xx : __logf(1.f + __expf(xx))); }
                ((float*)(PWS + W_GATES))[(size_t)row * 16 + lane] = r; }
        }
    }
}

struct EpiProj {
    static constexpr bool PERM = true, AFTER_DRAIN = false;
    bf16_t* O; int ldc; int actmode;
    __device__ __forceinline__ void operator()(const f32x4 (&acc)[2][2][4][2], const pg8::Unit& u, int wr, int wc, int fr, int fq) const {
        const int row0 = u.pm * 256 + wr * 64 + fr, col0 = u.pn * 256 + wc * 32 + 8 * fq;
        int act = 0;
        if (actmode) { const int pn = u.pn; act = (pn >= 24 || pn == 14 || pn == 15) ? 2 : ((pn == 6 || pn == 7 || pn == 16 || pn == 17 || pn == 22 || pn == 23) ? 1 : 0); }
#pragma unroll
        for (int ai = 0; ai < 2; ++ai)
#pragma unroll
            for (int m = 0; m < 4; ++m) { bf16_t* rowp = O + (size_t)(row0 + ai * 128 + m * 16) * ldc + col0;
#pragma unroll
                for (int bj = 0; bj < 2; ++bj) { float v[8];
#pragma unroll
                    for (int i = 0; i < 4; ++i) { v[i] = acc[ai][bj][m][0][i]; v[4 + i] = acc[ai][bj][m][1][i]; }
                    if (act == 1) {
#pragma unroll
                        for (int i = 0; i < 8; ++i) v[i] = silu(v[i]); }
                    else if (act == 2) {
#pragma unroll
                        for (int i = 0; i < 8; ++i) v[i] = sigm(v[i]); }
                    u32x4_t o; o[0] = pg8::cvt_pk_bf16(v[0], v[1]); o[1] = pg8::cvt_pk_bf16(v[2], v[3]); o[2] = pg8::cvt_pk_bf16(v[4], v[5]); o[3] = pg8::cvt_pk_bf16(v[6], v[7]);
                    *(u32x4_t*)(rowp + bj * 128) = o; } }
    }
};
struct EpiMerge {
    static constexpr bool PERM = true, AFTER_DRAIN = false;
    const bf16_t* G; bf16_t* Mx;
    __device__ __forceinline__ void operator()(const f32x4 (&acc)[2][2][4][2], const pg8::Unit& u, int wr, int wc, int fr, int fq) const {
        const int n = u.pn >> 2, first = (n == 0);
        const int row0 = (u.pm - n * (MT / 256)) * 256 + wr * 64 + fr, col0 = (u.pn & 3) * 256 + wc * 32 + 8 * fq;
        const bf16_t* Gn = G + n * 1024 + col0; bf16_t* Mc = Mx + col0;
        u32x4_t gc[2], oc[2], gn[2], on[2];
#pragma unroll
        for (int bj = 0; bj < 2; ++bj) { gc[bj] = *(const u32x4_t*)(Gn + (size_t)row0 * N1 + bj * 128); oc[bj] = first ? (u32x4_t){0u, 0u, 0u, 0u} : *(const u32x4_t*)(Mc + (size_t)row0 * DM + bj * 128); }
#pragma unroll
        for (int gI = 0; gI < 8; ++gI) { const int ai = gI >> 2, m = gI & 3; const size_t row = (size_t)(row0 + ai * 128 + m * 16);
            if (gI < 7) { const size_t row2 = (size_t)(row0 + ((gI + 1) >> 2) * 128 + ((gI + 1) & 3) * 16);
#pragma unroll
                for (int bj = 0; bj < 2; ++bj) { gn[bj] = *(const u32x4_t*)(Gn + row2 * N1 + bj * 128); on[bj] = first ? (u32x4_t){0u, 0u, 0u, 0u} : *(const u32x4_t*)(Mc + row2 * DM + bj * 128); } }
#pragma unroll
            for (int bj = 0; bj < 2; ++bj) { float v[8];
#pragma unroll
                for (int i = 0; i < 4; ++i) { v[i] = acc[ai][bj][m][0][i]; v[4 + i] = acc[ai][bj][m][1][i]; }
#pragma unroll
                for (int i = 0; i < 4; ++i) { v[2 * i] = v[2 * i] * bflo(gc[bj][i]) + bflo(oc[bj][i]); v[2 * i + 1] = v[2 * i + 1] * bfhi(gc[bj][i]) + bfhi(oc[bj][i]); }
                u32x4_t o; o[0] = pg8::cvt_pk_bf16(v[0], v[1]); o[1] = pg8::cvt_pk_bf16(v[2], v[3]); o[2] = pg8::cvt_pk_bf16(v[4], v[5]); o[3] = pg8::cvt_pk_bf16(v[6], v[7]);
                *(u32x4_t*)(Mc + row * DM + bj * 128) = o; }
#pragma unroll
            for (int bj = 0; bj < 2; ++bj) { gc[bj] = gn[bj]; oc[bj] = on[bj]; } }
    }
};
struct EpiResid {
    static constexpr bool PERM = false, AFTER_DRAIN = false;
    float* X; const float* Sa; const float* Sb;
    __device__ __forceinline__ void operator()(const f32x4 (&acc)[2][2][4][2], const pg8::Unit& u, int wr, int wc, int fr, int fq) const {
        const int row0 = u.pm * 256 + wr * 64 + fr, col0 = u.pn * 256 + wc * 32 + 4 * fq;
        const float* S = u.pm * 256 < MP ? Sa : Sb - (size_t)MP * DM;
        f32x4 cur[4], nxt[4];
#pragma unroll
        for (int q = 0; q < 4; ++q) cur[q] = *(const f32x4*)(S + (size_t)row0 * DM + col0 + (q >> 1) * 128 + (q & 1) * 16);
#pragma unroll
        for (int gI = 0; gI < 8; ++gI) { const int ai = gI >> 2, m = gI & 3; const size_t ro = (size_t)(row0 + ai * 128 + m * 16) * DM + col0;
            if (gI < 7) { const int ai2 = (gI + 1) >> 2, m2 = (gI + 1) & 3; const size_t ro2 = (size_t)(row0 + ai2 * 128 + m2 * 16) * DM + col0;
#pragma unroll
                for (int q = 0; q < 4; ++q) nxt[q] = *(const f32x4*)(S + ro2 + (q >> 1) * 128 + (q & 1) * 16); }
#pragma unroll
            for (int q = 0; q < 4; ++q) *(f32x4*)(X + ro + (q >> 1) * 128 + (q & 1) * 16) = cur[q] + acc[ai][q >> 1][m][q & 1];
#pragma unroll
            for (int q = 0; q < 4; ++q) cur[q] = nxt[q]; }
    }
};

struct EpiAtomic {
    static constexpr bool PERM = false, AFTER_DRAIN = false;
    float* X;
    __device__ __forceinline__ void operator()(const f32x4 (&acc)[2][2][4][2], const pg8::Unit& u, int wr, int wc, int fr, int fq) const {
        const int row0 = u.pm * 256 + wr * 64 + fr, col0 = u.pn * 256 + wc * 32 + 4 * fq;
#pragma unroll
        for (int ai = 0; ai < 2; ++ai)
#pragma unroll
            for (int m = 0; m < 4; ++m) { float* rowp = X + (size_t)(row0 + ai * 128 + m * 16) * DM + col0;
#pragma unroll
                for (int bj = 0; bj < 2; ++bj)
#pragma unroll
                    for (int n = 0; n < 2; ++n)
#pragma unroll
                        for (int e = 0; e < 4; ++e) unsafeAtomicAdd(rowp + bj * 128 + n * 16 + e, acc[ai][bj][m][n][e]); }
    }
};
struct MergeOrder {
    pg8::StaticOrder base;
    __device__ void init(int G_, int c_) { base.init(MT, 1024, G_, c_); }
    __device__ bool next(int i, pg8::Unit& u) const { const int t = i / 3, n = i - 3 * t; pg8::Unit b; if (!base.next(t, b)) return false; u.pm = n * (MT / 256) + b.pm; u.pn = n * 4 + b.pn; u.pk = 0; return true; }
    __device__ __forceinline__ void a_ready(const pg8::Unit&) const {}
    __device__ __forceinline__ void done(const pg8::Unit&) const {}
};
struct PieceOrder {
    int G, c, KP;
    __device__ bool next(int i, pg8::Unit& u) const { const int L = i * G + c; if (L >= 8 * KP) return false; const int tile = L / KP; u.pk = L - tile * KP; u.pm = MP / 256 + (tile >> 2); u.pn = tile & 3; return true; }
    __device__ __forceinline__ void a_ready(const pg8::Unit&) const {}
    __device__ __forceinline__ void done(const pg8::Unit&) const {}
};
__device__ __forceinline__ void phase_gdnprep(const Params& p, int l) {
    int tid_ = threadIdx.x; asm volatile("" : "+v"(tid_)); const int tid = tid_, j = tid & 15;
    const bf16_t* proj = (const bf16_t*)(PWS + W_PROJ);
    bf16_t* qkd = (bf16_t*)(PWS + W_HBF); bf16_t* vd = (bf16_t*)(PWS + W_OUTS);
    const float* cw = PIN(I_GCW) + (size_t)l * 4 * 1536; const float* cst = PIN(I_SGC) + (size_t)l * NBS * 3 * 1536;
    const int ngroups = MT * 12, half = ngroups / 2;
    for (int gid0 = bidx() * 32 + (tid >> 4); gid0 < half; gid0 += gdim() * 32) {
        const int part = gid0 % 12, col = part * 128 + 8 * j;
        float4 w0[4], w1[4];
#pragma unroll
        for (int jj = 0; jj < 4; ++jj) { w0[jj] = *(const float4*)(cw + jj * 1536 + col); w1[jj] = *(const float4*)(cw + jj * 1536 + col + 4); }
        float x[2][4][8]; int rr[2];
#pragma unroll
        for (int k = 0; k < 2; ++k) { const int gid = gid0 + k * half, r = gid / 12; rr[k] = r;
            const bool samp = r >= MP; const int t = samp ? ((r - MP) & 3) : (r & (SEQ - 1)), b2 = samp ? ((r - MP) >> 2) : 0;
#pragma unroll
            for (int jj = 0; jj < 4; ++jj) { const int tt = t - 3 + jj;
                if (tt >= 0) { const u32x4_t raw = *(const u32x4_t*)(proj + (size_t)(r - 3 + jj) * N1 + col);
#pragma unroll
                    for (int i = 0; i < 4; ++i) { x[k][jj][2 * i] = bflo(raw[i]); x[k][jj][2 * i + 1] = bfhi(raw[i]); } }
                else if (samp) { const float* cp = cst + (size_t)(b2 * 3 + 3 + tt) * 1536 + col; const float4 a0 = *(const float4*)cp, a1 = *(const float4*)(cp + 4);
                    x[k][jj][0] = a0.x; x[k][jj][1] = a0.y; x[k][jj][2] = a0.z; x[k][jj][3] = a0.w; x[k][jj][4] = a1.x; x[k][jj][5] = a1.y; x[k][jj][6] = a1.z; x[k][jj][7] = a1.w; }
                else {
#pragma unroll
                    for (int i = 0; i < 8; ++i) x[k][jj][i] = 0.f; } } }
#pragma unroll
        for (int k = 0; k < 2; ++k) { const int r = rr[k]; float y[8];
#pragma unroll
            for (int i = 0; i < 8; ++i) y[i] = 0.f;
#pragma unroll
            for (int jj = 0; jj < 4; ++jj) { y[0] += w0[jj].x * x[k][jj][0]; y[1] += w0[jj].y * x[k][jj][1]; y[2] += w0[jj].z * x[k][jj][2]; y[3] += w0[jj].w * x[k][jj][3];
                y[4] += w1[jj].x * x[k][jj][4]; y[5] += w1[jj].y * x[k][jj][5]; y[6] += w1[jj].z * x[k][jj][6]; y[7] += w1[jj].w * x[k][jj][7]; }
            float ss = 0.f;
#pragma unroll
            for (int i = 0; i < 8; ++i) { y[i] = silu(y[i]); ss += y[i] * y[i]; }
            ss = grp_sum16(ss);
            const float scl = part < 4 ? rsqrtf(ss + EPS) * QSCALE : (part < 8 ? rsqrtf(ss + EPS) : 1.f);
            u32x4_t o; o[0] = pg8::cvt_pk_bf16(y[0] * scl, y[1] * scl); o[1] = pg8::cvt_pk_bf16(y[2] * scl, y[3] * scl); o[2] = pg8::cvt_pk_bf16(y[4] * scl, y[5] * scl); o[3] = pg8::cvt_pk_bf16(y[6] * scl, y[7] * scl);
            if (part < 8) *(u32x4_t*)(qkd + (size_t)r * 1024 + col) = o; else *(u32x4_t*)(vd + (size_t)r * 512 + (col - 1024)) = o; }
    }
}

__device__ __forceinline__ void lds_barrier() { asm volatile("s_waitcnt lgkmcnt(0)" ::: "memory"); __builtin_amdgcn_s_barrier(); asm volatile("" ::: "memory"); }
typedef float f2 __attribute__((ext_vector_type(2)));
typedef float f4 __attribute__((ext_vector_type(4)));
template <int MIX>
__device__ __forceinline__ void scan_prompt_item(const Params& p, int l, int b, int h, int cgp, float* sm) {
    constexpr int T = 16, CPL = (MIX == 0) ? 1 : 2, NG = 128 / (4 * T), NP = 2 * NG, CPW = (64 / T) * CPL, CPG = 8 * CPW, TB = 32, BUFSZ = 16512, NBLK = SEQ / TB;
    int tid_ = threadIdx.x; asm volatile("" : "+v"(tid_)); const int tid = tid_, lane = tid & 63, w = tid >> 6, c = lane / T, j = lane % T;
    const int col = w * CPW + c, ecol = cgp * CPG + col;
    float* misc = sm + 2 * BUFSZ; float* gsc = misc; float* mcar = misc + 64;
    const float* gates = (const float*)(PWS + W_GATES);
    bf16_t* outp = (bf16_t*)(PWS + W_OUTS) + (size_t)MIX * MT * 512;
    const size_t rb = (size_t)b * SEQ;
    const int c8 = (tid & 31) * 8, srow = tid >> 5;
    const bf16_t* qsrc; size_t qld; const bf16_t* vsrc; size_t vld;
    if (MIX == 0) { qsrc = (const bf16_t*)(PWS + W_HBF) + rb * 1024 + (c8 < 128 ? h * 128 + c8 : 512 + h * 128 + (c8 - 128)); qld = 1024;
        vsrc = (const bf16_t*)(PWS + W_OUTS) + rb * 512 + h * 128 + cgp * 32; vld = 512; }
    else { const int base = MIX == 1 ? 2048 : 4096; qsrc = (const bf16_t*)(PWS + W_PROJ) + rb * N1 + base + (c8 < 128 ? h * 128 + c8 : 512 + h * 128 + (c8 - 128)); qld = N1;
        vsrc = (const bf16_t*)(PWS + W_PROJ) + rb * N1 + base + 1024 + h * 128 + cgp * 64; vld = N1; }
    constexpr int VPC = CPG / 8;
    const int vs = tid / VPC, vc8 = (tid % VPC) * 8; const bool vact = tid < TB * VPC;
    float lb8[8];
#pragma unroll
    for (int i = 0; i < 8; ++i) lb8[i] = 0.f;
    if (MIX == 2 && l > 0 && c8 >= 128) { const float* hl = PIN(I_HLB);
#pragma unroll
        for (int i = 0; i < 8; ++i) { const int cc = h * 128 + (c8 - 128) + i; lb8[i] = sigm(hl[512 + cc] - hl[cc]); } }
    f2 S2[CPL][NP];
#pragma unroll
    for (int cc = 0; cc < CPL; ++cc)
#pragma unroll
        for (int i = 0; i < NP; ++i) S2[cc][i] = (f2){0.f, 0.f};
    float nn = 0.f, okeep[CPL], oprev[CPL];
#pragma unroll
    for (int cc = 0; cc < CPL; ++cc) { okeep[cc] = 0.f; oprev[cc] = 0.f; }
    u32x4_t rq[2][2], rv[2]; float rg0[2] = {0.f, 0.f}, rg1[2] = {0.f, 0.f};
    rv[0] = (u32x4_t){0u, 0u, 0u, 0u}; rv[1] = rv[0];
#define SCAN_ISSUE(t0_, st_) do { \
        _Pragma("unroll") for (int i_ = 0; i_ < 2; ++i_) rq[st_][i_] = *(const u32x4_t*)(qsrc + (size_t)((t0_) + srow + 16 * i_) * qld); \
        if (vact) rv[st_] = *(const u32x4_t*)(vsrc + (size_t)((t0_) + vs) * vld + vc8); \
        if (MIX != 2 && tid < TB) { const size_t r_ = rb + (t0_) + tid; rg0[st_] = gates[r_ * 16 + (MIX == 0 ? 0 : 8) + h]; rg1[st_] = gates[r_ * 16 + (MIX == 0 ? 4 : 12) + h]; } } while (0)
#define SCAN_FINISH(B_, st_) do { float* qk_ = (B_); float* vv_ = (B_) + 8192; float* sc_ = (B_) + 10240; \
        _Pragma("unroll") for (int i_ = 0; i_ < 2; ++i_) { float x_[8]; \
            _Pragma("unroll") for (int e_ = 0; e_ < 4; ++e_) { x_[2 * e_] = bflo(rq[st_][i_][e_]); x_[2 * e_ + 1] = bfhi(rq[st_][i_][e_]); } \
            if (MIX == 2 && c8 >= 128) { _Pragma("unroll") for (int e_ = 0; e_ < 8; ++e_) x_[e_] = lb8[e_] + (1.f - lb8[e_]) * sigm(x_[e_]); } \
            float* d_ = qk_ + (srow + 16 * i_) * 256 + c8; *(f4*)d_ = (f4){x_[0], x_[1], x_[2], x_[3]}; *(f4*)(d_ + 4) = (f4){x_[4], x_[5], x_[6], x_[7]}; } \
        if (vact) { float* d_ = vv_ + vs * 64 + vc8; *(f4*)d_ = (f4){bflo(rv[st_][0]), bfhi(rv[st_][0]), bflo(rv[st_][1]), bfhi(rv[st_][1])}; *(f4*)(d_ + 4) = (f4){bflo(rv[st_][2]), bfhi(rv[st_][2]), bflo(rv[st_][3]), bfhi(rv[st_][3])}; } \
        if (MIX == 0 && tid < TB) { sc_[tid * 4] = rg0[st_]; sc_[tid * 4 + 1] = rg1[st_]; } \
        if (MIX == 1 && tid < TB) { gsc[tid * 2] = rg0[st_]; gsc[tid * 2 + 1] = rg1[st_]; } } while (0)
#define SCAN_CHAIN(B_) do { if (w == 1) { float* sc_ = (B_) + 10240; const int ls_ = lane & 31; const float m0_ = mcar[0]; \
            const float ig_ = gsc[2 * ls_], lf_ = gsc[2 * ls_ + 1]; \
            float F_ = lf_; F_ += dppf<0x111>(F_); F_ += dppf<0x112>(F_); F_ += dppf<0x114>(F_); F_ += dppf<0x118>(F_);              \
            { const float t0_ = rdlane(F_, 15); if (lane & 16) F_ += t0_; } \
            float P_ = ig_ - F_; P_ = fmaxf(P_, dppm<0x111>(P_)); P_ = fmaxf(P_, dppm<0x112>(P_)); P_ = fmaxf(P_, dppm<0x114>(P_)); P_ = fmaxf(P_, dppm<0x118>(P_)); \
            { const float t1_ = rdlane(P_, 15); if (lane & 16) P_ = fmaxf(P_, t1_); } \
            const float m_ = F_ + fmaxf(m0_, P_); \
            float mp_ = dppf<0x111>(m_); { const float t2_ = rdlane(m_, 15); if ((lane & 15) == 0) mp_ = (lane & 16) ? t2_ : m0_; } \
            const float mlast_ = rdlane(m_, 31); \
            if (lane < 32) { sc_[lane * 4] = __expf(lf_ + mp_ - m_); sc_[lane * 4 + 1] = __expf(ig_ - m_) * QSCALE; sc_[lane * 4 + 2] = m_; } \
            if (lane == 0) mcar[0] = mlast_; } } while (0)
    if (MIX == 1 && tid == 64) mcar[0] = 0.f;
    __syncthreads();
    SCAN_ISSUE(0, 0);
    SCAN_FINISH(sm, 0);
    SCAN_ISSUE(TB, 1);
    __syncthreads();
    if (MIX == 1) { SCAN_CHAIN(sm); __syncthreads(); }
#pragma unroll 1
    for (int blk2 = 0; blk2 < NBLK; blk2 += 2) {
#pragma unroll
      for (int par = 0; par < 2; ++par) {
        const int blk = blk2 + par;
        const int t0 = blk * TB;
        float* B = sm + (blk & 1) * BUFSZ; float* Bn = sm + ((blk & 1) ^ 1) * BUFSZ;
        const float* qk = B; const float* vv = B + 8192; const float* sc = B + 10240; float* denp = B + 10368; float* ost = B + 14464;
        if (blk + 2 < NBLK) SCAN_ISSUE(t0 + 2 * TB, par);
        f4 qa[2][NG], ka[2][NG]; float va[2][CPL], sa[2], sb[2], kda[2], qda[2];
#define SCAN_LOADOPS(slot_, s_) do { const float* qs_ = qk + (s_) * 256; \
            _Pragma("unroll") for (int g_ = 0; g_ < NG; ++g_) { qa[slot_][g_] = *(const f4*)(qs_ + g_ * 4 * T + 4 * j); ka[slot_][g_] = *(const f4*)(qs_ + 128 + g_ * 4 * T + 4 * j); } \
            _Pragma("unroll") for (int cc_ = 0; cc_ < CPL; ++cc_) va[slot_][cc_] = vv[(s_) * 64 + col + 4 * cc_]; \
            if (MIX != 2) { sa[slot_] = sc[(s_) * 4]; sb[slot_] = sc[(s_) * 4 + 1]; } \
            if (MIX == 1) { const int dn_ = 16 * w + (lane & 15); kda[slot_] = qs_[128 + dn_]; qda[slot_] = qs_[dn_]; } } while (0)
        SCAN_LOADOPS(0, 0);
#pragma unroll 1
        for (int sg = 0; sg < TB; sg += T) {
#pragma unroll
            for (int ss = 0; ss < T; ++ss) {
                const int s = sg + ss; constexpr int dummy = 0; (void)dummy;
                const int cur = ss & 1, nxt = cur ^ 1;
                SCAN_LOADOPS(nxt, (s + 1) & (TB - 1));
                __builtin_amdgcn_sched_barrier(0);
                f2 qq[NP], kk[NP];
#pragma unroll
                for (int g = 0; g < NG; ++g) { qq[2 * g] = qa[cur][g].xy; qq[2 * g + 1] = qa[cur][g].zw; kk[2 * g] = ka[cur][g].xy; kk[2 * g + 1] = ka[cur][g].zw; }
                float onew[CPL];
#pragma unroll
                for (int cc = 0; cc < CPL; ++cc) {
                    const float v = va[cur][cc];
                    f2 oa = (f2){0.f, 0.f}, ob = (f2){0.f, 0.f};
                    if (MIX == 0) {
                        const float beta = sa[cur], a = sb[cur];
                        f2 ka2 = kk[0] * S2[cc][0], kb2 = kk[1] * S2[cc][1];
#pragma unroll
                        for (int i = 2; i < NP; i += 2) { ka2 = kk[i] * S2[cc][i] + ka2; kb2 = kk[i + 1] * S2[cc][i + 1] + kb2; }
                        ka2 = ka2 + kb2;
                        const float ks = grp_sum<T>(ka2.x + ka2.y);
                        const float u = beta * (v - a * ks);
                        const f2 a2 = (f2){a, a}, u2 = (f2){u, u};
#pragma unroll
                        for (int i = 0; i < NP; i += 2) { S2[cc][i] = S2[cc][i] * a2 + kk[i] * u2; S2[cc][i + 1] = S2[cc][i + 1] * a2 + kk[i + 1] * u2; oa = qq[i] * S2[cc][i] + oa; ob = qq[i + 1] * S2[cc][i + 1] + ob; }
                    } else if (MIX == 1) {
                        const float fp = sa[cur], ip = sb[cur], iv = ip * v;
                        const f2 f2v = (f2){fp, fp}, iv2 = (f2){iv, iv};
#pragma unroll
                        for (int i = 0; i < NP; i += 2) { S2[cc][i] = S2[cc][i] * f2v + kk[i] * iv2; S2[cc][i + 1] = S2[cc][i + 1] * f2v + kk[i + 1] * iv2; oa = qq[i] * S2[cc][i] + oa; ob = qq[i + 1] * S2[cc][i + 1] + ob; }
                    } else {
                        const f2 v2 = (f2){v, v};
#pragma unroll
                        for (int i = 0; i < NP; i += 2) { S2[cc][i] = kk[i] * (S2[cc][i] - v2) + v2; S2[cc][i + 1] = kk[i + 1] * (S2[cc][i + 1] - v2) + v2; oa = qq[i] * S2[cc][i] + oa; ob = qq[i + 1] * S2[cc][i + 1] + ob; }
                    }
                    oa = oa + ob; onew[cc] = oa.x + oa.y;
                }
                if (MIX == 1) { const float fp = sa[cur], ip = sb[cur];
                    nn = fp * nn + ip * kda[cur];
                    denp[s * 128 + 16 * w + (lane & 15)] = qda[cur] * nn; }
#pragma unroll
                for (int cc = 0; cc < CPL; ++cc) {
                    if (ss > 0) { const float o = grp_sum<T>(oprev[cc]); okeep[cc] = (ss - 1 == j) ? o : okeep[cc]; }
                    oprev[cc] = onew[cc]; }
            }
#pragma unroll
            for (int cc = 0; cc < CPL; ++cc) { const float o = grp_sum<T>(oprev[cc]); okeep[cc] = (T - 1 == j) ? o : okeep[cc];
                ost[(sg + j) * CPG + col + 4 * cc] = okeep[cc]; }
        }
#undef SCAN_LOADOPS
        if (blk + 1 < NBLK) SCAN_FINISH(Bn, par ^ 1);
        __syncthreads();
        if (tid < TB * (CPG / 8)) { const int orow = tid / (CPG / 8), oc8 = (tid % (CPG / 8)) * 8; const f4 o0 = *(const f4*)(ost + orow * CPG + oc8), o1 = *(const f4*)(ost + orow * CPG + oc8 + 4);
            u32x4_t ov; ov[0] = pg8::cvt_pk_bf16(o0.x, o0.y); ov[1] = pg8::cvt_pk_bf16(o0.z, o0.w); ov[2] = pg8::cvt_pk_bf16(o1.x, o1.y); ov[3] = pg8::cvt_pk_bf16(o1.z, o1.w);
            *(u32x4_t*)(outp + (rb + t0 + orow) * 512 + h * 128 + cgp * CPG + oc8) = ov; }
        if (MIX == 1) {
            if (cgp == 0) { const int sr = tid >> 4, jl = tid & 15; const f4 a0 = *(const f4*)(denp + sr * 128 + 8 * jl), a1 = *(const f4*)(denp + sr * 128 + 8 * jl + 4);
                const float d = grp_sum16((a0.x + a0.y) + (a0.z + a0.w) + (a1.x + a1.y) + (a1.z + a1.w));
                if (jl == 0) { const size_t r = rb + t0 + sr; ((float*)(PWS + W_DEN))[r * 4 + h] = d; ((float*)(PWS + W_MT))[r * 4 + h] = sc[sr * 4 + 2]; } }
            if (blk + 1 < NBLK) SCAN_CHAIN(Bn);
            __syncthreads();
        }
      }
    }
#undef SCAN_ISSUE
#undef SCAN_FINISH
#undef SCAN_CHAIN
    const size_t sidx = ((size_t)(l * NBP + b) * NH + h);
    float* So = POUT + (MIX == 0 ? O_P_GS : (MIX == 1 ? O_P_MC : O_P_HS)) + sidx * 16384;
#pragma unroll
    for (int cc = 0; cc < CPL; ++cc)
#pragma unroll
        for (int g = 0; g < NG; ++g) { const int d0 = g * 4 * T + 4 * j, ec = ecol + 4 * cc;
            So[(size_t)(d0 + 0) * 128 + ec] = S2[cc][2 * g].x; So[(size_t)(d0 + 1) * 128 + ec] = S2[cc][2 * g].y; So[(size_t)(d0 + 2) * 128 + ec] = S2[cc][2 * g + 1].x; So[(size_t)(d0 + 3) * 128 + ec] = S2[cc][2 * g + 1].y; }
    if (MIX == 1 && cgp == 0) {
        if (lane < 16) POUT[O_P_MN + sidx * 128 + 16 * w + lane] = nn;
        if (tid == 64) POUT[O_P_MM + sidx] = mcar[0];
    }
    __syncthreads();
}

template <int MIX>
__device__ __forceinline__ void scan_prompt_lin(const Params& p, int l, int b, int h, int cgp, float* sm) {
    constexpr int TB = 32, NBLK = SEQ / TB;
    int tid_ = threadIdx.x; asm volatile("" : "+v"(tid_)); const int tid = tid_, lane = tid & 63, w = tid >> 6;
    float* qk = sm; float* vv = sm + 8192; float* denp = sm + 10240; float* opart = sm + 14336; float* scall = sm + 30720;
    const float* gates = (const float*)(PWS + W_GATES);
    bf16_t* outp = (bf16_t*)(PWS + W_OUTS) + (size_t)MIX * MT * 512;
    const size_t rb = (size_t)b * SEQ;
    const int c8 = (tid & 31) * 8, srow = tid >> 5;
    const int base = MIX == 1 ? 2048 : 4096;
    const bf16_t* qsrc = (const bf16_t*)(PWS + W_PROJ) + rb * N1 + base + (c8 < 128 ? h * 128 + c8 : 512 + h * 128 + (c8 - 128));
    const bf16_t* vsrc = (const bf16_t*)(PWS + W_PROJ) + rb * N1 + base + 1024 + h * 128 + cgp * 64;
    const int vs = tid >> 3, vc8 = (tid & 7) * 8; const bool vact = tid < TB * 8;
    float lb8[8];
#pragma unroll
    for (int i = 0; i < 8; ++i) lb8[i] = 0.f;
    if (MIX == 2 && l > 0 && c8 >= 128) { const float* hl = PIN(I_HLB);
#pragma unroll
        for (int i = 0; i < 8; ++i) { const int cc = h * 128 + (c8 - 128) + i; lb8[i] = sigm(hl[512 + cc] - hl[cc]); } }
    __syncthreads();
    float mfinal = 0.f;
    if (MIX == 1) {
        float* graw = opart;
        for (int i = tid; i < SEQ; i += 512) { const size_t r = rb + i; graw[2 * i] = gates[r * 16 + 8 + h]; graw[2 * i + 1] = gates[r * 16 + 12 + h]; }
        __syncthreads();
        if (w == 1) { float m0 = 0.f; const int ls = lane & 31;
            for (int t0 = 0; t0 < SEQ; t0 += 32) {
                const float ig = graw[2 * (t0 + ls)], lf = graw[2 * (t0 + ls) + 1];
                float F = lf; F += dppf<0x111>(F); F += dppf<0x112>(F); F += dppf<0x114>(F); F += dppf<0x118>(F);
                { const float t0v = rdlane(F, 15); if (lane & 16) F += t0v; }
                float P = ig - F; P = fmaxf(P, dppm<0x111>(P)); P = fmaxf(P, dppm<0x112>(P)); P = fmaxf(P, dppm<0x114>(P)); P = fmaxf(P, dppm<0x118>(P));
                { const float t1v = rdlane(P, 15); if (lane & 16) P = fmaxf(P, t1v); }
                const float m = F + fmaxf(m0, P);
                float mp = dppf<0x111>(m); { const float t2v = rdlane(m, 15); if ((lane & 15) == 0) mp = (lane & 16) ? t2v : m0; }
                (void)mp;
                if (lane < 32) { scall[2 * (t0 + lane)] = __expf(F + m0 - m); scall[2 * (t0 + lane) + 1] = __expf(ig - F - m0) * QSCALE;
                    if (cgp == 0) ((float*)(PWS + W_MT))[(rb + t0 + lane) * 4 + h] = m; }
                m0 = rdlane(m, 31); }
            mfinal = m0; }
        __syncthreads();
    }
    f2 S2[8];
#pragma unroll
    for (int i = 0; i < 8; ++i) S2[i] = (f2){0.f, 0.f};
    float nn = 0.f;
    u32x4_t rq[2][2], rv[2]; rv[0] = (u32x4_t){0u, 0u, 0u, 0u}; rv[1] = rv[0];
#define LIN_ISSUE(t0_, st_) do { \
        _Pragma("unroll") for (int i_ = 0; i_ < 2; ++i_) rq[st_][i_] = *(const u32x4_t*)(qsrc + (size_t)((t0_) + srow + 16 * i_) * N1); \
        if (vact) rv[st_] = *(const u32x4_t*)(vsrc + (size_t)((t0_) + vs) * N1 + vc8); } while (0)
#define LIN_FINISH(st_) do { \
        _Pragma("unroll") for (int i_ = 0; i_ < 2; ++i_) { float x_[8]; \
            _Pragma("unroll") for (int e_ = 0; e_ < 4; ++e_) { x_[2 * e_] = bflo(rq[st_][i_][e_]); x_[2 * e_ + 1] = bfhi(rq[st_][i_][e_]); } \
            if (MIX == 2 && c8 >= 128) { _Pragma("unroll") for (int e_ = 0; e_ < 8; ++e_) x_[e_] = lb8[e_] + (1.f - lb8[e_]) * sigm(x_[e_]); } \
            float* d_ = qk + (srow + 16 * i_) * 256 + c8; *(f4*)d_ = (f4){x_[0], x_[1], x_[2], x_[3]}; *(f4*)(d_ + 4) = (f4){x_[4], x_[5], x_[6], x_[7]}; } \
        if (vact) { float* d_ = vv + vs * 64 + vc8; *(f4*)d_ = (f4){bflo(rv[st_][0]), bfhi(rv[st_][0]), bflo(rv[st_][1]), bfhi(rv[st_][1])}; *(f4*)(d_ + 4) = (f4){bflo(rv[st_][2]), bfhi(rv[st_][2]), bflo(rv[st_][3]), bfhi(rv[st_][3])}; } } while (0)
    LIN_ISSUE(0, 0);
    LIN_FINISH(0);
    LIN_ISSUE(TB, 1);
    __syncthreads();
#pragma unroll 1
    for (int blk2 = 0; blk2 < NBLK; blk2 += 2) {
#pragma unroll
      for (int par = 0; par < 2; ++par) {
        const int blk = blk2 + par;
        const int t0 = blk * TB;
        if (blk + 2 < NBLK) LIN_ISSUE(t0 + 2 * TB, par);
        f4 qa[2][4], ka[2][4]; float va[2], kda[2], qda[2]; f2 sca[2];
#define LIN_LOADOPS(slot_, s_) do { const float* qs_ = qk + (s_) * 256 + 16 * w; \
            _Pragma("unroll") for (int g_ = 0; g_ < 4; ++g_) { qa[slot_][g_] = *(const f4*)(qs_ + 4 * g_); ka[slot_][g_] = *(const f4*)(qs_ + 128 + 4 * g_); } \
            va[slot_] = vv[(s_) * 64 + lane]; \
            if (MIX == 1) { sca[slot_] = *(const f2*)(scall + 2 * (t0 + (s_))); kda[slot_] = qs_[128 + (lane & 15)]; qda[slot_] = qs_[lane & 15]; } } while (0)
        LIN_LOADOPS(0, 0);
#pragma unroll 1
        for (int sg = 0; sg < TB; sg += 4) {
#pragma unroll
            for (int ss = 0; ss < 4; ++ss) {
                const int s = sg + ss, cur = ss & 1, nxt = cur ^ 1;
                LIN_LOADOPS(nxt, (s + 1) & (TB - 1));
                __builtin_amdgcn_sched_barrier(0);
                f2 qq[8], kk[8];
#pragma unroll
                for (int g = 0; g < 4; ++g) { qq[2 * g] = qa[cur][g].xy; qq[2 * g + 1] = qa[cur][g].zw; kk[2 * g] = ka[cur][g].xy; kk[2 * g + 1] = ka[cur][g].zw; }
                const float v = va[cur];
                f2 oa = (f2){0.f, 0.f}, ob = (f2){0.f, 0.f};
                if (MIX == 1) {
                    const float Fb = sca[cur].x, av = sca[cur].y, iv = av * v;
                    const f2 iv2 = (f2){iv, iv};
#pragma unroll
                    for (int i = 0; i < 8; i += 2) { S2[i] = kk[i] * iv2 + S2[i]; S2[i + 1] = kk[i + 1] * iv2 + S2[i + 1]; oa = qq[i] * S2[i] + oa; ob = qq[i + 1] * S2[i + 1] + ob; }
                    nn = av * kda[cur] + nn;
                    denp[s * 128 + 16 * w + (lane & 15)] = Fb * qda[cur] * nn;
                    oa = oa * (f2){Fb, Fb}; ob = ob * (f2){Fb, Fb};
                } else {
                    const f2 v2 = (f2){v, v};
#pragma unroll
                    for (int i = 0; i < 8; i += 2) { S2[i] = kk[i] * (S2[i] - v2) + v2; S2[i + 1] = kk[i + 1] * (S2[i + 1] - v2) + v2; oa = qq[i] * S2[i] + oa; ob = qq[i + 1] * S2[i + 1] + ob; }
                }
                oa = oa + ob;
                opart[(s * 8 + w) * 64 + lane] = oa.x + oa.y;
            }
        }
#undef LIN_LOADOPS
        if (MIX == 1) { const float Fe = scall[2 * (t0 + TB - 1)]; const f2 Fe2 = (f2){Fe, Fe};
#pragma unroll
            for (int i = 0; i < 8; ++i) S2[i] = S2[i] * Fe2;
            nn *= Fe; }
        __syncthreads();
        { const int s = tid >> 5, e2 = (tid & 31) * 2; f2 acc2 = (f2){0.f, 0.f};
#pragma unroll
            for (int ww = 0; ww < 8; ++ww) acc2 = acc2 + *(const f2*)(opart + (s * 8 + ww) * 64 + e2);
            const int s2 = s + 16; f2 acc3 = (f2){0.f, 0.f};
#pragma unroll
            for (int ww = 0; ww < 8; ++ww) acc3 = acc3 + *(const f2*)(opart + (s2 * 8 + ww) * 64 + e2);
            *(unsigned*)(outp + (rb + t0 + s) * 512 + h * 128 + cgp * 64 + e2) = pg8::cvt_pk_bf16(acc2.x, acc2.y);
            *(unsigned*)(outp + (rb + t0 + s2) * 512 + h * 128 + cgp * 64 + e2) = pg8::cvt_pk_bf16(acc3.x, acc3.y); }
        if (MIX == 1 && cgp == 0) { const int sr = tid >> 4, jl = tid & 15; const f4 a0 = *(const f4*)(denp + sr * 128 + 8 * jl), a1 = *(const f4*)(denp + sr * 128 + 8 * jl + 4);
            const float d = grp_sum16((a0.x + a0.y) + (a0.z + a0.w) + (a1.x + a1.y) + (a1.z + a1.w));
            if (jl == 0) ((float*)(PWS + W_DEN))[(rb + t0 + sr) * 4 + h] = d; }
        if (blk + 1 < NBLK) LIN_FINISH(par ^ 1);
        __syncthreads();
      }
    }
#undef LIN_ISSUE
#undef LIN_FINISH
    const size_t sidx = ((size_t)(l * NBP + b) * NH + h);
    float* So = POUT + (MIX == 1 ? O_P_MC : O_P_HS) + sidx * 16384;
#pragma unroll
    for (int i = 0; i < 8; ++i) { So[(size_t)(16 * w + 2 * i) * 128 + cgp * 64 + lane] = S2[i].x; So[(size_t)(16 * w + 2 * i + 1) * 128 + cgp * 64 + lane] = S2[i].y; }
    if (MIX == 1 && cgp == 0) {
        if (lane < 16) POUT[O_P_MN + sidx * 128 + 16 * w + lane] = nn;
        if (tid == 64) POUT[O_P_MM + sidx] = mfinal;
    }
    __syncthreads();
}

__device__ __forceinline__ void scan_sample_item(const Params& p, int l, int mix, int b, int h, float* sm) {
    int tid_ = threadIdx.x; asm volatile("" : "+v"(tid_)); const int tid = tid_, lane = tid & 63, w = tid >> 6, e = tid & 127, dg = tid >> 7;
    float* qk = sm; float* vv = sm + 1024; float* gs = sm + 1536; float* red = sm + 1600; float* dpart = sm + 1600 + 4096;
    const bf16_t* proj = (const bf16_t*)(PWS + W_PROJ);
    const float* gates = (const float*)(PWS + W_GATES);
    bf16_t* outp = (bf16_t*)(PWS + W_OUTS) + (size_t)mix * MT * 512;
    const size_t rs = (size_t)MP + (size_t)b * SSEQ;
    const size_t sidx = ((size_t)(l * NBS + b) * NH + h);
    const float* Sin = (mix == 0 ? PIN(I_SGS) : (mix == 1 ? PIN(I_SMC) : PIN(I_SHS))) + sidx * 16384;
    float S[32];
#pragma unroll
    for (int i = 0; i < 32; ++i) S[i] = Sin[(size_t)(32 * dg + i) * 128 + e];
    __syncthreads();
    for (int idx = tid; idx < 4 * 384; idx += 512) { const int s = idx / 384, ch = idx - s * 384; float val;
        if (mix == 0) { val = ch < 256 ? bf2f(((const bf16_t*)(PWS + W_HBF))[(rs + s) * 1024 + (ch >> 7) * 512 + h * 128 + (ch & 127)]) : bf2f(outp[(rs + s) * 512 + h * 128 + (ch - 256)]);
        } else if (mix == 1) { const int colx = 2048 + (ch >> 7) * 512 + h * 128 + (ch & 127); val = bf2f(proj[(rs + s) * N1 + colx]); }
        else { const int colx = 4096 + (ch >> 7) * 512 + h * 128 + (ch & 127); val = bf2f(proj[(rs + s) * N1 + colx]);
            if (ch >= 128 && ch < 256) { float lbv = 0.f; if (l > 0) { const float* hl = PIN(I_HLB); const int cc = h * 128 + (ch & 127); lbv = sigm(hl[512 + cc] - hl[cc]); } val = lbv + (1.f - lbv) * sigm(val); } }
        if (ch < 256) qk[s * 256 + ch] = val; else vv[s * 128 + ch - 256] = val; }
    if (tid < 4) { const size_t r = rs + tid;
        if (mix == 0) { gs[tid * 4] = gates[r * 16 + h]; gs[tid * 4 + 1] = gates[r * 16 + 4 + h]; }
        else if (mix == 1) { gs[tid * 4] = gates[r * 16 + 8 + h]; gs[tid * 4 + 1] = gates[r * 16 + 12 + h]; } }
    __syncthreads();
    float m = 0.f, nn = 0.f, mts[4] = {0.f, 0.f, 0.f, 0.f};
    if (mix == 1) { m = PIN(I_SMM)[sidx]; if (dg == 0) nn = PIN(I_SMN)[sidx * 128 + e]; }
#pragma unroll
    for (int s = 0; s < 4; ++s) {
        const float* qs = qk + s * 256 + 32 * dg; const float* ksp = qs + 128;
        const float v = vv[s * 128 + e];
        float po = 0.f;
        if (mix == 0) {
            const float beta = gs[s * 4], a = gs[s * 4 + 1];
            float pk = 0.f;
#pragma unroll
            for (int i = 0; i < 32; ++i) pk += ksp[i] * S[i];
            red[((s * 2) * 4 + dg) * 128 + e] = pk;
            __syncthreads();
            const float ks = red[((s * 2) * 4 + 0) * 128 + e] + red[((s * 2) * 4 + 1) * 128 + e] + red[((s * 2) * 4 + 2) * 128 + e] + red[((s * 2) * 4 + 3) * 128 + e];
            const float u = beta * (v - a * ks);
#pragma unroll
            for (int i = 0; i < 32; ++i) { S[i] = a * S[i] + ksp[i] * u; po += qs[i] * S[i]; }
        } else if (mix == 1) {
            const float ig = gs[s * 4], lf = gs[s * 4 + 1]; const float mn = fmaxf(lf + m, ig); const float fp = __expf(lf + m - mn), ip = __expf(ig - mn) * QSCALE; m = mn; mts[s] = mn;
            const float iv = ip * v;
#pragma unroll
            for (int i = 0; i < 32; ++i) { S[i] = fp * S[i] + ksp[i] * iv; po += qs[i] * S[i]; }
            if (dg == 0) { nn = fp * nn + ip * qk[s * 256 + 128 + e]; const float dp = wave_sum(qk[s * 256 + e] * nn); if (lane == 0) dpart[s * 2 + w] = dp; }
        } else {
#pragma unroll
            for (int i = 0; i < 32; ++i) { S[i] = ksp[i] * (S[i] - v) + v; po += qs[i] * S[i]; }
        }
        red[((s * 2 + 1) * 4 + dg) * 128 + e] = po;
    }
    __syncthreads();
    if (tid < 128) {
#pragma unroll
        for (int s = 0; s < 4; ++s) { const float o = red[((s * 2 + 1) * 4 + 0) * 128 + e] + red[((s * 2 + 1) * 4 + 1) * 128 + e] + red[((s * 2 + 1) * 4 + 2) * 128 + e] + red[((s * 2 + 1) * 4 + 3) * 128 + e];
            outp[(rs + s) * 512 + h * 128 + e] = f2bf(o); } }
    if (mix == 1 && tid == 0) {
#pragma unroll
        for (int s = 0; s < 4; ++s) { ((float*)(PWS + W_DEN))[(rs + s) * 4 + h] = dpart[s * 2] + dpart[s * 2 + 1]; ((float*)(PWS + W_MT))[(rs + s) * 4 + h] = mts[s]; }
        POUT[O_S_MM + sidx] = m; }
    float* So = POUT + (mix == 0 ? O_S_GS : (mix == 1 ? O_S_MC : O_S_HS)) + sidx * 16384;
#pragma unroll
    for (int i = 0; i < 32; ++i) So[(size_t)(32 * dg + i) * 128 + e] = S[i];
    if (mix == 1 && dg == 0) POUT[O_S_MN + sidx * 128 + e] = nn;
}

__device__ __forceinline__ void scan_sample_all(const Params& p, int l, float* sm) {
    int tid_ = threadIdx.x; asm volatile("" : "+v"(tid_)); const int tid = tid_, lane = tid & 63, w = tid >> 6, e = tid & 127, dg = tid >> 7;
    float* qk = sm; float* vv = sm + 1024; float* gs = sm + 1536; float* red = sm + 1600; float* dpart = sm + 1600 + 4096; volatile int* qslot = (volatile int*)(sm + 5760);
    float* simg = sm + 6144;
    PG8_LAS unsigned char* simg_l = (PG8_LAS unsigned char*)simg;
    const bf16_t* proj = (const bf16_t*)(PWS + W_PROJ); const bf16_t* hbf = (const bf16_t*)(PWS + W_HBF);
    const float* gates = (const float*)(PWS + W_GATES);
    bf16_t* outs = (bf16_t*)(PWS + W_OUTS);
    unsigned* qctr = (unsigned*)(PWS + W_BAR) + 64 * l;
    constexpr int NIT = 3 * NBS * NH;
    const float* hl = PIN(I_HLB);
    __syncthreads();
    if (tid == 0) { qslot[0] = (int)__hip_atomic_fetch_add(qctr, 1u, __ATOMIC_RELAXED, __HIP_MEMORY_SCOPE_AGENT); qslot[1] = (int)__hip_atomic_fetch_add(qctr, 1u, __ATOMIC_RELAXED, __HIP_MEMORY_SCOPE_AGENT); }
    __syncthreads();
    int it0 = qslot[0], it1 = qslot[1];
    float stg[3], gn0 = 0.f, gn1 = 0.f, mn_in = 0.f, nn_in = 0.f;
    stg[0] = stg[1] = stg[2] = 0.f;
#define SMP_ISSUE(it_) do { const int mix_ = (it_) / (NBS * NH), r_ = (it_) - mix_ * (NBS * NH), b_ = r_ >> 2, h_ = r_ & 3; \
        const size_t sidx_ = ((size_t)(l * NBS + b_) * NH + h_), rs_ = (size_t)MP + (size_t)b_ * SSEQ; \
        const float* Sin_ = (mix_ == 0 ? PIN(I_SGS) : (mix_ == 1 ? PIN(I_SMC) : PIN(I_SHS))) + sidx_ * 16384; \
        _Pragma("unroll") for (int k_ = 0; k_ < 8; ++k_) __builtin_amdgcn_global_load_lds((const unsigned*)((const char*)Sin_ + (size_t)((w * 8 + k_) * 1024 + lane * 16)), (PG8_LAS unsigned*)(simg_l + (w * 8 + k_) * 1024), 16, 0, 0); \
        int tq_ = tid; asm volatile("" : "+v"(tq_)); \
        _Pragma("unroll") for (int k_ = 0; k_ < 3; ++k_) { const int idx_ = tq_ + 512 * k_, s_ = idx_ / 384, ch_ = idx_ - s_ * 384; unsigned short raw_; \
            if (mix_ == 0) raw_ = ch_ < 256 ? hbf[(rs_ + s_) * 1024 + (ch_ >> 7) * 512 + h_ * 128 + (ch_ & 127)] : outs[(rs_ + s_) * 512 + h_ * 128 + (ch_ - 256)]; \
            else raw_ = proj[(rs_ + s_) * N1 + (mix_ == 1 ? 2048 : 4096) + (ch_ >> 7) * 512 + h_ * 128 + (ch_ & 127)]; \
            stg[k_] = bf2f(raw_); } \
        if (tid < 4 && mix_ != 2) { const size_t rr_ = rs_ + tid; gn0 = gates[rr_ * 16 + (mix_ == 0 ? 0 : 8) + h_]; gn1 = gates[rr_ * 16 + (mix_ == 0 ? 4 : 12) + h_]; } \
        if (mix_ == 1) { mn_in = PIN(I_SMM)[sidx_]; if (dg == 0) nn_in = PIN(I_SMN)[sidx_ * 128 + e]; } } while (0)
    if (it0 < NIT) SMP_ISSUE(it0);
    while (it0 < NIT) {
#ifdef TPROBE_ITEM
        const unsigned long long tst_ = __builtin_amdgcn_s_memrealtime();
#endif
        const int mix = it0 / (NBS * NH), r = it0 - mix * (NBS * NH), b = r >> 2, h = r & 3;
        const size_t sidx = ((size_t)(l * NBS + b) * NH + h), rs = (size_t)MP + (size_t)b * SSEQ;
        bf16_t* outp = outs + (size_t)mix * MT * 512;
        asm volatile("s_waitcnt vmcnt(0)" ::: "memory");
        lds_barrier();
        float S[32];
#pragma unroll
        for (int i = 0; i < 32; ++i) S[i] = simg[(32 * dg + i) * 128 + e];
        float m = mn_in, nn = nn_in;
#pragma unroll
        for (int k = 0; k < 3; ++k) { const int idx = tid + 512 * k, s = idx / 384, ch = idx - s * 384; float val = stg[k];
            if (mix == 2 && ch >= 128 && ch < 256) { float lbv = 0.f; if (l > 0) { const int cc = h * 128 + (ch & 127); lbv = sigm(hl[512 + cc] - hl[cc]); } val = lbv + (1.f - lbv) * sigm(val); }
            if (ch < 256) qk[s * 256 + ch] = val; else vv[s * 128 + ch - 256] = val; }
        if (tid < 4 && mix != 2) { gs[tid * 4] = gn0; gs[tid * 4 + 1] = gn1; }
        int it2 = NIT;
        if (tid == 0) it2 = (int)__hip_atomic_fetch_add(qctr, 1u, __ATOMIC_RELAXED, __HIP_MEMORY_SCOPE_AGENT);
        lds_barrier();
        if (it1 < NIT) SMP_ISSUE(it1);
#pragma unroll 1
        for (int s = 0; s < 4; ++s) {
            const float* qs = qk + s * 256 + 32 * dg; const float* ksp = qs + 128;
            const float v = vv[s * 128 + e];
            float po = 0.f;
            if (mix == 0) {
                const float beta = gs[s * 4], a = gs[s * 4 + 1];
                float pk = 0.f;
#pragma unroll
                for (int c4 = 0; c4 < 4; ++c4) {
#pragma unroll
                    for (int i = 8 * c4; i < 8 * c4 + 8; ++i) pk += ksp[i] * S[i];
                    __builtin_amdgcn_sched_barrier(0); }
                red[((s * 2) * 4 + dg) * 128 + e] = pk;
                lds_barrier();
                const float ks = red[((s * 2) * 4 + 0) * 128 + e] + red[((s * 2) * 4 + 1) * 128 + e] + red[((s * 2) * 4 + 2) * 128 + e] + red[((s * 2) * 4 + 3) * 128 + e];
                const float u = beta * (v - a * ks);
#pragma unroll
                for (int c4 = 0; c4 < 4; ++c4) {
#pragma unroll
                    for (int i = 8 * c4; i < 8 * c4 + 8; ++i) { S[i] = a * S[i] + ksp[i] * u; po += qs[i] * S[i]; }
                    __builtin_amdgcn_sched_barrier(0); }
            } else if (mix == 1) {
                const float ig = gs[s * 4], lf = gs[s * 4 + 1]; const float mn = fmaxf(lf + m, ig); const float fp = __expf(lf + m - mn), ip = __expf(ig - mn) * QSCALE; m = mn; if (tid == 0) ((float*)(PWS + W_MT))[(rs + s) * 4 + h] = mn;
                const float iv = ip * v;
#pragma unroll
                for (int c4 = 0; c4 < 4; ++c4) {
#pragma unroll
                    for (int i = 8 * c4; i < 8 * c4 + 8; ++i) { S[i] = fp * S[i] + ksp[i] * iv; po += qs[i] * S[i]; }
                    __builtin_amdgcn_sched_barrier(0); }
                if (dg == 0) { nn = fp * nn + ip * qk[s * 256 + 128 + e]; const float dp = wave_sum(qk[s * 256 + e] * nn); if (lane == 0) dpart[s * 2 + w] = dp; }
            } else {
#pragma unroll
                for (int c4 = 0; c4 < 4; ++c4) {
#pragma unroll
                    for (int i = 8 * c4; i < 8 * c4 + 8; ++i) { S[i] = ksp[i] * (S[i] - v) + v; po += qs[i] * S[i]; }
                    __builtin_amdgcn_sched_barrier(0); }
            }
            red[((s * 2 + 1) * 4 + dg) * 128 + e] = po;
        }
        if (tid == 0) qslot[0] = it2;
        lds_barrier();
        if (tid < 128) {
#pragma unroll
            for (int s = 0; s < 4; ++s) { const float o = red[((s * 2 + 1) * 4 + 0) * 128 + e] + red[((s * 2 + 1) * 4 + 1) * 128 + e] + red[((s * 2 + 1) * 4 + 2) * 128 + e] + red[((s * 2 + 1) * 4 + 3) * 128 + e];
                outp[(rs + s) * 512 + h * 128 + e] = f2bf(o); } }
        if (mix == 1 && tid == 0) {
#pragma unroll
            for (int s = 0; s < 4; ++s) { ((float*)(PWS + W_DEN))[(rs + s) * 4 + h] = dpart[s * 2] + dpart[s * 2 + 1]; }
            POUT[O_S_MM + sidx] = m; }
        float* So = POUT + (mix == 0 ? O_S_GS : (mix == 1 ? O_S_MC : O_S_HS)) + sidx * 16384;
#ifndef DUPST
#define DUPST 1
#endif
        for (int rst = 0; rst < DUPST; ++rst) {
#pragma unroll
        for (int i = 0; i < 32; ++i) So[(size_t)(32 * dg + i) * 128 + e] = S[i];
        if (DUPST > 1) { asm volatile("s_waitcnt vmcnt(0)" ::: "memory"); } }
        if (mix == 1 && dg == 0) POUT[O_S_MN + sidx * 128 + e] = nn;
        it0 = it1; it1 = qslot[0];
        lds_barrier();
#ifdef TPROBE_ITEM
        if (blockIdx.x == TPROBE_WG && threadIdx.x == 0) { volatile unsigned long long* sp_ = (volatile unsigned long long*)((unsigned char*)sm + LDS_MAIN + 64); sp_[40] += __builtin_amdgcn_s_memrealtime() - tst_; sp_[41] += 1; }
#endif
    }
#undef SMP_ISSUE
}
__device__ __forceinline__ void phase_postnorm(const Params& p, int l) {
    int tid_ = threadIdx.x; asm volatile("" : "+v"(tid_)); const int tid = tid_, j = tid & 15;
    bf16_t* outs = (bf16_t*)(PWS + W_OUTS);
    const bf16_t* proj = (const bf16_t*)(PWS + W_PROJ);
    const float* den = (const float*)(PWS + W_DEN); const float* mt = (const float*)(PWS + W_MT);
    const int ngroups = MT * 12, half = ngroups / 2;
    for (int gid0 = bidx() * 32 + (tid >> 4); gid0 < half; gid0 += gdim() * 32) {
        u32x4_t raw[2], gr[2]; float dnv[2], mtv[2]; float4 n0[2], n1[2]; bf16_t* opp[2]; int mixk[2];
#pragma unroll
        for (int k = 0; k < 2; ++k) { const int gid = gid0 + k * half;
            const int r = gid / 12, mh = gid - r * 12, mix = mh >> 2, h = mh & 3; mixk[k] = mix;
            opp[k] = outs + (size_t)mix * MT * 512 + (size_t)r * 512 + h * 128 + 8 * j;
            raw[k] = *(const u32x4_t*)opp[k];
            const int gcol = (mix == 0 ? 1536 : (mix == 1 ? 3584 : 5632)) + h * 128 + 8 * j;
            gr[k] = *(const u32x4_t*)(proj + (size_t)r * N1 + gcol);
            dnv[k] = den[(size_t)r * 4 + h]; mtv[k] = mt[(size_t)r * 4 + h];
            const float* nw = (mix == 0 ? PIN(I_GNORM) : (mix == 1 ? PIN(I_MNORM) : PIN(I_HNORM))) + l * 512 + h * 128 + 8 * j;
            n0[k] = *(const float4*)nw; n1[k] = *(const float4*)(nw + 4); }
#pragma unroll
        for (int k = 0; k < 2; ++k) {
            float v[8];
#pragma unroll
            for (int i = 0; i < 4; ++i) { v[2 * i] = bflo(raw[k][i]); v[2 * i + 1] = bfhi(raw[k][i]); }
            if (mixk[k] == 1) { const float dn = fmaxf(fabsf(dnv[k]), __expf(-mtv[k])); const float inv = 1.f / dn;
#pragma unroll
                for (int i = 0; i < 8; ++i) v[i] *= inv; }
            float ss = 0.f;
#pragma unroll
            for (int i = 0; i < 8; ++i) ss += v[i] * v[i];
            ss = grp_sum16(ss);
            const float rstd = rsqrtf(ss * (1.f / 128.f) + EPS);
            const float nwv[8] = {n0[k].x, n0[k].y, n0[k].z, n0[k].w, n1[k].x, n1[k].y, n1[k].z, n1[k].w};
#pragma unroll
            for (int i = 0; i < 4; ++i) { v[2 * i] *= rstd * nwv[2 * i] * bflo(gr[k][i]); v[2 * i + 1] *= rstd * nwv[2 * i + 1] * bfhi(gr[k][i]); }
            u32x4_t o; o[0] = pg8::cvt_pk_bf16(v[0], v[1]); o[1] = pg8::cvt_pk_bf16(v[2], v[3]); o[2] = pg8::cvt_pk_bf16(v[4], v[5]); o[3] = pg8::cvt_pk_bf16(v[6], v[7]);
            *(u32x4_t*)opp[k] = o; }
    }
    const int ncs = (NBP + NBS) * 3 * 1536;
    for (int i = bidx() * 512 + tid; i < ncs; i += gdim() * 512) {
        const int cc = i % 1536, ri = (i / 1536) % 3, bb = i / (3 * 1536);
        if (bb < NBP) POUT[O_P_GC + ((size_t)(l * NBP + bb) * 3 + ri) * 1536 + cc] = bf2f(proj[((size_t)bb * SEQ + SEQ - 3 + ri) * N1 + cc]);
        else { const int b2 = bb - NBP; POUT[O_S_GC + ((size_t)(l * NBS + b2) * 3 + ri) * 1536 + cc] = bf2f(proj[((size_t)MP + (size_t)b2 * SSEQ + 1 + ri) * N1 + cc]); }
    }
}

__device__ __forceinline__ void phase_convffn(const Params& p, int l) {
    int tid_ = threadIdx.x; asm volatile("" : "+v"(tid_)); const int tid = tid_;
    const bf16_t* u = (const bf16_t*)(PWS + W_PROJ);
    bf16_t* act = (bf16_t*)(PWS + W_ACT);
    const float* cw = PIN(I_FCW) + (size_t)l * 3 * NUP; const float* cb = PIN(I_FCB) + (size_t)l * NUP;
    const int nitems = (MT / 4) * (DFF / 8);
    for (int it = bidx() * 512 + tid; it < nitems; it += gdim() * 512) {
        const int jg = it % (DFF / 8), rbk = it / (DFF / 8), r0 = rbk * 4, jc = jg * 8;
        const bool samp = r0 >= MP; const int tf = samp ? 0 : (r0 & (SEQ - 1));
        float wa[3][8], wb[3][8], ba[8], bb[8];
#pragma unroll
        for (int i = 0; i < 3; ++i) { const float4 a0 = *(const float4*)(cw + i * NUP + jc), a1 = *(const float4*)(cw + i * NUP + jc + 4), b0 = *(const float4*)(cw + i * NUP + DFF + jc), b1 = *(const float4*)(cw + i * NUP + DFF + jc + 4);
            wa[i][0] = a0.x; wa[i][1] = a0.y; wa[i][2] = a0.z; wa[i][3] = a0.w; wa[i][4] = a1.x; wa[i][5] = a1.y; wa[i][6] = a1.z; wa[i][7] = a1.w;
            wb[i][0] = b0.x; wb[i][1] = b0.y; wb[i][2] = b0.z; wb[i][3] = b0.w; wb[i][4] = b1.x; wb[i][5] = b1.y; wb[i][6] = b1.z; wb[i][7] = b1.w; }
        { const float4 a0 = *(const float4*)(cb + jc), a1 = *(const float4*)(cb + jc + 4), b0 = *(const float4*)(cb + DFF + jc), b1 = *(const float4*)(cb + DFF + jc + 4);
            ba[0] = a0.x; ba[1] = a0.y; ba[2] = a0.z; ba[3] = a0.w; ba[4] = a1.x; ba[5] = a1.y; ba[6] = a1.z; ba[7] = a1.w;
            bb[0] = b0.x; bb[1] = b0.y; bb[2] = b0.z; bb[3] = b0.w; bb[4] = b1.x; bb[5] = b1.y; bb[6] = b1.z; bb[7] = b1.w; }
        float xa[6][8], xb[6][8];
#pragma unroll
        for (int rr = 0; rr < 6; ++rr) {
            if (rr < 2 && tf == 0) {
                if (samp) { const float* st = PIN(I_SFC) + ((size_t)(l * NBS + (r0 - MP) / 4) * 2 + rr) * NUP;
#pragma unroll
                    for (int i = 0; i < 8; ++i) { xa[rr][i] = st[jc + i]; xb[rr][i] = st[DFF + jc + i]; } }
                else {
#pragma unroll
                    for (int i = 0; i < 8; ++i) { xa[rr][i] = 0.f; xb[rr][i] = 0.f; } }
            } else { const bf16_t* ur = u + (size_t)(r0 - 2 + rr) * NUP; const u32x4_t ra = *(const u32x4_t*)(ur + jc), rbv = *(const u32x4_t*)(ur + DFF + jc);
#pragma unroll
                for (int i = 0; i < 4; ++i) { xa[rr][2 * i] = bflo(ra[i]); xa[rr][2 * i + 1] = bfhi(ra[i]); xb[rr][2 * i] = bflo(rbv[i]); xb[rr][2 * i + 1] = bfhi(rbv[i]); } }
        }
#pragma unroll
        for (int t = 0; t < 4; ++t) { float o[8];
#pragma unroll
            for (int i = 0; i < 8; ++i) { const float ya = wa[0][i] * xa[t][i] + wa[1][i] * xa[t + 1][i] + wa[2][i] * xa[t + 2][i] + ba[i]; const float yb = wb[0][i] * xb[t][i] + wb[1][i] * xb[t + 1][i] + wb[2][i] * xb[t + 2][i] + bb[i]; o[i] = silu(ya) * yb; }
            u32x4_t ov; ov[0] = pg8::cvt_pk_bf16(o[0], o[1]); ov[1] = pg8::cvt_pk_bf16(o[2], o[3]); ov[2] = pg8::cvt_pk_bf16(o[4], o[5]); ov[3] = pg8::cvt_pk_bf16(o[6], o[7]);
            *(u32x4_t*)(act + (size_t)(r0 + t) * DFF + jc) = ov; }
        if (samp || tf == SEQ - 4) {
            float* dst = samp ? POUT + O_S_FC + (size_t)(l * NBS + (r0 - MP) / 4) * 2 * NUP : POUT + O_P_FC + (size_t)(l * NBP + r0 / SEQ) * 2 * NUP;
#pragma unroll
            for (int rr = 0; rr < 2; ++rr)
#pragma unroll
                for (int i = 0; i < 8; ++i) { dst[(size_t)rr * NUP + jc + i] = xa[4 + rr][i]; dst[(size_t)rr * NUP + DFF + jc + i] = xb[4 + rr][i]; }
        }
    }
}

__device__ __forceinline__ void phase_final_norm(const Params& p) {
    int tid_ = threadIdx.x; asm volatile("" : "+v"(tid_)); const int tid = tid_, lane = tid & 63, w = tid >> 6;
    const float* gw = PIN(I_LNF);
    float4 g4[4];
#pragma unroll
    for (int i = 0; i < 4; ++i) g4[i] = *(const float4*)(gw + lane * 4 + 256 * i);
    for (int row = bidx() * 8 + w; row < MT; row += gdim() * 8) {
        float* xr = POUT + (size_t)row * DM; float4 v[4]; float ss = 0.f;
#pragma unroll
        for (int i = 0; i < 4; ++i) { v[i] = *(const float4*)(xr + lane * 4 + 256 * i); ss += v[i].x * v[i].x + v[i].y * v[i].y + v[i].z * v[i].z + v[i].w * v[i].w; }
        ss = wave_sum(ss); const float rstd = rsqrtf(ss * (1.f / 1024.f) + EPS);
#pragma unroll
        for (int i = 0; i < 4; ++i) { v[i].x *= rstd * g4[i].x; v[i].y *= rstd * g4[i].y; v[i].z *= rstd * g4[i].z; v[i].w *= rstd * g4[i].w; *(float4*)(xr + lane * 4 + 256 * i) = v[i]; }
    }
}

#ifndef PHM
#define PHM 0xFFFF
#endif
#ifndef DUPB
#define DUPB 1
#endif
#ifndef DUPC
#define DUPC 1
#endif
#ifndef DUPS
#define DUPS 1
#endif
#ifndef DUPH
#define DUPH 1
#endif
#ifndef DUPY
#define DUPY 1
#endif
#ifndef DUPA
#define DUPA 1
#endif
#ifndef DUPI
#define DUPI 1
#endif
#define GSYNC() do { for (int y_ = 0; y_ < DUPY; ++y_) xcd_barrier(xb); } while (0)
__global__ void __launch_bounds__(512, 2) fwd_megakernel(Params p) {
    extern __shared__ __attribute__((aligned(16))) unsigned char shm[];
    cg::grid_group grid = cg::this_grid();
    float* smf = (float*)shm;
    PG8_LAS unsigned char* lds = (PG8_LAS unsigned char*)shm;
    int tid_ = threadIdx.x; asm volatile("" : "+v"(tid_)); const int tid = tid_;
    float* X = POUT;
    volatile XLAS unsigned* xst = (volatile XLAS unsigned*)(lds + LDS_MAIN);
    if (tid == 0) { xst[0] = 0u; xst[1] = 0u; xst[2] = 0u; xst[3] = 0u; }
    __syncthreads();
    XcdBarrier xb = xcd_barrier_post((unsigned*)(PWS + W_BAR), xst);
#ifdef TPROBE1
    volatile XLAS unsigned long long* stp = (volatile XLAS unsigned long long*)(lds + LDS_MAIN + 64);
    int nst = 0;
#define STAMP() do { if (blockIdx.x == TPROBE_WG && threadIdx.x == 0) stp[nst] = __builtin_amdgcn_s_memrealtime(); ++nst; } while (0)
#else
#define STAMP() do {} while (0)
#endif
    STAMP();
#ifdef TPROBE_ITEM
    if (blockIdx.x == TPROBE_WG && threadIdx.x == 0) { stp[40] = 0; stp[41] = 0; }
#endif
    bf16_t* hbf = (bf16_t*)(PWS + W_HBF);
    bf16_t* proj = (bf16_t*)(PWS + W_PROJ);

    for (int l = 0; l < 2; ++l) {
        const int G = gdim(), bid = bidx();
        for (int repa = 0; repa < DUPA; ++repa) { if (PHM & 1) { int tc = 0;
          conv_T(PIN(I_WIN) + (size_t)l * 1024 * NIN, NIN, (bf16_t*)(PWS + W_WIN), 1024, N1, true, smf, tc);
          for (int n = 0; n < 3; ++n) conv_T(PIN(I_WBR) + ((size_t)l * 3 + n) * 512 * 1024, 1024, (bf16_t*)(PWS + W_WBR) + (size_t)n * 1024 * 512, 512, 1024, false, smf, tc);
          conv_T(PIN(I_WOUT) + (size_t)l * 1024 * 1024, 1024, (bf16_t*)(PWS + W_WOUT), 1024, 1024, false, smf, tc);
          conv_T(PIN(I_WUP) + (size_t)l * 1024 * NUP, NUP, (bf16_t*)(PWS + W_WUP), 1024, NUP, false, smf, tc);
          conv_T(PIN(I_WDN) + (size_t)l * DFF * 1024, 1024, (bf16_t*)(PWS + W_WDN), DFF, 1024, false, smf, tc);
          __syncthreads(); }
        if (PHM & 2) {
        if (l == 0) { int tq_ = threadIdx.x; asm volatile("" : "+v"(tq_)); const float4* s1 = (const float4*)PIN(I_XS); float4* d1 = (float4*)(X + (size_t)MP * DM);
            for (int i = bid * 512 + tq_; i < MS * DM / 4; i += G * 512) d1[i] = s1[i]; }
        phase_rmsnorm(p, l, l == 0 ? PIN(I_XP) : X, l == 0 ? PIN(I_XS) : X + (size_t)MP * DM, PIN(I_LNMIX) + l * DM, hbf, true, smf); } }
        if (PWS == nullptr) grid.sync();
        GSYNC();
        STAMP();
        for (int rep = 0; rep < DUPB; ++rep) { pg8::Gemm g{hbf, (const bf16_t*)(PWS + W_WIN), MT, N1, 1024, 1024}; pg8::StaticOrder S; S.init(MT, N1, G, bid); EpiProj E{proj, N1, 1}; pg8::gemm_phase(lds, g, S, E); }
        GSYNC(); STAMP();
        phase_gdnprep(p, l);
        GSYNC(); STAMP();
#ifdef TPROBE_MAX
        const unsigned long long tb_ = __builtin_amdgcn_s_memrealtime();
#endif
        for (int rep = 0; rep < DUPC; ++rep) for (int it = bid; it < 256; it += G) {
            if (it < 128) scan_prompt_item<0>(p, l, (it >> 2) >> 2, (it >> 2) & 3, it & 3, smf);
            else if (it < 192) { const int q = it - 128; scan_prompt_lin<1>(p, l, (q >> 1) >> 2, (q >> 1) & 3, q & 1, smf); }
            else { const int q = it - 192; scan_prompt_lin<2>(p, l, (q >> 1) >> 2, (q >> 1) & 3, q & 1, smf); }
        }
#ifdef TPROBE_MAX
        if (l == TPROBE_MAX - 1 && threadIdx.x == 0) { const unsigned dt_ = (unsigned)(__builtin_amdgcn_s_memrealtime() - tb_); atomicMax((unsigned*)(PWS + W_BAR) + 32, (dt_ << 8) | (unsigned)blockIdx.x); if (dt_ > 40000u) atomicAdd((unsigned*)(PWS + W_BAR) + 33, 1u); if (dt_ > 30000u) atomicAdd((unsigned*)(PWS + W_BAR) + 34, 1u); if (dt_ > 20000u) atomicAdd((unsigned*)(PWS + W_BAR) + 35, 1u); }
#endif
        STAMP();
#ifdef SEQ_SAMPLE
        GSYNC();
#endif
        scan_sample_all(p, l, smf);
        GSYNC(); STAMP();
        if (PHM & 32) phase_postnorm(p, l);
        GSYNC(); STAMP();
        if (PHM & 64) { pg8::Gemm g{(const bf16_t*)(PWS + W_OUTS), (const bf16_t*)(PWS + W_WBR), 3 * MT, 3 * 1024, 512, 512};
            MergeOrder S; S.init(G, bid); EpiMerge E{proj + 6144, hbf}; pg8::gemm_phase(lds, g, S, E); }
        GSYNC(); STAMP();
        if (PHM & 128) { pg8::Gemm g{hbf, (const bf16_t*)(PWS + W_WOUT), MT, 1024, 1024, 1024}; pg8::StaticOrder S; S.init(MT, 1024, G, bid); EpiResid E{X, l == 0 ? PIN(I_XP) : X, l == 0 ? PIN(I_XS) : X + (size_t)MP * DM}; pg8::gemm_phase(lds, g, S, E); }
        GSYNC(); STAMP();
        if (PHM & 256) phase_rmsnorm(p, l, X, X + (size_t)MP * DM, PIN(I_LNFFN) + l * DM, hbf, false, smf);
        GSYNC(); STAMP();
        for (int rep = 0; rep < DUPH; ++rep) { pg8::Gemm g{hbf, (const bf16_t*)(PWS + W_WUP), MT, NUP, 1024, 1024}; pg8::StaticOrder S; S.init(MT, NUP, G, bid); EpiProj E{proj, NUP, 0}; pg8::gemm_phase(lds, g, S, E); }
        GSYNC(); STAMP();
        for (int repi = 0; repi < DUPI; ++repi) phase_convffn(p, l);
        GSYNC(); STAMP();
        if (PHM & 2048) { { pg8::Gemm g{(const bf16_t*)(PWS + W_ACT), (const bf16_t*)(PWS + W_WDN), MP, 1024, DFF, DFF}; pg8::StaticOrder S; S.init(MP, 1024, G, bid); EpiResid E{X, X, X + (size_t)MP * DM}; pg8::gemm_phase(lds, g, S, E); }
            { pg8::Gemm g{(const bf16_t*)(PWS + W_ACT), (const bf16_t*)(PWS + W_WDN), MT, 1024, DFF / 2, DFF}; PieceOrder S{G, (bid + G / 2) % G, 2}; EpiAtomic E{X}; pg8::gemm_phase(lds, g, S, E); } }
        GSYNC(); STAMP();
    }
    if (PHM & 4096) phase_final_norm(p);
#ifdef TPROBE1
    if (blockIdx.x == TPROBE_WG && threadIdx.x == 0) {
        const int per = (nst - 1) / 2;
        unsigned long long d1 = 0, d2 = 0;
        for (int l2 = 0; l2 < 2; ++l2) { d1 += stp[l2 * per + TPROBE1E] - stp[l2 * per + TPROBE1]; d2 += stp[l2 * per + TPROBE2E] - stp[l2 * per + TPROBE2]; }
        unsigned long long cntcode_ = 0;
        unsigned long long q1 = (d1 + 1000) / 2000, q2 = (d2 + 500) / 1000;
#ifdef TPROBE_MAX
        { const unsigned mx_ = __hip_atomic_load((unsigned*)(PWS + W_BAR) + 32, __ATOMIC_RELAXED, __HIP_MEMORY_SCOPE_AGENT); q1 = ((mx_ >> 8) + 1000) / 2000 * 10 + (mx_ & 255) / 100; q2 = (mx_ & 255) % 100;
#ifdef TPROBE_CNT
          const unsigned c4_ = __hip_atomic_load((unsigned*)(PWS + W_BAR) + 33, __ATOMIC_RELAXED, __HIP_MEMORY_SCOPE_AGENT), c3_ = __hip_atomic_load((unsigned*)(PWS + W_BAR) + 34, __ATOMIC_RELAXED, __HIP_MEMORY_SCOPE_AGENT), c2_ = __hip_atomic_load((unsigned*)(PWS + W_BAR) + 35, __ATOMIC_RELAXED, __HIP_MEMORY_SCOPE_AGENT);
          q1 = 0; q2 = 0; cntcode_ = c4_ * 300 + c3_; (void)c2_;
#endif
 }
#endif
#ifdef TPROBE_ITEM
        q1 = stp[41] ? (stp[40] / stp[41] + 50) / 100 : 0; q2 = stp[41];
#endif if (q2 > 99) q2 = 99;
#ifndef TPROBE_MAX
        if (q1 > 99) q1 = 99;
#endif
        const unsigned long long wait = (q1 * 100 + q2) * 2000ull + cntcode_ * 200ull, t0 = __builtin_amdgcn_s_memrealtime();
        while (__builtin_amdgcn_s_memrealtime() - t0 < wait) __builtin_amdgcn_s_sleep(32);
    }
#endif
}

extern "C" void kernel_launch(void* const* d_in, const int* in_sizes, int n_in, void* d_out, int out_size, void* d_ws, size_t ws_size, hipStream_t stream) {
    static int grid_blocks = 0;
    if (grid_blocks == 0) {
        if (n_in != 28 || (size_t)out_size != O_END || ws_size < W_END) { fprintf(stderr, "kernel_launch: unexpected shapes: n_in %d out %d (want %zu) ws %zu (need %zu)\n", n_in, out_size, (size_t)O_END, ws_size, (size_t)W_END); grid_blocks = -1; return; }
        int dev = 0, cus = 0, per_cu = 0;
        hipGetDevice(&dev); hipDeviceGetAttribute(&cus, hipDeviceAttributeMultiprocessorCount, dev);
        if (hipFuncSetAttribute((const void*)fwd_megakernel, hipFuncAttributeMaxDynamicSharedMemorySize, LDS_BYTES) != hipSuccess) { fprintf(stderr, "kernel_launch: hipFuncSetAttribute failed\n"); grid_blocks = -1; return; }
        if (hipOccupancyMaxActiveBlocksPerMultiprocessor(&per_cu, (const void*)fwd_megakernel, 512, LDS_BYTES) != hipSuccess || per_cu < 1) { fprintf(stderr, "kernel_launch: occupancy query gave %d\n", per_cu); per_cu = 1; (void)hipGetLastError(); }
        grid_blocks = cus * per_cu;
    }
    if (grid_blocks < 0) return;
    if (hipMemsetAsync((unsigned char*)d_ws + W_BAR, 0, XCD_BAR_WORDS * 4, stream) != hipSuccess) { fprintf(stderr, "kernel_launch: memset of barrier words failed\n"); return; }
    Params p{};
    for (int i = 0; i < 28; ++i) p.in[i] = (const float*)d_in[i];
    p.out = (float*)d_out; p.ws = (unsigned char*)d_ws;
    void* args[] = {&p};
    hipError_t e = hipLaunchCooperativeKernel((const void*)fwd_megakernel, dim3(grid_blocks), dim3(512), args, LDS_BYTES, stream);
    if (e != hipSuccess) fprintf(stderr, "kernel_launch: cooperative launch failed: %s (grid %d)\n", hipGetErrorString(e), grid_blocks);
}
```

```cpp
#include <hip/hip_runtime.h>
#include <hip/hip_cooperative_groups.h>
#include <cstdio>
namespace cg = cooperative_groups;
namespace pg8 {
#define PG8_LAS __attribute__((address_space(3)))
typedef unsigned short bf16_t;
typedef short bf16x8 __attribute__((ext_vector_type(8)));
typedef float f32x4 __attribute__((ext_vector_type(4)));
typedef unsigned u32x4 __attribute__((ext_vector_type(4)));
constexpr int BM = 256, BK = 64, HALF = 128, HTB = HALF * BK * 2  , STAGE_BYTES = 8 * HTB, NXCD = 8, WGM = 8;

__host__ __device__ __forceinline__ int lds_byte(int r, int c) { const int st = (r >> 4) * 2 + (c >> 5), rr = r & 15, cc = c & 31, ob = rr * 64 + cc * 2; return st * 1024 + (ob ^ (((ob >> 9) & 1) << 5)); }
__host__ __device__ __forceinline__ void stage_rc(int b, int& R, int& C) { const int st = b / 1024, sb = b % 1024, swz = sb ^ (((sb >> 9) & 1) << 5); R = (st >> 1) * 16 + swz / 64; C = (st & 1) * 32 + (swz % 64) / 2; }
__host__ __device__ __forceinline__ int perm32(int rho) { const int n = rho >> 4, i = rho & 15; return 8 * (i >> 2) + 4 * n + (i & 3); }

struct Unit { int pm, pn, pk; };
struct Gemm { const bf16_t* A; const bf16_t* Bt; int M, N, K, ld; };

struct StaticOrder {
    int nM, nN, nwg, G, c;
    __host__ __device__ void init(int M, int N, int G_, int c_) { nM = M / BM; nN = N / BM; nwg = nM * nN; G = G_; c = c_; }
    __host__ __device__ bool next(int i, Unit& u) const {
        const long L = (long)i * G + c; if (L >= nwg) return false;
        int wgid = (int)L; { const int q = nwg / NXCD, r = nwg % NXCD, xcd = wgid % NXCD, off = wgid / NXCD; wgid = (xcd < r ? xcd * (q + 1) : r * (q + 1) + (xcd - r) * q) + off; }
        const int nig = WGM * nN, gid = wgid / nig, fm = gid * WGM, gsz = (nM - fm) < WGM ? (nM - fm) : WGM;
        u.pm = fm + ((wgid % nig) % gsz); u.pn = (wgid % nig) / gsz; u.pk = 0; return true;
    }
    __device__ __forceinline__ void a_ready(const Unit&) const {}
    __device__ __forceinline__ void done(const Unit&) const {}
};
__device__ __forceinline__ unsigned cvt_pk_bf16(float lo, float hi) { unsigned r; asm volatile("v_cvt_pk_bf16_f32 %0, %1, %2" : "=v"(r) : "v"(lo), "v"(hi)); return r; }
template <class Epi, class Sched>
__device__ __forceinline__ void gemm_phase(PG8_LAS unsigned char* lds, const Gemm g, const Sched& S, const Epi& E) {
    int tid_ = threadIdx.x; asm volatile("" : "+v"(tid_));
    const int tid = tid_, wid = __builtin_amdgcn_readfirstlane(tid >> 6), lane = tid & 63, wr = wid >> 2, wc = wid & 3, fr = lane & 15, fq = lane >> 4;
    const int K = g.K, nt = K / BK, ld = g.ld;
    unsigned voffA[2], voffB[2];
#pragma unroll
    for (int i = 0; i < 2; ++i) { int R, C; stage_rc(tid * 16 + i * 8192, R, C); const int Rb = Epi::PERM ? ((R & ~31) + perm32(R & 31)) : R;
        voffA[i] = (unsigned)(R * ld + C) * 2u; voffB[i] = (unsigned)(Rb * ld + C) * 2u; }
    const size_t kstep = (size_t)(BK * 2);
    const size_t hstep = (size_t)HALF * ld * 2;
    const size_t tstep = 2 * hstep;
    const unsigned ldsw = (unsigned)wid * 1024u;
    const int aoff = lds_byte(wr * 64 + fr, fq * 8), boff = lds_byte(wc * 32 + fr, fq * 8);
#define PG8_SA(b, h) (((b) * 2 + (h)) * HTB)
#define PG8_SB(b, h) ((4 + (b) * 2 + (h)) * HTB)
#define PG8_STAGE(bufoff, gbase, voff) do { _Pragma("unroll") for (int _i = 0; _i < 2; ++_i) \
        __builtin_amdgcn_global_load_lds((const unsigned*)((const char*)(gbase) + (voff)[_i]), (PG8_LAS unsigned*)(lds + (bufoff) + ldsw + _i * 8192), 16, 0, 0); } while (0)
#define PG8_LDA(dst, b, h) do { _Pragma("unroll") for (int m = 0; m < 4; ++m) _Pragma("unroll") for (int k = 0; k < 2; ++k) dst[m][k] = *(const PG8_LAS bf16x8*)(lds + PG8_SA(b, h) + aoff + m * 2048 + k * 1024); } while (0)
#define PG8_LDB(dst, b, h) do { _Pragma("unroll") for (int n = 0; n < 2; ++n) _Pragma("unroll") for (int k = 0; k < 2; ++k) dst[n][k] = *(const PG8_LAS bf16x8*)(lds + PG8_SB(b, h) + boff + n * 2048 + k * 1024); } while (0)
#define PG8_MMA(ai, bj, At, Bt) do { __builtin_amdgcn_s_setprio(1); _Pragma("unroll") for (int m = 0; m < 4; ++m) _Pragma("unroll") for (int n = 0; n < 2; ++n) _Pragma("unroll") for (int k = 0; k < 2; ++k) \
        acc[ai][bj][m][n] = __builtin_amdgcn_mfma_f32_16x16x32_bf16(Bt[n][k], At[m][k], acc[ai][bj][m][n], 0, 0, 0); __builtin_amdgcn_s_setprio(0); } while (0)
#define PG8_WAIT_V(n) asm volatile("s_waitcnt vmcnt(" #n ")" ::: "memory")
#define PG8_WAIT_L(n) asm volatile("s_waitcnt lgkmcnt(" #n ")" ::: "memory")
#define PG8_BAR __builtin_amdgcn_s_barrier()
#define PG8_SCHED __builtin_amdgcn_sched_barrier(0)
    Unit cur, nxt; int ui = 0;
    if (!S.next(0, cur)) return;
    f32x4 acc[2][2][4][2];
#pragma unroll
    for (int a = 0; a < 2; ++a)
#pragma unroll
        for (int b = 0; b < 2; ++b)
#pragma unroll
            for (int m = 0; m < 4; ++m)
#pragma unroll
                for (int n = 0; n < 2; ++n) acc[a][b][m][n] = (f32x4){0.f, 0.f, 0.f, 0.f};
    bf16x8 At[4][2], B0[2][2], B1[2][2];
    const char* cA = (const char*)g.A + (size_t)cur.pm * tstep + (size_t)cur.pk * K * 2; const char* cB = (const char*)g.Bt + (size_t)cur.pn * tstep + (size_t)cur.pk * K * 2;
    S.a_ready(cur);
    PG8_STAGE(PG8_SB(0, 0), cB, voffB); PG8_STAGE(PG8_SA(0, 0), cA, voffA); PG8_STAGE(PG8_SB(0, 1), cB + hstep, voffB); PG8_STAGE(PG8_SA(0, 1), cA + hstep, voffA);
    if (wr == 1) PG8_BAR;
    PG8_WAIT_V(4); PG8_BAR;
    PG8_STAGE(PG8_SB(1, 0), cB + kstep, voffB); PG8_STAGE(PG8_SA(1, 0), cA + kstep, voffA); PG8_STAGE(PG8_SB(1, 1), cB + hstep + kstep, voffB);
    PG8_WAIT_V(6); PG8_BAR;
    for (;;) {
        const bool has_next = S.next(ui + 1, nxt);
        const char* nA = has_next ? (const char*)g.A + (size_t)nxt.pm * tstep + (size_t)nxt.pk * K * 2 : cA; const char* nB = has_next ? (const char*)g.Bt + (size_t)nxt.pn * tstep + (size_t)nxt.pk * K * 2 : cB;
        for (int t = 0; t < nt; t += 2) {
            const bool last = (t == nt - 2);
            const char* a1 = cA + (size_t)(t + 1) * kstep;
            const char* a2 = last ? nA : cA + (size_t)(t + 2) * kstep; const char* b2 = last ? nB : cB + (size_t)(t + 2) * kstep;
            const char* a3 = a2 + kstep; const char* b3 = b2 + kstep;
            if (last && has_next) S.a_ready(nxt);
            PG8_LDB(B0, 0, 0); PG8_SCHED; PG8_LDA(At, 0, 0); PG8_STAGE(PG8_SA(1, 1), a1 + hstep, voffA);
            PG8_WAIT_L(8); PG8_BAR; PG8_WAIT_L(0); PG8_MMA(0, 0, At, B0); PG8_BAR; PG8_SCHED;
            PG8_LDB(B1, 0, 1); PG8_STAGE(PG8_SB(0, 0), b2, voffB);
            PG8_BAR; PG8_WAIT_L(0); PG8_MMA(0, 1, At, B1); PG8_BAR;
            PG8_LDA(At, 0, 1); PG8_STAGE(PG8_SA(0, 0), a2, voffA);
            PG8_BAR; PG8_WAIT_L(0); PG8_MMA(1, 0, At, B0); PG8_BAR; PG8_SCHED;
            PG8_STAGE(PG8_SB(0, 1), b2 + hstep, voffB);
            PG8_WAIT_V(6); PG8_BAR; PG8_MMA(1, 1, At, B1); PG8_BAR;
            PG8_LDB(B0, 1, 0); PG8_SCHED; PG8_LDA(At, 1, 0); PG8_STAGE(PG8_SA(0, 1), a2 + hstep, voffA);
            PG8_WAIT_L(8); PG8_BAR; PG8_WAIT_L(0); PG8_MMA(0, 0, At, B0); PG8_BAR; PG8_SCHED;
            PG8_LDB(B1, 1, 1); PG8_STAGE(PG8_SB(1, 0), b3, voffB);
            PG8_BAR; PG8_WAIT_L(0); PG8_MMA(0, 1, At, B1); PG8_BAR;
            PG8_LDA(At, 1, 1); PG8_STAGE(PG8_SA(1, 0), a3, voffA);
            PG8_BAR; PG8_WAIT_L(0); PG8_MMA(1, 0, At, B0); PG8_BAR; PG8_SCHED;
            PG8_STAGE(PG8_SB(1, 1), b3 + hstep, voffB);
            PG8_WAIT_V(6); PG8_BAR; PG8_MMA(1, 1, At, B1); PG8_BAR;
        }
        if constexpr (!Epi::AFTER_DRAIN) { E(acc, cur, wr, wc, fr, fq); S.done(cur); }
        if (!has_next) break;
#pragma unroll
        for (int a = 0; a < 2; ++a)
#pragma unroll
            for (int b = 0; b < 2; ++b)
#pragma unroll
                for (int m = 0; m < 4; ++m)
#pragma unroll
                    for (int n = 0; n < 2; ++n) acc[a][b][m][n] = (f32x4){0.f, 0.f, 0.f, 0.f};
        cur = nxt; cA = nA; cB = nB; ++ui;
    }
    PG8_WAIT_V(0);
    if (wr == 0) PG8_BAR;
    PG8_BAR;
    if constexpr (Epi::AFTER_DRAIN) { E.fused(acc, cur, wr, wc, fr, fq, lds, wid, lane); S.done(cur); }
#undef PG8_SA
#undef PG8_SB
#undef PG8_STAGE
#undef PG8_LDA
#undef PG8_LDB
#undef PG8_MMA
#undef PG8_WAIT_V
#undef PG8_WAIT_L
#undef PG8_BAR
#undef PG8_SCHED
}
}

#define XB_TMO      128
#define XB_XCNT(j)  (256  + 64 * (j))
#define XB_XSUB(j)  (1280 + 64 * (j))
#define XB_XGEN(j)  (2304 + 64 * (j))
#define XB_TOP      3328
#define XB_TOPGEN   3392
#define XCD_BAR_WORDS 3456
#define XB_SPIN_CAP (1u << 18)
#define XLAS __attribute__((address_space(3)))

__device__ __forceinline__ unsigned xb_ld(unsigned* p)              { return __hip_atomic_load(p, __ATOMIC_RELAXED, __HIP_MEMORY_SCOPE_AGENT); }
__device__ __forceinline__ unsigned xb_add(unsigned* p, unsigned v) { return __hip_atomic_fetch_add(p, v, __ATOMIC_RELAXED, __HIP_MEMORY_SCOPE_AGENT); }
__device__ __forceinline__ unsigned xb_xcc_id() { return (unsigned)__builtin_amdgcn_s_getreg((3 << 11) | 20) & 0xFu; }
#define XB_SPIN(cond, bar) do { unsigned _sp = 0; while (cond) { __builtin_amdgcn_s_sleep(1); \
    if ((++_sp & 255u) == 0u) { if (xb_ld(&(bar)[XB_TMO])) break; if (_sp > XB_SPIN_CAP) { atomicAdd(&(bar)[XB_TMO], 1u); break; } } } } while (0)

struct XcdBarrier {
    unsigned* bar; unsigned x;
    volatile XLAS unsigned* st;
};

__device__ __forceinline__ XcdBarrier xcd_barrier_post(unsigned* bar, volatile XLAS unsigned* st) {
    XcdBarrier b; b.bar = bar; b.x = xb_xcc_id(); b.st = st;
    if (threadIdx.x == 0) (void)xb_add(&bar[XB_XCNT(b.x)], 1u);
    return b;
}
__device__ __forceinline__ void xcd_barrier_complete(unsigned* bar, unsigned x, unsigned& nloc, unsigned& nx) {
    const unsigned G = gridDim.x * gridDim.y * gridDim.z;
    unsigned sum, cnt, mine, sp = 0u;
    for (;;) {
        sum = 0u; cnt = 0u; mine = 0u;
#pragma unroll
        for (unsigned j = 0; j < 16; ++j) { const unsigned c = xb_ld(&bar[XB_XCNT(j)]); sum += c; cnt += (c > 0u) ? 1u : 0u; mine = (j == x) ? c : mine; }
        if (sum == G) break;
        __builtin_amdgcn_s_sleep(1);
        if ((++sp & 255u) == 0u) { if (xb_ld(&bar[XB_TMO])) break; if (sp > XB_SPIN_CAP) { atomicAdd(&bar[XB_TMO], 1u); break; } }
    }
    nloc = mine > 0u ? mine : 1u; nx = cnt > 0u ? cnt : 1u;
}

__device__ __forceinline__ void xcd_barrier(const XcdBarrier& b) {
    asm volatile("s_waitcnt vmcnt(0)" ::: "memory");
    __syncthreads();
    if (threadIdx.x == 0) {
        unsigned* bar = b.bar;
        __builtin_amdgcn_s_waitcnt(0);
        unsigned nloc = b.st[0], nx = b.st[1];
        if (nloc == 0u) { xcd_barrier_complete(bar, b.x, nloc, nx); b.st[0] = nloc; b.st[1] = nx; }
        const unsigned old = xb_add(&bar[XB_XSUB(b.x)], 1u);
        const unsigned gen = old / nloc;
        if (old + 1u == (gen + 1u) * nloc) {
            __builtin_amdgcn_fence(__ATOMIC_RELEASE, "agent");
            asm volatile("s_waitcnt vmcnt(0)" ::: "memory");
            const unsigned og = xb_add(&bar[XB_TOP], 1u);
            const unsigned tg = og / nx;
            if (og + 1u == (tg + 1u) * nx) xb_add(&bar[XB_TOPGEN], 1u);
            else XB_SPIN(xb_ld(&bar[XB_TOPGEN]) == tg, bar);
            __builtin_amdgcn_fence(__ATOMIC_ACQUIRE, "agent");
            xb_add(&bar[XB_XGEN(b.x)], 1u);
            asm volatile("s_waitcnt vmcnt(0)" ::: "memory");
        } else {
            XB_SPIN(xb_ld(&bar[XB_XGEN(b.x)]) == gen, bar);
            __builtin_amdgcn_fence(__ATOMIC_ACQUIRE, "agent");
            asm volatile("s_waitcnt vmcnt(0)" ::: "memory");
        }
    }
    __syncthreads();
}

using pg8::bf16_t; using pg8::f32x4; using pg8::bf16x8;
typedef unsigned u32x4_t __attribute__((ext_vector_type(4)));
typedef unsigned u32x2_t __attribute__((ext_vector_type(2)));

constexpr int DM = 1024, NBP = 8, SEQ = 2048, NBS = 128, SSEQ = 4, NH = 4, HD = 128, MW = 512;
constexpr int MP = NBP * SEQ, MS = NBS * SSEQ, MT = MP + MS;
constexpr int NIN = 9232, N1 = 9216, DFF = 2816, NUP = 5632;
constexpr float EPS = 1e-6f;
constexpr float QSCALE = 0.08838834764831845f;

constexpr size_t O_Y = 0;
constexpr size_t O_P_GS = (size_t)MT * DM;
constexpr size_t O_P_GC = O_P_GS + (size_t)2 * 8 * 4 * 128 * 128;
constexpr size_t O_P_MC = O_P_GC + (size_t)2 * 8 * 3 * 1536;
constexpr size_t O_P_MN = O_P_MC + (size_t)2 * 8 * 4 * 128 * 128;
constexpr size_t O_P_MM = O_P_MN + (size_t)2 * 8 * 4 * 128;
constexpr size_t O_P_HS = O_P_MM + (size_t)2 * 8 * 4;
constexpr size_t O_P_FC = O_P_HS + (size_t)2 * 8 * 4 * 128 * 128;
constexpr size_t O_S_GS = O_P_FC + (size_t)2 * 8 * 2 * 5632;
constexpr size_t O_S_GC = O_S_GS + (size_t)2 * 128 * 4 * 128 * 128;
constexpr size_t O_S_MC = O_S_GC + (size_t)2 * 128 * 3 * 1536;
constexpr size_t O_S_MN = O_S_MC + (size_t)2 * 128 * 4 * 128 * 128;
constexpr size_t O_S_MM = O_S_MN + (size_t)2 * 128 * 4 * 128;
constexpr size_t O_S_HS = O_S_MM + (size_t)2 * 128 * 4;
constexpr size_t O_S_FC = O_S_HS + (size_t)2 * 128 * 4 * 128 * 128;
constexpr size_t O_END  = O_S_FC + (size_t)2 * 128 * 2 * 5632;

constexpr size_t W_WIN = 0;
constexpr size_t W_WBR = W_WIN + (size_t)N1 * 1024 * 2;
constexpr size_t W_WOUT = W_WBR + (size_t)3 * 1024 * 512 * 2;
constexpr size_t W_WUP = W_WOUT + (size_t)1024 * 1024 * 2;
constexpr size_t W_WDN = W_WUP + (size_t)NUP * 1024 * 2;
constexpr size_t W_HBF = W_WDN + (size_t)1024 * DFF * 2;
constexpr size_t W_PROJ = W_HBF + (size_t)MT * 1024 * 2;
constexpr size_t W_ACT = W_PROJ + (size_t)MT * NUP * 2;
constexpr size_t W_OUTS = W_PROJ + (size_t)MT * N1 * 2;
constexpr size_t W_GATES = W_OUTS + (size_t)3 * MT * 512 * 2;
constexpr size_t W_DEN = W_GATES + (size_t)MT * 16 * 4;
constexpr size_t W_MT = W_DEN + (size_t)MT * 4 * 4;
constexpr size_t W_BAR = W_MT + (size_t)MT * 4 * 4;
constexpr size_t W_END = W_BAR + 16384;

constexpr int LDS_MAIN = 143360;
constexpr int LDS_BYTES = LDS_MAIN + 64 + 512;

struct Params { const float* in[28]; float* out; unsigned char* ws; };
enum { I_XP = 0, I_XS, I_SGS, I_SGC, I_SMC, I_SMN, I_SMM, I_SHS, I_SFC, I_LNMIX, I_WIN, I_GCW, I_ALOG, I_DTB, I_GNORM, I_MIB, I_MFB, I_MNORM, I_HLB, I_HNORM,
       I_WBR, I_WOUT, I_LNFFN, I_WUP, I_FCW, I_FCB, I_WDN, I_LNF };

typedef const float* const __attribute__((address_space(4))) * kargp_t;
__device__ __forceinline__ const float* argp(int i) { kargp_t kp = (kargp_t)__builtin_amdgcn_kernarg_segment_ptr(); asm volatile("" : "+s"(i)); return kp[i]; }
__device__ __forceinline__ int bidx() { int b = (int)blockIdx.x; asm volatile("" : "+s"(b)); return b; }
__device__ __forceinline__ int gdim() { int g = (int)gridDim.x; asm volatile("" : "+s"(g)); return g; }
#define PIN(i) argp(i)
#define POUT ((float*)argp(28))
#define PWS ((unsigned char*)argp(29))
__device__ __forceinline__ float bf2f(bf16_t b) { return __uint_as_float(((unsigned)b) << 16); }
__device__ __forceinline__ float bflo(unsigned u) { return __uint_as_float(u << 16); }
__device__ __forceinline__ float bfhi(unsigned u) { return __uint_as_float(u & 0xffff0000u); }
__device__ __forceinline__ bf16_t f2bf(float f) { return (bf16_t)(pg8::cvt_pk_bf16(f, 0.f) & 0xffffu); }
__device__ __forceinline__ float sigm(float x) { return __builtin_amdgcn_rcpf(1.f + __expf(-x)); }
__device__ __forceinline__ float silu(float x) { return x * sigm(x); }
__device__ __forceinline__ float rdlane(float x, int l) { return __builtin_bit_cast(float, __builtin_amdgcn_readlane(__builtin_bit_cast(int, x), l)); }
template <int CTRL> __device__ __forceinline__ float dppf(float x) { return __builtin_bit_cast(float, __builtin_amdgcn_update_dpp(0, __builtin_bit_cast(int, x), CTRL, 0xf, 0xf, true)); }
__device__ __forceinline__ float grp_sum8(float x) { x += dppf<0xB1>(x); x += dppf<0x4E>(x); x += dppf<0x141>(x); return x; }
__device__ __forceinline__ float grp_sum16(float x) { x = grp_sum8(x); x += dppf<0x140>(x); return x; }
__device__ __forceinline__ float wave_sum(float x) { x = grp_sum16(x);
    x += __builtin_bit_cast(float, __builtin_amdgcn_update_dpp(0, __builtin_bit_cast(int, x), 0x142, 0xa, 0xf, false));
    x += __builtin_bit_cast(float, __builtin_amdgcn_update_dpp(0, __builtin_bit_cast(int, x), 0x143, 0xc, 0xf, false));
    return rdlane(x, 63); }
template <int CTRL> __device__ __forceinline__ float dppm(float x) { return __builtin_bit_cast(float, __builtin_amdgcn_update_dpp(__builtin_bit_cast(int, -INFINITY), __builtin_bit_cast(int, x), CTRL, 0xf, 0xf, false)); }
template <int T> __device__ __forceinline__ float grp_sum(float x) { if constexpr (T == 16) return grp_sum16(x); else return grp_sum8(x); }

__device__ __forceinline__ int win_srccol(int n0) { const int blk = n0 >> 9, r = n0 & 511; int base;
    if (blk < 4) base = blk * 512; else if (blk < 8) base = 2056 + (blk - 4) * 512; else if (blk < 12) base = 4112 + (blk - 8) * 512; else base = 6160 + (blk - 12) * 512;
    return base + r; }
__device__ __forceinline__ void conv_T(const float* __restrict__ src, int ld, bf16_t* __restrict__ dst, int K, int N, bool winmap, float* tile, int& tcount) {
    int tid_ = threadIdx.x; asm volatile("" : "+v"(tid_)); const int tid = tid_, ntn = N / 64, ntiles = ntn * (K / 64);
    int t = bidx() - (tcount % gdim()); if (t < 0) t += gdim();
    const int kk = tid >> 4, n4 = (tid & 15) * 4;
    float4 va[2], vb[2];
#define CT_LOAD(dst_, t_) do { const int tn_ = (t_) % ntn, tk_ = (t_) / ntn, n0_ = tn_ * 64, k0_ = tk_ * 64, sc0_ = winmap ? win_srccol(n0_) : n0_; \
        _Pragma("unroll") for (int pp_ = 0; pp_ < 2; ++pp_) dst_[pp_] = *(const float4*)(src + (size_t)(k0_ + kk + 32 * pp_) * ld + sc0_ + n4); } while (0)
    if (t < ntiles) CT_LOAD(va, t);
    for (; t < ntiles; t += gdim()) {
        const int tn = t % ntn, tk = t / ntn, n0 = tn * 64, k0 = tk * 64;
        const int tnext = t + gdim();
        if (tnext < ntiles) CT_LOAD(vb, tnext);
        __syncthreads();
#pragma unroll
        for (int pp = 0; pp < 2; ++pp) { float* tp = tile + (kk + 32 * pp) * 65 + n4; tp[0] = va[pp].x; tp[1] = va[pp].y; tp[2] = va[pp].z; tp[3] = va[pp].w; }
        __syncthreads();
        { const int n = tid >> 3, k8 = (tid & 7) * 8; float f[8];
#pragma unroll
          for (int i = 0; i < 8; ++i) f[i] = tile[(k8 + i) * 65 + n];
          u32x4_t o; o[0] = pg8::cvt_pk_bf16(f[0], f[1]); o[1] = pg8::cvt_pk_bf16(f[2], f[3]); o[2] = pg8::cvt_pk_bf16(f[4], f[5]); o[3] = pg8::cvt_pk_bf16(f[6], f[7]);
          *(u32x4_t*)(dst + (size_t)(n0 + n) * K + k0 + k8) = o; }
        va[0] = vb[0]; va[1] = vb[1];
    }
#undef CT_LOAD
    tcount += ntiles;
}

__device__ __forceinline__ void phase_rmsnorm(const Params& p, int l, const float* xa, const float* xb, const float* __restrict__ gw, bf16_t* __restrict__ hout, bool do_gates, float* sm) {
    int tid_ = threadIdx.x; asm volatile("" : "+v"(tid_)); const int tid = tid_, lane = tid & 63, w = tid >> 6;
    float* wgT = sm;
    if (do_gates) {
        const float* win = PIN(I_WIN) + (size_t)l * 1024 * NIN;
        __syncthreads();
        for (int i = tid; i < 16 * 1024; i += 512) { const int k = i >> 4, j = i & 15; const int gc = j < 8 ? 2048 + j : 4104 + (j - 8); wgT[j * 1024 + k] = win[(size_t)k * NIN + gc]; }
        __syncthreads();
    }
    float4 g4[4];
#pragma unroll
    for (int i = 0; i < 4; ++i) g4[i] = *(const float4*)(gw + lane * 4 + 256 * i);
    for (int row = bidx() * 8 + w; row < MT; row += gdim() * 8) {
        const float* xr = row < MP ? xa + (size_t)row * DM : xb + (size_t)(row - MP) * DM;
        float4 v[4]; float ss = 0.f;
#pragma unroll
        for (int i = 0; i < 4; ++i) { v[i] = *(const float4*)(xr + lane * 4 + 256 * i); ss += v[i].x * v[i].x + v[i].y * v[i].y + v[i].z * v[i].z + v[i].w * v[i].w; }
        ss = wave_sum(ss);
        const float rstd = rsqrtf(ss * (1.f / 1024.f) + EPS);
#pragma unroll
        for (int i = 0; i < 4; ++i) { v[i].x *= rstd * g4[i].x; v[i].y *= rstd * g4[i].y; v[i].z *= rstd * g4[i].z; v[i].w *= rstd * g4[i].w;
            u32x2_t o; o[0] = pg8::cvt_pk_bf16(v[i].x, v[i].y); o[1] = pg8::cvt_pk_bf16(v[i].z, v[i].w);
            *(u32x2_t*)(hout + (size_t)row * DM + lane * 4 + 256 * i) = o; }
        if (do_gates) {
            float mine = 0.f;
#pragma unroll
            for (int j = 0; j < 16; ++j) { float a = 0.f;
#pragma unroll
                for (int i = 0; i < 4; ++i) { const float4 wv = *(const float4*)(wgT + j * 1024 + lane * 4 + 256 * i); a += v[i].x * wv.x + v[i].y * wv.y + v[i].z * wv.z + v[i].w * wv.w; }
                a = wave_sum(a); if (lane == j) mine = a; }
            if (lane < 16) { const int h = lane & 3, kind = lane >> 2; float r;
                if (kind == 0) r = sigm(mine);
                else if (kind == 1) { const float xx = mine + PIN(I_DTB)[l * 4 + h]; const float sp = xx > 20.f ? xx : __logf(1.f + __expf(xx)); r = __expf(-__expf(PIN(I_ALOG)[l * 4 + h]) * sp); }
                else if (kind == 2) r = mine + PIN(I_MIB)[l * 4 + h];
                else { const float xx = -(mine + PIN(I_MFB)[l * 4 + h]); r = -(xx > 20.f ? xx : __logf(1.f + __expf(xx))); }
                ((float*)(PWS + W_GATES))[(size_t)row * 16 + lane] = r; }
        }
    }
}

struct EpiProj {
    static constexpr bool PERM = true, AFTER_DRAIN = false;
    bf16_t* O; int ldc; int actmode;
    __device__ __forceinline__ void operator()(const f32x4 (&acc)[2][2][4][2], const pg8::Unit& u, int wr, int wc, int fr, int fq) const {
        const int row0 = u.pm * 256 + wr * 64 + fr, col0 = u.pn * 256 + wc * 32 + 8 * fq;
        int act = 0;
        if (actmode) { const int pn = u.pn; act = (pn >= 24 || pn == 14 || pn == 15) ? 2 : ((pn == 6 || pn == 7 || pn == 16 || pn == 17 || pn == 22 || pn == 23) ? 1 : 0); }
#pragma unroll
        for (int ai = 0; ai < 2; ++ai)
#pragma unroll
            for (int m = 0; m < 4; ++m) { bf16_t* rowp = O + (size_t)(row0 + ai * 128 + m * 16) * ldc + col0;
#pragma unroll
                for (int bj = 0; bj < 2; ++bj) { float v[8];
#pragma unroll
                    for (int i = 0; i < 4; ++i) { v[i] = acc[ai][bj][m][0][i]; v[4 + i] = acc[ai][bj][m][1][i]; }
                    if (act == 1) {
#pragma unroll
                        for (int i = 0; i < 8; ++i) v[i] = silu(v[i]); }
                    else if (act == 2) {
#pragma unroll
                        for (int i = 0; i < 8; ++i) v[i] = sigm(v[i]); }
                    u32x4_t o; o[0] = pg8::cvt_pk_bf16(v[0], v[1]); o[1] = pg8::cvt_pk_bf16(v[2], v[3]); o[2] = pg8::cvt_pk_bf16(v[4], v[5]); o[3] = pg8::cvt_pk_bf16(v[6], v[7]);
                    *(u32x4_t*)(rowp + bj * 128) = o; } }
    }
};
struct EpiMerge {
    static constexpr bool PERM = true, AFTER_DRAIN = false;
    const bf16_t* G; bf16_t* Mx;
    __device__ __forceinline__ void operator()(const f32x4 (&acc)[2][2][4][2], const pg8::Unit& u, int wr, int wc, int fr, int fq) const {
        const int n = u.pn >> 2, first = (n == 0);
        const int row0 = (u.pm - n * (MT / 256)) * 256 + wr * 64 + fr, col0 = (u.pn & 3) * 256 + wc * 32 + 8 * fq;
        const bf16_t* Gn = G + n * 1024 + col0; bf16_t* Mc = Mx + col0;
        u32x4_t gc[2], oc[2], gn[2], on[2];
#pragma unroll
        for (int bj = 0; bj < 2; ++bj) { gc[bj] = *(const u32x4_t*)(Gn + (size_t)row0 * N1 + bj * 128); oc[bj] = first ? (u32x4_t){0u, 0u, 0u, 0u} : *(const u32x4_t*)(Mc + (size_t)row0 * DM + bj * 128); }
#pragma unroll
        for (int gI = 0; gI < 8; ++gI) { const int ai = gI >> 2, m = gI & 3; const size_t row = (size_t)(row0 + ai * 128 + m * 16);
            if (gI < 7) { const size_t row2 = (size_t)(row0 + ((gI + 1) >> 2) * 128 + ((gI + 1) & 3) * 16);
#pragma unroll
                for (int bj = 0; bj < 2; ++bj) { gn[bj] = *(const u32x4_t*)(Gn + row2 * N1 + bj * 128); on[bj] = first ? (u32x4_t){0u, 0u, 0u, 0u} : *(const u32x4_t*)(Mc + row2 * DM + bj * 128); } }
#pragma unroll
            for (int bj = 0; bj < 2; ++bj) { float v[8];
#pragma unroll
                for (int i = 0; i < 4; ++i) { v[i] = acc[ai][bj][m][0][i]; v[4 + i] = acc[ai][bj][m][1][i]; }
#pragma unroll
                for (int i = 0; i < 4; ++i) { v[2 * i] = v[2 * i] * bflo(gc[bj][i]) + bflo(oc[bj][i]); v[2 * i + 1] = v[2 * i + 1] * bfhi(gc[bj][i]) + bfhi(oc[bj][i]); }
                u32x4_t o; o[0] = pg8::cvt_pk_bf16(v[0], v[1]); o[1] = pg8::cvt_pk_bf16(v[2], v[3]); o[2] = pg8::cvt_pk_bf16(v[4], v[5]); o[3] = pg8::cvt_pk_bf16(v[6], v[7]);
                *(u32x4_t*)(Mc + row * DM + bj * 128) = o; }
#pragma unroll
            for (int bj = 0; bj < 2; ++bj) { gc[bj] = gn[bj]; oc[bj] = on[bj]; } }
    }
};
struct EpiResid {
    static constexpr bool PERM = false, AFTER_DRAIN = false;
    float* X; const float* Sa; const float* Sb;
    __device__ __forceinline__ void operator()(const f32x4 (&acc)[2][2][4][2], const pg8::Unit& u, int wr, int wc, int fr, int fq) const {
        const int row0 = u.pm * 256 + wr * 64 + fr, col0 = u.pn * 256 + wc * 32 + 4 * fq;
        const float* S = u.pm * 256 < MP ? Sa : Sb - (size_t)MP * DM;
        f32x4 cur[4], nxt[4];
#pragma unroll
        for (int q = 0; q < 4; ++q) cur[q] = *(const f32x4*)(S + (size_t)row0 * DM + col0 + (q >> 1) * 128 + (q & 1) * 16);
#pragma unroll
        for (int gI = 0; gI < 8; ++gI) { const int ai = gI >> 2, m = gI & 3; const size_t ro = (size_t)(row0 + ai * 128 + m * 16) * DM + col0;
            if (gI < 7) { const int ai2 = (gI + 1) >> 2, m2 = (gI + 1) & 3; const size_t ro2 = (size_t)(row0 + ai2 * 128 + m2 * 16) * DM + col0;
#pragma unroll
                for (int q = 0; q < 4; ++q) nxt[q] = *(const f32x4*)(S + ro2 + (q >> 1) * 128 + (q & 1) * 16); }
#pragma unroll
            for (int q = 0; q < 4; ++q) *(f32x4*)(X + ro + (q >> 1) * 128 + (q & 1) * 16) = cur[q] + acc[ai][q >> 1][m][q & 1];
#pragma unroll
            for (int q = 0; q < 4; ++q) cur[q] = nxt[q]; }
    }
};

struct EpiAtomic {
    static constexpr bool PERM = false, AFTER_DRAIN = false;
    float* X;
    __device__ __forceinline__ void operator()(const f32x4 (&acc)[2][2][4][2], const pg8::Unit& u, int wr, int wc, int fr, int fq) const {
        const int row0 = u.pm * 256 + wr * 64 + fr, col0 = u.pn * 256 + wc * 32 + 4 * fq;
#pragma unroll
        for (int ai = 0; ai < 2; ++ai)
#pragma unroll
            for (int m = 0; m < 4; ++m) { float* rowp = X + (size_t)(row0 + ai * 128 + m * 16) * DM + col0;
#pragma unroll
                for (int bj = 0; bj < 2; ++bj)
#pragma unroll
                    for (int n = 0; n < 2; ++n)
#pragma unroll
                        for (int e = 0; e < 4; ++e) unsafeAtomicAdd(rowp + bj * 128 + n * 16 + e, acc[ai][bj][m][n][e]); }
    }
};
struct MergeOrder {
    pg8::StaticOrder base;
    __device__ void init(int G_, int c_) { base.init(MT, 1024, G_, c_); }
    __device__ bool next(int i, pg8::Unit& u) const { const int t = i / 3, n = i - 3 * t; pg8::Unit b; if (!base.next(t, b)) return false; u.pm = n * (MT / 256) + b.pm; u.pn = n * 4 + b.pn; u.pk = 0; return true; }
    __device__ __forceinline__ void a_ready(const pg8::Unit&) const {}
    __device__ __forceinline__ void done(const pg8::Unit&) const {}
};
struct PieceOrder {
    int G, c, KP;
    __device__ bool next(int i, pg8::Unit& u) const { const int L = i * G + c; if (L >= 8 * KP) return false; const int tile = L / KP; u.pk = L - tile * KP; u.pm = MP / 256 + (tile >> 2); u.pn = tile & 3; return true; }
    __device__ __forceinline__ void a_ready(const pg8::Unit&) const {}
    __device__ __forceinline__ void done(const pg8::Unit&) const {}
};
__device__ __forceinline__ void phase_gdnprep(const Params& p, int l) {
    int tid_ = threadIdx.x; asm volatile("" : "+v"(tid_)); const int tid = tid_, j = tid & 15;
    const bf16_t* proj = (const bf16_t*)(PWS + W_PROJ);
    bf16_t* qkd = (bf16_t*)(PWS + W_HBF); bf16_t* vd = (bf16_t*)(PWS + W_OUTS);
    const float* cw = PIN(I_GCW) + (size_t)l * 4 * 1536; const float* cst = PIN(I_SGC) + (size_t)l * NBS * 3 * 1536;
    const int ngroups = MT * 12, half = ngroups / 2;
    for (int gid0 = bidx() * 32 + (tid >> 4); gid0 < half; gid0 += gdim() * 32) {
        const int part = gid0 % 12, col = part * 128 + 8 * j;
        float4 w0[4], w1[4];
#pragma unroll
        for (int jj = 0; jj < 4; ++jj) { w0[jj] = *(const float4*)(cw + jj * 1536 + col); w1[jj] = *(const float4*)(cw + jj * 1536 + col + 4); }
        float x[2][4][8]; int rr[2];
#pragma unroll
        for (int k = 0; k < 2; ++k) { const int gid = gid0 + k * half, r = gid / 12; rr[k] = r;
            const bool samp = r >= MP; const int t = samp ? ((r - MP) & 3) : (r & (SEQ - 1)), b2 = samp ? ((r - MP) >> 2) : 0;
#pragma unroll
            for (int jj = 0; jj < 4; ++jj) { const int tt = t - 3 + jj;
                if (tt >= 0) { const u32x4_t raw = *(const u32x4_t*)(proj + (size_t)(r - 3 + jj) * N1 + col);
#pragma unroll
                    for (int i = 0; i < 4; ++i) { x[k][jj][2 * i] = bflo(raw[i]); x[k][jj][2 * i + 1] = bfhi(raw[i]); } }
                else if (samp) { const float* cp = cst + (size_t)(b2 * 3 + 3 + tt) * 1536 + col; const float4 a0 = *(const float4*)cp, a1 = *(const float4*)(cp + 4);
                    x[k][jj][0] = a0.x; x[k][jj][1] = a0.y; x[k][jj][2] = a0.z; x[k][jj][3] = a0.w; x[k][jj][4] = a1.x; x[k][jj][5] = a1.y; x[k][jj][6] = a1.z; x[k][jj][7] = a1.w; }
                else {
#pragma unroll
                    for (int i = 0; i < 8; ++i) x[k][jj][i] = 0.f; } } }
#pragma unroll
        for (int k = 0; k < 2; ++k) { const int r = rr[k]; float y[8];
#pragma unroll
            for (int i = 0; i < 8; ++i) y[i] = 0.f;
#pragma unroll
            for (int jj = 0; jj < 4; ++jj) { y[0] += w0[jj].x * x[k][jj][0]; y[1] += w0[jj].y * x[k][jj][1]; y[2] += w0[jj].z * x[k][jj][2]; y[3] += w0[jj].w * x[k][jj][3];
                y[4] += w1[jj].x * x[k][jj][4]; y[5] += w1[jj].y * x[k][jj][5]; y[6] += w1[jj].z * x[k][jj][6]; y[7] += w1[jj].w * x[k][jj][7]; }
            float ss = 0.f;
#pragma unroll
            for (int i = 0; i < 8; ++i) { y[i] = silu(y[i]); ss += y[i] * y[i]; }
            ss = grp_sum16(ss);
            const float scl = part < 4 ? rsqrtf(ss + EPS) * QSCALE : (part < 8 ? rsqrtf(ss + EPS) : 1.f);
            u32x4_t o; o[0] = pg8::cvt_pk_bf16(y[0] * scl, y[1] * scl); o[1] = pg8::cvt_pk_bf16(y[2] * scl, y[3] * scl); o[2] = pg8::cvt_pk_bf16(y[4] * scl, y[5] * scl); o[3] = pg8::cvt_pk_bf16(y[6] * scl, y[7] * scl);
            if (part < 8) *(u32x4_t*)(qkd + (size_t)r * 1024 + col) = o; else *(u32x4_t*)(vd + (size_t)r * 512 + (col - 1024)) = o; }
    }
}

__device__ __forceinline__ void lds_barrier() { asm volatile("s_waitcnt lgkmcnt(0)" ::: "memory"); __builtin_amdgcn_s_barrier(); asm volatile("" ::: "memory"); }
typedef float f2 __attribute__((ext_vector_type(2)));
typedef float f4 __attribute__((ext_vector_type(4)));
template <int MIX>
__device__ __forceinline__ void scan_prompt_item(const Params& p, int l, int b, int h, int cgp, float* sm) {
    constexpr int T = 16, CPL = (MIX == 0) ? 1 : 2, NG = 128 / (4 * T), NP = 2 * NG, CPW = (64 / T) * CPL, CPG = 8 * CPW, TB = 32, BUFSZ = 16512, NBLK = SEQ / TB;
    int tid_ = threadIdx.x; asm volatile("" : "+v"(tid_)); const int tid = tid_, lane = tid & 63, w = tid >> 6, c = lane / T, j = lane % T;
    const int col = w * CPW + c, ecol = cgp * CPG + col;
    float* misc = sm + 2 * BUFSZ; float* gsc = misc; float* mcar = misc + 64;
    const float* gates = (const float*)(PWS + W_GATES);
    bf16_t* outp = (bf16_t*)(PWS + W_OUTS) + (size_t)MIX * MT * 512;
    const size_t rb = (size_t)b * SEQ;
    const int c8 = (tid & 31) * 8, srow = tid >> 5;
    const bf16_t* qsrc; size_t qld; const bf16_t* vsrc; size_t vld;
    if (MIX == 0) { qsrc = (const bf16_t*)(PWS + W_HBF) + rb * 1024 + (c8 < 128 ? h * 128 + c8 : 512 + h * 128 + (c8 - 128)); qld = 1024;
        vsrc = (const bf16_t*)(PWS + W_OUTS) + rb * 512 + h * 128 + cgp * 32; vld = 512; }
    else { const int base = MIX == 1 ? 2048 : 4096; qsrc = (const bf16_t*)(PWS + W_PROJ) + rb * N1 + base + (c8 < 128 ? h * 128 + c8 : 512 + h * 128 + (c8 - 128)); qld = N1;
        vsrc = (const bf16_t*)(PWS + W_PROJ) + rb * N1 + base + 1024 + h * 128 + cgp * 64; vld = N1; }
    constexpr int VPC = CPG / 8;
    const int vs = tid / VPC, vc8 = (tid % VPC) * 8; const bool vact = tid < TB * VPC;
    float lb8[8];
#pragma unroll
    for (int i = 0; i < 8; ++i) lb8[i] = 0.f;
    if (MIX == 2 && l > 0 && c8 >= 128) { const float* hl = PIN(I_HLB);
#pragma unroll
        for (int i = 0; i < 8; ++i) { const int cc = h * 128 + (c8 - 128) + i; lb8[i] = sigm(hl[512 + cc] - hl[cc]); } }
    f2 S2[CPL][NP];
#pragma unroll
    for (int cc = 0; cc < CPL; ++cc)
#pragma unroll
        for (int i = 0; i < NP; ++i) S2[cc][i] = (f2){0.f, 0.f};
    float nn = 0.f, okeep[CPL], oprev[CPL];
#pragma unroll
    for (int cc = 0; cc < CPL; ++cc) { okeep[cc] = 0.f; oprev[cc] = 0.f; }
    u32x4_t rq[2][2], rv[2]; float rg0[2] = {0.f, 0.f}, rg1[2] = {0.f, 0.f};
    rv[0] = (u32x4_t){0u, 0u, 0u, 0u}; rv[1] = rv[0];
#define SCAN_ISSUE(t0_, st_) do { \
        _Pragma("unroll") for (int i_ = 0; i_ < 2; ++i_) rq[st_][i_] = *(const u32x4_t*)(qsrc + (size_t)((t0_) + srow + 16 * i_) * qld); \
        if (vact) rv[st_] = *(const u32x4_t*)(vsrc + (size_t)((t0_) + vs) * vld + vc8); \
        if (MIX != 2 && tid < TB) { const size_t r_ = rb + (t0_) + tid; rg0[st_] = gates[r_ * 16 + (MIX == 0 ? 0 : 8) + h]; rg1[st_] = gates[r_ * 16 + (MIX == 0 ? 4 : 12) + h]; } } while (0)
#define SCAN_FINISH(B_, st_) do { float* qk_ = (B_); float* vv_ = (B_) + 8192; float* sc_ = (B_) + 10240; \
        _Pragma("unroll") for (int i_ = 0; i_ < 2; ++i_) { float x_[8]; \
            _Pragma("unroll") for (int e_ = 0; e_ < 4; ++e_) { x_[2 * e_] = bflo(rq[st_][i_][e_]); x_[2 * e_ + 1] = bfhi(rq[st_][i_][e_]); } \
            if (MIX == 2 && c8 >= 128) { _Pragma("unroll") for (int e_ = 0; e_ < 8; ++e_) x_[e_] = lb8[e_] + (1.f - lb8[e_]) * sigm(x_[e_]); } \
            float* d_ = qk_ + (srow + 16 * i_) * 256 + c8; *(f4*)d_ = (f4){x_[0], x_[1], x_[2], x_[3]}; *(f4*)(d_ + 4) = (f4){x_[4], x_[5], x_[6], x_[7]}; } \
        if (vact) { float* d_ = vv_ + vs * 64 + vc8; *(f4*)d_ = (f4){bflo(rv[st_][0]), bfhi(rv[st_][0]), bflo(rv[st_][1]), bfhi(rv[st_][1])}; *(f4*)(d_ + 4) = (f4){bflo(rv[st_][2]), bfhi(rv[st_][2]), bflo(rv[st_][3]), bfhi(rv[st_][3])}; } \
        if (MIX == 0 && tid < TB) { sc_[tid * 4] = rg0[st_]; sc_[tid * 4 + 1] = rg1[st_]; } \
        if (MIX == 1 && tid < TB) { gsc[tid * 2] = rg0[st_]; gsc[tid * 2 + 1] = rg1[st_]; } } while (0)
#define SCAN_CHAIN(B_) do { if (w == 1) { float* sc_ = (B_) + 10240; const int ls_ = lane & 31; const float m0_ = mcar[0]; \
            const float ig_ = gsc[2 * ls_], lf_ = gsc[2 * ls_ + 1]; \
            float F_ = lf_; F_ += dppf<0x111>(F_); F_ += dppf<0x112>(F_); F_ += dppf<0x114>(F_); F_ += dppf<0x118>(F_);              \
            { const float t0_ = rdlane(F_, 15); if (lane & 16) F_ += t0_; } \
            float P_ = ig_ - F_; P_ = fmaxf(P_, dppm<0x111>(P_)); P_ = fmaxf(P_, dppm<0x112>(P_)); P_ = fmaxf(P_, dppm<0x114>(P_)); P_ = fmaxf(P_, dppm<0x118>(P_)); \
            { const float t1_ = rdlane(P_, 15); if (lane & 16) P_ = fmaxf(P_, t1_); } \
            const float m_ = F_ + fmaxf(m0_, P_); \
            float mp_ = dppf<0x111>(m_); { const float t2_ = rdlane(m_, 15); if ((lane & 15) == 0) mp_ = (lane & 16) ? t2_ : m0_; } \
            const float mlast_ = rdlane(m_, 31); \
            if (lane < 32) { sc_[lane * 4] = __expf(lf_ + mp_ - m_); sc_[lane * 4 + 1] = __expf(ig_ - m_) * QSCALE; sc_[lane * 4 + 2] = m_; } \
            if (lane == 0) mcar[0] = mlast_; } } while (0)
    if (MIX == 1 && tid == 64) mcar[0] = 0.f;
    __syncthreads();
    SCAN_ISSUE(0, 0);
    SCAN_FINISH(sm, 0);
    SCAN_ISSUE(TB, 1);
    __syncthreads();
    if (MIX == 1) { SCAN_CHAIN(sm); __syncthreads(); }
#pragma unroll 1
    for (int blk2 = 0; blk2 < NBLK; blk2 += 2) {
#pragma unroll
      for (int par = 0; par < 2; ++par) {
        const int blk = blk2 + par;
        const int t0 = blk * TB;
        float* B = sm + (blk & 1) * BUFSZ; float* Bn = sm + ((blk & 1) ^ 1) * BUFSZ;
        const float* qk = B; const float* vv = B + 8192; const float* sc = B + 10240; float* denp = B + 10368; float* ost = B + 14464;
        if (blk + 2 < NBLK) SCAN_ISSUE(t0 + 2 * TB, par);
        f4 qa[2][NG], ka[2][NG]; float va[2][CPL], sa[2], sb[2], kda[2], qda[2];
#define SCAN_LOADOPS(slot_, s_) do { const float* qs_ = qk + (s_) * 256; \
            _Pragma("unroll") for (int g_ = 0; g_ < NG; ++g_) { qa[slot_][g_] = *(const f4*)(qs_ + g_ * 4 * T + 4 * j); ka[slot_][g_] = *(const f4*)(qs_ + 128 + g_ * 4 * T + 4 * j); } \
            _Pragma("unroll") for (int cc_ = 0; cc_ < CPL; ++cc_) va[slot_][cc_] = vv[(s_) * 64 + col + 4 * cc_]; \
            if (MIX != 2) { sa[slot_] = sc[(s_) * 4]; sb[slot_] = sc[(s_) * 4 + 1]; } \
            if (MIX == 1) { const int dn_ = 16 * w + (lane & 15); kda[slot_] = qs_[128 + dn_]; qda[slot_] = qs_[dn_]; } } while (0)
        SCAN_LOADOPS(0, 0);
#pragma unroll 1
        for (int sg = 0; sg < TB; sg += T) {
#pragma unroll
            for (int ss = 0; ss < T; ++ss) {
                const int s = sg + ss; constexpr int dummy = 0; (void)dummy;
                const int cur = ss & 1, nxt = cur ^ 1;
                SCAN_LOADOPS(nxt, (s + 1) & (TB - 1));
                __builtin_amdgcn_sched_barrier(0);
                f2 qq[NP], kk[NP];
#pragma unroll
                for (int g = 0; g < NG; ++g) { qq[2 * g] = qa[cur][g].xy; qq[2 * g + 1] = qa[cur][g].zw; kk[2 * g] = ka[cur][g].xy; kk[2 * g + 1] = ka[cur][g].zw; }
                float onew[CPL];
#pragma unroll
                for (int cc = 0; cc < CPL; ++cc) {
                    const float v = va[cur][cc];
                    f2 oa = (f2){0.f, 0.f}, ob = (f2){0.f, 0.f};
                    if (MIX == 0) {
                        const float beta = sa[cur], a = sb[cur];
                        f2 ka2 = kk[0] * S2[cc][0], kb2 = kk[1] * S2[cc][1];
#pragma unroll
                        for (int i = 2; i < NP; i += 2) { ka2 = kk[i] * S2[cc][i] + ka2; kb2 = kk[i + 1] * S2[cc][i + 1] + kb2; }
                        ka2 = ka2 + kb2;
                        const float ks = grp_sum<T>(ka2.x + ka2.y);
                        const float u = beta * (v - a * ks);
                        const f2 a2 = (f2){a, a}, u2 = (f2){u, u};
#pragma unroll
                        for (int i = 0; i < NP; i += 2) { S2[cc][i] = S2[cc][i] * a2 + kk[i] * u2; S2[cc][i + 1] = S2[cc][i + 1] * a2 + kk[i + 1] * u2; oa = qq[i] * S2[cc][i] + oa; ob = qq[i + 1] * S2[cc][i + 1] + ob; }
                    } else if (MIX == 1) {
                        const float fp = sa[cur], ip = sb[cur], iv = ip * v;
                        const f2 f2v = (f2){fp, fp}, iv2 = (f2){iv, iv};
#pragma unroll
                        for (int i = 0; i < NP; i += 2) { S2[cc][i] = S2[cc][i] * f2v + kk[i] * iv2; S2[cc][i + 1] = S2[cc][i + 1] * f2v + kk[i + 1] * iv2; oa = qq[i] * S2[cc][i] + oa; ob = qq[i + 1] * S2[cc][i + 1] + ob; }
                    } else {
                        const f2 v2 = (f2){v, v};
#pragma unroll
                        for (int i = 0; i < NP; i += 2) { S2[cc][i] = kk[i] * (S2[cc][i] - v2) + v2; S2[cc][i + 1] = kk[i + 1] * (S2[cc][i + 1] - v2) + v2; oa = qq[i] * S2[cc][i] + oa; ob = qq[i + 1] * S2[cc][i + 1] + ob; }
                    }
                    oa = oa + ob; onew[cc] = oa.x + oa.y;
                }
                if (MIX == 1) { const float fp = sa[cur], ip = sb[cur];
                    nn = fp * nn + ip * kda[cur];
                    denp[s * 128 + 16 * w + (lane & 15)] = qda[cur] * nn; }
#pragma unroll
                for (int cc = 0; cc < CPL; ++cc) {
                    if (ss > 0) { const float o = grp_sum<T>(oprev[cc]); okeep[cc] = (ss - 1 == j) ? o : okeep[cc]; }
                    oprev[cc] = onew[cc]; }
            }
#pragma unroll
            for (int cc = 0; cc < CPL; ++cc) { const float o = grp_sum<T>(oprev[cc]); okeep[cc] = (T - 1 == j) ? o : okeep[cc];
                ost[(sg + j) * CPG + col + 4 * cc] = okeep[cc]; }
        }
#undef SCAN_LOADOPS
        if (blk + 1 < NBLK) SCAN_FINISH(Bn, par ^ 1);
        __syncthreads();
        if (tid < TB * (CPG / 8)) { const int orow = tid / (CPG / 8), oc8 = (tid % (CPG / 8)) * 8; const f4 o0 = *(const f4*)(ost + orow * CPG + oc8), o1 = *(const f4*)(ost + orow * CPG + oc8 + 4);
            u32x4_t ov; ov[0] = pg8::cvt_pk_bf16(o0.x, o0.y); ov[1] = pg8::cvt_pk_bf16(o0.z, o0.w); ov[2] = pg8::cvt_pk_bf16(o1.x, o1.y); ov[3] = pg8::cvt_pk_bf16(o1.z, o1.w);
            *(u32x4_t*)(outp + (rb + t0 + orow) * 512 + h * 128 + cgp * CPG + oc8) = ov; }
        if (MIX == 1) {
            if (cgp == 0) { const int sr = tid >> 4, jl = tid & 15; const f4 a0 = *(const f4*)(denp + sr * 128 + 8 * jl), a1 = *(const f4*)(denp + sr * 128 + 8 * jl + 4);
                const float d = grp_sum16((a0.x + a0.y) + (a0.z + a0.w) + (a1.x + a1.y) + (a1.z + a1.w));
                if (jl == 0) { const size_t r = rb + t0 + sr; ((float*)(PWS + W_DEN))[r * 4 + h] = d; ((float*)(PWS + W_MT))[r * 4 + h] = sc[sr * 4 + 2]; } }
            if (blk + 1 < NBLK) SCAN_CHAIN(Bn);
            __syncthreads();
        }
      }
    }
#undef SCAN_ISSUE
#undef SCAN_FINISH
#undef SCAN_CHAIN
    const size_t sidx = ((size_t)(l * NBP + b) * NH + h);
    float* So = POUT + (MIX == 0 ? O_P_GS : (MIX == 1 ? O_P_MC : O_P_HS)) + sidx * 16384;
#pragma unroll
    for (int cc = 0; cc < CPL; ++cc)
#pragma unroll
        for (int g = 0; g < NG; ++g) { const int d0 = g * 4 * T + 4 * j, ec = ecol + 4 * cc;
            So[(size_t)(d0 + 0) * 128 + ec] = S2[cc][2 * g].x; So[(size_t)(d0 + 1) * 128 + ec] = S2[cc][2 * g].y; So[(size_t)(d0 + 2) * 128 + ec] = S2[cc][2 * g + 1].x; So[(size_t)(d0 + 3) * 128 + ec] = S2[cc][2 * g + 1].y; }
    if (MIX == 1 && cgp == 0) {
        if (lane < 16) POUT[O_P_MN + sidx * 128 + 16 * w + lane] = nn;
        if (tid == 64) POUT[O_P_MM + sidx] = mcar[0];
    }
    __syncthreads();
}

template <int MIX>
__device__ __forceinline__ void scan_prompt_lin(const Params& p, int l, int b, int h, int cgp, float* sm) {
    constexpr int TB = 32, NBLK = SEQ / TB;
    int tid_ = threadIdx.x; asm volatile("" : "+v"(tid_)); const int tid = tid_, lane = tid & 63, w = tid >> 6;
    float* qk = sm; float* vv = sm + 8192; float* denp = sm + 10240; float* opart = sm + 14336; float* scall = sm + 30720;
    const float* gates = (const float*)(PWS + W_GATES);
    bf16_t* outp = (bf16_t*)(PWS + W_OUTS) + (size_t)MIX * MT * 512;
    const size_t rb = (size_t)b * SEQ;
    const int c8 = (tid & 31) * 8, srow = tid >> 5;
    const int base = MIX == 1 ? 2048 : 4096;
    const bf16_t* qsrc = (const bf16_t*)(PWS + W_PROJ) + rb * N1 + base + (c8 < 128 ? h * 128 + c8 : 512 + h * 128 + (c8 - 128));
    const bf16_t* vsrc = (const bf16_t*)(PWS + W_PROJ) + rb * N1 + base + 1024 + h * 128 + cgp * 64;
    const int vs = tid >> 3, vc8 = (tid & 7) * 8; const bool vact = tid < TB * 8;
    float lb8[8];
#pragma unroll
    for (int i = 0; i < 8; ++i) lb8[i] = 0.f;
    if (MIX == 2 && l > 0 && c8 >= 128) { const float* hl = PIN(I_HLB);
#pragma unroll
        for (int i = 0; i < 8; ++i) { const int cc = h * 128 + (c8 - 128) + i; lb8[i] = sigm(hl[512 + cc] - hl[cc]); } }
    __syncthreads();
    float mfinal = 0.f;
    if (MIX == 1) {
        float* graw = opart;
        for (int i = tid; i < SEQ; i += 512) { const size_t r = rb + i; graw[2 * i] = gates[r * 16 + 8 + h]; graw[2 * i + 1] = gates[r * 16 + 12 + h]; }
        __syncthreads();
        if (w == 1) { float m0 = 0.f; const int ls = lane & 31;
            for (int t0 = 0; t0 < SEQ; t0 += 32) {
                const float ig = graw[2 * (t0 + ls)], lf = graw[2 * (t0 + ls) + 1];
                float F = lf; F += dppf<0x111>(F); F += dppf<0x112>(F); F += dppf<0x114>(F); F += dppf<0x118>(F);
                { const float t0v = rdlane(F, 15); if (lane & 16) F += t0v; }
                float P = ig - F; P = fmaxf(P, dppm<0x111>(P)); P = fmaxf(P, dppm<0x112>(P)); P = fmaxf(P, dppm<0x114>(P)); P = fmaxf(P, dppm<0x118>(P));
                { const float t1v = rdlane(P, 15); if (lane & 16) P = fmaxf(P, t1v); }
                const float m = F + fmaxf(m0, P);
                float mp = dppf<0x111>(m); { const float t2v = rdlane(m, 15); if ((lane & 15) == 0) mp = (lane & 16) ? t2v : m0; }
                (void)mp;
                if (lane < 32) { scall[2 * (t0 + lane)] = __expf(F + m0 - m); scall[2 * (t0 + lane) + 1] = __expf(ig - F - m0) * QSCALE;
                    if (cgp == 0) ((float*)(PWS + W_MT))[(rb + t0 + lane) * 4 + h] = m; }
                m0 = rdlane(m, 31); }
            mfinal = m0; }
        __syncthreads();
    }
    f2 S2[8];
#pragma unroll
    for (int i = 0; i < 8; ++i) S2[i] = (f2){0.f, 0.f};
    float nn = 0.f;
    u32x4_t rq[2][2], rv[2]; rv[0] = (u32x4_t){0u, 0u, 0u, 0u}; rv[1] = rv[0];
#define LIN_ISSUE(t0_, st_) do { \
        _Pragma("unroll") for (int i_ = 0; i_ < 2; ++i_) rq[st_][i_] = *(const u32x4_t*)(qsrc + (size_t)((t0_) + srow + 16 * i_) * N1); \
        if (vact) rv[st_] = *(const u32x4_t*)(vsrc + (size_t)((t0_) + vs) * N1 + vc8); } while (0)
#define LIN_FINISH(st_) do { \
        _Pragma("unroll") for (int i_ = 0; i_ < 2; ++i_) { float x_[8]; \
            _Pragma("unroll") for (int e_ = 0; e_ < 4; ++e_) { x_[2 * e_] = bflo(rq[st_][i_][e_]); x_[2 * e_ + 1] = bfhi(rq[st_][i_][e_]); } \
            if (MIX == 2 && c8 >= 128) { _Pragma("unroll") for (int e_ = 0; e_ < 8; ++e_) x_[e_] = lb8[e_] + (1.f - lb8[e_]) * sigm(x_[e_]); } \
            float* d_ = qk + (srow + 16 * i_) * 256 + c8; *(f4*)d_ = (f4){x_[0], x_[1], x_[2], x_[3]}; *(f4*)(d_ + 4) = (f4){x_[4], x_[5], x_[6], x_[7]}; } \
        if (vact) { float* d_ = vv + vs * 64 + vc8; *(f4*)d_ = (f4){bflo(rv[st_][0]), bfhi(rv[st_][0]), bflo(rv[st_][1]), bfhi(rv[st_][1])}; *(f4*)(d_ + 4) = (f4){bflo(rv[st_][2]), bfhi(rv[st_][2]), bflo(rv[st_][3]), bfhi(rv[st_][3])}; } } while (0)
    LIN_ISSUE(0, 0);
    LIN_FINISH(0);
    LIN_ISSUE(TB, 1);
    __syncthreads();
#pragma unroll 1
    for (int blk2 = 0; blk2 < NBLK; blk2 += 2) {
#pragma unroll
      for (int par = 0; par < 2; ++par) {
        const int blk = blk2 + par;
        const int t0 = blk * TB;
        if (blk + 2 < NBLK) LIN_ISSUE(t0 + 2 * TB, par);
        f4 qa[2][4], ka[2][4]; float va[2], kda[2], qda[2]; f2 sca[2];
#define LIN_LOADOPS(slot_, s_) do { const float* qs_ = qk + (s_) * 256 + 16 * w; \
            _Pragma("unroll") for (int g_ = 0; g_ < 4; ++g_) { qa[slot_][g_] = *(const f4*)(qs_ + 4 * g_); ka[slot_][g_] = *(const f4*)(qs_ + 128 + 4 * g_); } \
            va[slot_] = vv[(s_) * 64 + lane]; \
            if (MIX == 1) { sca[slot_] = *(const f2*)(scall + 2 * (t0 + (s_))); kda[slot_] = qs_[128 + (lane & 15)]; qda[slot_] = qs_[lane & 15]; } } while (0)
        LIN_LOADOPS(0, 0);
#pragma unroll 1
        for (int sg = 0; sg < TB; sg += 4) {
#pragma unroll
            for (int ss = 0; ss < 4; ++ss) {
                const int s = sg + ss, cur = ss & 1, nxt = cur ^ 1;
                LIN_LOADOPS(nxt, (s + 1) & (TB - 1));
                __builtin_amdgcn_sched_barrier(0);
                f2 qq[8], kk[8];
#pragma unroll
                for (int g = 0; g < 4; ++g) { qq[2 * g] = qa[cur][g].xy; qq[2 * g + 1] = qa[cur][g].zw; kk[2 * g] = ka[cur][g].xy; kk[2 * g + 1] = ka[cur][g].zw; }
                const float v = va[cur];
                f2 oa = (f2){0.f, 0.f}, ob = (f2){0.f, 0.f};
                if (MIX == 1) {
                    const float Fb = sca[cur].x, av = sca[cur].y, iv = av * v;
                    const f2 iv2 = (f2){iv, iv};
#pragma unroll
                    for (int i = 0; i < 8; i += 2) { S2[i] = kk[i] * iv2 + S2[i]; S2[i + 1] = kk[i + 1] * iv2 + S2[i + 1]; oa = qq[i] * S2[i] + oa; ob = qq[i + 1] * S2[i + 1] + ob; }
                    nn = av * kda[cur] + nn;
                    denp[s * 128 + 16 * w + (lane & 15)] = Fb * qda[cur] * nn;
                    oa = oa * (f2){Fb, Fb}; ob = ob * (f2){Fb, Fb};
                } else {
                    const f2 v2 = (f2){v, v};
#pragma unroll
                    for (int i = 0; i < 8; i += 2) { S2[i] = kk[i] * (S2[i] - v2) + v2; S2[i + 1] = kk[i + 1] * (S2[i + 1] - v2) + v2; oa = qq[i] * S2[i] + oa; ob = qq[i + 1] * S2[i + 1] + ob; }
                }
                oa = oa + ob;
                opart[(s * 8 + w) * 64 + lane] = oa.x + oa.y;
            }
        }
#undef LIN_LOADOPS
        if (MIX == 1) { const float Fe = scall[2 * (t0 + TB - 1)]; const f2 Fe2 = (f2){Fe, Fe};
#pragma unroll
            for (int i = 0; i < 8; ++i) S2[i] = S2[i] * Fe2;
            nn *= Fe; }
        __syncthreads();
        { const int s = tid >> 5, e2 = (tid & 31) * 2; f2 acc2 = (f2){0.f, 0.f};
#pragma unroll
            for (int ww = 0; ww < 8; ++ww) acc2 = acc2 + *(const f2*)(opart + (s * 8 + ww) * 64 + e2);
            const int s2 = s + 16; f2 acc3 = (f2){0.f, 0.f};
#pragma unroll
            for (int ww = 0; ww < 8; ++ww) acc3 = acc3 + *(const f2*)(opart + (s2 * 8 + ww) * 64 + e2);
            *(unsigned*)(outp + (rb + t0 + s) * 512 + h * 128 + cgp * 64 + e2) = pg8::cvt_pk_bf16(acc2.x, acc2.y);
            *(unsigned*)(outp + (rb + t0 + s2) * 512 + h * 128 + cgp * 64 + e2) = pg8::cvt_pk_bf16(acc3.x, acc3.y); }
        if (MIX == 1 && cgp == 0) { const int sr = tid >> 4, jl = tid & 15; const f4 a0 = *(const f4*)(denp + sr * 128 + 8 * jl), a1 = *(const f4*)(denp + sr * 128 + 8 * jl + 4);
            const float d = grp_sum16((a0.x + a0.y) + (a0.z + a0.w) + (a1.x + a1.y) + (a1.z + a1.w));
            if (jl == 0) ((float*)(PWS + W_DEN))[(rb + t0 + sr) * 4 + h] = d; }
        if (blk + 1 < NBLK) LIN_FINISH(par ^ 1);
        __syncthreads();
      }
    }
#undef LIN_ISSUE
#undef LIN_FINISH
    const size_t sidx = ((size_t)(l * NBP + b) * NH + h);
    float* So = POUT + (MIX == 1 ? O_P_MC : O_P_HS) + sidx * 16384;
#pragma unroll
    for (int i = 0; i < 8; ++i) { So[(size_t)(16 * w + 2 * i) * 128 + cgp * 64 + lane] = S2[i].x; So[(size_t)(16 * w + 2 * i + 1) * 128 + cgp * 64 + lane] = S2[i].y; }
    if (MIX == 1 && cgp == 0) {
        if (lane < 16) POUT[O_P_MN + sidx * 128 + 16 * w + lane] = nn;
        if (tid == 64) POUT[O_P_MM + sidx] = mfinal;
    }
    __syncthreads();
}

__device__ __forceinline__ void scan_sample_item(const Params& p, int l, int mix, int b, int h, float* sm) {
    int tid_ = threadIdx.x; asm volatile("" : "+v"(tid_)); const int tid = tid_, lane = tid & 63, w = tid >> 6, e = tid & 127, dg = tid >> 7;
    float* qk = sm; float* vv = sm + 1024; float* gs = sm + 1536; float* red = sm + 1600; float* dpart = sm + 1600 + 4096;
    const bf16_t* proj = (const bf16_t*)(PWS + W_PROJ);
    const float* gates = (const float*)(PWS + W_GATES);
    bf16_t* outp = (bf16_t*)(PWS + W_OUTS) + (size_t)mix * MT * 512;
    const size_t rs = (size_t)MP + (size_t)b * SSEQ;
    const size_t sidx = ((size_t)(l * NBS + b) * NH + h);
    const float* Sin = (mix == 0 ? PIN(I_SGS) : (mix == 1 ? PIN(I_SMC) : PIN(I_SHS))) + sidx * 16384;
    float S[32];
#pragma unroll
    for (int i = 0; i < 32; ++i) S[i] = Sin[(size_t)(32 * dg + i) * 128 + e];
    __syncthreads();
    for (int idx = tid; idx < 4 * 384; idx += 512) { const int s = idx / 384, ch = idx - s * 384; float val;
        if (mix == 0) { val = ch < 256 ? bf2f(((const bf16_t*)(PWS + W_HBF))[(rs + s) * 1024 + (ch >> 7) * 512 + h * 128 + (ch & 127)]) : bf2f(outp[(rs + s) * 512 + h * 128 + (ch - 256)]);
        } else if (mix == 1) { const int colx = 2048 + (ch >> 7) * 512 + h * 128 + (ch & 127); val = bf2f(proj[(rs + s) * N1 + colx]); }
        else { const int colx = 4096 + (ch >> 7) * 512 + h * 128 + (ch & 127); val = bf2f(proj[(rs + s) * N1 + colx]);
            if (ch >= 128 && ch < 256) { float lbv = 0.f; if (l > 0) { const float* hl = PIN(I_HLB); const int cc = h * 128 + (ch & 127); lbv = sigm(hl[512 + cc] - hl[cc]); } val = lbv + (1.f - lbv) * sigm(val); } }
        if (ch < 256) qk[s * 256 + ch] = val; else vv[s * 128 + ch - 256] = val; }
    if (tid < 4) { const size_t r = rs + tid;
        if (mix == 0) { gs[tid * 4] = gates[r * 16 + h]; gs[tid * 4 + 1] = gates[r * 16 + 4 + h]; }
        else if (mix == 1) { gs[tid * 4] = gates[r * 16 + 8 + h]; gs[tid * 4 + 1] = gates[r * 16 + 12 + h]; } }
    __syncthreads();
    float m = 0.f, nn = 0.f, mts[4] = {0.f, 0.f, 0.f, 0.f};
    if (mix == 1) { m = PIN(I_SMM)[sidx]; if (dg == 0) nn = PIN(I_SMN)[sidx * 128 + e]; }
#pragma unroll
    for (int s = 0; s < 4; ++s) {
        const float* qs = qk + s * 256 + 32 * dg; const float* ksp = qs + 128;
        const float v = vv[s * 128 + e];
        float po = 0.f;
        if (mix == 0) {
            const float beta = gs[s * 4], a = gs[s * 4 + 1];
            float pk = 0.f;
#pragma unroll
            for (int i = 0; i < 32; ++i) pk += ksp[i] * S[i];
            red[((s * 2) * 4 + dg) * 128 + e] = pk;
            __syncthreads();
            const float ks = red[((s * 2) * 4 + 0) * 128 + e] + red[((s * 2) * 4 + 1) * 128 + e] + red[((s * 2) * 4 + 2) * 128 + e] + red[((s * 2) * 4 + 3) * 128 + e];
            const float u = beta * (v - a * ks);
#pragma unroll
            for (int i = 0; i < 32; ++i) { S[i] = a * S[i] + ksp[i] * u; po += qs[i] * S[i]; }
        } else if (mix == 1) {
            const float ig = gs[s * 4], lf = gs[s * 4 + 1]; const float mn = fmaxf(lf + m, ig); const float fp = __expf(lf + m - mn), ip = __expf(ig - mn) * QSCALE; m = mn; mts[s] = mn;
            const float iv = ip * v;
#pragma unroll
            for (int i = 0; i < 32; ++i) { S[i] = fp * S[i] + ksp[i] * iv; po += qs[i] * S[i]; }
            if (dg == 0) { nn = fp * nn + ip * qk[s * 256 + 128 + e]; const float dp = wave_sum(qk[s * 256 + e] * nn); if (lane == 0) dpart[s * 2 + w] = dp; }
        } else {
#pragma unroll
            for (int i = 0; i < 32; ++i) { S[i] = ksp[i] * (S[i] - v) + v; po += qs[i] * S[i]; }
        }
        red[((s * 2 + 1) * 4 + dg) * 128 + e] = po;
    }
    __syncthreads();
    if (tid < 128) {
#pragma unroll
        for (int s = 0; s < 4; ++s) { const float o = red[((s * 2 + 1) * 4 + 0) * 128 + e] + red[((s * 2 + 1) * 4 + 1) * 128 + e] + red[((s * 2 + 1) * 4 + 2) * 128 + e] + red[((s * 2 + 1) * 4 + 3) * 128 + e];
            outp[(rs + s) * 512 + h * 128 + e] = f2bf(o); } }
    if (mix == 1 && tid == 0) {
#pragma unroll
        for (int s = 0; s < 4; ++s) { ((float*)(PWS + W_DEN))[(rs + s) * 4 + h] = dpart[s * 2] + dpart[s * 2 + 1]; ((float*)(PWS + W_MT))[(rs + s) * 4 + h] = mts[s]; }
        POUT[O_S_MM + sidx] = m; }
    float* So = POUT + (mix == 0 ? O_S_GS : (mix == 1 ? O_S_MC : O_S_HS)) + sidx * 16384;
#pragma unroll
    for (int i = 0; i < 32; ++i) So[(size_t)(32 * dg + i) * 128 + e] = S[i];
    if (mix == 1 && dg == 0) POUT[O_S_MN + sidx * 128 + e] = nn;
}

__device__ __forceinline__ void scan_sample_all(const Params& p, int l, float* sm) {
    int tid_ = threadIdx.x; asm volatile("" : "+v"(tid_)); const int tid = tid_, lane = tid & 63, w = tid >> 6, e = tid & 127, dg = tid >> 7;
    float* qk = sm; float* vv = sm + 1024; float* gs = sm + 1536; float* red = sm + 1600; float* dpart = sm + 1600 + 4096; volatile int* qslot = (volatile int*)(sm + 5760);
    float* simg = sm + 6144;
    PG8_LAS unsigned char* simg_l = (PG8_LAS unsigned char*)simg;
    const bf16_t* proj = (const bf16_t*)(PWS + W_PROJ); const bf16_t* hbf = (const bf16_t*)(PWS + W_HBF);
    const float* gates = (const float*)(PWS + W_GATES);
    bf16_t* outs = (bf16_t*)(PWS + W_OUTS);
    unsigned* qctr = (unsigned*)(PWS + W_BAR) + 64 * l;
    constexpr int NIT = 3 * NBS * NH;
    const float* hl = PIN(I_HLB);
    __syncthreads();
    if (tid == 0) { qslot[0] = (int)__hip_atomic_fetch_add(qctr, 1u, __ATOMIC_RELAXED, __HIP_MEMORY_SCOPE_AGENT); qslot[1] = (int)__hip_atomic_fetch_add(qctr, 1u, __ATOMIC_RELAXED, __HIP_MEMORY_SCOPE_AGENT); }
    __syncthreads();
    int it0 = qslot[0], it1 = qslot[1];
    float stg[3], gn0 = 0.f, gn1 = 0.f, mn_in = 0.f, nn_in = 0.f;
    stg[0] = stg[1] = stg[2] = 0.f;
#define SMP_ISSUE(it_) do { const int mix_ = (it_) / (NBS * NH), r_ = (it_) - mix_ * (NBS * NH), b_ = r_ >> 2, h_ = r_ & 3; \
        const size_t sidx_ = ((size_t)(l * NBS + b_) * NH + h_), rs_ = (size_t)MP + (size_t)b_ * SSEQ; \
        const float* Sin_ = (mix_ == 0 ? PIN(I_SGS) : (mix_ == 1 ? PIN(I_SMC) : PIN(I_SHS))) + sidx_ * 16384; \
        _Pragma("unroll") for (int k_ = 0; k_ < 8; ++k_) __builtin_amdgcn_global_load_lds((const unsigned*)((const char*)Sin_ + (size_t)((w * 8 + k_) * 1024 + lane * 16)), (PG8_LAS unsigned*)(simg_l + (w * 8 + k_) * 1024), 16, 0, 0); \
        int tq_ = tid; asm volatile("" : "+v"(tq_)); \
        _Pragma("unroll") for (int k_ = 0; k_ < 3; ++k_) { const int idx_ = tq_ + 512 * k_, s_ = idx_ / 384, ch_ = idx_ - s_ * 384; unsigned short raw_; \
            if (mix_ == 0) raw_ = ch_ < 256 ? hbf[(rs_ + s_) * 1024 + (ch_ >> 7) * 512 + h_ * 128 + (ch_ & 127)] : outs[(rs_ + s_) * 512 + h_ * 128 + (ch_ - 256)]; \
            else raw_ = proj[(rs_ + s_) * N1 + (mix_ == 1 ? 2048 : 4096) + (ch_ >> 7) * 512 + h_ * 128 + (ch_ & 127)]; \
            stg[k_] = bf2f(raw_); } \
        if (tid < 4 && mix_ != 2) { const size_t rr_ = rs_ + tid; gn0 = gates[rr_ * 16 + (mix_ == 0 ? 0 : 8) + h_]; gn1 = gates[rr_ * 16 + (mix_ == 0 ? 4 : 12) + h_]; } \
        if (mix_ == 1) { mn_in = PIN(I_SMM)[sidx_]; if (dg == 0) nn_in = PIN(I_SMN)[sidx_ * 128 + e]; } } while (0)
    if (it0 < NIT) SMP_ISSUE(it0);
    while (it0 < NIT) {
#ifdef TPROBE_ITEM
        const unsigned long long tst_ = __builtin_amdgcn_s_memrealtime();
#endif
        const int mix = it0 / (NBS * NH), r = it0 - mix * (NBS * NH), b = r >> 2, h = r & 3;
        const size_t sidx = ((size_t)(l * NBS + b) * NH + h), rs = (size_t)MP + (size_t)b * SSEQ;
        bf16_t* outp = outs + (size_t)mix * MT * 512;
        asm volatile("s_waitcnt vmcnt(0)" ::: "memory");
        lds_barrier();
        float S[32];
#pragma unroll
        for (int i = 0; i < 32; ++i) S[i] = simg[(32 * dg + i) * 128 + e];
        float m = mn_in, nn = nn_in;
#pragma unroll
        for (int k = 0; k < 3; ++k) { const int idx = tid + 512 * k, s = idx / 384, ch = idx - s * 384; float val = stg[k];
            if (mix == 2 && ch >= 128 && ch < 256) { float lbv = 0.f; if (l > 0) { const int cc = h * 128 + (ch & 127); lbv = sigm(hl[512 + cc] - hl[cc]); } val = lbv + (1.f - lbv) * sigm(val); }
            if (ch < 256) qk[s * 256 + ch] = val; else vv[s * 128 + ch - 256] = val; }
        if (tid < 4 && mix != 2) { gs[tid * 4] = gn0; gs[tid * 4 + 1] = gn1; }
        int it2 = NIT;
        if (tid == 0) it2 = (int)__hip_atomic_fetch_add(qctr, 1u, __ATOMIC_RELAXED, __HIP_MEMORY_SCOPE_AGENT);
        lds_barrier();
        if (it1 < NIT) SMP_ISSUE(it1);
#pragma unroll 1
        for (int s = 0; s < 4; ++s) {
            const float* qs = qk + s * 256 + 32 * dg; const float* ksp = qs + 128;
            const float v = vv[s * 128 + e];
            float po = 0.f;
            if (mix == 0) {
                const float beta = gs[s * 4], a = gs[s * 4 + 1];
                float pk = 0.f;
#pragma unroll
                for (int c4 = 0; c4 < 4; ++c4) {
#pragma unroll
                    for (int i = 8 * c4; i < 8 * c4 + 8; ++i) pk += ksp[i] * S[i];
                    __builtin_amdgcn_sched_barrier(0); }
                red[((s * 2) * 4 + dg) * 128 + e] = pk;
                lds_barrier();
                const float ks = red[((s * 2) * 4 + 0) * 128 + e] + red[((s * 2) * 4 + 1) * 128 + e] + red[((s * 2) * 4 + 2) * 128 + e] + red[((s * 2) * 4 + 3) * 128 + e];
                const float u = beta * (v - a * ks);
#pragma unroll
                for (int c4 = 0; c4 < 4; ++c4) {
#pragma unroll
                    for (int i = 8 * c4; i < 8 * c4 + 8; ++i) { S[i] = a * S[i] + ksp[i] * u; po += qs[i] * S[i]; }
                    __builtin_amdgcn_sched_barrier(0); }
            } else if (mix == 1) {
                const float ig = gs[s * 4], lf = gs[s * 4 + 1]; const float mn = fmaxf(lf + m, ig); const float fp = __expf(lf + m - mn), ip = __expf(ig - mn) * QSCALE; m = mn; if (tid == 0) ((float*)(PWS + W_MT))[(rs + s) * 4 + h] = mn;
                const float iv = ip * v;
#pragma unroll
                for (int c4 = 0; c4 < 4; ++c4) {
#pragma unroll
                    for (int i = 8 * c4; i < 8 * c4 + 8; ++i) { S[i] = fp * S[i] + ksp[i] * iv; po += qs[i] * S[i]; }
                    __builtin_amdgcn_sched_barrier(0); }
                if (dg == 0) { nn = fp * nn + ip * qk[s * 256 + 128 + e]; const float dp = wave_sum(qk[s * 256 + e] * nn); if (lane == 0) dpart[s * 2 + w] = dp; }
            } else {
#pragma unroll
                for (int c4 = 0; c4 < 4; ++c4) {
#pragma unroll
                    for (int i = 8 * c4; i < 8 * c4 + 8; ++i) { S[i] = ksp[i] * (S[i] - v) + v; po += qs[i] * S[i]; }
                    __builtin_amdgcn_sched_barrier(0); }
            }
            red[((s * 2 + 1) * 4 + dg) * 128 + e] = po;
        }
        if (tid == 0) qslot[0] = it2;
        lds_barrier();
        if (tid < 128) {
#pragma unroll
            for (int s = 0; s < 4; ++s) { const float o = red[((s * 2 + 1) * 4 + 0) * 128 + e] + red[((s * 2 + 1) * 4 + 1) * 128 + e] + red[((s * 2 + 1) * 4 + 2) * 128 + e] + red[((s * 2 + 1) * 4 + 3) * 128 + e];
                outp[(rs + s) * 512 + h * 128 + e] = f2bf(o); } }
        if (mix == 1 && tid == 0) {
#pragma unroll
            for (int s = 0; s < 4; ++s) { ((float*)(PWS + W_DEN))[(rs + s) * 4 + h] = dpart[s * 2] + dpart[s * 2 + 1]; }
            POUT[O_S_MM + sidx] = m; }
        float* So = POUT + (mix == 0 ? O_S_GS : (mix == 1 ? O_S_MC : O_S_HS)) + sidx * 16384;
#ifndef DUPST
#define DUPST 1
#endif
        for (int rst = 0; rst < DUPST; ++rst) {
#pragma unroll
        for (int i = 0; i < 32; ++i) So[(size_t)(32 * dg + i) * 128 + e] = S[i];
        if (DUPST > 1) { asm volatile("s_waitcnt vmcnt(0)" ::: "memory"); } }
        if (mix == 1 && dg == 0) POUT[O_S_MN + sidx * 128 + e] = nn;
        it0 = it1; it1 = qslot[0];
        lds_barrier();
#ifdef TPROBE_ITEM
        if (blockIdx.x == TPROBE_WG && threadIdx.x == 0) { volatile unsigned long long* sp_ = (volatile unsigned long long*)((unsigned char*)sm + LDS_MAIN + 64); sp_[40] += __builtin_amdgcn_s_memrealtime() - tst_; sp_[41] += 1; }
#endif
    }
#undef SMP_ISSUE
}
__device__ __forceinline__ void phase_postnorm(const Params& p, int l) {
    int tid_ = threadIdx.x; asm volatile("" : "+v"(tid_)); const int tid = tid_, j = tid & 15;
    bf16_t* outs = (bf16_t*)(PWS + W_OUTS);
    const bf16_t* proj = (const bf16_t*)(PWS + W_PROJ);
    const float* den = (const float*)(PWS + W_DEN); const float* mt = (const float*)(PWS + W_MT);
    const int ngroups = MT * 12, half = ngroups / 2;
    for (int gid0 = bidx() * 32 + (tid >> 4); gid0 < half; gid0 += gdim() * 32) {
        u32x4_t raw[2], gr[2]; float dnv[2], mtv[2]; float4 n0[2], n1[2]; bf16_t* opp[2]; int mixk[2];
#pragma unroll
        for (int k = 0; k < 2; ++k) { const int gid = gid0 + k * half;
            const int r = gid / 12, mh = gid - r * 12, mix = mh >> 2, h = mh & 3; mixk[k] = mix;
            opp[k] = outs + (size_t)mix * MT * 512 + (size_t)r * 512 + h * 128 + 8 * j;
            raw[k] = *(const u32x4_t*)opp[k];
            const int gcol = (mix == 0 ? 1536 : (mix == 1 ? 3584 : 5632)) + h * 128 + 8 * j;
            gr[k] = *(const u32x4_t*)(proj + (size_t)r * N1 + gcol);
            dnv[k] = den[(size_t)r * 4 + h]; mtv[k] = mt[(size_t)r * 4 + h];
            const float* nw = (mix == 0 ? PIN(I_GNORM) : (mix == 1 ? PIN(I_MNORM) : PIN(I_HNORM))) + l * 512 + h * 128 + 8 * j;
            n0[k] = *(const float4*)nw; n1[k] = *(const float4*)(nw + 4); }
#pragma unroll
        for (int k = 0; k < 2; ++k) {
            float v[8];
#pragma unroll
            for (int i = 0; i < 4; ++i) { v[2 * i] = bflo(raw[k][i]); v[2 * i + 1] = bfhi(raw[k][i]); }
            if (mixk[k] == 1) { const float dn = fmaxf(fabsf(dnv[k]), __expf(-mtv[k])); const float inv = 1.f / dn;
#pragma unroll
                for (int i = 0; i < 8; ++i) v[i] *= inv; }
            float ss = 0.f;
#pragma unroll
            for (int i = 0; i < 8; ++i) ss += v[i] * v[i];
            ss = grp_sum16(ss);
            const float rstd = rsqrtf(ss * (1.f / 128.f) + EPS);
            const float nwv[8] = {n0[k].x, n0[k].y, n0[k].z, n0[k].w, n1[k].x, n1[k].y, n1[k].z, n1[k].w};
#pragma unroll
            for (int i = 0; i < 4; ++i) { v[2 * i] *= rstd * nwv[2 * i] * bflo(gr[k][i]); v[2 * i + 1] *= rstd * nwv[2 * i + 1] * bfhi(gr[k][i]); }
            u32x4_t o; o[0] = pg8::cvt_pk_bf16(v[0], v[1]); o[1] = pg8::cvt_pk_bf16(v[2], v[3]); o[2] = pg8::cvt_pk_bf16(v[4], v[5]); o[3] = pg8::cvt_pk_bf16(v[6], v[7]);
            *(u32x4_t*)opp[k] = o; }
    }
    const int ncs = (NBP + NBS) * 3 * 1536;
    for (int i = bidx() * 512 + tid; i < ncs; i += gdim() * 512) {
        const int cc = i % 1536, ri = (i / 1536) % 3, bb = i / (3 * 1536);
        if (bb < NBP) POUT[O_P_GC + ((size_t)(l * NBP + bb) * 3 + ri) * 1536 + cc] = bf2f(proj[((size_t)bb * SEQ + SEQ - 3 + ri) * N1 + cc]);
        else { const int b2 = bb - NBP; POUT[O_S_GC + ((size_t)(l * NBS + b2) * 3 + ri) * 1536 + cc] = bf2f(proj[((size_t)MP + (size_t)b2 * SSEQ + 1 + ri) * N1 + cc]); }
    }
}

__device__ __forceinline__ void phase_convffn(const Params& p, int l) {
    int tid_ = threadIdx.x; asm volatile("" : "+v"(tid_)); const int tid = tid_;
    const bf16_t* u = (const bf16_t*)(PWS + W_PROJ);
    bf16_t* act = (bf16_t*)(PWS + W_ACT);
    const float* cw = PIN(I_FCW) + (size_t)l * 3 * NUP; const float* cb = PIN(I_FCB) + (size_t)l * NUP;
    const int nitems = (MT / 4) * (DFF / 8);
    for (int it = bidx() * 512 + tid; it < nitems; it += gdim() * 512) {
        const int jg = it % (DFF / 8), rbk = it / (DFF / 8), r0 = rbk * 4, jc = jg * 8;
        const bool samp = r0 >= MP; const int tf = samp ? 0 : (r0 & (SEQ - 1));
        float wa[3][8], wb[3][8], ba[8], bb[8];
#pragma unroll
        for (int i = 0; i < 3; ++i) { const float4 a0 = *(const float4*)(cw + i * NUP + jc), a1 = *(const float4*)(cw + i * NUP + jc + 4), b0 = *(const float4*)(cw + i * NUP + DFF + jc), b1 = *(const float4*)(cw + i * NUP + DFF + jc + 4);
            wa[i][0] = a0.x; wa[i][1] = a0.y; wa[i][2] = a0.z; wa[i][3] = a0.w; wa[i][4] = a1.x; wa[i][5] = a1.y; wa[i][6] = a1.z; wa[i][7] = a1.w;
            wb[i][0] = b0.x; wb[i][1] = b0.y; wb[i][2] = b0.z; wb[i][3] = b0.w; wb[i][4] = b1.x; wb[i][5] = b1.y; wb[i][6] = b1.z; wb[i][7] = b1.w; }
        { const float4 a0 = *(const float4*)(cb + jc), a1 = *(const float4*)(cb + jc + 4), b0 = *(const float4*)(cb + DFF + jc), b1 = *(const float4*)(cb + DFF + jc + 4);
            ba[0] = a0.x; ba[1] = a0.y; ba[2] = a0.z; ba[3] = a0.w; ba[4] = a1.x; ba[5] = a1.y; ba[6] = a1.z; ba[7] = a1.w;
            bb[0] = b0.x; bb[1] = b0.y; bb[2] = b0.z; bb[3] = b0.w; bb[4] = b1.x; bb[5] = b1.y; bb[6] = b1.z; bb[7] = b1.w; }
        float xa[6][8], xb[6][8];
#pragma unroll
        for (int rr = 0; rr < 6; ++rr) {
            if (rr < 2 && tf == 0) {
                if (samp) { const float* st = PIN(I_SFC) + ((size_t)(l * NBS + (r0 - MP) / 4) * 2 + rr) * NUP;
#pragma unroll
                    for (int i = 0; i < 8; ++i) { xa[rr][i] = st[jc + i]; xb[rr][i] = st[DFF + jc + i]; } }
                else {
#pragma unroll
                    for (int i = 0; i < 8; ++i) { xa[rr][i] = 0.f; xb[rr][i] = 0.f; } }
            } else { const bf16_t* ur = u + (size_t)(r0 - 2 + rr) * NUP; const u32x4_t ra = *(const u32x4_t*)(ur + jc), rbv = *(const u32x4_t*)(ur + DFF + jc);
#pragma unroll
                for (int i = 0; i < 4; ++i) { xa[rr][2 * i] = bflo(ra[i]); xa[rr][2 * i + 1] = bfhi(ra[i]); xb[rr][2 * i] = bflo(rbv[i]); xb[rr][2 * i + 1] = bfhi(rbv[i]); } }
        }
#pragma unroll
        for (int t = 0; t < 4; ++t) { float o[8];
#pragma unroll
            for (int i = 0; i < 8; ++i) { const float ya = wa[0][i] * xa[t][i] + wa[1][i] * xa[t + 1][i] + wa[2][i] * xa[t + 2][i] + ba[i]; const float yb = wb[0][i] * xb[t][i] + wb[1][i] * xb[t + 1][i] + wb[2][i] * xb[t + 2][i] + bb[i]; o[i] = silu(ya) * yb; }
            u32x4_t ov; ov[0] = pg8::cvt_pk_bf16(o[0], o[1]); ov[1] = pg8::cvt_pk_bf16(o[2], o[3]); ov[2] = pg8::cvt_pk_bf16(o[4], o[5]); ov[3] = pg8::cvt_pk_bf16(o[6], o[7]);
            *(u32x4_t*)(act + (size_t)(r0 + t) * DFF + jc) = ov; }
        if (samp || tf == SEQ - 4) {
            float* dst = samp ? POUT + O_S_FC + (size_t)(l * NBS + (r0 - MP) / 4) * 2 * NUP : POUT + O_P_FC + (size_t)(l * NBP + r0 / SEQ) * 2 * NUP;
#pragma unroll
            for (int rr = 0; rr < 2; ++rr)
#pragma unroll
                for (int i = 0; i < 8; ++i) { dst[(size_t)rr * NUP + jc + i] = xa[4 + rr][i]; dst[(size_t)rr * NUP + DFF + jc + i] = xb[4 + rr][i]; }
        }
    }
}

__device__ __forceinline__ void phase_final_norm(const Params& p) {
    int tid_ = threadIdx.x; asm volatile("" : "+v"(tid_)); const int tid = tid_, lane = tid & 63, w = tid >> 6;
    const float* gw = PIN(I_LNF);
    float4 g4[4];
#pragma unroll
    for (int i = 0; i < 4; ++i) g4[i] = *(const float4*)(gw + lane * 4 + 256 * i);
    for (int row = bidx() * 8 + w; row < MT; row += gdim() * 8) {
        float* xr = POUT + (size_t)row * DM; float4 v[4]; float ss = 0.f;
#pragma unroll
        for (int i = 0; i < 4; ++i) { v[i] = *(const float4*)(xr + lane * 4 + 256 * i); ss += v[i].x * v[i].x + v[i].y * v[i].y + v[i].z * v[i].z + v[i].w * v[i].w; }
        ss = wave_sum(ss); const float rstd = rsqrtf(ss * (1.f / 1024.f) + EPS);
#pragma unroll
        for (int i = 0; i < 4; ++i) { v[i].x *= rstd * g4[i].x; v[i].y *= rstd * g4[i].y; v[i].z *= rstd * g4[i].z; v[i].w *= rstd * g4[i].w; *(float4*)(xr + lane * 4 + 256 * i) = v[i]; }
    }
}

#ifndef PHM
#define PHM 0xFFFF
#endif
#ifndef DUPB
#define DUPB 1
#endif
#ifndef DUPC
#define DUPC 1
#endif
#ifndef DUPS
#define DUPS 1
#endif
#ifndef DUPH
#define DUPH 1
#endif
#ifndef DUPY
#define DUPY 1
#endif
#ifndef DUPA
#define DUPA 1
#endif
#ifndef DUPI
#define DUPI 1
#endif
#define GSYNC() do { for (int y_ = 0; y_ < DUPY; ++y_) xcd_barrier(xb); } while (0)
__global__ void __launch_bounds__(512, 2) fwd_megakernel(Params p) {
    extern __shared__ __attribute__((aligned(16))) unsigned char shm[];
    cg::grid_group grid = cg::this_grid();
    float* smf = (float*)shm;
    PG8_LAS unsigned char* lds = (PG8_LAS unsigned char*)shm;
    int tid_ = threadIdx.x; asm volatile("" : "+v"(tid_)); const int tid = tid_;
    float* X = POUT;
    volatile XLAS unsigned* xst = (volatile XLAS unsigned*)(lds + LDS_MAIN);
    if (tid == 0) { xst[0] = 0u; xst[1] = 0u; xst[2] = 0u; xst[3] = 0u; }
    __syncthreads();
    XcdBarrier xb = xcd_barrier_post((unsigned*)(PWS + W_BAR), xst);
#ifdef TPROBE1
    volatile XLAS unsigned long long* stp = (volatile XLAS unsigned long long*)(lds + LDS_MAIN + 64);
    int nst = 0;
#define STAMP() do { if (blockIdx.x == TPROBE_WG && threadIdx.x == 0) stp[nst] = __builtin_amdgcn_s_memrealtime(); ++nst; } while (0)
#else
#define STAMP() do {} while (0)
#endif
    STAMP();
#ifdef TPROBE_ITEM
    if (blockIdx.x == TPROBE_WG && threadIdx.x == 0) { stp[40] = 0; stp[41] = 0; }
#endif
    bf16_t* hbf = (bf16_t*)(PWS + W_HBF);
    bf16_t* proj = (bf16_t*)(PWS + W_PROJ);

    for (int l = 0; l < 2; ++l) {
        const int G = gdim(), bid = bidx();
        for (int repa = 0; repa < DUPA; ++repa) { if (PHM & 1) { int tc = 0;
          conv_T(PIN(I_WIN) + (size_t)l * 1024 * NIN, NIN, (bf16_t*)(PWS + W_WIN), 1024, N1, true, smf, tc);
          for (int n = 0; n < 3; ++n) conv_T(PIN(I_WBR) + ((size_t)l * 3 + n) * 512 * 1024, 1024, (bf16_t*)(PWS + W_WBR) + (size_t)n * 1024 * 512, 512, 1024, false, smf, tc);
          conv_T(PIN(I_WOUT) + (size_t)l * 1024 * 1024, 1024, (bf16_t*)(PWS + W_WOUT), 1024, 1024, false, smf, tc);
          conv_T(PIN(I_WUP) + (size_t)l * 1024 * NUP, NUP, (bf16_t*)(PWS + W_WUP), 1024, NUP, false, smf, tc);
          conv_T(PIN(I_WDN) + (size_t)l * DFF * 1024, 1024, (bf16_t*)(PWS + W_WDN), DFF, 1024, false, smf, tc);
          __syncthreads(); }
        if (PHM & 2) {
        if (l == 0) { int tq_ = threadIdx.x; asm volatile("" : "+v"(tq_)); const float4* s1 = (const float4*)PIN(I_XS); float4* d1 = (float4*)(X + (size_t)MP * DM);
            for (int i = bid * 512 + tq_; i < MS * DM / 4; i += G * 512) d1[i] = s1[i]; }
        phase_rmsnorm(p, l, l == 0 ? PIN(I_XP) : X, l == 0 ? PIN(I_XS) : X + (size_t)MP * DM, PIN(I_LNMIX) + l * DM, hbf, true, smf); } }
        if (PWS == nullptr) grid.sync();
        GSYNC();
        STAMP();
        for (int rep = 0; rep < DUPB; ++rep) { pg8::Gemm g{hbf, (const bf16_t*)(PWS + W_WIN), MT, N1, 1024, 1024}; pg8::StaticOrder S; S.init(MT, N1, G, bid); EpiProj E{proj, N1, 1}; pg8::gemm_phase(lds, g, S, E); }
        GSYNC(); STAMP();
        phase_gdnprep(p, l);
        GSYNC(); STAMP();
#ifdef TPROBE_MAX
        const unsigned long long tb_ = __builtin_amdgcn_s_memrealtime();
#endif
        for (int rep = 0; rep < DUPC; ++rep) for (int it = bid; it < 256; it += G) {
            if (it < 128) scan_prompt_item<0>(p, l, (it >> 2) >> 2, (it >> 2) & 3, it & 3, smf);
            else if (it < 192) { const int q = it - 128; scan_prompt_lin<1>(p, l, (q >> 1) >> 2, (q >> 1) & 3, q & 1, smf); }
            else { const int q = it - 192; scan_prompt_lin<2>(p, l, (q >> 1) >> 2, (q >> 1) & 3, q & 1, smf); }
        }
#ifdef TPROBE_MAX
        if (l == TPROBE_MAX - 1 && threadIdx.x == 0) { const unsigned dt_ = (unsigned)(__builtin_amdgcn_s_memrealtime() - tb_); atomicMax((unsigned*)(PWS + W_BAR) + 32, (dt_ << 8) | (unsigned)blockIdx.x); if (dt_ > 40000u) atomicAdd((unsigned*)(PWS + W_BAR) + 33, 1u); if (dt_ > 30000u) atomicAdd((unsigned*)(PWS + W_BAR) + 34, 1u); if (dt_ > 20000u) atomicAdd((unsigned*)(PWS + W_BAR) + 35, 1u); }
#endif
        STAMP();
#ifdef SEQ_SAMPLE
        GSYNC();
#endif
        scan_sample_all(p, l, smf);
        GSYNC(); STAMP();
        if (PHM & 32) phase_postnorm(p, l);
        GSYNC(); STAMP();
        if (PHM & 64) { pg8::Gemm g{(const bf16_t*)(PWS + W_OUTS), (const bf16_t*)(PWS + W_WBR), 3 * MT, 3 * 1024, 512, 512};
            MergeOrder S; S.init(G, bid); EpiMerge E{proj + 6144, hbf}; pg8::gemm_phase(lds, g, S, E); }
        GSYNC(); STAMP();
        if (PHM & 128) { pg8::Gemm g{hbf, (const bf16_t*)(PWS + W_WOUT), MT, 1024, 1024, 1024}; pg8::StaticOrder S; S.init(MT, 1024, G, bid); EpiResid E{X, l == 0 ? PIN(I_XP) : X, l == 0 ? PIN(I_XS) : X + (size_t)MP * DM}; pg8::gemm_phase(lds, g, S, E); }
        GSYNC(); STAMP();
        if (PHM & 256) phase_rmsnorm(p, l, X, X + (size_t)MP * DM, PIN(I_LNFFN) + l * DM, hbf, false, smf);
        GSYNC(); STAMP();
        for (int rep = 0; rep < DUPH; ++rep) { pg8::Gemm g{hbf, (const bf16_t*)(PWS + W_WUP), MT, NUP, 1024, 1024}; pg8::StaticOrder S; S.init(MT, NUP, G, bid); EpiProj E{proj, NUP, 0}; pg8::gemm_phase(lds, g, S, E); }
        GSYNC(); STAMP();
        for (int repi = 0; repi < DUPI; ++repi) phase_convffn(p, l);
        GSYNC(); STAMP();
        if (PHM & 2048) { pg8::Gemm g{(const bf16_t*)(PWS + W_ACT), (const bf16_t*)(PWS + W_WDN), MT, 1024, DFF, DFF}; pg8::StaticOrder S; S.init(MT, 1024, G, bid); EpiResid E{X, X, X + (size_t)MP * DM}; pg8::gemm_phase(lds, g, S, E); }
        GSYNC(); STAMP();
    }
    if (PHM & 4096) phase_final_norm(p);
#ifdef TPROBE1
    if (blockIdx.x == TPROBE_WG && threadIdx.x == 0) {
        const int per = (nst - 1) / 2;
        unsigned long long d1 = 0, d2 = 0;
        for (int l2 = 0; l2 < 2; ++l2) { d1 += stp[l2 * per + TPROBE1E] - stp[l2 * per + TPROBE1]; d2 += stp[l2 * per + TPROBE2E] - stp[l2 * per + TPROBE2]; }
        unsigned long long cntcode_ = 0;
        unsigned long long q1 = (d1 + 1000) / 2000, q2 = (d2 + 500) / 1000;
#ifdef TPROBE_MAX
        { const unsigned mx_ = __hip_atomic_load((unsigned*)(PWS + W_BAR) + 32, __ATOMIC_RELAXED, __HIP_MEMORY_SCOPE_AGENT); q1 = ((mx_ >> 8) + 1000) / 2000 * 10 + (mx_ & 255) / 100; q2 = (mx_ & 255) % 100;
#ifdef TPROBE_CNT
          const unsigned c4_ = __hip_atomic_load((unsigned*)(PWS + W_BAR) + 33, __ATOMIC_RELAXED, __HIP_MEMORY_SCOPE_AGENT), c3_ = __hip_atomic_load((unsigned*)(PWS + W_BAR) + 34, __ATOMIC_RELAXED, __HIP_MEMORY_SCOPE_AGENT), c2_ = __hip_atomic_load((unsigned*)(PWS + W_BAR) + 35, __ATOMIC_RELAXED, __HIP_MEMORY_SCOPE_AGENT);
          q1 = 0; q2 = 0; cntcode_ = c4_ * 300 + c3_; (void)c2_;
#endif
 }
#endif
#ifdef TPROBE_ITEM
        q1 = stp[41] ? (stp[40] / stp[41] + 50) / 100 : 0; q2 = stp[41];
#endif if (q2 > 99) q2 = 99;
#ifndef TPROBE_MAX
        if (q1 > 99) q1 = 99;
#endif
        const unsigned long long wait = (q1 * 100 + q2) * 2000ull + cntcode_ * 200ull, t0 = __builtin_amdgcn_s_memrealtime();
        while (__builtin_amdgcn_s_memrealtime() - t0 < wait) __builtin_amdgcn_s_sleep(32);
    }
#endif
}

extern "C" void kernel_launch(void* const* d_in, const int* in_sizes, int n_in, void* d_out, int out_size, void* d_ws, size_t ws_size, hipStream_t stream) {
    static int grid_blocks = 0;
    if (grid_blocks == 0) {
        if (n_in != 28 || (size_t)out_size != O_END || ws_size < W_END) { fprintf(stderr, "kernel_launch: unexpected shapes: n_in %d out %d (want %zu) ws %zu (need %zu)\n", n_in, out_size, (size_t)O_END, ws_size, (size_t)W_END); grid_blocks = -1; return; }
        int dev = 0, cus = 0, per_cu = 0;
        hipGetDevice(&dev); hipDeviceGetAttribute(&cus, hipDeviceAttributeMultiprocessorCount, dev);
        if (hipFuncSetAttribute((const void*)fwd_megakernel, hipFuncAttributeMaxDynamicSharedMemorySize, LDS_BYTES) != hipSuccess) { fprintf(stderr, "kernel_launch: hipFuncSetAttribute failed\n"); grid_blocks = -1; return; }
        if (hipOccupancyMaxActiveBlocksPerMultiprocessor(&per_cu, (const void*)fwd_megakernel, 512, LDS_BYTES) != hipSuccess || per_cu < 1) { fprintf(stderr, "kernel_launch: occupancy query gave %d\n", per_cu); per_cu = 1; (void)hipGetLastError(); }
        grid_blocks = cus * per_cu;
    }
    if (grid_blocks < 0) return;
    if (hipMemsetAsync((unsigned char*)d_ws + W_BAR, 0, XCD_BAR_WORDS * 4, stream) != hipSuccess) { fprintf(stderr, "kernel_launch: memset of barrier words failed\n"); return; }
    Params p{};
    for (int i = 0; i < 28; ++i) p.in[i] = (const float*)d_in[i];
    p.out = (float*)d_out; p.ws = (unsigned char*)d_ws;
    void* args[] = {&p};
    hipError_t e = hipLaunchCooperativeKernel((const void*)fwd_megakernel, dim3(grid_blocks), dim3(512), args, LDS_BYTES, stream);
    if (e != hipSuccess) fprintf(stderr, "kernel_launch: cooperative launch failed: %s (grid %d)\n", hipGetErrorString(e), grid_blocks);
}
```
